# Optimizing an MI355X kernel written in HIP

```python
import math
import jax, jax.numpy as jnp
from jax import lax
import numpy as np

D_MODEL = 1024
BATCH = 4
SEQ = 8192
DEPTH = 1

GLA_HEADS = 4
GLA_DK = 64
GLA_DV = 128
GLA_GATE_RANK = 16
GLA_GATE_TAU = 16.0
GLA_CHUNK = 64
DIFF_HEADS = 4
DIFF_DK = 64
DIFF_DV = 2 * DIFF_DK
ROPE_DIM = DIFF_DK // 4
ROPE_THETA = 500000.0
Q_BLOCK = 128
MIX_WIDTH = GLA_HEADS * GLA_DV + DIFF_HEADS * DIFF_DV

IN_SPLITS = [
    GLA_HEADS * GLA_DK,
    GLA_HEADS * GLA_DK,
    GLA_HEADS * GLA_DV,
    GLA_GATE_RANK,
    GLA_HEADS * GLA_DV,
    2 * DIFF_HEADS * DIFF_DK,
    2 * DIFF_HEADS * DIFF_DK,
    DIFF_HEADS * DIFF_DV,
]
IN_WIDTH = int(sum(IN_SPLITS))
SPLIT_IDX = [int(v) for v in np.cumsum(IN_SPLITS)[:-1]]

PEER_HEADS = 8
PEER_NKEYS = 128
PEER_EXPERTS = PEER_NKEYS * PEER_NKEYS
PEER_QDIM = 256
PEER_TOPK = 16
PEER_TOKEN_BLOCK = 128

RMS_EPS = 1e-6

kernel_name = "hymba_gla_diffattn_peer_block"


def rms_norm(x, g):
    xf = x.astype(jnp.float32)
    y = xf * lax.rsqrt(jnp.mean(xf * xf, axis=-1, keepdims=True) + RMS_EPS)
    return (y * g.astype(jnp.float32)).astype(x.dtype)


def rope_tables(positions):
    inv_freq = ROPE_THETA ** (-jnp.arange(0, ROPE_DIM, 2, dtype=jnp.float32) / ROPE_DIM)
    ang = positions.astype(jnp.float32)[..., None] * inv_freq
    return jnp.cos(ang), jnp.sin(ang)


def partial_rope(t, cos, sin):
    half = ROPE_DIM // 2
    x1 = t[..., :half].astype(jnp.float32)
    x2 = t[..., half:ROPE_DIM].astype(jnp.float32)
    rot = jnp.concatenate([x1 * cos - x2 * sin, x2 * cos + x1 * sin], axis=-1).astype(t.dtype)
    return jnp.concatenate([rot, t[..., ROPE_DIM:]], axis=-1)


def gla_chunked(q, k, v, log_a):
    B, H, S, dk = q.shape
    dv = v.shape[-1]
    n = S // GLA_CHUNK
    f32 = jnp.float32
    q = q.astype(f32).reshape(B, H, n, GLA_CHUNK, dk)
    k = k.astype(f32).reshape(B, H, n, GLA_CHUNK, dk)
    v = v.astype(f32).reshape(B, H, n, GLA_CHUNK, dv)
    b = jnp.cumsum(log_a.astype(f32).reshape(B, H, n, GLA_CHUNK, dk), axis=-2)
    b_end = b[..., -1:, :]
    q_t = q * jnp.exp(b)
    k_t = k * jnp.exp(-b)
    causal = jnp.tril(jnp.ones((GLA_CHUNK, GLA_CHUNK), dtype=bool))
    att = jnp.where(causal, jnp.einsum('bhncd,bhnsd->bhncs', q_t, k_t), 0.0)
    o_intra = jnp.einsum('bhncs,bhnsv->bhncv', att, v)
    chunk_kv = jnp.einsum('bhncd,bhncv->bhndv', k * jnp.exp(b_end - b), v)
    decay_end = jnp.exp(b_end[..., 0, :])

    def step(state, inp):
        dec, kv = inp
        return dec[..., None] * state + kv, state

    init = jnp.zeros((B, H, dk, dv), f32)
    _, states = lax.scan(step, init, (jnp.moveaxis(decay_end, 2, 0), jnp.moveaxis(chunk_kv, 2, 0)))
    states = jnp.moveaxis(states, 0, 2)
    o_inter = jnp.einsum('bhncd,bhndv->bhncv', q_t, states)
    return (o_intra + o_inter).reshape(B, H, S, dv)


def gla_mixer(gq, gk, gv, ga, gr, w_gate, b_gate, g_out):
    B, S, _ = gq.shape
    to_heads = lambda t, d: t.reshape(B, S, GLA_HEADS, d).transpose(0, 2, 1, 3)
    q = to_heads(gq, GLA_DK) * (GLA_DK ** -0.5)
    k = to_heads(gk, GLA_DK)
    v = to_heads(gv, GLA_DV)
    log_a = jax.nn.log_sigmoid((ga @ w_gate + b_gate).astype(jnp.float32)) / GLA_GATE_TAU
    log_a = to_heads(log_a, GLA_DK)
    o = gla_chunked(q, k, v, log_a).astype(gv.dtype)
    o = rms_norm(o, g_out).transpose(0, 2, 1, 3).reshape(B, S, GLA_HEADS * GLA_DV)
    return o * jax.nn.silu(gr)


def diff_mixer(dq, dk, dv, cos, sin, g_q, g_k, lq1, lk1, lq2, lk2, g_sub, lambda_init):
    B, S, _ = dq.shape
    q = dq.reshape(B, S, DIFF_HEADS, 2, DIFF_DK).transpose(0, 2, 3, 1, 4)
    k = dk.reshape(B, S, DIFF_HEADS, 2, DIFF_DK).transpose(0, 2, 3, 1, 4)
    v = dv.reshape(B, S, DIFF_HEADS, DIFF_DV).transpose(0, 2, 1, 3)
    c = cos[:, None, None]
    s_ = sin[:, None, None]
    q = partial_rope(rms_norm(q, g_q), c, s_)
    k = partial_rope(rms_norm(k, g_k), c, s_)
    lam = (jnp.exp(jnp.sum(lq1.astype(jnp.float32) * lk1.astype(jnp.float32)))
           - jnp.exp(jnp.sum(lq2.astype(jnp.float32) * lk2.astype(jnp.float32))) + lambda_init)
    scale = DIFF_DK ** -0.5
    nb = S // Q_BLOCK
    qb = jnp.moveaxis(q.reshape(B, DIFF_HEADS, 2, nb, Q_BLOCK, DIFF_DK), 3, 0)
    kidx = jnp.arange(S)

    def block(args):
        qblk, i = args
        sc = jnp.einsum('bhmqd,bhmkd->bhmqk', qblk, k).astype(jnp.float32) * scale
        qidx = i * Q_BLOCK + jnp.arange(Q_BLOCK)
        sc = jnp.where(kidx[None, :] <= qidx[:, None], sc, -jnp.inf)
        p = jax.nn.softmax(sc, axis=-1)
        a = p[:, :, 0] - lam * p[:, :, 1]
        return jnp.einsum('bhqk,bhkv->bhqv', a.astype(v.dtype), v)

    o = lax.map(block, (qb, jnp.arange(nb)))
    o = jnp.moveaxis(o, 0, 2).reshape(B, DIFF_HEADS, S, DIFF_DV)
    o = rms_norm(o, g_sub) * (1.0 - lambda_init)
    return o.transpose(0, 2, 1, 3).reshape(B, S, DIFF_HEADS * DIFF_DV)


def peer_mixer(x2, w_q, sub_keys, u, v):
    B, S, D = x2.shape
    T = B * S
    xt = x2.reshape(T, D)
    q = (xt @ w_q).reshape(T, PEER_HEADS, 2, PEER_QDIM // 2)
    s = jnp.einsum('thpd,hpkd->thpk', q, sub_keys).astype(jnp.float32)
    s_top, i_top = lax.top_k(s, PEER_TOPK)
    cand_s = (s_top[:, :, 0, :, None] + s_top[:, :, 1, None, :]).reshape(T, PEER_HEADS, PEER_TOPK * PEER_TOPK)
    cand_i = (i_top[:, :, 0, :, None] * PEER_NKEYS + i_top[:, :, 1, None, :]).reshape(T, PEER_HEADS, PEER_TOPK * PEER_TOPK)
    best_s, best_pos = lax.top_k(cand_s, PEER_TOPK)
    idx = jnp.take_along_axis(cand_i, best_pos, axis=-1)
    g = jax.nn.softmax(best_s, axis=-1).astype(x2.dtype)
    nblk = T // PEER_TOKEN_BLOCK
    E = PEER_HEADS * PEER_TOPK
    xb = xt.reshape(nblk, PEER_TOKEN_BLOCK, D)
    ib = idx.reshape(nblk, PEER_TOKEN_BLOCK, E)
    gb = g.reshape(nblk, PEER_TOKEN_BLOCK, E)

    def block(args):
        xc, ic, gc = args
        h = jnp.einsum('td,ted->te', xc, jnp.take(u, ic, axis=0))
        a = jax.nn.gelu(h, approximate=False) * gc
        return jnp.einsum('te,ted->td', a, jnp.take(v, ic, axis=0))

    return lax.map(block, (xb, ib, gb)).reshape(B, S, D)


def setup_inputs(seed: int = 0) -> dict:
    key = jax.random.key(seed)
    ks = jax.random.split(key, 24)
    f32 = jnp.float32
    L, D = DEPTH, D_MODEL
    nrm = lambda k, shape, sc: jax.random.normal(k, shape, f32) * sc
    x = jax.random.normal(ks[0], (BATCH, SEQ, D), f32)
    offsets = jax.random.randint(ks[1], (BATCH, 1), 0, 4096, dtype=jnp.int32)
    positions = (jnp.arange(SEQ, dtype=jnp.int32)[None, :] + offsets).astype(jnp.int32)
    return {
        "x": x,
        "positions": positions,
        "g_mix": 1.0 + nrm(ks[2], (L, D), 0.1),
        "w_in": nrm(ks[3], (L, D, IN_WIDTH), D ** -0.5),
        "w_gla_gate": nrm(ks[4], (L, GLA_GATE_RANK, GLA_HEADS * GLA_DK), GLA_GATE_RANK ** -0.5),
        "b_gla_gate": nrm(ks[5], (L, GLA_HEADS * GLA_DK), 0.1),
        "g_gla_out": 1.0 + nrm(ks[6], (L, GLA_DV), 0.1),
        "g_q": 1.0 + nrm(ks[7], (L, DIFF_DK), 0.1),
        "g_k": 1.0 + nrm(ks[8], (L, DIFF_DK), 0.1),
        "lambda_q1": nrm(ks[9], (L, DIFF_DK), 0.1),
        "lambda_k1": nrm(ks[10], (L, DIFF_DK), 0.1),
        "lambda_q2": nrm(ks[11], (L, DIFF_DK), 0.1),
        "lambda_k2": nrm(ks[12], (L, DIFF_DK), 0.1),
        "g_diff_sub": 1.0 + nrm(ks[13], (L, DIFF_DV), 0.1),
        "w_out": nrm(ks[14], (L, MIX_WIDTH, D), MIX_WIDTH ** -0.5),
        "g_ffn": 1.0 + nrm(ks[15], (L, D), 0.1),
        "w_peer_q": nrm(ks[16], (L, D, PEER_HEADS * PEER_QDIM), D ** -0.5),
        "peer_sub_keys": nrm(ks[17], (L, PEER_HEADS, 2, PEER_NKEYS, PEER_QDIM // 2), (PEER_QDIM // 2) ** -0.5),
        "peer_u": nrm(ks[18], (L, PEER_EXPERTS, D), D ** -0.5),
        "peer_v": nrm(ks[19], (L, PEER_EXPERTS, D), 0.5),
    }


def reference(x, positions, g_mix, w_in, w_gla_gate, b_gla_gate, g_gla_out, g_q, g_k,
              lambda_q1, lambda_k1, lambda_q2, lambda_k2, g_diff_sub, w_out, g_ffn,
              w_peer_q, peer_sub_keys, peer_u, peer_v):
    cos, sin = rope_tables(positions)
    h = x
    for l in range(DEPTH):
        lambda_init = 0.8 - 0.6 * math.exp(-0.3 * l)
        xn = rms_norm(h, g_mix[l])
        proj = xn @ w_in[l]
        gq, gk, gv, ga, gr, dq, dk, dv = jnp.split(proj, SPLIT_IDX, axis=-1)
        o_gla = gla_mixer(gq, gk, gv, ga, gr, w_gla_gate[l], b_gla_gate[l], g_gla_out[l])
        o_diff = diff_mixer(dq, dk, dv, cos, sin, g_q[l], g_k[l], lambda_q1[l], lambda_k1[l],
                            lambda_q2[l], lambda_k2[l], g_diff_sub[l], lambda_init)
        h = h + jnp.concatenate([o_gla, o_diff], axis=-1) @ w_out[l]
        h = h + peer_mixer(rms_norm(h, g_ffn[l]), w_peer_q[l], peer_sub_keys[l], peer_u[l], peer_v[l])
    return h
```

```cpp
#include <hip/hip_runtime.h>
#include <hip/hip_bf16.h>
#include <cstdio>
#include <cstdint>
#include <cmath>
#define MK_N_LAUNCHES 1
namespace pg8 {
#define PG8_LAS __attribute__((address_space(3)))
typedef unsigned short bf16_t;
typedef short bf16x8 __attribute__((ext_vector_type(8)));
typedef float f32x4 __attribute__((ext_vector_type(4)));
typedef unsigned u32x4 __attribute__((ext_vector_type(4)));
constexpr int BM = 256, BK = 64, HALF = 128, HTB = HALF * BK * 2  , STAGE_BYTES = 8 * HTB, NXCD = 8, WGM = 8;

__host__ __device__ __forceinline__ int lds_byte(int r, int c) { const int st = (r >> 4) * 2 + (c >> 5), rr = r & 15, cc = c & 31, ob = rr * 64 + cc * 2; return st * 1024 + (ob ^ (((ob >> 9) & 1) << 5)); }
__host__ __device__ __forceinline__ void stage_rc(int b, int& R, int& C) { const int st = b / 1024, sb = b % 1024, swz = sb ^ (((sb >> 9) & 1) << 5); R = (st >> 1) * 16 + swz / 64; C = (st & 1) * 32 + (swz % 64) / 2; }
__host__ __device__ __forceinline__ int perm32(int rho) { const int n = rho >> 4, i = rho & 15; return 8 * (i >> 2) + 4 * n + (i & 3); }

struct Unit { int pm, pn; };
struct Gemm { const bf16_t* A; const bf16_t* Bt; int M, N, K; };

struct StaticOrder {
    int nM, nN, nwg, G, c;
    __host__ __device__ void init(int M, int N, int G_, int c_) { nM = M / BM; nN = N / BM; nwg = nM * nN; G = G_; c = c_; }
    __host__ __device__ bool next(int i, Unit& u) const {
        const long L = (long)i * G + c; if (L >= nwg) return false;
        int wgid = (int)L; { const int q = nwg / NXCD, r = nwg % NXCD, xcd = wgid % NXCD, off = wgid / NXCD; wgid = (xcd < r ? xcd * (q + 1) : r * (q + 1) + (xcd - r) * q) + off; }
        const int nig = WGM * nN, gid = wgid / nig, fm = gid * WGM, gsz = (nM - fm) < WGM ? (nM - fm) : WGM;
        u.pm = fm + ((wgid % nig) % gsz); u.pn = (wgid % nig) / gsz; return true;
    }
    __device__ __forceinline__ void a_ready(const Unit&) const {}
    __device__ __forceinline__ void done(const Unit&) const {}
};

__device__ __forceinline__ unsigned cvt_pk_bf16(float lo, float hi) { unsigned r; asm volatile("v_cvt_pk_bf16_f32 %0, %1, %2" : "=v"(r) : "v"(lo), "v"(hi)); return r; }
typedef float f32x2 __attribute__((ext_vector_type(2)));
__device__ __forceinline__ f32x2 gelu_pk(f32x2 v) {
    const f32x2 av = __builtin_elementwise_abs(v), d = av * 0.2316418882f + 1.0f;
    f32x2 t; t.x = __builtin_amdgcn_rcpf(d.x); t.y = __builtin_amdgcn_rcpf(d.y);
    f32x2 q = t * 0.5307027145f + (-0.7265760135f); q = q * t + 0.7107068705f; q = q * t + (-0.142248368f); q = q * t + 0.127414796f; q = q * t;
    const f32x2 s = (v * v) * (-0.72134752044f);
    f32x2 e; e.x = __builtin_amdgcn_exp2f(s.x); e.y = __builtin_amdgcn_exp2f(s.y);
    const f32x2 m = v * (q * e), r = v - m;
    f32x2 o; o.x = v.x < 0.f ? m.x : r.x; o.y = v.y < 0.f ? m.y : r.y; return o;
}

template <int ACT  > struct EpiBf16 {
    static constexpr bool PERM = true, AFTER_DRAIN = false; static_assert(ACT == 0 || ACT == 1, "EpiBf16: ACT is 0 (none) or 1 (gelu_pk)");
    bf16_t* O; int ldc; const float* bias; int split_cols; size_t split_stride; float scale0;
    __device__ __forceinline__ void operator()(const f32x4 (&acc)[2][2][4][2], const Unit& u, int wr, int wc, int fr, int fq) const {
        const int row0 = u.pm * BM + wr * 64 + fr; int colt = u.pn * BM; bf16_t* base = O;
        float sc = 1.f; if (split_cols) { const int t = colt / split_cols; base += (size_t)t * split_stride; colt -= t * split_cols; if (t == 0) sc = scale0; }
        const int col0 = colt + wc * 32 + 8 * fq, bcol0 = u.pn * BM + wc * 32 + 8 * fq;
        f32x4 bv[2][2];
#pragma unroll
        for (int bj = 0; bj < 2; ++bj)
#pragma unroll
            for (int n = 0; n < 2; ++n) bv[bj][n] = bias ? *(const f32x4*)(bias + bcol0 + bj * HALF + 4 * n) : (f32x4){0.f, 0.f, 0.f, 0.f};
#pragma unroll
        for (int ai = 0; ai < 2; ++ai)
#pragma unroll
            for (int m = 0; m < 4; ++m) { bf16_t* rowp = base + (size_t)(row0 + ai * HALF + m * 16) * ldc + col0;
#pragma unroll
                for (int bj = 0; bj < 2; ++bj) { f32x4 v0 = acc[ai][bj][m][0] + bv[bj][0], v1 = acc[ai][bj][m][1] + bv[bj][1];
                    if (ACT == 1) { f32x2 a = gelu_pk((f32x2){v0[0], v0[1]}), b = gelu_pk((f32x2){v0[2], v0[3]}), c = gelu_pk((f32x2){v1[0], v1[1]}), d = gelu_pk((f32x2){v1[2], v1[3]});
                        v0 = (f32x4){a.x, a.y, b.x, b.y}; v1 = (f32x4){c.x, c.y, d.x, d.y}; }
                    v0 = v0 * sc; v1 = v1 * sc; u32x4 w; w.x = cvt_pk_bf16(v0[0], v0[1]); w.y = cvt_pk_bf16(v0[2], v0[3]); w.z = cvt_pk_bf16(v1[0], v1[1]); w.w = cvt_pk_bf16(v1[2], v1[3]);
                    *(u32x4*)(rowp + bj * HALF) = w; } }
    }
};
struct EpiResF32 {
    static constexpr bool PERM = true, AFTER_DRAIN = false;
    const float* X; float* O; int ldc;
    __device__ __forceinline__ void operator()(const f32x4 (&acc)[2][2][4][2], const Unit& u, int wr, int wc, int fr, int fq) const {
        const int row0 = u.pm * BM + wr * 64 + fr, col0 = u.pn * BM + wc * 32 + 8 * fq;
#pragma unroll
        for (int ai = 0; ai < 2; ++ai)
#pragma unroll
            for (int m = 0; m < 4; ++m) { const size_t ro = (size_t)(row0 + ai * HALF + m * 16) * ldc + col0;
#pragma unroll
                for (int bj = 0; bj < 2; ++bj) { const size_t off = ro + bj * HALF;
                    const f32x4 x0 = *(const f32x4*)(X + off), x1 = *(const f32x4*)(X + off + 4);
                    *(f32x4*)(O + off) = x0 + acc[ai][bj][m][0]; *(f32x4*)(O + off + 4) = x1 + acc[ai][bj][m][1]; } }
    }
};
struct EpiResF32X {
    static constexpr bool PERM = true, AFTER_DRAIN = false;
    const float* X; int ldc; bf16_t* HB; unsigned char* X8; float* SSP; int tok;
    static __device__ __forceinline__ unsigned pk8(float a, float b, float c, float d) { int w = __builtin_amdgcn_cvt_pk_fp8_f32(a, b, 0, false); w = __builtin_amdgcn_cvt_pk_fp8_f32(c, d, w, true); return (unsigned)w; }
    __device__ __forceinline__ void operator()(const f32x4 (&acc)[2][2][4][2], const Unit& u, int wr, int wc, int fr, int fq) const {
        const int row0 = u.pm * BM + wr * 64 + fr, col0 = u.pn * BM + wc * 32 + 8 * fq;
#pragma unroll
        for (int ai = 0; ai < 2; ++ai) {
            f32x4 xv[4][2][2];
#pragma unroll
            for (int m = 0; m < 4; ++m)
#pragma unroll
                for (int bj = 0; bj < 2; ++bj) { const size_t off = (size_t)(row0 + ai * HALF + m * 16) * ldc + col0 + bj * HALF; xv[m][bj][0] = *(const f32x4*)(X + off); xv[m][bj][1] = *(const f32x4*)(X + off + 4); }
#pragma unroll
            for (int m = 0; m < 4; ++m) { const int row = row0 + ai * HALF + m * 16; const size_t ro = (size_t)row * ldc + col0; float ss = 0.f;
#pragma unroll
                for (int bj = 0; bj < 2; ++bj) { const size_t off = ro + bj * HALF;
                    const f32x4 h0 = xv[m][bj][0] + acc[ai][bj][m][0], h1 = xv[m][bj][1] + acc[ai][bj][m][1];
                    ss += (h0.x * h0.x + h0.y * h0.y) + (h0.z * h0.z + h0.w * h0.w) + (h1.x * h1.x + h1.y * h1.y) + (h1.z * h1.z + h1.w * h1.w);
                    u32x4 w; w.x = cvt_pk_bf16(h0.x, h0.y); w.y = cvt_pk_bf16(h0.z, h0.w); w.z = cvt_pk_bf16(h1.x, h1.y); w.w = cvt_pk_bf16(h1.z, h1.w);
                    *(u32x4*)(HB + off) = w;
                    typedef unsigned u32x2 __attribute__((ext_vector_type(2)));
                    const u32x2 q = {pk8(h0.x, h0.y, h0.z, h0.w), pk8(h1.x, h1.y, h1.z, h1.w)};
                    *(u32x2*)(X8 + ((size_t)((col0 + bj * HALF) >> 3) * tok + row) * 8) = q; }
                ss += __shfl_xor(ss, 16); ss += __shfl_xor(ss, 32);
                if (fq == 0) SSP[(size_t)row * 16 + u.pn * 4 + wc] = ss; } }
    }
};
struct EpiBf16Row {
    static constexpr bool PERM = true, AFTER_DRAIN = false;
    bf16_t* O; int ldc; const float* SSP; float* RSTD; float eps, inv_n;
    __device__ __forceinline__ void operator()(const f32x4 (&acc)[2][2][4][2], const Unit& u, int wr, int wc, int fr, int fq) const {
        const int row0 = u.pm * BM + wr * 64 + fr, col0 = u.pn * BM + wc * 32 + 8 * fq;
#pragma unroll
        for (int ai = 0; ai < 2; ++ai) {
            float rs[4];
#pragma unroll
            for (int m = 0; m < 4; ++m) { const f32x4* sp = (const f32x4*)(SSP + (size_t)(row0 + ai * HALF + m * 16) * 16);
                const f32x4 s4 = (sp[0] + sp[1]) + (sp[2] + sp[3]); rs[m] = 1.f / sqrtf(((s4.x + s4.y) + (s4.z + s4.w)) * inv_n + eps); }
#pragma unroll
            for (int m = 0; m < 4; ++m) { const int row = row0 + ai * HALF + m * 16; bf16_t* rowp = O + (size_t)row * ldc + col0;
                const float rstd = rs[m];
                if (u.pn == 0 && wc == 0 && fq == 0) RSTD[row] = rstd;
#pragma unroll
                for (int bj = 0; bj < 2; ++bj) { const f32x4 v0 = acc[ai][bj][m][0] * rstd, v1 = acc[ai][bj][m][1] * rstd;
                    u32x4 w; w.x = cvt_pk_bf16(v0[0], v0[1]); w.y = cvt_pk_bf16(v0[2], v0[3]); w.z = cvt_pk_bf16(v1[0], v1[1]); w.w = cvt_pk_bf16(v1[2], v1[3]);
                    *(u32x4*)(rowp + bj * HALF) = w; } } }
    }
};
template <class Epi, class Sched, bool ALIGN_EPI = false, bool SP2 = false>
__device__ __forceinline__ void gemm_phase(PG8_LAS unsigned char* lds, const Gemm g, const Sched& S, const Epi& E) {
    const int tid = threadIdx.x, wid = __builtin_amdgcn_readfirstlane(tid >> 6), lane = tid & 63, wr = wid >> 2, wc = wid & 3, fr = lane & 15, fq = lane >> 4;
    const int K = g.K, nt = K / BK;
    unsigned voffA[2], voffB[2];
#pragma unroll
    for (int i = 0; i < 2; ++i) { int R, C; stage_rc(tid * 16 + i * 8192, R, C); const int Rb = Epi::PERM ? ((R & ~31) + perm32(R & 31)) : R;
        voffA[i] = (unsigned)(R * K + C) * 2u; voffB[i] = (unsigned)(Rb * K + C) * 2u; }
    const size_t kstep = (size_t)(BK * 2);
    const size_t hstep = (size_t)HALF * K * 2;
    const size_t tstep = 2 * hstep;
    const unsigned ldsw = (unsigned)wid * 1024u;
    const int aoff = lds_byte(wr * 64 + fr, fq * 8), boff = lds_byte(wc * 32 + fr, fq * 8);
#define PG8_SA(b, h) (((b) * 2 + (h)) * HTB)
#define PG8_SB(b, h) ((4 + (b) * 2 + (h)) * HTB)
#define PG8_STAGE(bufoff, gbase, voff) do { _Pragma("unroll") for (int _i = 0; _i < 2; ++_i) \
        __builtin_amdgcn_global_load_lds((const unsigned*)((const char*)(gbase) + (voff)[_i]), (PG8_LAS unsigned*)(lds + (bufoff) + ldsw + _i * 8192), 16, 0, 0); } while (0)
#define PG8_LDA(dst, b, h) do { _Pragma("unroll") for (int m = 0; m < 4; ++m) _Pragma("unroll") for (int k = 0; k < 2; ++k) dst[m][k] = *(const PG8_LAS bf16x8*)(lds + PG8_SA(b, h) + aoff + m * 2048 + k * 1024); } while (0)
#define PG8_LDB(dst, b, h) do { _Pragma("unroll") for (int n = 0; n < 2; ++n) _Pragma("unroll") for (int k = 0; k < 2; ++k) dst[n][k] = *(const PG8_LAS bf16x8*)(lds + PG8_SB(b, h) + boff + n * 2048 + k * 1024); } while (0)
#define PG8_MMA(ai, bj, At, Bt) do { __builtin_amdgcn_s_setprio(1); _Pragma("unroll") for (int m = 0; m < 4; ++m) _Pragma("unroll") for (int n = 0; n < 2; ++n) _Pragma("unroll") for (int k = 0; k < 2; ++k) \
        acc[ai][bj][m][n] = __builtin_amdgcn_mfma_f32_16x16x32_bf16(Bt[n][k], At[m][k], acc[ai][bj][m][n], 0, 0, 0); __builtin_amdgcn_s_setprio(0); } while (0)
#define PG8_WAIT_V(n) asm volatile("s_waitcnt vmcnt(" #n ")" ::: "memory")
#define PG8_WAIT_L(n) asm volatile("s_waitcnt lgkmcnt(" #n ")" ::: "memory")
#define PG8_BAR __builtin_amdgcn_s_barrier()
#define PG8_SCHED __builtin_amdgcn_sched_barrier(0)
    Unit cur, nxt; int ui = 0;
    if (!S.next(0, cur)) return;
    f32x4 acc[2][2][4][2];
#pragma unroll
    for (int a = 0; a < 2; ++a)
#pragma unroll
        for (int b = 0; b < 2; ++b)
#pragma unroll
            for (int m = 0; m < 4; ++m)
#pragma unroll
                for (int n = 0; n < 2; ++n) acc[a][b][m][n] = (f32x4){0.f, 0.f, 0.f, 0.f};
    bf16x8 At[4][2], B0[2][2], B1[2][2];
    const char* cA = (const char*)g.A + (size_t)cur.pm * tstep; const char* cB = (const char*)g.Bt + (size_t)cur.pn * tstep;
    S.a_ready(cur);
    if constexpr (SP2) {
        PG8_STAGE(PG8_SB(0, 0), cB, voffB); PG8_STAGE(PG8_SB(0, 1), cB + hstep, voffB); PG8_STAGE(PG8_SA(0, 0), cA, voffA); PG8_STAGE(PG8_SA(0, 1), cA + hstep, voffA);
        if (wr == 1) PG8_BAR;
        PG8_WAIT_V(2); PG8_BAR;
        PG8_STAGE(PG8_SB(1, 0), cB + kstep, voffB); PG8_STAGE(PG8_SA(1, 0), cA + kstep, voffA); PG8_STAGE(PG8_SB(1, 1), cB + hstep + kstep, voffB);
        PG8_WAIT_V(6); PG8_BAR;
    } else {
        PG8_STAGE(PG8_SB(0, 0), cB, voffB); PG8_STAGE(PG8_SA(0, 0), cA, voffA); PG8_STAGE(PG8_SB(0, 1), cB + hstep, voffB); PG8_STAGE(PG8_SA(0, 1), cA + hstep, voffA);
        if (wr == 1) PG8_BAR;
        PG8_WAIT_V(4); PG8_BAR;
        PG8_STAGE(PG8_SB(1, 0), cB + kstep, voffB); PG8_STAGE(PG8_SA(1, 0), cA + kstep, voffA); PG8_STAGE(PG8_SB(1, 1), cB + hstep + kstep, voffB);
        PG8_WAIT_V(6); PG8_BAR;
    }
    for (;;) {
        const bool has_next = S.next(ui + 1, nxt);
        const char* nA = has_next ? (const char*)g.A + (size_t)nxt.pm * tstep : cA; const char* nB = has_next ? (const char*)g.Bt + (size_t)nxt.pn * tstep : cB;
        for (int t = 0; t < nt; t += 2) {
            const bool last = (t == nt - 2);
            const char* a1 = cA + (size_t)(t + 1) * kstep;
            const char* a2 = last ? nA : cA + (size_t)(t + 2) * kstep; const char* b2 = last ? nB : cB + (size_t)(t + 2) * kstep;
            const char* a3 = a2 + kstep; const char* b3 = b2 + kstep;
            if (last && has_next) S.a_ready(nxt);
            if constexpr (SP2) {
            PG8_LDB(B0, 0, 0); PG8_LDB(B1, 0, 1); PG8_SCHED; PG8_LDA(At, 0, 0); PG8_STAGE(PG8_SA(1, 1), a1 + hstep, voffA);
            PG8_WAIT_V(8); PG8_WAIT_L(0); PG8_BAR; PG8_MMA(0, 0, At, B0); PG8_MMA(0, 1, At, B1); PG8_BAR; PG8_SCHED;
            PG8_LDA(At, 0, 1); PG8_STAGE(PG8_SB(0, 0), b2, voffB); PG8_STAGE(PG8_SB(0, 1), b2 + hstep, voffB); PG8_STAGE(PG8_SA(0, 0), a2, voffA);
            PG8_WAIT_V(8); PG8_WAIT_L(0); PG8_BAR; PG8_MMA(1, 0, At, B0); PG8_MMA(1, 1, At, B1); PG8_BAR; PG8_SCHED;
            PG8_LDB(B0, 1, 0); PG8_LDB(B1, 1, 1); PG8_SCHED; PG8_LDA(At, 1, 0); PG8_STAGE(PG8_SA(0, 1), a2 + hstep, voffA);
            PG8_WAIT_V(8); PG8_WAIT_L(0); PG8_BAR; PG8_MMA(0, 0, At, B0); PG8_MMA(0, 1, At, B1); PG8_BAR; PG8_SCHED;
            PG8_LDA(At, 1, 1); PG8_STAGE(PG8_SB(1, 0), b3, voffB); PG8_STAGE(PG8_SB(1, 1), b3 + hstep, voffB); PG8_STAGE(PG8_SA(1, 0), a3, voffA);
            PG8_WAIT_V(8); PG8_WAIT_L(0); PG8_BAR; PG8_MMA(1, 0, At, B0); PG8_MMA(1, 1, At, B1); PG8_BAR; PG8_SCHED;
            } else {
            PG8_LDB(B0, 0, 0); PG8_SCHED; PG8_LDA(At, 0, 0); PG8_STAGE(PG8_SA(1, 1), a1 + hstep, voffA);
            PG8_WAIT_L(8); PG8_BAR; PG8_WAIT_L(0); PG8_MMA(0, 0, At, B0); PG8_BAR; PG8_SCHED;
            PG8_LDB(B1, 0, 1); PG8_STAGE(PG8_SB(0, 0), b2, voffB);
            PG8_BAR; PG8_WAIT_L(0); PG8_MMA(0, 1, At, B1); PG8_BAR;
            PG8_LDA(At, 0, 1); PG8_STAGE(PG8_SA(0, 0), a2, voffA);
            PG8_BAR; PG8_WAIT_L(0); PG8_MMA(1, 0, At, B0); PG8_BAR; PG8_SCHED;
            PG8_STAGE(PG8_SB(0, 1), b2 + hstep, voffB);
            PG8_WAIT_V(6); PG8_BAR; PG8_MMA(1, 1, At, B1); PG8_BAR;
            PG8_LDB(B0, 1, 0); PG8_SCHED; PG8_LDA(At, 1, 0); PG8_STAGE(PG8_SA(0, 1), a2 + hstep, voffA);
            PG8_WAIT_L(8); PG8_BAR; PG8_WAIT_L(0); PG8_MMA(0, 0, At, B0); PG8_BAR; PG8_SCHED;
            PG8_LDB(B1, 1, 1); PG8_STAGE(PG8_SB(1, 0), b3, voffB);
            PG8_BAR; PG8_WAIT_L(0); PG8_MMA(0, 1, At, B1); PG8_BAR;
            PG8_LDA(At, 1, 1); PG8_STAGE(PG8_SA(1, 0), a3, voffA);
            PG8_BAR; PG8_WAIT_L(0); PG8_MMA(1, 0, At, B0); PG8_BAR; PG8_SCHED;
            PG8_STAGE(PG8_SB(1, 1), b3 + hstep, voffB);
            PG8_WAIT_V(6); PG8_BAR; PG8_MMA(1, 1, At, B1); PG8_BAR;
            }
        }
        if constexpr (ALIGN_EPI) { if (wr == 0) PG8_BAR; }
        if constexpr (!Epi::AFTER_DRAIN) { E(acc, cur, wr, wc, fr, fq); S.done(cur); }
        if (!has_next) break;
#pragma unroll
        for (int a = 0; a < 2; ++a)
#pragma unroll
            for (int b = 0; b < 2; ++b)
#pragma unroll
                for (int m = 0; m < 4; ++m)
#pragma unroll
                    for (int n = 0; n < 2; ++n) acc[a][b][m][n] = (f32x4){0.f, 0.f, 0.f, 0.f};
        cur = nxt; cA = nA; cB = nB; ++ui;
        if constexpr (ALIGN_EPI) { if (wr == 1) PG8_BAR; }
    }
    PG8_WAIT_V(0);
    if constexpr (!ALIGN_EPI) { if (wr == 0) PG8_BAR; }
    PG8_BAR;
    if constexpr (Epi::AFTER_DRAIN) { E.fused(acc, cur, wr, wc, fr, fq, lds, wid, lane); S.done(cur); }
#undef PG8_SA
#undef PG8_SB
#undef PG8_STAGE
#undef PG8_LDA
#undef PG8_LDB
#undef PG8_MMA
#undef PG8_WAIT_V
#undef PG8_WAIT_L
#undef PG8_BAR
#undef PG8_SCHED
}
}

#ifndef PG8_SP2
#define PG8_SP2 true
#endif
#ifndef PG8_ALIGN
#define PG8_ALIGN true
#endif
#include <hip/hip_bf16.h>
#include <cmath>
namespace attn_body {
using bf16=__hip_bfloat16;
using bf16x8=__attribute__((ext_vector_type(8)))short;
using s16x4=__attribute__((ext_vector_type(4)))short;
using f32x16=__attribute__((ext_vector_type(16)))float;
using u32x4=__attribute__((ext_vector_type(4)))unsigned;
constexpr int SEQ=8192,D=64,PQ=3328,PK=3328,PV=3328,PO=2048;
constexpr int NW=8,QBLK=32,QB=QBLK*NW,KVBLK=64,NQB=SEQ/QB;
constexpr int ATTN_UNIT_ROWS=QB;
__device__ __forceinline__ int crow(int r,int hi){return (r&3)+8*(r>>2)+4*hi;}
#define SBAR() __builtin_amdgcn_sched_barrier(0)
__device__ __forceinline__ void cmask(f32x16&p0,f32x16&p1,int jb,int qrel,int hi){
  const float NEG=-INFINITY; int kb=64*jb+4*hi;
  #pragma unroll
  for(int r=0;r<16;++r){int kv=kb+(r&3)+8*(r>>2); if(kv>qrel)p0[r]=NEG; if(kv+32>qrel)p1[r]=NEG;}
}

constexpr int NSLOT=3, SLOTB=8192;
constexpr int LDS_K=0, LDS_V=NSLOT*SLOTB, LDS_WS=2*NSLOT*SLOTB, LDS_OST=LDS_WS+NW*64*4, LDS_BYTES=LDS_OST+NW*4096;
constexpr float C2=0.125f*1.4426950408889634f;
__device__ __forceinline__ void glds16(const void*gsrc,unsigned lds_dst){unsigned keep;
  asm volatile("s_mov_b32 %0, m0\n\ts_mov_b32 m0, %2\n\ts_nop 0\n\tglobal_load_lds_dwordx4 %1, off\n\ts_mov_b32 m0, %0":"=&s"(keep):"v"(gsrc),"s"(lds_dst):"memory");}
__device__ __forceinline__ float max3f(float a,float b,float c){float r;asm("v_max3_f32 %0, %1, %2, %3":"=v"(r):"v"(a),"v"(b),"v"(c));return r;}
__device__ __forceinline__ float max2f(float a,float b){float r;asm("v_max_f32_e32 %0, %1, %2":"=v"(r):"v"(a),"v"(b));return r;}
__device__ __forceinline__ float fadd_s(float a,float b){float r;asm("v_add_f32_e32 %0, %1, %2":"=v"(r):"v"(a),"v"(b));return r;}
__device__ __forceinline__ float fsub_s(float a,float b){float r;asm("v_sub_f32_e32 %0, %1, %2":"=v"(r):"v"(a),"v"(b));return r;}
typedef float f32x2_t __attribute__((ext_vector_type(2))); typedef __bf16 bf16x2_t __attribute__((ext_vector_type(2)));
__device__ __forceinline__ unsigned cvtpk_s(float lo,float hi){f32x2_t v={lo,hi};bf16x2_t b=__builtin_convertvector(v,bf16x2_t);return __builtin_bit_cast(unsigned,b);}
#define WAIT_BAR(N) asm volatile("s_waitcnt vmcnt(" #N ") lgkmcnt(0)\n\ts_barrier":::"memory")

__device__ __forceinline__ void qkt(f32x16&p0,f32x16&p1,const char*Kslot,const bf16x8*qr,const f32x16&negm,int r32,int hi){
  const char*kb=Kslot+hi*1024+r32*16;
  #pragma unroll
  for(int d0=0;d0<4;++d0){
    const bf16x8 b0=*reinterpret_cast<const bf16x8*>(kb+d0*2048);
    const bf16x8 b1=*reinterpret_cast<const bf16x8*>(kb+d0*2048+512);
    if(d0==0){p0=__builtin_amdgcn_mfma_f32_32x32x16_bf16(b0,qr[0],negm,0,0,0);p1=__builtin_amdgcn_mfma_f32_32x32x16_bf16(b1,qr[0],negm,0,0,0);}
    else{p0=__builtin_amdgcn_mfma_f32_32x32x16_bf16(b0,qr[d0],p0,0,0,0);p1=__builtin_amdgcn_mfma_f32_32x32x16_bf16(b1,qr[d0],p1,0,0,0);}}
}
typedef __attribute__((address_space(3))) const char* lds_cptr;
typedef short v4i16_t __attribute__((ext_vector_type(4)));
__device__ __forceinline__ void kload8(bf16x8*kf,lds_cptr kp){
  kf[0]=*(const __attribute__((address_space(3))) bf16x8*)(kp);      kf[1]=*(const __attribute__((address_space(3))) bf16x8*)(kp+512);
  kf[2]=*(const __attribute__((address_space(3))) bf16x8*)(kp+2048); kf[3]=*(const __attribute__((address_space(3))) bf16x8*)(kp+2560);
  kf[4]=*(const __attribute__((address_space(3))) bf16x8*)(kp+4096); kf[5]=*(const __attribute__((address_space(3))) bf16x8*)(kp+4608);
  kf[6]=*(const __attribute__((address_space(3))) bf16x8*)(kp+6144); kf[7]=*(const __attribute__((address_space(3))) bf16x8*)(kp+6656);
}
__device__ __forceinline__ void kload2(bf16x8*kf,lds_cptr kp,int j){ kf[2*j]=*(const __attribute__((address_space(3))) bf16x8*)(kp+j*2048); kf[2*j+1]=*(const __attribute__((address_space(3))) bf16x8*)(kp+j*2048+512); }
__device__ __forceinline__ s16x4 vtr(lds_cptr p){ return __builtin_bit_cast(s16x4,__builtin_amdgcn_ds_read_tr16_b64_v4i16((__attribute__((address_space(3))) v4i16_t*)p)); }
__device__ __forceinline__ float rowmax(const f32x16&p0,const f32x16&p1){
  float a=max3f(p0[0],p0[1],p1[0]),b=max3f(p0[2],p0[3],p1[1]);a=max3f(a,p1[2],p1[3]);
  #pragma unroll
  for(int r=4;r<16;r+=4){a=max3f(a,p0[r],p0[r+1]);b=max3f(b,p0[r+2],p0[r+3]);a=max3f(a,p1[r],p1[r+1]);b=max3f(b,p1[r+2],p1[r+3]);}
  const float m=max2f(a,b);
  auto rr=__builtin_amdgcn_permlane32_swap(__float_as_uint(m),__float_as_uint(m),false,false);
  return max2f(__uint_as_float(rr[0]),__uint_as_float(rr[1]));
}
__device__ __forceinline__ void pv(f32x16*o,int vb,bf16x8 pa0,bf16x8 pa1,bf16x8 pa2,bf16x8 pa3){
  #pragma unroll
  for(int d0=0;d0<2;++d0){s16x4 lo[4],hi[4];
    #pragma unroll
    for(int ks=0;ks<4;++ks){
      asm volatile("ds_read_b64_tr_b16 %0,%1 offset:%c2":"=&v"(lo[ks]):"v"(vb),"i"(d0*4096+ks*1024):"memory");
      asm volatile("ds_read_b64_tr_b16 %0,%1 offset:%c2":"=&v"(hi[ks]):"v"(vb),"i"(d0*4096+ks*1024+512):"memory");}
    asm volatile("s_waitcnt lgkmcnt(0)":::"memory");SBAR();
    #define PK(k) (bf16x8){lo[k][0],lo[k][1],lo[k][2],lo[k][3],hi[k][0],hi[k][1],hi[k][2],hi[k][3]}
    o[d0]=__builtin_amdgcn_mfma_f32_32x32x16_bf16(pa0,PK(0),o[d0],0,0,0);
    o[d0]=__builtin_amdgcn_mfma_f32_32x32x16_bf16(pa1,PK(1),o[d0],0,0,0);
    o[d0]=__builtin_amdgcn_mfma_f32_32x32x16_bf16(pa2,PK(2),o[d0],0,0,0);
    o[d0]=__builtin_amdgcn_mfma_f32_32x32x16_bf16(pa3,PK(3),o[d0],0,0,0);
    #undef PK
  }
}

#ifndef ATTN_STORE16
#define ATTN_STORE16(p,v) (*(u32x4*)(p)=(v))
#endif
template<int THRL> __device__ __forceinline__ void attn_unit(int b,int qcol,int kcol,int vcol,int ocol,int qb,const bf16*Q,const bf16*__restrict__ K,const bf16*__restrict__ V,bf16*O,char*shm){
  int tid=threadIdx.x; asm volatile("":"+v"(tid));
  const int lane=tid&63,r32=lane&31,hi=lane>>5; const int wid=__builtin_amdgcn_readfirstlane(tid>>6);
  const long rowbase=(long)b*SEQ; const int q0=qb*QB;
  const bf16*Qw=Q+(rowbase+q0+wid*QBLK)*PQ+qcol;
  const bf16*Kh=K+rowbase*PK+kcol,*Vh=V+rowbase*PV+vcol;
  const unsigned lds0=(unsigned)(uintptr_t)shm;
  float*wsf=(float*)(shm+LDS_WS)+wid*64;
  const bf16*ksrc=Kh+(long)lane*PK+wid*8;
  const bf16*vsrc=Vh+(long)(16*(wid&3)+(lane>>2))*PV+(wid>>2)*32+(lane&3)*8;
  const unsigned kdst=lds0+LDS_K+wid*1024, vdst=lds0+LDS_V+wid*1024;
  #define DMA_K(t,slot) glds16(ksrc+(long)(t)*KVBLK*PK,(unsigned)__builtin_amdgcn_readfirstlane(kdst+(slot)))
  #define DMA_V(t,slot) glds16(vsrc+(long)(t)*KVBLK*PV,(unsigned)__builtin_amdgcn_readfirstlane(vdst+(slot)))
  const int vb0=(int)(lds0+LDS_V)+((lane>>4)&1)*32+(lane&3)*8+(4*hi+((lane&15)>>2))*64;
  const char*Kbase=shm+LDS_K; bf16x8 kf[8];
  const lds_cptr shm3=(lds_cptr)shm; const lds_cptr kp0=shm3+LDS_K+hi*1024+r32*16; const lds_cptr vp0=shm3+LDS_V+((lane>>4)&1)*32+(lane&3)*8+(4*hi+((lane&15)>>2))*64;
  const int NT=(q0+QB)/KVBLK;
  DMA_K(0,0);DMA_V(0,0);DMA_K(1,SLOTB);
  bf16x8 qr[4];
  #pragma unroll
  for(int d0=0;d0<4;++d0)qr[d0]=*reinterpret_cast<const bf16x8*>(&Qw[(long)r32*PQ+d0*16+hi*8]);
  float mhat=0.f,l_reg=0.f;f32x16 o[2];o[0]=f32x16{};o[1]=f32x16{};f32x16 negm=f32x16{};asm volatile("":"+v"(negm));
  const int qrel=wid*QBLK+r32;
  #define CMASK(P0,P1,t) do{int jb_=(t)-(NT-4); if(jb_>=0)cmask(P0,P1,jb_,qrel,hi);}while(0)
  bool resc=false;
  #define START(P0,P1) do{ const float rm=rowmax(P0,P1); resc=false; \
    { const float dl=rm; mhat=fadd_s(mhat,dl); \
      _Pragma("unroll") for(int r=0;r<16;++r){P0[r]=fsub_s(P0[r],dl);P1[r]=fsub_s(P1[r],dl);} \
      _Pragma("unroll") for(int r=0;r<16;++r)negm[r]=-mhat; asm volatile("":"+v"(negm)); } \
    _Pragma("unroll") for(int r=0;r<16;++r)P0[r]=__builtin_amdgcn_exp2f(P0[r]); }while(0)
  #define RESC() do{ if(resc){ asm volatile("s_waitcnt lgkmcnt(0)":::"memory"); \
      _Pragma("unroll") for(int d_=0;d_<2;++d_) _Pragma("unroll") for(int r=0;r<16;++r)o[d_][r]*=wsf[crow(r,hi)]; } }while(0)
  f32x16 pA0,pA1,pB0,pB1;
  int sl_prev=0,sl_cur=0,sl_next=SLOTB;
  #define ROT() do{sl_prev=sl_cur;sl_cur=sl_next;sl_next=(sl_next==(NSLOT-1)*SLOTB)?0:sl_next+SLOTB;}while(0)
  DMA_K(2,2*SLOTB);
  WAIT_BAR(3);
  qkt(pA0,pA1,Kbase,qr,negm,r32,hi);asm volatile("s_nop 15\n\ts_nop 7":"+v"(pA0),"+v"(pA1));CMASK(pA0,pA1,0);
  START(pA0,pA1);
  _Pragma("unroll") for(int r=0;r<16;++r)pA1[r]=__builtin_amdgcn_exp2f(pA1[r]);
  WAIT_BAR(0);
  DMA_K(3,0);DMA_V(1,SLOTB);
  ROT();
  kload8(kf,kp0+sl_cur);
  WAIT_BAR(2);
  s16x4 vlo[8],vhi[8]; u32x4 pw0,pw1,pw2,pw3;
  #define PKW(P,B) cvtpk_s(P[B],P[B+1])
  #define PAF(k) __builtin_bit_cast(bf16x8,pw##k)
  #define VFR(i) (bf16x8){vlo[i][0],vlo[i][1],vlo[i][2],vlo[i][3],vhi[i][0],vhi[i][1],vhi[i][2],vhi[i][3]}
  #define PIN(x) asm volatile("":"+v"(x))
  #define MX3(a,b,c) __builtin_fmaxf(__builtin_fmaxf((a),(b)),(c))
  #define GAPA(MF,A0,A1,A2,A3,W0,W1,PW) do{ MF; sacc+=A0; sacc+=A1; sacc+=A2; sacc+=A3; PIN(sacc); W0; W1; PIN(PW); SBAR(); }while(0)
  #define EX(v) __builtin_amdgcn_exp2f(v)
  #define GAPB(MF,X,B) do{ MF; X[B]=EX(X[B]); X[B+1]=EX(X[B+1]); X[B+2]=EX(X[B+2]); X[B+3]=EX(X[B+3]); PIN(X); SBAR(); }while(0)
  #define VRD(i) do{ vlo[i]=vtr(vp_+(((i)>>2)*4096+((i)&3)*1024)); vhi[i]=vtr(vp_+(((i)>>2)*4096+((i)&3)*1024+512)); }while(0)
  #define KRD(G,j) do{ if(G){ kload2(kf,kp0+sl_next,j); SBAR(); } }while(0)
  #define STEP(C0,C1,P0,P1,t,GK,GV,GL) do{ SBAR(); \
    const lds_cptr vp_=vp0+sl_prev; \
    VRD(0); SBAR(); float sacc=(P0[0]+P0[1]); \
    GAPA(C0=__builtin_amdgcn_mfma_f32_32x32x16_bf16(kf[0],qr[0],negm,0,0,0), P0[2],P0[3],P0[4],P0[5],     pw0[0]=PKW(P0,0), pw0[1]=PKW(P0,2), pw0); \
    VRD(4); SBAR(); GAPA(C1=__builtin_amdgcn_mfma_f32_32x32x16_bf16(kf[1],qr[0],negm,0,0,0), P0[6],P0[7],P0[8],P0[9],     pw0[2]=PKW(P0,4), pw0[3]=PKW(P0,6), pw0); \
    VRD(1); SBAR(); GAPA(C0=__builtin_amdgcn_mfma_f32_32x32x16_bf16(kf[2],qr[1],C0,0,0,0),   P0[10],P0[11],P0[12],P0[13], pw1[0]=PKW(P0,8), pw1[1]=PKW(P0,10), pw1); \
    VRD(5); SBAR(); GAPA(C1=__builtin_amdgcn_mfma_f32_32x32x16_bf16(kf[3],qr[1],C1,0,0,0),   P0[14],P0[15],P1[0],P1[1],   pw1[2]=PKW(P0,12),pw1[3]=PKW(P0,14), pw1); \
    VRD(2); SBAR(); GAPA(C0=__builtin_amdgcn_mfma_f32_32x32x16_bf16(kf[4],qr[2],C0,0,0,0),   P1[2],P1[3],P1[4],P1[5],     pw2[0]=PKW(P1,0), pw2[1]=PKW(P1,2), pw2); \
    VRD(6); SBAR(); GAPA(C1=__builtin_amdgcn_mfma_f32_32x32x16_bf16(kf[5],qr[2],C1,0,0,0),   P1[6],P1[7],P1[8],P1[9],     pw2[2]=PKW(P1,4), pw2[3]=PKW(P1,6), pw2); \
    VRD(3); SBAR(); GAPA(C0=__builtin_amdgcn_mfma_f32_32x32x16_bf16(kf[6],qr[3],C0,0,0,0),   P1[10],P1[11],P1[12],P1[13], pw3[0]=PKW(P1,8), pw3[1]=PKW(P1,10), pw3); \
    VRD(7); SBAR(); GAPA(C1=__builtin_amdgcn_mfma_f32_32x32x16_bf16(kf[7],qr[3],C1,0,0,0),   P1[14],P1[15],0.f,0.f,       pw3[2]=PKW(P1,12),pw3[3]=PKW(P1,14), pw3); \
    l_reg+=sacc; \
    if(GK){DMA_K((t)+3,sl_cur);} if(GV){DMA_V((t)+1,sl_next);} \
    CMASK(C0,C1,t); \
    { float a=MX3(C0[0],C0[1],C1[0]),b=MX3(C0[2],C0[3],C1[1]); a=MX3(a,C1[2],C1[3]); \
      _Pragma("unroll") for(int r=4;r<16;r+=4){a=MX3(a,C0[r],C0[r+1]);b=MX3(b,C0[r+2],C0[r+3]);a=MX3(a,C1[r],C1[r+1]);b=MX3(b,C1[r+2],C1[r+3]);} \
      float rm=__builtin_fmaxf(a,b); { auto rr=__builtin_amdgcn_permlane32_swap(__float_as_uint(rm),__float_as_uint(rm),false,false); rm=__builtin_fmaxf(__uint_as_float(rr[0]),__uint_as_float(rr[1])); } \
      resc=false; \
      if(__builtin_expect(__any(rm>(float)THRL),0)){ const float dl=__builtin_fmaxf(rm,0.f); mhat+=dl; \
        _Pragma("unroll") for(int r=0;r<16;++r){C0[r]-=dl;C1[r]-=dl;} \
        _Pragma("unroll") for(int r=0;r<16;++r)negm[r]=-mhat; asm volatile("":"+v"(negm)); \
        const float f=__builtin_amdgcn_exp2f(-dl); l_reg*=f; if(hi==0)wsf[r32]=f; resc=true; } } \
    SBAR(); \
    GAPB(o[0]=__builtin_amdgcn_mfma_f32_32x32x16_bf16(PAF(0),VFR(0),o[0],0,0,0), C0,0); \
    GAPB(o[1]=__builtin_amdgcn_mfma_f32_32x32x16_bf16(PAF(0),VFR(4),o[1],0,0,0), C0,4); \
    KRD(GL,0); GAPB(o[0]=__builtin_amdgcn_mfma_f32_32x32x16_bf16(PAF(1),VFR(1),o[0],0,0,0), C0,8); \
    KRD(GL,1); GAPB(o[1]=__builtin_amdgcn_mfma_f32_32x32x16_bf16(PAF(1),VFR(5),o[1],0,0,0), C0,12); \
    KRD(GL,2); GAPB(o[0]=__builtin_amdgcn_mfma_f32_32x32x16_bf16(PAF(2),VFR(2),o[0],0,0,0), C1,0); \
    KRD(GL,3); GAPB(o[1]=__builtin_amdgcn_mfma_f32_32x32x16_bf16(PAF(2),VFR(6),o[1],0,0,0), C1,4); \
    GAPB(o[0]=__builtin_amdgcn_mfma_f32_32x32x16_bf16(PAF(3),VFR(3),o[0],0,0,0), C1,8); \
    GAPB(o[1]=__builtin_amdgcn_mfma_f32_32x32x16_bf16(PAF(3),VFR(7),o[1],0,0,0), C1,12); \
    }while(0)
  int t=1;
  #undef CMASK
  #define CMASK(P0,P1,t) do{}while(0)
  for(;t+5<NT;t+=2){
    STEP(pB0,pB1,pA0,pA1,t,true,true,true);     WAIT_BAR(2); RESC(); ROT();
    STEP(pA0,pA1,pB0,pB1,t+1,true,true,true);   WAIT_BAR(2); RESC(); ROT();
  }
  #undef CMASK
  #define CMASK(P0,P1,t) do{int jb_=(t)-(NT-4); if(jb_>=0)cmask(P0,P1,jb_,qrel,hi);}while(0)
  #define ENDW(tt) do{ if((tt)+3<NT){WAIT_BAR(2);} else if((tt)+2<NT){WAIT_BAR(1);} else {WAIT_BAR(0);} }while(0)
  for(;t+1<NT;t+=2){
    STEP(pB0,pB1,pA0,pA1,t,(t+3<NT),(t+1<NT),(t+1<NT));       ENDW(t);   RESC(); ROT();
    STEP(pA0,pA1,pB0,pB1,t+1,(t+4<NT),(t+2<NT),(t+2<NT));     ENDW(t+1); RESC(); ROT();
  }
  STEP(pB0,pB1,pA0,pA1,NT-1,false,false,false); RESC();
  { float sacc=pB0[0]+pB0[1]; _Pragma("unroll") for(int r=2;r<16;++r)sacc+=pB0[r]; _Pragma("unroll") for(int r=0;r<16;++r)sacc+=pB1[r]; l_reg+=sacc;
    pw0=(u32x4){PKW(pB0,0),PKW(pB0,2),PKW(pB0,4),PKW(pB0,6)};pw1=(u32x4){PKW(pB0,8),PKW(pB0,10),PKW(pB0,12),PKW(pB0,14)};pw2=(u32x4){PKW(pB1,0),PKW(pB1,2),PKW(pB1,4),PKW(pB1,6)};pw3=(u32x4){PKW(pB1,8),PKW(pB1,10),PKW(pB1,12),PKW(pB1,14)};
    SBAR(); pv(o,vb0+sl_cur,PAF(0),PAF(1),PAF(2),PAF(3)); }
  #undef PKW
  #undef PAF
  #undef VFR
  #undef PIN
  #undef MX3
  #undef GAPA
  #undef GAPB
  #undef EX
  #undef VRD
  #undef KRD
  #undef STEP
  #undef ENDW
  {auto rr=__builtin_amdgcn_permlane32_swap(__float_as_uint(l_reg),__float_as_uint(l_reg),false,false);l_reg=__uint_as_float(rr[0])+__uint_as_float(rr[1]);}
  if(hi==0)wsf[32+r32]=l_reg;asm volatile("s_waitcnt lgkmcnt(0)":::"memory");
  float rli[16];
  #pragma unroll
  for(int r=0;r<16;++r)rli[r]=__builtin_amdgcn_rcpf(wsf[32+crow(r,hi)]);
  bf16*Ow=O+(rowbase+q0+wid*QBLK)*PO+ocol;
  { bf16*stg=(bf16*)(shm+LDS_OST)+wid*2048;
    #pragma unroll
    for(int r=0;r<16;++r){const int orow=crow(r,hi);
      #pragma unroll
      for(int d0=0;d0<2;++d0)stg[orow*64+d0*32+r32]=__float2bfloat16(o[d0][r]*rli[r]);}
    asm volatile("s_waitcnt lgkmcnt(0)":::"memory");
    #pragma unroll
    for(int i=0;i<4;++i){const int row=i*8+(lane>>3),ch=lane&7; const u32x4 v=*(const u32x4*)(stg+row*64+ch*8); ATTN_STORE16(Ow+(long)row*PO+ch*8,v);} }
  asm volatile("s_waitcnt lgkmcnt(0)\n\ts_barrier":::"memory");
  #undef DMA_K
  #undef DMA_V
  #undef CMASK
  #undef START
  #undef RESC
  #undef ROT
}
constexpr int ATTN_LDS_BYTES=LDS_BYTES;
#undef SBAR
#undef WAIT_BAR
}
#include <hip/hip_bf16.h>
#include <cmath>
namespace attn_body2 {
using bf16=__hip_bfloat16;
using bf16x8=__attribute__((ext_vector_type(8)))short;
using s16x4=__attribute__((ext_vector_type(4)))short;
using f32x16=__attribute__((ext_vector_type(16)))float;
using u32x4=__attribute__((ext_vector_type(4)))unsigned;
constexpr int SEQ=8192,D=64,PQ=3328,PK=3328,PV=3328,PO=2048;
constexpr int NW=8,QBLK=32,QB=QBLK*NW,KVBLK=64,NQB=SEQ/QB;
constexpr int ATTN_UNIT_ROWS=QB;
__device__ __forceinline__ int crow(int r,int hi){return (r&3)+8*(r>>2)+4*hi;}
#define SBAR() __builtin_amdgcn_sched_barrier(0)
__device__ __forceinline__ void cmask(f32x16&p0,f32x16&p1,int jb,int qrel,int hi){
  const float NEG=-INFINITY; int kb=64*jb+4*hi;
  #pragma unroll
  for(int r=0;r<16;++r){int kv=kb+(r&3)+8*(r>>2); if(kv>qrel)p0[r]=NEG; if(kv+32>qrel)p1[r]=NEG;}
}

constexpr int NSLOT=3, SLOTB=8192, VSLOT=16384;
constexpr int LDS_K=0, LDS_V=NSLOT*SLOTB, LDS_WS=LDS_V+NSLOT*VSLOT, LDS_OST=LDS_WS+NW*64*4, LDS_BYTES=LDS_OST+NW*8192;
constexpr float C2=0.125f*1.4426950408889634f;
__device__ __forceinline__ void glds16(const void*gsrc,unsigned lds_dst){unsigned keep;
  asm volatile("s_mov_b32 %0, m0\n\ts_mov_b32 m0, %2\n\ts_nop 0\n\tglobal_load_lds_dwordx4 %1, off\n\ts_mov_b32 m0, %0":"=&s"(keep):"v"(gsrc),"s"(lds_dst):"memory");}
__device__ __forceinline__ float max3f(float a,float b,float c){float r;asm("v_max3_f32 %0, %1, %2, %3":"=v"(r):"v"(a),"v"(b),"v"(c));return r;}
__device__ __forceinline__ float max2f(float a,float b){float r;asm("v_max_f32_e32 %0, %1, %2":"=v"(r):"v"(a),"v"(b));return r;}
__device__ __forceinline__ float fadd_s(float a,float b){float r;asm("v_add_f32_e32 %0, %1, %2":"=v"(r):"v"(a),"v"(b));return r;}
__device__ __forceinline__ float fsub_s(float a,float b){float r;asm("v_sub_f32_e32 %0, %1, %2":"=v"(r):"v"(a),"v"(b));return r;}
typedef float f32x2_t __attribute__((ext_vector_type(2))); typedef __bf16 bf16x2_t __attribute__((ext_vector_type(2)));
__device__ __forceinline__ unsigned cvtpk_s(float lo,float hi){f32x2_t v={lo,hi};bf16x2_t b=__builtin_convertvector(v,bf16x2_t);return __builtin_bit_cast(unsigned,b);}
#define WAIT_BAR(N) asm volatile("s_waitcnt vmcnt(" #N ") lgkmcnt(0)\n\ts_barrier":::"memory")

__device__ __forceinline__ void qkt(f32x16&p0,f32x16&p1,const char*Kslot,const bf16x8*qr,const f32x16&negm,int r32,int hi){
  const char*kb=Kslot+hi*1024+r32*16;
  #pragma unroll
  for(int d0=0;d0<4;++d0){
    const bf16x8 b0=*reinterpret_cast<const bf16x8*>(kb+d0*2048);
    const bf16x8 b1=*reinterpret_cast<const bf16x8*>(kb+d0*2048+512);
    if(d0==0){p0=__builtin_amdgcn_mfma_f32_32x32x16_bf16(b0,qr[0],negm,0,0,0);p1=__builtin_amdgcn_mfma_f32_32x32x16_bf16(b1,qr[0],negm,0,0,0);}
    else{p0=__builtin_amdgcn_mfma_f32_32x32x16_bf16(b0,qr[d0],p0,0,0,0);p1=__builtin_amdgcn_mfma_f32_32x32x16_bf16(b1,qr[d0],p1,0,0,0);}}
}
typedef __attribute__((address_space(3))) const char* lds_cptr;
typedef short v4i16_t __attribute__((ext_vector_type(4)));
__device__ __forceinline__ void kload8(bf16x8*kf,lds_cptr kp){
  kf[0]=*(const __attribute__((address_space(3))) bf16x8*)(kp);      kf[1]=*(const __attribute__((address_space(3))) bf16x8*)(kp+512);
  kf[2]=*(const __attribute__((address_space(3))) bf16x8*)(kp+2048); kf[3]=*(const __attribute__((address_space(3))) bf16x8*)(kp+2560);
  kf[4]=*(const __attribute__((address_space(3))) bf16x8*)(kp+4096); kf[5]=*(const __attribute__((address_space(3))) bf16x8*)(kp+4608);
  kf[6]=*(const __attribute__((address_space(3))) bf16x8*)(kp+6144); kf[7]=*(const __attribute__((address_space(3))) bf16x8*)(kp+6656);
}
__device__ __forceinline__ void kload2(bf16x8*kf,lds_cptr kp,int j){ kf[2*j]=*(const __attribute__((address_space(3))) bf16x8*)(kp+j*2048); kf[2*j+1]=*(const __attribute__((address_space(3))) bf16x8*)(kp+j*2048+512); }
__device__ __forceinline__ s16x4 vtr(lds_cptr p){ return __builtin_bit_cast(s16x4,__builtin_amdgcn_ds_read_tr16_b64_v4i16((__attribute__((address_space(3))) v4i16_t*)p)); }
__device__ __forceinline__ float rowmax(const f32x16&p0,const f32x16&p1){
  float a=max3f(p0[0],p0[1],p1[0]),b=max3f(p0[2],p0[3],p1[1]);a=max3f(a,p1[2],p1[3]);
  #pragma unroll
  for(int r=4;r<16;r+=4){a=max3f(a,p0[r],p0[r+1]);b=max3f(b,p0[r+2],p0[r+3]);a=max3f(a,p1[r],p1[r+1]);b=max3f(b,p1[r+2],p1[r+3]);}
  const float m=max2f(a,b);
  auto rr=__builtin_amdgcn_permlane32_swap(__float_as_uint(m),__float_as_uint(m),false,false);
  return max2f(__uint_as_float(rr[0]),__uint_as_float(rr[1]));
}
__device__ __forceinline__ void pv(f32x16*o,int vb,bf16x8 pa0,bf16x8 pa1,bf16x8 pa2,bf16x8 pa3){
  #pragma unroll
  for(int d0=0;d0<4;++d0){s16x4 lo[4],hi[4];
    #pragma unroll
    for(int ks=0;ks<4;++ks){
      asm volatile("ds_read_b64_tr_b16 %0,%1 offset:%c2":"=&v"(lo[ks]):"v"(vb),"i"(d0*4096+ks*1024):"memory");
      asm volatile("ds_read_b64_tr_b16 %0,%1 offset:%c2":"=&v"(hi[ks]):"v"(vb),"i"(d0*4096+ks*1024+512):"memory");}
    asm volatile("s_waitcnt lgkmcnt(0)":::"memory");SBAR();
    #define PK(k) (bf16x8){lo[k][0],lo[k][1],lo[k][2],lo[k][3],hi[k][0],hi[k][1],hi[k][2],hi[k][3]}
    o[d0]=__builtin_amdgcn_mfma_f32_32x32x16_bf16(pa0,PK(0),o[d0],0,0,0);
    o[d0]=__builtin_amdgcn_mfma_f32_32x32x16_bf16(pa1,PK(1),o[d0],0,0,0);
    o[d0]=__builtin_amdgcn_mfma_f32_32x32x16_bf16(pa2,PK(2),o[d0],0,0,0);
    o[d0]=__builtin_amdgcn_mfma_f32_32x32x16_bf16(pa3,PK(3),o[d0],0,0,0);
    #undef PK
  }
}

#ifndef ATTN_STORE16
#define ATTN_STORE16(p,v) (*(u32x4*)(p)=(v))
#endif
template<int THRL> __device__ __forceinline__ void attn_unit(int b,int qcol,int kcol,int vcol,int ocol,int qb,const bf16*Q,const bf16*__restrict__ K,const bf16*__restrict__ V,bf16*O,char*shm){
  int tid=threadIdx.x; asm volatile("":"+v"(tid));
  const int lane=tid&63,r32=lane&31,hi=lane>>5; const int wid=__builtin_amdgcn_readfirstlane(tid>>6);
  const long rowbase=(long)b*SEQ; const int q0=qb*QB;
  const bf16*Qw=Q+(rowbase+q0+wid*QBLK)*PQ+qcol;
  const bf16*Kh=K+rowbase*PK+kcol,*Vh=V+rowbase*PV+vcol;
  const unsigned lds0=(unsigned)(uintptr_t)shm;
  float*wsf=(float*)(shm+LDS_WS)+wid*64;
  const bf16*ksrc=Kh+(long)lane*PK+wid*8;
  const bf16*vsrc=Vh+(long)(16*(wid&3)+(lane>>2))*PV+(wid>>2)*32+(lane&3)*8;
  const unsigned kdst=lds0+LDS_K+wid*1024, vdst=lds0+LDS_V+wid*1024;
  #define DMA_K(t,slot) glds16(ksrc+(long)(t)*KVBLK*PK,(unsigned)__builtin_amdgcn_readfirstlane(kdst+(slot)))
  #define DMA_V(t,slot) do{ glds16(vsrc+(long)(t)*KVBLK*PV,(unsigned)__builtin_amdgcn_readfirstlane(vdst+2*(slot))); glds16(vsrc+64+(long)(t)*KVBLK*PV,(unsigned)__builtin_amdgcn_readfirstlane(vdst+2*(slot)+8192)); }while(0)
  const int vb0=(int)(lds0+LDS_V)+((lane>>4)&1)*32+(lane&3)*8+(4*hi+((lane&15)>>2))*64;
  const char*Kbase=shm+LDS_K; bf16x8 kf[8];
  const lds_cptr shm3=(lds_cptr)shm; const lds_cptr kp0=shm3+LDS_K+hi*1024+r32*16; const lds_cptr vp0=shm3+LDS_V+((lane>>4)&1)*32+(lane&3)*8+(4*hi+((lane&15)>>2))*64;
  const int NT=(q0+QB)/KVBLK;
  DMA_K(0,0);DMA_V(0,0);DMA_K(1,SLOTB);
  bf16x8 qr[4];
  #pragma unroll
  for(int d0=0;d0<4;++d0)qr[d0]=*reinterpret_cast<const bf16x8*>(&Qw[(long)r32*PQ+d0*16+hi*8]);
  { u32x4*qst_=(u32x4*)(shm+LDS_OST+wid*8192);
    _Pragma("unroll") for(int d0=0;d0<4;++d0)qst_[d0*64+lane]=__builtin_bit_cast(u32x4,qr[d0]); }
  const lds_cptr qsp=(lds_cptr)shm+LDS_OST+wid*8192+lane*16;
  float mhat=0.f,l_reg=0.f;f32x16 o[4];o[0]=f32x16{};o[1]=f32x16{};o[2]=f32x16{};o[3]=f32x16{};const f32x16 ZR=f32x16{};
  const int qrel=wid*QBLK+r32;
  #define CMASK(P0,P1,t) do{int jb_=(t)-(NT-4); if(jb_>=0)cmask(P0,P1,jb_,qrel,hi);}while(0)
  bool resc=false;
  #define START(P0,P1) do{ const float rm=rowmax(P0,P1); resc=false; \
    { const float dl=rm; mhat=fadd_s(mhat,dl); \
      _Pragma("unroll") for(int r=0;r<16;++r){P0[r]=fsub_s(P0[r],dl);P1[r]=fsub_s(P1[r],dl);} \
      } \
    _Pragma("unroll") for(int r=0;r<16;++r)P0[r]=__builtin_amdgcn_exp2f(P0[r]); }while(0)
  #define RESC() do{ if(resc){ asm volatile("s_waitcnt lgkmcnt(0)":::"memory"); \
      _Pragma("unroll") for(int d_=0;d_<4;++d_) _Pragma("unroll") for(int r=0;r<16;++r)o[d_][r]*=wsf[crow(r,hi)]; } }while(0)
  f32x16 pA0,pA1,pB0,pB1;
  int sl_prev=0,sl_cur=0,sl_next=SLOTB;
  #define ROT() do{sl_prev=sl_cur;sl_cur=sl_next;sl_next=(sl_next==(NSLOT-1)*SLOTB)?0:sl_next+SLOTB;}while(0)
  DMA_K(2,2*SLOTB);
  WAIT_BAR(4);
  qkt(pA0,pA1,Kbase,qr,ZR,r32,hi);asm volatile("s_nop 15\n\ts_nop 7":"+v"(pA0),"+v"(pA1));CMASK(pA0,pA1,0);
  START(pA0,pA1);
  _Pragma("unroll") for(int r=0;r<16;++r)pA1[r]=__builtin_amdgcn_exp2f(pA1[r]);
  WAIT_BAR(0);
  DMA_K(3,0);DMA_V(1,SLOTB);
  ROT();
  kload8(kf,kp0+sl_cur);
  WAIT_BAR(3);
  s16x4 vlo[8],vhi[8]; u32x4 pw0,pw1,pw2,pw3;
  #define PKW(P,B) cvtpk_s(P[B],P[B+1])
  #define PAF(k) __builtin_bit_cast(bf16x8,pw##k)
  #define VFR(i) (bf16x8){vlo[i][0],vlo[i][1],vlo[i][2],vlo[i][3],vhi[i][0],vhi[i][1],vhi[i][2],vhi[i][3]}
  #define PIN(x) asm volatile("":"+v"(x))
  #define MX3(a,b,c) __builtin_fmaxf(__builtin_fmaxf((a),(b)),(c))
  #define GAPA(MF,A0,A1,A2,A3,W0,W1,PW) do{ MF; sacc+=A0; sacc+=A1; sacc+=A2; sacc+=A3; PIN(sacc); W0; W1; PIN(PW); SBAR(); }while(0)
  #define EX(v) __builtin_amdgcn_exp2f(v)
  #define GAPB(MF,X,B) do{ MF; X[B]=EX(X[B]); X[B+1]=EX(X[B+1]); X[B+2]=EX(X[B+2]); X[B+3]=EX(X[B+3]); PIN(X); SBAR(); }while(0)
  #define VRD(i) do{ vlo[i]=vtr(vp_+(((i)>>2)*4096+((i)&3)*1024)); vhi[i]=vtr(vp_+(((i)>>2)*4096+((i)&3)*1024+512)); }while(0)
  #define VRD2(i) do{ vlo[i]=vtr(vp_+((((i)>>2)+2)*4096+((i)&3)*1024)); vhi[i]=vtr(vp_+((((i)>>2)+2)*4096+((i)&3)*1024+512)); }while(0)
  #define GAPB2(MF,X,B,RD) do{ MF; X[B]=__builtin_amdgcn_exp2f(X[B]); X[B+1]=__builtin_amdgcn_exp2f(X[B+1]); asm volatile("":"+v"(X)); RD; SBAR(); }while(0)
  #define KRD(G,j) do{ if(G){ kload2(kf,kp0+sl_next,j); SBAR(); } }while(0)
  #define STEP(C0,C1,P0,P1,t,GK,GV,GL) do{ SBAR(); \
    const lds_cptr vp_=vp0+2*sl_prev; \
    _Pragma("unroll") for(int d0=0;d0<4;++d0)qr[d0]=*(const __attribute__((address_space(3))) bf16x8*)(qsp+d0*1024); SBAR(); \
    float sacc=(P0[0]+P0[1]); \
    GAPA(C0=__builtin_amdgcn_mfma_f32_32x32x16_bf16(kf[0],qr[0],ZR,0,0,0), P0[2],P0[3],P0[4],P0[5],     pw0[0]=PKW(P0,0), pw0[1]=PKW(P0,2), pw0); VRD(0); SBAR(); \
    GAPA(C1=__builtin_amdgcn_mfma_f32_32x32x16_bf16(kf[1],qr[0],ZR,0,0,0), P0[6],P0[7],P0[8],P0[9],     pw0[2]=PKW(P0,4), pw0[3]=PKW(P0,6), pw0); VRD(4); SBAR(); \
    GAPA(C0=__builtin_amdgcn_mfma_f32_32x32x16_bf16(kf[2],qr[1],C0,0,0,0),   P0[10],P0[11],P0[12],P0[13], pw1[0]=PKW(P0,8), pw1[1]=PKW(P0,10), pw1); VRD(1); SBAR(); \
    GAPA(C1=__builtin_amdgcn_mfma_f32_32x32x16_bf16(kf[3],qr[1],C1,0,0,0),   P0[14],P0[15],P1[0],P1[1],   pw1[2]=PKW(P0,12),pw1[3]=PKW(P0,14), pw1); VRD(5); SBAR(); \
    GAPA(C0=__builtin_amdgcn_mfma_f32_32x32x16_bf16(kf[4],qr[2],C0,0,0,0),   P1[2],P1[3],P1[4],P1[5],     pw2[0]=PKW(P1,0), pw2[1]=PKW(P1,2), pw2); VRD(2); SBAR(); \
    GAPA(C1=__builtin_amdgcn_mfma_f32_32x32x16_bf16(kf[5],qr[2],C1,0,0,0),   P1[6],P1[7],P1[8],P1[9],     pw2[2]=PKW(P1,4), pw2[3]=PKW(P1,6), pw2); VRD(6); SBAR(); \
    GAPA(C0=__builtin_amdgcn_mfma_f32_32x32x16_bf16(kf[6],qr[3],C0,0,0,0),   P1[10],P1[11],P1[12],P1[13], pw3[0]=PKW(P1,8), pw3[1]=PKW(P1,10), pw3); VRD(3); SBAR(); \
    GAPA(C1=__builtin_amdgcn_mfma_f32_32x32x16_bf16(kf[7],qr[3],C1,0,0,0),   P1[14],P1[15],0.f,0.f,       pw3[2]=PKW(P1,12),pw3[3]=PKW(P1,14), pw3); VRD(7); SBAR(); \
    _Pragma("unroll") for(int r=0;r<16;++r){C0[r]-=mhat;C1[r]-=mhat;} \
    l_reg+=sacc; \
    if(GK){DMA_K((t)+3,sl_cur);} if(GV){DMA_V((t)+1,sl_next);} \
    CMASK(C0,C1,t); \
    { float a=MX3(C0[0],C0[1],C1[0]),b=MX3(C0[2],C0[3],C1[1]); a=MX3(a,C1[2],C1[3]); \
      _Pragma("unroll") for(int r=4;r<16;r+=4){a=MX3(a,C0[r],C0[r+1]);b=MX3(b,C0[r+2],C0[r+3]);a=MX3(a,C1[r],C1[r+1]);b=MX3(b,C1[r+2],C1[r+3]);} \
      float rm=__builtin_fmaxf(a,b); { auto rr=__builtin_amdgcn_permlane32_swap(__float_as_uint(rm),__float_as_uint(rm),false,false); rm=__builtin_fmaxf(__uint_as_float(rr[0]),__uint_as_float(rr[1])); } \
      resc=false; \
      if(__builtin_expect(__any(rm>(float)THRL),0)){ const float dl=__builtin_fmaxf(rm,0.f); mhat+=dl; \
        _Pragma("unroll") for(int r=0;r<16;++r){C0[r]-=dl;C1[r]-=dl;} \
        const float f=__builtin_amdgcn_exp2f(-dl); l_reg*=f; if(hi==0)wsf[r32]=f; resc=true; } } \
    SBAR(); \
      \
    GAPB2(o[0]=__builtin_amdgcn_mfma_f32_32x32x16_bf16(PAF(0),VFR(0),o[0],0,0,0), C0,0,  VRD2(0)); \
    GAPB2(o[1]=__builtin_amdgcn_mfma_f32_32x32x16_bf16(PAF(0),VFR(4),o[1],0,0,0), C0,2,  VRD2(4)); \
    GAPB2(o[0]=__builtin_amdgcn_mfma_f32_32x32x16_bf16(PAF(1),VFR(1),o[0],0,0,0), C0,4,  VRD2(1)); \
    GAPB2(o[1]=__builtin_amdgcn_mfma_f32_32x32x16_bf16(PAF(1),VFR(5),o[1],0,0,0), C0,6,  VRD2(5)); \
    GAPB2(o[0]=__builtin_amdgcn_mfma_f32_32x32x16_bf16(PAF(2),VFR(2),o[0],0,0,0), C0,8,  VRD2(2)); \
    GAPB2(o[1]=__builtin_amdgcn_mfma_f32_32x32x16_bf16(PAF(2),VFR(6),o[1],0,0,0), C0,10, VRD2(6)); \
    GAPB2(o[0]=__builtin_amdgcn_mfma_f32_32x32x16_bf16(PAF(3),VFR(3),o[0],0,0,0), C0,12, VRD2(3)); \
    GAPB2(o[1]=__builtin_amdgcn_mfma_f32_32x32x16_bf16(PAF(3),VFR(7),o[1],0,0,0), C0,14, VRD2(7)); \
      \
    GAPB2(o[2]=__builtin_amdgcn_mfma_f32_32x32x16_bf16(PAF(0),VFR(0),o[2],0,0,0), C1,0,  (void)0); \
    GAPB2(o[3]=__builtin_amdgcn_mfma_f32_32x32x16_bf16(PAF(0),VFR(4),o[3],0,0,0), C1,2,  (void)0); \
    KRD(GL,0); GAPB2(o[2]=__builtin_amdgcn_mfma_f32_32x32x16_bf16(PAF(1),VFR(1),o[2],0,0,0), C1,4,  (void)0); \
    KRD(GL,1); GAPB2(o[3]=__builtin_amdgcn_mfma_f32_32x32x16_bf16(PAF(1),VFR(5),o[3],0,0,0), C1,6,  (void)0); \
    KRD(GL,2); GAPB2(o[2]=__builtin_amdgcn_mfma_f32_32x32x16_bf16(PAF(2),VFR(2),o[2],0,0,0), C1,8,  (void)0); \
    KRD(GL,3); GAPB2(o[3]=__builtin_amdgcn_mfma_f32_32x32x16_bf16(PAF(2),VFR(6),o[3],0,0,0), C1,10, (void)0); \
    GAPB2(o[2]=__builtin_amdgcn_mfma_f32_32x32x16_bf16(PAF(3),VFR(3),o[2],0,0,0), C1,12, (void)0); \
    GAPB2(o[3]=__builtin_amdgcn_mfma_f32_32x32x16_bf16(PAF(3),VFR(7),o[3],0,0,0), C1,14, (void)0); \
    }while(0)
  int t=1;
  #undef CMASK
  #define CMASK(P0,P1,t) do{}while(0)
  for(;t+5<NT;t+=2){
    STEP(pB0,pB1,pA0,pA1,t,true,true,true);     WAIT_BAR(3); RESC(); ROT();
    STEP(pA0,pA1,pB0,pB1,t+1,true,true,true);   WAIT_BAR(3); RESC(); ROT();
  }
  #undef CMASK
  #define CMASK(P0,P1,t) do{int jb_=(t)-(NT-4); if(jb_>=0)cmask(P0,P1,jb_,qrel,hi);}while(0)
  #define ENDW(tt) do{ if((tt)+3<NT){WAIT_BAR(3);} else if((tt)+2<NT){WAIT_BAR(2);} else {WAIT_BAR(0);} }while(0)
  for(;t+1<NT;t+=2){
    STEP(pB0,pB1,pA0,pA1,t,(t+3<NT),(t+1<NT),(t+1<NT));       ENDW(t);   RESC(); ROT();
    STEP(pA0,pA1,pB0,pB1,t+1,(t+4<NT),(t+2<NT),(t+2<NT));     ENDW(t+1); RESC(); ROT();
  }
  STEP(pB0,pB1,pA0,pA1,NT-1,false,false,false); RESC();
  { float sacc=pB0[0]+pB0[1]; _Pragma("unroll") for(int r=2;r<16;++r)sacc+=pB0[r]; _Pragma("unroll") for(int r=0;r<16;++r)sacc+=pB1[r]; l_reg+=sacc;
    pw0=(u32x4){PKW(pB0,0),PKW(pB0,2),PKW(pB0,4),PKW(pB0,6)};pw1=(u32x4){PKW(pB0,8),PKW(pB0,10),PKW(pB0,12),PKW(pB0,14)};pw2=(u32x4){PKW(pB1,0),PKW(pB1,2),PKW(pB1,4),PKW(pB1,6)};pw3=(u32x4){PKW(pB1,8),PKW(pB1,10),PKW(pB1,12),PKW(pB1,14)};
    SBAR(); pv(o,vb0+2*sl_cur,PAF(0),PAF(1),PAF(2),PAF(3)); }
  #undef PKW
  #undef PAF
  #undef VFR
  #undef PIN
  #undef MX3
  #undef GAPA
  #undef GAPB
  #undef EX
  #undef VRD
  #undef VRD2
  #undef GAPB2
  #undef KRD
  #undef STEP
  #undef ENDW
  {auto rr=__builtin_amdgcn_permlane32_swap(__float_as_uint(l_reg),__float_as_uint(l_reg),false,false);l_reg=__uint_as_float(rr[0])+__uint_as_float(rr[1]);}
  if(hi==0)wsf[32+r32]=l_reg;asm volatile("s_waitcnt lgkmcnt(0)":::"memory");
  float rli[16];
  #pragma unroll
  for(int r=0;r<16;++r)rli[r]=__builtin_amdgcn_rcpf(wsf[32+crow(r,hi)]);
  bf16*Ow=O+(rowbase+q0+wid*QBLK)*PO+ocol;
  { bf16*stg=(bf16*)(shm+LDS_OST)+wid*4096;
    #pragma unroll
    for(int r=0;r<16;++r){const int orow=crow(r,hi);
      #pragma unroll
      for(int d0=0;d0<4;++d0)stg[orow*128+d0*32+r32]=__float2bfloat16(o[d0][r]*rli[r]);}
    asm volatile("s_waitcnt lgkmcnt(0)":::"memory");
    #pragma unroll
    for(int i=0;i<8;++i){const int row=i*4+(lane>>4),ch=lane&15; const u32x4 v=*(const u32x4*)(stg+row*128+ch*8); ATTN_STORE16(Ow+(long)row*PO+ch*8,v);} }
  asm volatile("s_waitcnt lgkmcnt(0)\n\ts_barrier":::"memory");
  #undef DMA_K
  #undef DMA_V
  #undef CMASK
  #undef START
  #undef RESC
  #undef ROT
}
constexpr int ATTN_LDS_BYTES=LDS_BYTES;
#undef SBAR
#undef WAIT_BAR
}
constexpr int NWAVES = 8;
#ifndef MK_N_LAUNCHES
#define MK_N_LAUNCHES 1
#endif
constexpr int NPHASE = 13;
constexpr int N_LAUNCHES = MK_N_LAUNCHES;

constexpr int NB = 4, SEQL = 8192, DMODEL = 1024, TOK = NB * SEQL;
constexpr int IN_W = 3088;
constexpr int NPROJ = 3328;
constexpr int C_GQ = 0, C_GK = 256, C_GV = 512, C_GZ = 1024, C_GR = 1280, C_DQ = 1792, C_DK = 2304, C_DV = 2816;
constexpr int NUNIT = 2048;
constexpr int PEER_N = 16384, NQP = 2048;
constexpr float RMS_EPS = 1e-6f;
constexpr float LAMBDA_INIT = 0.2f;

constexpr size_t MiB = 1u << 20;
constexpr size_t WS_CTL = 0, CTL_ZERO_BYTES = 65536;
constexpr size_t WS_WIN = 1 * MiB, WS_WOUT = 8 * MiB, WS_WQ = 10 * MiB, WS_KEYS = 14 * MiB;
constexpr size_t WS_KVT = 16 * MiB, WS_VT = 48 * MiB;
constexpr size_t WS_U = 16 * MiB, WS_V = 48 * MiB;
constexpr size_t WS_SGE = 80 * MiB, WS_AE = 96 * MiB, WS_OFFS = 112 * MiB;
constexpr size_t WS_XT = 384 * MiB;
constexpr size_t WS_AE2 = 208 * MiB, WS_CNT = 113 * MiB;
constexpr size_t WS_XN = 80 * MiB, WS_MIX = 80 * MiB;
constexpr size_t WS_PROJ = 144 * MiB;
constexpr size_t WS_XN2 = 144 * MiB, WS_QP = 208 * MiB;
constexpr size_t WS_O = 352 * MiB;
constexpr size_t WS_IDX = 352 * MiB;
constexpr size_t WS_KTT = 480 * MiB;
constexpr size_t WS_DEC = 496 * MiB;
constexpr size_t WS_ROPE = 497 * MiB;
constexpr size_t WS_SSP = 499 * MiB, WS_RSTD = 501 * MiB;
constexpr size_t WS_END = 502 * MiB;
constexpr int CW_BAR = 4096;

constexpr int RING_OFF = 0, RING_BYTES = 131072;
constexpr int LDSCTL_OFF = 163840 - 512, MISC_OFF = LDSCTL_OFF + 320;
constexpr int LDS_BYTES = 163840;
static_assert(MISC_OFF + 128 <= LDS_BYTES, "LDS map");

#define GAS __attribute__((address_space(1)))
#define LAS __attribute__((address_space(3)))
typedef unsigned short bf16;
typedef unsigned v4u __attribute__((ext_vector_type(4)));
typedef unsigned v2u __attribute__((ext_vector_type(2)));
typedef float f32x4 __attribute__((ext_vector_type(4)));
typedef float f32x16 __attribute__((ext_vector_type(16)));
typedef short bf16x8 __attribute__((ext_vector_type(8)));
typedef short s16x4 __attribute__((ext_vector_type(4)));
typedef GAS unsigned gu32;
typedef _Float16 h2 __attribute__((ext_vector_type(2)));
typedef _Float16 f16x8 __attribute__((ext_vector_type(8)));
#define RLX_AGENT __ATOMIC_RELAXED, __HIP_MEMORY_SCOPE_AGENT
#define LDS_WAIT() asm volatile("s_waitcnt lgkmcnt(0)" ::: "memory")
#define VM_WAIT() asm volatile("s_waitcnt vmcnt(0)" ::: "memory")
__device__ __forceinline__ unsigned f2bf(float f) { unsigned u = __builtin_bit_cast(unsigned, f); return (u + 0x7fffu + ((u >> 16) & 1u)) >> 16; }
__device__ __forceinline__ unsigned pk2(float lo, float hi) { return f2bf(lo) | (f2bf(hi) << 16); }
__device__ __forceinline__ unsigned pkh(float lo, float hi) { h2 v; v.x = (_Float16)lo; v.y = (_Float16)hi; return __builtin_bit_cast(unsigned, v); }
__device__ __forceinline__ h2 u2h(unsigned u) { return __builtin_bit_cast(h2, u); }
__device__ __forceinline__ void fma_mix_lo(float& acc, unsigned hb, float a) { asm("v_fma_mix_f32 %0, %1, %2, %0 op_sel_hi:[1,0,0]" : "+v"(acc) : "v"(hb), "v"(a)); }
__device__ __forceinline__ void fma_mix_hi(float& acc, unsigned hb, float a) { asm("v_fma_mix_f32 %0, %1, %2, %0 op_sel:[1,0,0] op_sel_hi:[1,0,0]" : "+v"(acc) : "v"(hb), "v"(a)); }
__device__ __forceinline__ f16x8 v2f16x8(v4u v) { return __builtin_bit_cast(f16x8, v); }
__device__ __forceinline__ long v2l(v2u v) { return __builtin_bit_cast(long, v); }
__device__ __forceinline__ unsigned pk8(float a, float b, float c, float d) { int w = __builtin_amdgcn_cvt_pk_fp8_f32(a, b, 0, false); w = __builtin_amdgcn_cvt_pk_fp8_f32(c, d, w, true); return (unsigned)w; }
__device__ __forceinline__ float bf2f(unsigned b) { return __builtin_bit_cast(float, b << 16); }
__device__ __forceinline__ float bflo(unsigned w) { return __builtin_bit_cast(float, w << 16); }
__device__ __forceinline__ float bfhi(unsigned w) { return __builtin_bit_cast(float, w & 0xffff0000u); }
__device__ __forceinline__ int crow(int r, int hi) { return (r & 3) + 8 * (r >> 2) + 4 * hi; }
__device__ __forceinline__ float wave_sum(float v) {
#pragma unroll
    for (int o = 1; o < 64; o <<= 1) v += __shfl_xor(v, o);
    return v;
}
__device__ __forceinline__ float fmax_s(float a, float b) { float r; asm("v_max_f32_e32 %0, %1, %2" : "=v"(r) : "v"(a), "v"(b)); return r; }
__device__ __forceinline__ float fmin_s(float a, float b) { float r; asm("v_min_f32_e32 %0, %1, %2" : "=v"(r) : "v"(a), "v"(b)); return r; }

#define XB_TMO      128
#define XB_XCNT(j)  (256  + 64 * (j))
#define XB_XSUB(j)  (1280 + 64 * (j))
#define XB_XGEN(j)  (2304 + 64 * (j))
#define XB_TOP      3328
#define XB_TOPGEN   3392
#define XCD_BAR_WORDS 3456
#define XB_SPIN_CAP (1u << 18)

__device__ __forceinline__ unsigned xb_ld(unsigned* p)              { return __hip_atomic_load(p, __ATOMIC_RELAXED, __HIP_MEMORY_SCOPE_AGENT); }
__device__ __forceinline__ unsigned xb_add(unsigned* p, unsigned v) { return __hip_atomic_fetch_add(p, v, __ATOMIC_RELAXED, __HIP_MEMORY_SCOPE_AGENT); }
__device__ __forceinline__ unsigned xb_xcc_id() { return (unsigned)__builtin_amdgcn_s_getreg((3 << 11) | 20) & 0xFu; }
#define XB_SPIN(cond, bar) do { unsigned _sp = 0; while (cond) { __builtin_amdgcn_s_sleep(1); \
    if ((++_sp & 255u) == 0u) { if (xb_ld(&(bar)[XB_TMO])) break; if (_sp > XB_SPIN_CAP) { atomicAdd(&(bar)[XB_TMO], 1u); break; } } } } while (0)

struct XcdBarrier {
    unsigned* bar; unsigned x;
    volatile LAS unsigned* st;
};

__device__ __forceinline__ XcdBarrier xcd_barrier_post(unsigned* bar, volatile LAS unsigned* st) {
    XcdBarrier b; b.bar = bar; b.x = xb_xcc_id(); b.st = st;
    if (threadIdx.x == 0) (void)xb_add(&bar[XB_XCNT(b.x)], 1u);
    return b;
}
__device__ __forceinline__ void xcd_barrier_complete(unsigned* bar, unsigned x, unsigned& nloc, unsigned& nx) {
    const unsigned G = gridDim.x * gridDim.y * gridDim.z;
    unsigned sum, cnt, mine, sp = 0u;
    for (;;) {
        sum = 0u; cnt = 0u; mine = 0u;
#pragma unroll
        for (unsigned j = 0; j < 16; ++j) { const unsigned c = xb_ld(&bar[XB_XCNT(j)]); sum += c; cnt += (c > 0u) ? 1u : 0u; mine = (j == x) ? c : mine; }
        if (sum == G) break;
        __builtin_amdgcn_s_sleep(1);
        if ((++sp & 255u) == 0u) { if (xb_ld(&bar[XB_TMO])) break; if (sp > XB_SPIN_CAP) { atomicAdd(&bar[XB_TMO], 1u); break; } }
    }
    nloc = mine > 0u ? mine : 1u; nx = cnt > 0u ? cnt : 1u;
}

__device__ __forceinline__ void xcd_barrier(const XcdBarrier& b) {
    asm volatile("s_waitcnt vmcnt(0)" ::: "memory");
    __syncthreads();
    if (threadIdx.x == 0) {
        unsigned* bar = b.bar;
        __builtin_amdgcn_s_waitcnt(0);
        unsigned nloc = b.st[0], nx = b.st[1];
        if (nloc == 0u) { xcd_barrier_complete(bar, b.x, nloc, nx); b.st[0] = nloc; b.st[1] = nx; }
        const unsigned old = xb_add(&bar[XB_XSUB(b.x)], 1u);
        const unsigned gen = old / nloc;
        if (old + 1u == (gen + 1u) * nloc) {
            __builtin_amdgcn_fence(__ATOMIC_RELEASE, "agent");
            asm volatile("s_waitcnt vmcnt(0)" ::: "memory");
            const unsigned og = xb_add(&bar[XB_TOP], 1u);
            const unsigned tg = og / nx;
            if (og + 1u == (tg + 1u) * nx) xb_add(&bar[XB_TOPGEN], 1u);
            else XB_SPIN(xb_ld(&bar[XB_TOPGEN]) == tg, bar);
            __builtin_amdgcn_fence(__ATOMIC_ACQUIRE, "agent");
            xb_add(&bar[XB_XGEN(b.x)], 1u);
            asm volatile("s_waitcnt vmcnt(0)" ::: "memory");
        } else {
            XB_SPIN(xb_ld(&bar[XB_XGEN(b.x)]) == gen, bar);
            __builtin_amdgcn_fence(__ATOMIC_ACQUIRE, "agent");
            asm volatile("s_waitcnt vmcnt(0)" ::: "memory");
        }
    }
    __syncthreads();
}


__device__ __forceinline__ void transpose_item(const float* W, int pitch, int K, bf16* WT, int row_off, LAS float* scr, int kb, int nb, int lane, const float* ksc = nullptr) {
    const int k0 = 64 * kb, n0 = 32 * nb;
#pragma unroll 8
    for (int i = 0; i < 32; ++i) { const int kk = 2 * i + (lane >> 5); const float w_ = W[(size_t)(k0 + kk) * pitch + n0 + (lane & 31)]; scr[kk * 33 + (lane & 31)] = ksc ? w_ * ksc[k0 + kk] : w_; }
    LDS_WAIT(); asm volatile("" ::: "memory");
    const int c = lane & 7;
#pragma unroll
    for (int j = 0; j < 4; ++j) { const int n = (lane >> 3) + 8 * j; const LAS float* s = scr + (8 * c) * 33 + n;
        v4u o; o.x = pk2(s[0 * 33], s[1 * 33]); o.y = pk2(s[2 * 33], s[3 * 33]); o.z = pk2(s[4 * 33], s[5 * 33]); o.w = pk2(s[6 * 33], s[7 * 33]);
        *(GAS v4u*)(WT + (size_t)(row_off + n0 + n) * K + k0 + 8 * c) = o; }
    LDS_WAIT(); asm volatile("" ::: "memory");
}
template <bool HALF_COPY> __device__ __forceinline__ void rms_row_to_bf16(const float* xrow, const float* gain, bf16* orow, LAS unsigned char* hrow, int lane) {
    const GAS f32x4* xr = (const GAS f32x4*)xrow + lane; const GAS f32x4* gr = (const GAS f32x4*)gain + lane;
    f32x4 v[4]; float s = 0.f;
#pragma unroll
    for (int j = 0; j < 4; ++j) { v[j] = xr[64 * j]; s += (v[j].x * v[j].x + v[j].y * v[j].y) + (v[j].z * v[j].z + v[j].w * v[j].w); }
    const float rstd = 1.f / sqrtf(wave_sum(s) * (1.f / DMODEL) + RMS_EPS);
    GAS unsigned long long* o8 = (GAS unsigned long long*)orow + lane;
#pragma unroll
    for (int j = 0; j < 4; ++j) { const f32x4 g = gr[64 * j];
        o8[64 * j] = (unsigned long long)pk2(v[j].x * rstd * g.x, v[j].y * rstd * g.y) | ((unsigned long long)pk2(v[j].z * rstd * g.z, v[j].w * rstd * g.w) << 32);
        if (HALF_COPY) ((LAS unsigned*)hrow + lane)[64 * j] = pk8(v[j].x * rstd * g.x, v[j].y * rstd * g.y, v[j].z * rstd * g.z, v[j].w * rstd * g.w); }
}

template <int S> __device__ __forceinline__ int shfl_xor_c(int v) {
    if constexpr (S == 1) return __builtin_amdgcn_mov_dpp(v, 0xB1, 0xF, 0xF, true);
    else if constexpr (S == 2) return __builtin_amdgcn_mov_dpp(v, 0x4E, 0xF, 0xF, true);
    else if constexpr (S == 4) return __builtin_amdgcn_mov_dpp(__builtin_amdgcn_mov_dpp(v, 0x1B, 0xF, 0xF, true), 0x141, 0xF, 0xF, true);
    else if constexpr (S == 8) return __builtin_amdgcn_mov_dpp(__builtin_amdgcn_mov_dpp(v, 0x141, 0xF, 0xF, true), 0x140, 0xF, 0xF, true);
    else return __shfl_xor(v, S);
}
template <int SIZE, int STRIDE> __device__ __forceinline__ void sort128_level(int& k0, int& k1, int lane) {
    if constexpr (STRIDE == 64) { const int mn = min(k0, k1), mxv = max(k0, k1); k0 = mn; k1 = mxv; }
    else {
        const bool lower = (lane & STRIDE) == 0;
        { const int o = shfl_xor_c<STRIDE>(k0); const bool up = ((lane & SIZE) == 0); k0 = (lower == up) ? min(k0, o) : max(k0, o); }
        { const int o = shfl_xor_c<STRIDE>(k1); const bool up = (((64 + lane) & SIZE) == 0); k1 = (lower == up) ? min(k1, o) : max(k1, o); }
    }
}
template <int SIZE, int STRIDE> __device__ __forceinline__ void sort128_merge(int& k0, int& k1, int lane) {
    sort128_level<SIZE, STRIDE>(k0, k1, lane);
    if constexpr (STRIDE > 1) sort128_merge<SIZE, STRIDE / 2>(k0, k1, lane);
}
template <int SIZE> __device__ __forceinline__ void sort128_from(int& k0, int& k1, int lane) {
    sort128_merge<SIZE, SIZE / 2>(k0, k1, lane);
    if constexpr (SIZE < 128) sort128_from<SIZE * 2>(k0, k1, lane);
}

__device__ __forceinline__ void ce_desc(float& a, float& b) { const float mx = fmax_s(a, b), mn = fmin_s(a, b); a = mx; b = mn; }
__device__ __forceinline__ void sort16_desc(float (&v)[16]) {
#pragma unroll
    for (int k = 2; k <= 16; k <<= 1) {
#pragma unroll
        for (int j = k >> 1; j > 0; j >>= 1) {
#pragma unroll
            for (int i = 0; i < 16; ++i) { const int l = i ^ j; if (l > i) { if ((i & k) == 0) ce_desc(v[i], v[l]); else ce_desc(v[l], v[i]); } }
        }
    }
}
__device__ __forceinline__ void merge16_desc(float (&a)[16], const float (&b)[16]) {
#pragma unroll
    for (int i = 0; i < 16; ++i) a[i] = fmax_s(a[i], b[15 - i]);
#pragma unroll
    for (int j = 8; j > 0; j >>= 1) {
#pragma unroll
        for (int i = 0; i < 16; ++i) { const int l = i ^ j; if (l > i) ce_desc(a[i], a[l]); }
    }
}
__device__ __forceinline__ float gelu_erf(float v) {
    const float av = fabsf(v), t = __builtin_amdgcn_rcpf(av * 0.2316418882f + 1.0f);
    float q = t * 0.5307027145f + (-0.7265760135f); q = q * t + 0.7107068705f; q = q * t + (-0.142248368f); q = q * t + 0.127414796f; q = q * t;
    const float e = __builtin_amdgcn_exp2f((v * v) * (-0.72134752044f));
    const float m = v * (q * e);
    return v < 0.f ? m : v - m;
}

struct Args { const void* in[20]; float* out; unsigned char* ws; int ph_lo, ph_hi, li, pad; };
__global__ void __launch_bounds__(NWAVES * 64, 2) hymba_fwd(Args args) {
    extern __shared__ __attribute__((aligned(16))) unsigned char lds[];
    LAS unsigned char* const ldsl = (LAS unsigned char*)lds;
    volatile LAS unsigned* const MISC = (volatile LAS unsigned*)(ldsl + MISC_OFF);
    const int tid = threadIdx.x, lane = tid & 63, wave = __builtin_amdgcn_readfirstlane(tid >> 6);
    const int G = gridDim.x; const int bx = blockIdx.x; const int vcu = (G % 8 == 0) ? (bx % 8) * (G / 8) + bx / 8 : bx;
    const int gw = vcu * NWAVES + wave, NGW = G * NWAVES;
    const int gt = vcu * (NWAVES * 64) + tid, NGT = G * NWAVES * 64;
    const int r32 = lane & 31, hi = lane >> 5;
#define PHASE_LOCALS int tid_o_ = threadIdx.x; asm volatile("" : "+v"(tid_o_)); const int tid = tid_o_, lane = tid & 63, r32 = lane & 31, hi = lane >> 5; const int gt = vcu * (NWAVES * 64) + tid; (void)r32; (void)hi; (void)gt; (void)lane;
    unsigned char* const ws = args.ws;
    gu32* const ctl = (gu32*)(ws + WS_CTL);
    const float* x = (const float*)args.in[0]; const int* positions = (const int*)args.in[1]; const float* g_mix = (const float*)args.in[2]; const float* w_in = (const float*)args.in[3];
    const float* w_gate = (const float*)args.in[4]; const float* b_gate = (const float*)args.in[5]; const float* g_gla_out = (const float*)args.in[6]; const float* g_q = (const float*)args.in[7];
    const float* g_k = (const float*)args.in[8]; const float* lq1 = (const float*)args.in[9]; const float* lk1 = (const float*)args.in[10]; const float* lq2 = (const float*)args.in[11];
    const float* lk2 = (const float*)args.in[12]; const float* g_sub = (const float*)args.in[13]; const float* w_out = (const float*)args.in[14]; const float* g_ffn = (const float*)args.in[15];
    const float* w_pq = (const float*)args.in[16]; const float* sub_keys = (const float*)args.in[17]; const float* peer_u = (const float*)args.in[18]; const float* peer_v = (const float*)args.in[19];
    float* const out = args.out;
    bf16* const Win_t = (bf16*)(ws + WS_WIN); bf16* const Wout_t = (bf16*)(ws + WS_WOUT); bf16* const Wq_t = (bf16*)(ws + WS_WQ); bf16* const KEYS = (bf16*)(ws + WS_KEYS);
    bf16* const KVT = (bf16*)(ws + WS_KVT); bf16* const VT = (bf16*)(ws + WS_VT); bf16* const UB = (bf16*)(ws + WS_U); bf16* const VB = (bf16*)(ws + WS_V);
    bf16* const XN = (bf16*)(ws + WS_XN); bf16* const MIX = (bf16*)(ws + WS_MIX); bf16* const PROJ = (bf16*)(ws + WS_PROJ); bf16* const XN2 = (bf16*)(ws + WS_XN2);
    bf16* const QP = (bf16*)(ws + WS_QP); bf16* const OAT = (bf16*)(ws + WS_O); int* const IDX = (int*)(ws + WS_IDX);
    unsigned* const SGE = (unsigned*)(ws + WS_SGE); unsigned* const AE = (unsigned*)(ws + WS_AE); unsigned char* const OFFS = ws + WS_OFFS; bf16* const XT = (bf16*)(ws + WS_XT); unsigned* const AE2 = (unsigned*)(ws + WS_AE2); unsigned char* const CNT = ws + WS_CNT;
    bf16* const UH = UB; bf16* const VH = VB;
    float* const SSP = (float*)(ws + WS_SSP); float* const RSTD = (float*)(ws + WS_RSTD);
    bf16* const KTT = (bf16*)(ws + WS_KTT); float* const DEC = (float*)(ws + WS_DEC); float* const ROPE_C = (float*)(ws + WS_ROPE); float* const ROPE_S = ROPE_C + TOK * 8;

    for (int u = tid; u < (LDS_BYTES - LDSCTL_OFF) / 4; u += NWAVES * 64) ((LAS unsigned*)(ldsl + LDSCTL_OFF))[u] = 0u;
    __syncthreads();
    XcdBarrier bar; bar.bar = (unsigned*)(ctl + CW_BAR); bar.x = 0; bar.st = nullptr;
    if (N_LAUNCHES == 1) bar = xcd_barrier_post((unsigned*)(ctl + CW_BAR), MISC + 8);
#define GRID_BAR() do { if (N_LAUNCHES == 1) { xcd_barrier(bar); } } while (0)
    const int lo = args.ph_lo, hi_ph = args.ph_hi;
#ifndef PHASE_MASK
#define PHASE_MASK 0x1fff
#endif
#define IN(k) (((PHASE_MASK >> (k)) & 1) && lo <= (k) && (k) < hi_ph)
#define BOTH(k) (IN(k) && IN((k) + 1))

    if (IN(0)) {
        PHASE_LOCALS
        LAS float* scr = (LAS float*)(ldsl + RING_OFF + wave * 16384);
        for (int it = gw; it < 3072; it += NGW) {
            int r = it;
            if (r < 512) { transpose_item(w_in, IN_W, DMODEL, Win_t, 0, scr, r >> 5, r & 31, lane); continue; } r -= 512;
            if (r < 1024) { transpose_item(w_in + 1040, IN_W, DMODEL, Win_t, 1280, scr, r >> 6, r & 63, lane); continue; } r -= 1024;
            if (r < 512) { transpose_item(w_out, DMODEL, DMODEL, Wout_t, 0, scr, r >> 5, r & 31, lane); continue; } r -= 512;
            transpose_item(w_pq, NQP, DMODEL, Wq_t, 0, scr, r >> 6, r & 63, lane, g_ffn);
        }
        for (int task = gt; task < 32768; task += NGT) {
            const int n = task >> 7, k0 = (task & 127) * 8;
            float wg[16];
#pragma unroll
            for (int r = 0; r < 16; ++r) wg[r] = w_gate[r * 256 + n];
            float acc[8];
#pragma unroll
            for (int j = 0; j < 8; ++j) { const f32x4* wr = (const f32x4*)(w_in + (size_t)(k0 + j) * IN_W + 1024); float a = 0.f;
#pragma unroll
                for (int q = 0; q < 4; ++q) { const f32x4 w4 = wr[q]; a += w4.x * wg[4 * q] + w4.y * wg[4 * q + 1] + w4.z * wg[4 * q + 2] + w4.w * wg[4 * q + 3]; }
                acc[j] = a; }
            v4u o; o.x = pk2(acc[0], acc[1]); o.y = pk2(acc[2], acc[3]); o.z = pk2(acc[4], acc[5]); o.w = pk2(acc[6], acc[7]);
            *(v4u*)(Win_t + (size_t)(1024 + n) * DMODEL + k0) = o;
        }
        for (int task = gt; task < 32768; task += NGT) {
            const f32x4 a = ((const f32x4*)sub_keys)[2 * task], b = ((const f32x4*)sub_keys)[2 * task + 1];
            v4u o; o.x = pk2(a.x, a.y); o.y = pk2(a.z, a.w); o.z = pk2(b.x, b.y); o.w = pk2(b.z, b.w); ((v4u*)KEYS)[task] = o;
        }
        for (int task = gt; task < TOK * 8; task += NGT) {
            const int t = task >> 3, i = task & 7;
            const double invf[8] = {1.0, 0.19392274474868576, 0.03760603093086393, 0.007292664737217109, 0.001414213562373095, 0.0002742481756762073, 5.318295896944988e-05, 1.031338537721246e-05};
            double inv = invf[0];
#pragma unroll
            for (int q = 1; q < 8; ++q) inv = (i == q) ? invf[q] : inv;
            const double ang = (double)positions[t] * inv;
            const double rr = ang - 6.283185307179586 * rint(ang * 0.15915494309189535);
            const float rf = (float)rr;
            ROPE_C[task] = cosf(rf); ROPE_S[task] = sinf(rf);
        }
        {
            f32x4 gg[4], vn[4];
#pragma unroll
            for (int j = 0; j < 4; ++j) { gg[j] = ((const f32x4*)g_mix)[lane + 64 * j]; vn[j] = ((const f32x4*)(x + (size_t)gw * DMODEL))[lane + 64 * j]; }
            for (int m = gw; m < TOK; m += NGW) {
                f32x4 v[4]; float sq = 0.f;
#pragma unroll
                for (int j = 0; j < 4; ++j) { v[j] = vn[j]; sq += (v[j].x * v[j].x + v[j].y * v[j].y) + (v[j].z * v[j].z + v[j].w * v[j].w); }
                const int mn = (m + NGW < TOK) ? m + NGW : m;
#pragma unroll
                for (int j = 0; j < 4; ++j) vn[j] = ((const f32x4*)(x + (size_t)mn * DMODEL))[lane + 64 * j];
                const float rstd = 1.f / sqrtf(wave_sum(sq) * (1.f / DMODEL) + RMS_EPS);
                unsigned long long* o8 = (unsigned long long*)(XN + (size_t)m * DMODEL) + lane;
#pragma unroll
                for (int j = 0; j < 4; ++j) o8[64 * j] = (unsigned long long)pk2(v[j].x * rstd * gg[j].x, v[j].y * rstd * gg[j].y) | ((unsigned long long)pk2(v[j].z * rstd * gg[j].z, v[j].w * rstd * gg[j].w) << 32);
            }
        }
        if (BOTH(0)) GRID_BAR();
    }

    if (IN(1)) {
        PHASE_LOCALS
        pg8::Gemm g{XN, Win_t, TOK, NPROJ, DMODEL}; pg8::StaticOrder S; S.init(TOK, NPROJ, G, (int)blockIdx.x);
        pg8::EpiBf16<0> E{PROJ, NPROJ, nullptr, 0, 0, 1.f};
        pg8::gemm_phase<pg8::EpiBf16<0>, pg8::StaticOrder, PG8_ALIGN, PG8_SP2>(ldsl + RING_OFF, g, S, E);
        if (BOTH(1)) GRID_BAR();
    }

    if (IN(2)) {
        PHASE_LOCALS
        for (int u = gw; u < NUNIT; u += NGW) {
            const int g = u >> 2, h = u & 3; const int su = ((g >> 7) * 4 + h) * 128 + (g & 127);
            bf16* const rowp = PROJ + (size_t)(g * 64) * NPROJ;
            const float bg = b_gate[h * 64 + lane];
            float bsum = 0.f;
            unsigned ktt[32], vt0[32], vt1[32];
#pragma unroll
            for (int c0 = 0; c0 < 64; c0 += 16) {
                unsigned zz[16], qq[16], kk[16], va[16], vb[16];
#pragma unroll
                for (int j = 0; j < 16; ++j) { const bf16* const r = rowp + (size_t)(c0 + j) * NPROJ;
                    zz[j] = r[C_GZ + h * 64 + lane]; qq[j] = r[C_GQ + h * 64 + lane]; kk[j] = r[C_GK + h * 64 + lane]; va[j] = r[C_GV + h * 128 + lane]; vb[j] = r[C_GV + h * 128 + 64 + lane]; }
#pragma unroll
                for (int j = 0; j < 16; ++j) { const int c = c0 + j;
                    bf16* const r = rowp + (size_t)c * NPROJ;
                    const float z = bf2f(zz[j]) + bg;
                    const float ls = fminf(z, 0.f) - __logf(1.f + __expf(-fabsf(z)));
                    bsum += ls * (1.f / 16.f);
                    const float eb = __expf(bsum), ebi = __expf(-bsum);
                    const float q = bf2f(qq[j]) * 0.125f * eb;
                    const float kt = bf2f(kk[j]) * ebi;
                    const unsigned ktb = f2bf(kt);
                    r[C_GQ + h * 64 + lane] = (bf16)f2bf(q); r[C_GK + h * 64 + lane] = (bf16)ktb;
                    const unsigned v0 = va[j], v1 = vb[j];
                    if (c & 1) { ktt[c >> 1] |= ktb << 16; vt0[c >> 1] |= v0 << 16; vt1[c >> 1] |= v1 << 16; }
                    else { ktt[c >> 1] = ktb; vt0[c >> 1] = v0; vt1[c >> 1] = v1; }
                }
            }
            DEC[su * 64 + lane] = __expf(bsum);
            v4u* kp = (v4u*)(KTT + ((size_t)u * 64 + lane) * 64); v4u* vp0 = (v4u*)(VT + ((size_t)u * 128 + lane) * 64); v4u* vp1 = (v4u*)(VT + ((size_t)u * 128 + 64 + lane) * 64);
#pragma unroll
            for (int q = 0; q < 8; ++q) { kp[q] = (v4u){ktt[4 * q], ktt[4 * q + 1], ktt[4 * q + 2], ktt[4 * q + 3]};
                vp0[q] = (v4u){vt0[4 * q], vt0[4 * q + 1], vt0[4 * q + 2], vt0[4 * q + 3]}; vp1[q] = (v4u){vt1[4 * q], vt1[4 * q + 1], vt1[4 * q + 2], vt1[4 * q + 3]}; }
        }
        {
            const int v = lane >> 2, qd = lane & 3;
            const int col = (v < 8 ? C_DQ + v * 64 : C_DK + (v - 8) * 64) + qd * 16;
            const float* gp = (v < 8 ? g_q : g_k) + qd * 16;
            float gn[16];
#pragma unroll
            for (int i = 0; i < 16; ++i) gn[i] = gp[i];
            const float osc = (v < 8) ? attn_body::C2 : 1.f;
            v4u w0 = ((const v4u*)(PROJ + (size_t)gw * NPROJ + col))[0], w1 = ((const v4u*)(PROJ + (size_t)gw * NPROJ + col))[1];
            f32x4 rc0 = *(const f32x4*)(ROPE_C + gw * 8), rc1 = *(const f32x4*)(ROPE_C + gw * 8 + 4), rs0 = *(const f32x4*)(ROPE_S + gw * 8), rs1 = *(const f32x4*)(ROPE_S + gw * 8 + 4);
            for (int t = gw; t < TOK; t += NGW) {
                v4u* p = (v4u*)(PROJ + (size_t)t * NPROJ + col);
                const int tn = (t + NGW < TOK) ? t + NGW : t;
                const v4u* pn = (const v4u*)(PROJ + (size_t)tn * NPROJ + col);
                const v4u n0 = pn[0], n1 = pn[1];
                const f32x4 c0 = rc0, c1 = rc1, s0 = rs0, s1 = rs1;
                rc0 = *(const f32x4*)(ROPE_C + tn * 8); rc1 = *(const f32x4*)(ROPE_C + tn * 8 + 4); rs0 = *(const f32x4*)(ROPE_S + tn * 8); rs1 = *(const f32x4*)(ROPE_S + tn * 8 + 4);
                float y[16];
                y[0] = bflo(w0.x); y[1] = bfhi(w0.x); y[2] = bflo(w0.y); y[3] = bfhi(w0.y); y[4] = bflo(w0.z); y[5] = bfhi(w0.z); y[6] = bflo(w0.w); y[7] = bfhi(w0.w);
                y[8] = bflo(w1.x); y[9] = bfhi(w1.x); y[10] = bflo(w1.y); y[11] = bfhi(w1.y); y[12] = bflo(w1.z); y[13] = bfhi(w1.z); y[14] = bflo(w1.w); y[15] = bfhi(w1.w);
                float ss = 0.f;
#pragma unroll
                for (int i = 0; i < 16; ++i) ss += y[i] * y[i];
                ss += __shfl_xor(ss, 1); ss += __shfl_xor(ss, 2);
                const float rstd = 1.f / sqrtf(ss * (1.f / 64.f) + RMS_EPS);
#pragma unroll
                for (int i = 0; i < 16; ++i) y[i] = y[i] * rstd * gn[i];
                if (qd == 0) {
                    const float cs[8] = {c0.x, c0.y, c0.z, c0.w, c1.x, c1.y, c1.z, c1.w}, sn[8] = {s0.x, s0.y, s0.z, s0.w, s1.x, s1.y, s1.z, s1.w};
#pragma unroll
                    for (int i = 0; i < 8; ++i) { const float a = y[i], b = y[i + 8]; y[i] = a * cs[i] - b * sn[i]; y[i + 8] = b * cs[i] + a * sn[i]; }
                }
#pragma unroll
                for (int i = 0; i < 16; ++i) y[i] *= osc;
                p[0] = (v4u){pk2(y[0], y[1]), pk2(y[2], y[3]), pk2(y[4], y[5]), pk2(y[6], y[7])};
                p[1] = (v4u){pk2(y[8], y[9]), pk2(y[10], y[11]), pk2(y[12], y[13]), pk2(y[14], y[15])};
                w0 = n0; w1 = n1;
            }
        }
        if (BOTH(2)) GRID_BAR();
    }

    if (IN(3)) {
        PHASE_LOCALS
        for (int L = vcu; L < 1024; L += G) {
            const int vv = L & 255, i = L >> 8, s = vv & 7, bh = vv >> 3;
            const int qb = (i == 0) ? s : (i == 1) ? 15 - s : (i == 2) ? 16 + s : 31 - s;
            const int b = bh >> 3, hh = (bh & 7) >> 1, mp = bh & 1;
            attn_body2::attn_unit<8>(b, C_DQ + (hh * 2 + mp) * 64, C_DK + (hh * 2 + mp) * 64, C_DV + hh * 128, (hh * 2 + mp) * 128, qb,
                                     (const attn_body2::bf16*)PROJ, (const attn_body2::bf16*)PROJ, (const attn_body2::bf16*)PROJ, (attn_body2::bf16*)OAT, (char*)lds + RING_OFF);
        }
        for (int u = gw; u < NUNIT; u += NGW) {
            const int g = u >> 2, h = u & 3; const int su = ((g >> 7) * 4 + h) * 128 + (g & 127);
            const bf16* vt = VT + (size_t)u * 8192; const bf16* kt = KTT + (size_t)u * 4096;
            f32x16 acc[4][2];
#pragma unroll
            for (int a = 0; a < 4; ++a) { acc[a][0] = f32x16{}; acc[a][1] = f32x16{}; }
#pragma unroll
            for (int k2 = 0; k2 < 4; k2 += 2) {
                bf16x8 af[2][4], bfr[2][2];
#pragma unroll
                for (int kq = 0; kq < 2; ++kq) { const int ks = k2 + kq;
#pragma unroll
                    for (int et = 0; et < 4; ++et) af[kq][et] = *(const bf16x8*)(vt + (et * 32 + r32) * 64 + ks * 16 + hi * 8);
#pragma unroll
                    for (int dt = 0; dt < 2; ++dt) bfr[kq][dt] = *(const bf16x8*)(kt + (dt * 32 + r32) * 64 + ks * 16 + hi * 8); }
                __builtin_amdgcn_sched_barrier(0);
#pragma unroll
                for (int kq = 0; kq < 2; ++kq)
#pragma unroll
                    for (int et = 0; et < 4; ++et)
#pragma unroll
                        for (int dt = 0; dt < 2; ++dt) acc[et][dt] = __builtin_amdgcn_mfma_f32_32x32x16_bf16(af[kq][et], bfr[kq][dt], acc[et][dt], 0, 0, 0);
            }
            bf16* const kv = KVT + (size_t)su * 8192;
#pragma unroll
            for (int dt = 0; dt < 2; ++dt) { const float dc = DEC[su * 64 + dt * 32 + r32];
#pragma unroll
                for (int et = 0; et < 4; ++et)
#pragma unroll
                    for (int r = 0; r < 16; ++r) kv[(et * 32 + crow(r, hi)) * 64 + dt * 32 + r32] = (bf16)f2bf(acc[et][dt][r] * dc); }
        }
        if (BOTH(3)) GRID_BAR();
    }

    if (IN(4)) {
        PHASE_LOCALS
        for (int el = gt; el < 16 * 8192; el += NGT) {
            const int bh = el >> 13, ed = el & 8191, d = ed & 63;
            bf16* p = KVT + (size_t)bh * 128 * 8192 + ed; const float* dp = DEC + bh * 128 * 64 + d;
            float s = 0.f;
            unsigned kva[16], kvb[16]; float dca[16], dcb[16];
#define SCAN_LOAD(KV_, DC_, n0_) do { _Pragma("unroll") for (int j = 0; j < 16; ++j) { KV_[j] = p[(size_t)((n0_) + j) * 8192]; DC_[j] = dp[((n0_) + j) * 64]; } } while (0)
#define SCAN_RUN(KV_, DC_, n0_) do { _Pragma("unroll") for (int j = 0; j < 16; ++j) { const float o = s; s = DC_[j] * s + bf2f(KV_[j]); p[(size_t)((n0_) + j) * 8192] = (bf16)f2bf(o); } } while (0)
            SCAN_LOAD(kva, dca, 0);
#pragma unroll 1
            for (int n0 = 0; n0 < 128; n0 += 32) {
                SCAN_LOAD(kvb, dcb, n0 + 16);
                SCAN_RUN(kva, dca, n0);
                if (n0 + 32 < 128) SCAN_LOAD(kva, dca, n0 + 32);
                SCAN_RUN(kvb, dcb, n0 + 16);
            }
#undef SCAN_LOAD
#undef SCAN_RUN
        }
        if (BOTH(4)) GRID_BAR();
    }

    if (IN(5)) {
        PHASE_LOCALS
        for (int u = gw; u < NUNIT; u += NGW) {
            const int g = u >> 2, h = u & 3; const int su = ((g >> 7) * 4 + h) * 128 + (g & 127);
            const bf16* vt = VT + (size_t)u * 8192; const bf16* st = KVT + (size_t)su * 8192;
            const bf16* qtp = PROJ + (size_t)(g * 64) * NPROJ + C_GQ + h * 64; const bf16* ktp = PROJ + (size_t)(g * 64) * NPROJ + C_GK + h * 64;
#pragma unroll
            for (int ct = 0; ct < 2; ++ct) {
                bf16x8 qf[4];
#pragma unroll
                for (int ks = 0; ks < 4; ++ks) qf[ks] = *(const bf16x8*)(qtp + (size_t)(ct * 32 + r32) * NPROJ + ks * 16 + hi * 8);
                f32x16 o[4];
#pragma unroll
                for (int et = 0; et < 4; ++et) o[et] = f32x16{};
                bf16x8 sf[4][4], kfa[2][4];
#pragma unroll
                for (int ks = 0; ks < 4; ++ks)
#pragma unroll
                    for (int et = 0; et < 4; ++et) sf[ks][et] = *(const bf16x8*)(st + (et * 32 + r32) * 64 + ks * 16 + hi * 8);
#pragma unroll
                for (int stl = 0; stl <= ct; ++stl)
#pragma unroll
                    for (int ks = 0; ks < 4; ++ks) kfa[stl][ks] = *(const bf16x8*)(ktp + (size_t)(stl * 32 + r32) * NPROJ + ks * 16 + hi * 8);
                __builtin_amdgcn_sched_barrier(0);
#pragma unroll
                for (int ks = 0; ks < 4; ++ks)
#pragma unroll
                    for (int et = 0; et < 4; ++et) o[et] = __builtin_amdgcn_mfma_f32_32x32x16_bf16(sf[ks][et], qf[ks], o[et], 0, 0, 0);
#pragma unroll
                for (int stl = 0; stl <= ct; ++stl) {
                    v4u vfa[2][4];
#pragma unroll
                    for (int kk = 0; kk < 2; ++kk)
#pragma unroll
                        for (int et = 0; et < 4; ++et) { const bf16* ap = vt + (et * 32 + r32) * 64 + stl * 32 + 16 * kk + 4 * hi;
                            const v2u a0 = *(const v2u*)ap, a1 = *(const v2u*)(ap + 8); vfa[kk][et] = (v4u){a0.x, a0.y, a1.x, a1.y}; }
                    __builtin_amdgcn_sched_barrier(0);
                    f32x16 xx = f32x16{};
#pragma unroll
                    for (int ks = 0; ks < 4; ++ks) xx = __builtin_amdgcn_mfma_f32_32x32x16_bf16(kfa[stl][ks], qf[ks], xx, 0, 0, 0);
                    if (stl == ct) {
#pragma unroll
                        for (int r = 0; r < 16; ++r) if (crow(r, hi) > r32) xx[r] = 0.f;
                    }
#pragma unroll
                    for (int kk = 0; kk < 2; ++kk) {
                        v4u w; w.x = pk2(xx[8 * kk], xx[8 * kk + 1]); w.y = pk2(xx[8 * kk + 2], xx[8 * kk + 3]); w.z = pk2(xx[8 * kk + 4], xx[8 * kk + 5]); w.w = pk2(xx[8 * kk + 6], xx[8 * kk + 7]);
                        const bf16x8 pb = __builtin_bit_cast(bf16x8, w);
#pragma unroll
                        for (int et = 0; et < 4; ++et) o[et] = __builtin_amdgcn_mfma_f32_32x32x16_bf16(__builtin_bit_cast(bf16x8, vfa[kk][et]), pb, o[et], 0, 0, 0);
                    }
                }
                float ss = 0.f;
#pragma unroll
                for (int et = 0; et < 4; ++et)
#pragma unroll
                    for (int r = 0; r < 16; ++r) ss += o[et][r] * o[et][r];
                ss += __shfl_xor(ss, 32);
                const float rstd = 1.f / sqrtf(ss * (1.f / 128.f) + RMS_EPS);
                const int t = g * 64 + ct * 32 + r32;
                v2u gwa[16]; f32x4 goa[16];
#pragma unroll
                for (int i = 0; i < 16; ++i) { const int e0 = (i >> 2) * 32 + 8 * (i & 3) + 4 * hi; gwa[i] = *(const v2u*)(PROJ + (size_t)t * NPROJ + C_GR + h * 128 + e0); goa[i] = *(const f32x4*)(g_gla_out + e0); }
#pragma unroll
                for (int et = 0; et < 4; ++et)
#pragma unroll
                    for (int q4 = 0; q4 < 4; ++q4) {
                        const int e0 = et * 32 + 8 * q4 + 4 * hi;
                        const v2u gw2 = gwa[et * 4 + q4];
                        const f32x4 go = goa[et * 4 + q4];
                        const float gr0 = bflo(gw2.x), gr1 = bfhi(gw2.x), gr2 = bflo(gw2.y), gr3 = bfhi(gw2.y);
                        const float y0 = o[et][4 * q4] * rstd * go.x * (gr0 / (1.f + __expf(-gr0)));
                        const float y1 = o[et][4 * q4 + 1] * rstd * go.y * (gr1 / (1.f + __expf(-gr1)));
                        const float y2 = o[et][4 * q4 + 2] * rstd * go.z * (gr2 / (1.f + __expf(-gr2)));
                        const float y3 = o[et][4 * q4 + 3] * rstd * go.w * (gr3 / (1.f + __expf(-gr3)));
                        *(v2u*)(MIX + (size_t)t * DMODEL + h * 128 + e0) = (v2u){pk2(y0, y1), pk2(y2, y3)};
                    }
            }
        }
        {
            const float s1 = wave_sum(lq1[lane] * lk1[lane]), s2 = wave_sum(lq2[lane] * lk2[lane]);
            const float lam = expf(s1) - expf(s2) + LAMBDA_INIT;
            const int hh = lane >> 4, e0 = (lane & 15) * 8;
            const f32x4 ga = *(const f32x4*)(g_sub + e0), gb = *(const f32x4*)(g_sub + e0 + 4);
            const float gs[8] = {ga.x, ga.y, ga.z, ga.w, gb.x, gb.y, gb.z, gb.w};
            v4u a = *(const v4u*)(OAT + (size_t)gw * 2048 + (hh * 2) * 128 + e0), b = *(const v4u*)(OAT + (size_t)gw * 2048 + (hh * 2 + 1) * 128 + e0);
            for (int t = gw; t < TOK; t += NGW) {
                const int tn = (t + NGW < TOK) ? t + NGW : t;
                const v4u an = *(const v4u*)(OAT + (size_t)tn * 2048 + (hh * 2) * 128 + e0), bn = *(const v4u*)(OAT + (size_t)tn * 2048 + (hh * 2 + 1) * 128 + e0);
                float y[8];
                y[0] = bflo(a.x) - lam * bflo(b.x); y[1] = bfhi(a.x) - lam * bfhi(b.x); y[2] = bflo(a.y) - lam * bflo(b.y); y[3] = bfhi(a.y) - lam * bfhi(b.y);
                y[4] = bflo(a.z) - lam * bflo(b.z); y[5] = bfhi(a.z) - lam * bfhi(b.z); y[6] = bflo(a.w) - lam * bflo(b.w); y[7] = bfhi(a.w) - lam * bfhi(b.w);
                float ss = 0.f;
#pragma unroll
                for (int i = 0; i < 8; ++i) ss += y[i] * y[i];
                ss += __shfl_xor(ss, 1); ss += __shfl_xor(ss, 2); ss += __shfl_xor(ss, 4); ss += __shfl_xor(ss, 8);
                const float rstd = (1.f - LAMBDA_INIT) / sqrtf(ss * (1.f / 128.f) + RMS_EPS);
#pragma unroll
                for (int i = 0; i < 8; ++i) y[i] = y[i] * rstd * gs[i];
                *(v4u*)(MIX + (size_t)t * DMODEL + 512 + hh * 128 + e0) = (v4u){pk2(y[0], y[1]), pk2(y[2], y[3]), pk2(y[4], y[5]), pk2(y[6], y[7])};
                a = an; b = bn;
            }
        }
        if (BOTH(5)) GRID_BAR();
    }

    if (IN(6)) {
        PHASE_LOCALS
        constexpr int NVT = PEER_N * DMODEL / 8, NUT = PEER_N * DMODEL / 16;
        for (int task0 = gt; task0 < NVT; task0 += 4 * NGT) {
            f32x4 a[4], b[4]; int oo[4];
#pragma unroll
            for (int j = 0; j < 4; ++j) { const int o = task0 + j * NGT; oo[j] = o; if (o < NVT) { const int sl_ = o >> 17, r_ = (o >> 3) & (PEER_N - 1), c_ = o & 7;
                const int e_ = ((((r_ >> 7) - (r_ & 127)) & 127) << 7) | (r_ & 127);
                const f32x4* src = (const f32x4*)peer_v + (size_t)e_ * 256 + (sl_ * 8 + c_) * 2; a[j] = src[0]; b[j] = src[1]; } }
#pragma unroll
            for (int j = 0; j < 4; ++j) if (oo[j] < NVT) ((v4u*)VB)[oo[j]] = (v4u){pkh(a[j].x, a[j].y), pkh(a[j].z, a[j].w), pkh(b[j].x, b[j].y), pkh(b[j].z, b[j].w)};
        }
        for (int task0 = gt; task0 < NUT; task0 += 2 * NGT) {
            f32x4 a[2], b[2], c[2], d[2], ga[2], gb[2], gc[2], gd[2]; int oo[2];
#pragma unroll
            for (int j = 0; j < 2; ++j) { const int o = task0 + j * NGT; oo[j] = o; if (o < NUT) { const int sl_ = o >> 16, r_ = (o >> 2) & (PEER_N - 1), c_ = o & 3;
                const int e_ = ((((r_ >> 7) - (r_ & 127)) & 127) << 7) | (r_ & 127);
                const f32x4* src = (const f32x4*)peer_u + (size_t)e_ * 256 + (sl_ * 4 + c_) * 4; const f32x4* gs_ = (const f32x4*)g_ffn + (sl_ * 4 + c_) * 4;
                a[j] = src[0]; b[j] = src[1]; c[j] = src[2]; d[j] = src[3]; ga[j] = gs_[0]; gb[j] = gs_[1]; gc[j] = gs_[2]; gd[j] = gs_[3]; } }
#pragma unroll
            for (int j = 0; j < 2; ++j) if (oo[j] < NUT) { const f32x4 a_ = a[j] * 32.f * ga[j], b_ = b[j] * 32.f * gb[j], c_ = c[j] * 32.f * gc[j], d_ = d[j] * 32.f * gd[j];
                ((v4u*)UB)[oo[j]] = (v4u){pk8(a_.x, a_.y, a_.z, a_.w), pk8(b_.x, b_.y, b_.z, b_.w), pk8(c_.x, c_.y, c_.z, c_.w), pk8(d_.x, d_.y, d_.z, d_.w)}; }
        }
        pg8::Gemm g{MIX, Wout_t, TOK, DMODEL, DMODEL}; pg8::StaticOrder S; S.init(TOK, DMODEL, G, (int)blockIdx.x);
        pg8::EpiResF32X E{x, DMODEL, XN2, (unsigned char*)XT, SSP, TOK};
        pg8::gemm_phase<pg8::EpiResF32X, pg8::StaticOrder, PG8_ALIGN, PG8_SP2>(ldsl + RING_OFF, g, S, E);
        if (BOTH(6)) GRID_BAR();
    }


    if (IN(8)) {
        PHASE_LOCALS
        pg8::Gemm g{XN2, Wq_t, TOK, NQP, DMODEL}; pg8::StaticOrder S; S.init(TOK, NQP, G, (int)blockIdx.x);
        pg8::EpiBf16Row E{QP, NQP, SSP, RSTD, RMS_EPS, 1.f / DMODEL};
        pg8::gemm_phase<pg8::EpiBf16Row, pg8::StaticOrder, PG8_ALIGN, PG8_SP2>(ldsl + RING_OFF, g, S, E);
        if (BOTH(8)) GRID_BAR();
    }

    if (IN(9)) {
        PHASE_LOCALS
        const int nper = G / 8;
        const int head = vcu % 8, part = vcu / 8;
        for (int c = tid; c < 4096; c += NWAVES * 64) {
            const int p = c >> 11, row = (c >> 4) & 127, ch = c & 15;
            const v4u v = *(const v4u*)(KEYS + ((size_t)(head * 2 + p) * 128 + row) * 128 + ch * 8);
            *(LAS v4u*)(ldsl + p * 32768 + row * 256 + ((ch ^ (row & 15)) * 16)) = v;
        }
        __syncthreads();
        LAS unsigned* const lscr = (LAS unsigned*)(ldsl + 65536 + wave * 8192);
        for (int tg = part * NWAVES + wave; tg < TOK / 32; tg += nper * NWAVES) {
            const int t0 = tg * 32;
            float top[2][16];
#pragma unroll
            for (int p = 0; p < 2; ++p) {
                bf16x8 qf[8];
#pragma unroll
                for (int ks = 0; ks < 8; ++ks) qf[ks] = *(const bf16x8*)(QP + (size_t)(t0 + r32) * NQP + head * 256 + p * 128 + ks * 16 + hi * 8);
                float sc[4][16];
#pragma unroll
                for (int tile = 0; tile < 4; ++tile) {
                    f32x16 acc = f32x16{};
#pragma unroll
                    for (int ks = 0; ks < 8; ++ks) {
                        const bf16x8 kf = *(const LAS bf16x8*)(ldsl + p * 32768 + (tile * 32 + r32) * 256 + (((2 * ks + hi) ^ (r32 & 15)) * 16));
                        acc = __builtin_amdgcn_mfma_f32_32x32x16_bf16(kf, qf[ks], acc, 0, 0, 0);
                    }
#pragma unroll
                    for (int r = 0; r < 16; ++r) { const unsigned kid = (unsigned)(tile * 32 + crow(r, hi));
                        const float av = acc[r];
                        sc[tile][r] = __uint_as_float((__float_as_uint(av) & 0xffffff80u) | (127u - kid)); }
                    sort16_desc(sc[tile]);
                }
                merge16_desc(sc[0], sc[1]); merge16_desc(sc[2], sc[3]); merge16_desc(sc[0], sc[2]);
                float ot[16];
#pragma unroll
                for (int i = 0; i < 16; ++i) ot[i] = __shfl_xor(sc[0][i], 32);
                merge16_desc(sc[0], ot);
#pragma unroll
                for (int i = 0; i < 16; ++i) top[p][i] = sc[0][i];
            }
#pragma unroll
            for (int i = 0; i < 16; ++i) { lscr[i * 64 + lane] = 127u - (__float_as_uint(top[0][i]) & 127u); lscr[(16 + i) * 64 + lane] = 127u - (__float_as_uint(top[1][i]) & 127u); }
            float v0[16], v1[16];
#pragma unroll
            for (int i = 0; i < 16; ++i) { v0[i] = __uint_as_float(__float_as_uint(top[0][i]) & 0xffffff80u); v1[i] = __uint_as_float(__float_as_uint(top[1][i]) & 0xffffff80u); }
#define CAND(i, j) __uint_as_float((__float_as_uint(v0[i] + v1[j]) & 0xffffff00u) | (255u - (unsigned)((i) * 16 + (j))))
            const float NEGB = -3.0e38f;
            float cA[16], cB[16], cC[16], cD[16];
#pragma unroll
            for (int j = 0; j < 16; ++j) cA[j] = CAND(0, j);
#pragma unroll
            for (int j = 0; j < 8; ++j) cB[j] = CAND(1, j);
#pragma unroll
            for (int j = 0; j < 5; ++j) cB[8 + j] = CAND(2, j);
            cB[13] = NEGB; cB[14] = NEGB; cB[15] = NEGB;
#pragma unroll
            for (int j = 0; j < 4; ++j) cC[j] = CAND(3, j);
#pragma unroll
            for (int j = 0; j < 3; ++j) cC[4 + j] = CAND(4, j);
            cC[7] = CAND(5, 0); cC[8] = CAND(5, 1); cC[9] = CAND(6, 0); cC[10] = CAND(6, 1); cC[11] = CAND(7, 0); cC[12] = CAND(7, 1);
            cC[13] = NEGB; cC[14] = NEGB; cC[15] = NEGB;
            cD[0] = CAND(8, 0); cD[1] = CAND(9, 0); cD[2] = CAND(10, 0); cD[3] = CAND(11, 0); cD[4] = CAND(12, 0); cD[5] = CAND(13, 0); cD[6] = CAND(14, 0); cD[7] = CAND(15, 0);
#pragma unroll
            for (int j = 8; j < 16; ++j) cD[j] = NEGB;
#undef CAND
            sort16_desc(cB); sort16_desc(cC); sort16_desc(cD);
            merge16_desc(cA, cB); merge16_desc(cC, cD); merge16_desc(cA, cC);
            LDS_WAIT();
            float gv[16]; int ex[16]; float gsum = 0.f;
            const float mx = __uint_as_float(__float_as_uint(cA[0]) & 0xffffff00u);
#pragma unroll
            for (int w = 0; w < 16; ++w) {
                const unsigned bits = __float_as_uint(cA[w]); const unsigned code = 255u - (bits & 255u);
                const float val = __uint_as_float(bits & 0xffffff00u);
                gv[w] = __expf(val - mx); gsum += gv[w];
                const unsigned e0 = lscr[(code >> 4) * 64 + lane], e1 = lscr[(16 + (code & 15)) * 64 + lane];
                ex[w] = (int)(e0 * 128u + e1);
            }
            const float ginv = 1.f / gsum;
            const size_t ob = (size_t)(t0 + r32) * 128 + head * 16;
#pragma unroll
            for (int q = 0; q < 4; ++q) if ((q >> 1) == hi)
                *(v4u*)(IDX + ob + 4 * q) = (v4u){(f2bf(gv[4 * q] * ginv) << 16) | (unsigned)ex[4 * q], (f2bf(gv[4 * q + 1] * ginv) << 16) | (unsigned)ex[4 * q + 1],
                                                  (f2bf(gv[4 * q + 2] * ginv) << 16) | (unsigned)ex[4 * q + 2], (f2bf(gv[4 * q + 3] * ginv) << 16) | (unsigned)ex[4 * q + 3]};
            LDS_WAIT();
        }
        if (BOTH(9)) GRID_BAR();
    }

    if (IN(10)) {
        PHASE_LOCALS
        LAS int* const hst = (LAS int*)(ldsl + wave * 256);
        int w0n = IDX[(size_t)gw * 128 + lane], w1n = IDX[(size_t)gw * 128 + 64 + lane];
        for (int t = gw; t < TOK; t += NGW) {
            const int w0 = w0n, w1 = w1n;
            { const int tn = (t + NGW < TOK) ? t + NGW : t; w0n = IDX[(size_t)tn * 128 + lane]; w1n = IDX[(size_t)tn * 128 + 64 + lane]; }
            const int x0 = w0 & 0xffff, x1 = w1 & 0xffff;
            const int r0 = ((((x0 >> 7) + (x0 & 127)) & 127) << 7) | (x0 & 127), r1 = ((((x1 >> 7) + (x1 & 127)) & 127) << 7) | (x1 & 127);
            const int b0 = r0 >> 9, b1 = r1 >> 9;
            if (lane < 32) hst[lane] = 0;
            const int rk0 = __hip_atomic_fetch_add(hst + b0, 1, __ATOMIC_RELAXED, __HIP_MEMORY_SCOPE_WORKGROUP);
            const int rk1 = __hip_atomic_fetch_add(hst + b1, 1, __ATOMIC_RELAXED, __HIP_MEMORY_SCOPE_WORKGROUP);
            const int myc = __hip_atomic_load(hst + (lane & 31), __ATOMIC_RELAXED, __HIP_MEMORY_SCOPE_WORKGROUP);
            int incl = myc;
#pragma unroll
            for (int o = 1; o < 32; o <<= 1) { const int v = __shfl_up(incl, o); if ((lane & 31) >= o) incl += v; }
            if (lane < 32) { OFFS[(size_t)t * 32 + lane] = (unsigned char)(incl - myc); __hip_atomic_store(hst + 32 + lane, incl - myc, __ATOMIC_RELAXED, __HIP_MEMORY_SCOPE_WORKGROUP); }
            const int o0 = __hip_atomic_load(hst + 32 + b0, __ATOMIC_RELAXED, __HIP_MEMORY_SCOPE_WORKGROUP), o1 = __hip_atomic_load(hst + 32 + b1, __ATOMIC_RELAXED, __HIP_MEMORY_SCOPE_WORKGROUP);
            SGE[(size_t)t * 128 + o0 + rk0] = ((unsigned)w0 & 0xffff0000u) | (unsigned)r0; SGE[(size_t)t * 128 + o1 + rk1] = ((unsigned)w1 & 0xffff0000u) | (unsigned)r1;
        }
        if (BOTH(10)) GRID_BAR();
    }

    if (IN(11)) {
        PHASE_LOCALS
        constexpr int NC = 112, NTL = 7;
        LAS unsigned* const GCOL = (LAS unsigned*)(ldsl + 132096);
        LAS unsigned* const GW = (LAS unsigned*)(ldsl + 132096 + 32 * NC * 4);
        LAS int* const gcnt = (LAS int*)(ldsl + 132096 + 2 * 32 * NC * 4);
        const unsigned lds0 = (unsigned)(uintptr_t)lds;
        const unsigned u_lane_off = (unsigned)(lane >> 2) * 64u + (unsigned)(((lane & 3) ^ ((lane >> 4) & 3)) * 16);
        for (int k = 0; k < 2048; k += 1) {
            int tb, eb;
            if (G == 256) { if (k >= 8) break; eb = vcu & 31; tb = 8 * (vcu >> 5) + (((vcu & 31) + k) & 7); }
            else { const int task = vcu + k * G; if (task >= 2048) break; tb = task >> 5; eb = task & 31; }
            const int t = tb * 512 + tid;
            const unsigned char* usrc = (const unsigned char*)UH + (size_t)eb * 512 * 64;
            const unsigned char* xsrc = (const unsigned char*)XT + ((size_t)tb * 512) * 8;
#define DMA_UX(hs_, buf_) do { unsigned ulo_ = u_lane_off, xlo_ = (unsigned)lane * 16u; asm volatile("" : "+v"(ulo_), "+v"(xlo_)); _Pragma("unroll") for (int q_ = 0; q_ < 4; ++q_) { const int j_ = wave + 8 * q_; \
                attn_body::glds16(usrc + ulo_ + (size_t)(hs_) * (PEER_N * 64) + (size_t)j_ * 1024, (unsigned)__builtin_amdgcn_readfirstlane(lds0 + (buf_) * 32768 + j_ * 1024)); \
                attn_body::glds16(xsrc + xlo_ + (size_t)((hs_) * 8 + (j_ >> 2)) * ((size_t)TOK * 8) + (size_t)(j_ & 3) * 1024, (unsigned)__builtin_amdgcn_readfirstlane(lds0 + 65536 + (buf_) * 32896 + (j_ >> 2) * 4112 + (j_ & 3) * 1024)); } } while (0)
            DMA_UX(0, 0);
            for (int c = tid; c < 32 * NC; c += NWAVES * 64) GCOL[c] = 0u;
            if (tid < 32) gcnt[tid] = 0;
            const int p0 = OFFS[(size_t)t * 32 + eb]; const int p1 = (eb < 31) ? (int)OFFS[(size_t)t * 32 + eb + 1] : 128; const int n = p1 - p0;
            unsigned ent[16];
#pragma unroll
            for (int i = 0; i < 16; ++i) ent[i] = (i < n) ? SGE[(size_t)t * 128 + p0 + i] : 0u;
            unsigned tid_o = (unsigned)tid; asm volatile("" : "+v"(tid_o));
            unsigned char* const a2u = (unsigned char*)AE2 + ((size_t)(tb * 32 + eb) * 12) * 2048; const unsigned toff4 = tid_o * 4u;
            CNT[(size_t)(tb * 32 + eb) * 512 + tid] = (unsigned char)n;
            __syncthreads();
            unsigned ovmask = 0u;
#pragma unroll
            for (int i = 0; i < 16; ++i) if (i < n) { const unsigned r = ent[i] & 0xffffu; const int g = (int)((r >> 4) & 31u);
                const int c = __hip_atomic_fetch_add(gcnt + g, 1, __ATOMIC_RELAXED, __HIP_MEMORY_SCOPE_WORKGROUP);
                if (c < NC) { GCOL[g * NC + c] = ((unsigned)tid << 15) | ((unsigned)(p0 + i) << 8) | ((unsigned)i << 4) | (r & 15u); GW[g * NC + c] = ent[i]; } else ovmask |= 1u << i; }
            __syncthreads();
            int cg[4]; unsigned tko[4][NTL]; f32x4 acc[4][NTL];
            const unsigned aoff = (unsigned)((4 * wave) * 16 + (lane & 15)) * 64u + (unsigned)((((lane >> 5) & 1) ^ ((lane >> 2) & 3)) * 16) + (unsigned)((lane >> 4) & 1) * 8u;
#pragma unroll
            for (int gi = 0; gi < 4; ++gi) { const int cc = gcnt[4 * wave + gi]; cg[gi] = __builtin_amdgcn_readfirstlane(cc < NC ? cc : NC);
#pragma unroll
                for (int ct = 0; ct < NTL; ++ct) { tko[gi][ct] = 65536u + (unsigned)(lane >> 4) * 4112u + (GCOL[(4 * wave + gi) * NC + ct * 16 + (lane & 15)] >> 15) * 8u;     acc[gi][ct] = (f32x4){0.f, 0.f, 0.f, 0.f}; } }
#define UPM_COMPUTE(buf_) do { _Pragma("unroll") for (int gi = 0; gi < 4; ++gi) { if (cg[gi] > 0) { \
                const long af0_ = v2l(*(const LAS v2u*)(ldsl + aoff + gi * 1024 + (buf_) * 32768)), af1_ = v2l(*(const LAS v2u*)(ldsl + (aoff ^ 32u) + gi * 1024 + (buf_) * 32768)); \
                _Pragma("unroll") for (int ct = 0; ct < NTL; ++ct) { if (ct * 16 < cg[gi]) { \
                    const long bf0_ = v2l(*(const LAS v2u*)(ldsl + tko[gi][ct] + (buf_) * 32896)), bf1_ = v2l(*(const LAS v2u*)(ldsl + tko[gi][ct] + 16448 + (buf_) * 32896)); \
                    acc[gi][ct] = __builtin_amdgcn_mfma_f32_16x16x32_fp8_fp8(af0_, bf0_, acc[gi][ct], 0, 0, 0); \
                    acc[gi][ct] = __builtin_amdgcn_mfma_f32_16x16x32_fp8_fp8(af1_, bf1_, acc[gi][ct], 0, 0, 0); } } } } } while (0)
#pragma unroll 1
            for (int hs = 0; hs < 16; hs += 2) {
                __builtin_amdgcn_s_waitcnt(0x0F70); __syncthreads();
                DMA_UX(hs + 1, 1);
                UPM_COMPUTE(0);
                __builtin_amdgcn_s_waitcnt(0x0F70); __syncthreads();
                if (hs + 2 < 16) DMA_UX(hs + 2, 0);
                UPM_COMPUTE(1);
            }
#undef UPM_COMPUTE
#undef DMA_UX
#pragma unroll
            for (int gi = 0; gi < 4; ++gi)
#pragma unroll
                for (int ct = 0; ct < NTL; ++ct) if (ct * 16 < cg[gi]) {
                    const int c = ct * 16 + (lane & 15); const unsigned en = GCOL[(4 * wave + gi) * NC + c], gw = GW[(4 * wave + gi) * NC + c];
                    const unsigned row = en & 15u; const f32x4 av = acc[gi][ct];
                    const float hsel = (row & 2u) ? ((row & 1u) ? av.w : av.z) : ((row & 1u) ? av.y : av.x);
                    if (c < cg[gi] && (int)(row >> 2) == (lane >> 4)) {
                        const unsigned tk = en >> 15, pp = (en >> 8) & 127u, ii = (en >> 4) & 15u;
                        const unsigned w = (f2bf(gelu_erf(hsel * (1.f / 32.f) * RSTD[tb * 512 + (int)tk]) * __uint_as_float(gw & 0xffff0000u)) << 16) | (gw & 0xffffu);
                        if (ii < 12u) *(unsigned*)(a2u + (size_t)ii * 2048 + tk * 4u) = w; else AE[((size_t)tb * 512 + tk) * 128 + pp] = w;
                    }
                    __builtin_amdgcn_sched_barrier(0);
                }
            if (__any(n > 16 || ovmask != 0u)) {
                for (int i = 0; i < n; ++i) if (i >= 16 || ((ovmask >> i) & 1u)) { const unsigned en = SGE[(size_t)t * 128 + p0 + i]; const unsigned rr_ = en & 0xffffu; float a_ = 0.f;
                    for (int c = 0; c < 128; ++c) {
                        const v2u r_ = *(const v2u*)((const unsigned char*)UH + ((size_t)(c >> 3) * PEER_N + rr_) * 64 + (c & 7) * 8), x_ = *(const v2u*)((const unsigned char*)XT + ((size_t)c * TOK + t) * 8);
                        const int r0 = (int)r_.x, r1 = (int)r_.y, x0 = (int)x_.x, x1 = (int)x_.y;
                        a_ += __builtin_amdgcn_cvt_f32_fp8(r0, 0) * __builtin_amdgcn_cvt_f32_fp8(x0, 0) + __builtin_amdgcn_cvt_f32_fp8(r0, 1) * __builtin_amdgcn_cvt_f32_fp8(x0, 1)
                            + __builtin_amdgcn_cvt_f32_fp8(r0, 2) * __builtin_amdgcn_cvt_f32_fp8(x0, 2) + __builtin_amdgcn_cvt_f32_fp8(r0, 3) * __builtin_amdgcn_cvt_f32_fp8(x0, 3)
                            + __builtin_amdgcn_cvt_f32_fp8(r1, 0) * __builtin_amdgcn_cvt_f32_fp8(x1, 0) + __builtin_amdgcn_cvt_f32_fp8(r1, 1) * __builtin_amdgcn_cvt_f32_fp8(x1, 1)
                            + __builtin_amdgcn_cvt_f32_fp8(r1, 2) * __builtin_amdgcn_cvt_f32_fp8(x1, 2) + __builtin_amdgcn_cvt_f32_fp8(r1, 3) * __builtin_amdgcn_cvt_f32_fp8(x1, 3); }
                    const unsigned w_ = (f2bf(gelu_erf(a_ * (1.f / 32.f) * RSTD[t]) * __uint_as_float(en & 0xffff0000u)) << 16) | (en & 0xffffu); if (i < 12) *(unsigned*)(a2u + (size_t)i * 2048 + toff4) = w_; else AE[(size_t)t * 128 + p0 + i] = w_; }
            }
            __syncthreads();
        }
        if (BOTH(11)) GRID_BAR();
    }

#define DMA_T(src, ds_, buf_) do { _Pragma("unroll") for (int q_ = 0; q_ < 8; ++q_) { const int j_ = wave + 8 * q_; \
                attn_body::glds16((src) + (size_t)j_ * 1024 + (size_t)(ds_) * (PEER_N * 128), (unsigned)__builtin_amdgcn_readfirstlane(lds0 + (buf_) * 65536 + j_ * 1024)); } } while (0)
#define ROW_READ(R_, ew_, buf_) do { unsigned ea_ = (ew_); asm volatile("" : "+v"(ea_)); const unsigned el_ = ea_ & 511u; \
                const LAS unsigned char* rp_ = ldsl + (buf_) * 65536 + el_ * 128; \
                _Pragma("unroll") for (int c = 0; c < 8; ++c) R_[c] = *(const LAS v4u*)(rp_ + ((c ^ l7) * 16)); } while (0)
    if (IN(12)) {
        PHASE_LOCALS
        const unsigned lds0 = (unsigned)(uintptr_t)lds;
        const unsigned dma_lane_off = (unsigned)lane * 16u;
        unsigned l7 = (unsigned)lane & 7u; asm volatile("" : "+v"(l7));
        for (int k = 0; k < 1024; ++k) {
            int tb, ds;
            if (G == 256) { if (k >= 4) break; const int c_ = vcu & 31; ds = c_ & 15; tb = 8 * (vcu >> 5) + (((c_ >> 4) + 2 * k + (c_ & 7)) & 7); }
            else { const int task = vcu + k * G; if (task >= 1024) break; tb = task >> 4; ds = task & 15; }
            const int t = tb * 512 + tid;
            h2 acc[32];
#pragma unroll
            for (int d = 0; d < 32; ++d) acc[d] = (h2){(_Float16)0.f, (_Float16)0.f};
            const unsigned char* vsrc = (const unsigned char*)VH + (size_t)ds * (PEER_N * 128) + dma_lane_off;
            const unsigned char* const a2u = (const unsigned char*)AE2 + ((size_t)(tb * 32) * 12) * 2048;
            const unsigned char* const cnu = CNT + (size_t)(tb * 32) * 512;
            unsigned tid_o = (unsigned)tid; asm volatile("" : "+v"(tid_o));
            const unsigned toff4 = tid_o * 4u, toff1 = tid_o;
#define DN_FMA(R_, ew_) do { const _Float16 ah_ = (_Float16)__uint_as_float((ew_) & 0xffff0000u); const h2 a2_ = (h2){ah_, ah_}; _Pragma("unroll") for (int c = 0; c < 8; ++c) { \
                acc[4 * c + 0] = u2h(R_[c].x) * a2_ + acc[4 * c + 0]; acc[4 * c + 1] = u2h(R_[c].y) * a2_ + acc[4 * c + 1]; \
                acc[4 * c + 2] = u2h(R_[c].z) * a2_ + acc[4 * c + 2]; acc[4 * c + 3] = u2h(R_[c].w) * a2_ + acc[4 * c + 3]; } } while (0)
#define LOAD_ENT(E_, n_, sb_) do { n_ = *(cnu + (size_t)(sb_) * 512 + toff1); _Pragma("unroll") for (int i = 0; i < 12; ++i) E_[i] = *(const unsigned*)(a2u + (size_t)((sb_) * 12 + i) * 2048 + toff4); } while (0)
#define DN_STEP(E_, n_, sb_, buf_, En_, nn_, has_next_) do { \
                {   \
                  unsigned e0_ = (0 < n_) ? E_[0] : 0u, e1_ = 0u; ROW_READ(R0, e0_, buf_);     \
                  if (has_next_) { DMA_T(vsrc + (size_t)((sb_) + 1) * (512 * 128), 0, 1 - (buf_)); LOAD_ENT(En_, nn_, (sb_) + 1); } \
                  _Pragma("unroll") for (int i = 0; i < 12; i += 2) { if (__any(i < n_)) { \
                    e1_ = (i + 1 < n_) ? E_[i + 1] : 0u; ROW_READ(R1, e1_, buf_); \
                    DN_FMA(R0, e0_); \
                    if (i + 2 < 12) { e0_ = (i + 2 < n_) ? E_[i + 2] : 0u; ROW_READ(R0, e0_, buf_); } \
                    DN_FMA(R1, e1_); } } \
                  if (__any(n_ > 12)) { if (n_ > 12) { const unsigned* ao_ = AE + (size_t)t * 128 + OFFS[(size_t)t * 32 + (sb_)]; \
                      for (int i = 12; i < n_; ++i) { const unsigned en_ = ao_[i]; ROW_READ(R0, en_, buf_); DN_FMA(R0, en_); } } } } } while (0)
            unsigned entA[12], entB[12]; int nA, nB; v4u R0[8], R1[8];
#pragma unroll
            for (int c = 0; c < 8; ++c) { R0[c] = (v4u){0u, 0u, 0u, 0u}; R1[c] = (v4u){0u, 0u, 0u, 0u}; }
            DMA_T(vsrc, 0, 0); LOAD_ENT(entA, nA, 0);
#pragma unroll 1
            for (int sb = 0; sb < 32; sb += 2) {
                __builtin_amdgcn_s_waitcnt(0x0F70); __syncthreads();
                DN_STEP(entA, nA, sb, 0, entB, nB, true);
                __builtin_amdgcn_s_waitcnt(0x0F70); __syncthreads();
                DN_STEP(entB, nB, sb + 1, 1, entA, nA, (sb + 2 < 32));
            }
#undef DN_STEP
#undef LOAD_ENT
#undef DN_FMA
            f32x4* op = (f32x4*)(out + (size_t)t * DMODEL + ds * 64); const v4u* hp = (const v4u*)(XN2 + (size_t)t * DMODEL + ds * 64);
            v4u hba[8];
#pragma unroll
            for (int c = 0; c < 8; ++c) hba[c] = hp[(unsigned)c ^ l7];
#pragma unroll
            for (int c = 0; c < 8; ++c) { const unsigned cc = (unsigned)c ^ l7; const v4u hb = hba[c];
                f32x4 o0, o1; o0.x = bflo(hb.x) + (float)acc[4 * c].x; o0.y = bfhi(hb.x) + (float)acc[4 * c].y; o0.z = bflo(hb.y) + (float)acc[4 * c + 1].x; o0.w = bfhi(hb.y) + (float)acc[4 * c + 1].y;
                o1.x = bflo(hb.z) + (float)acc[4 * c + 2].x; o1.y = bfhi(hb.z) + (float)acc[4 * c + 2].y; o1.z = bflo(hb.w) + (float)acc[4 * c + 3].x; o1.w = bfhi(hb.w) + (float)acc[4 * c + 3].y;
                op[2 * cc] = o0; op[2 * cc + 1] = o1; }
        }
#undef ROW_READ
#undef DMA_T
    }
#undef IN
#undef BOTH
#undef GRID_BAR
}

extern "C" void kernel_launch(void* const* d_in, const int* in_sizes, int n_in, void* d_out, int out_size, void* d_ws, size_t ws_size, hipStream_t stream) {
    static int grid = 0;
    if (grid == 0) {
        if (n_in != 20 || in_sizes[0] != TOK * DMODEL || out_size != TOK * DMODEL || ws_size < WS_END) {
            fprintf(stderr, "kernel_launch: unexpected shapes: n_in %d in0 %d out %d ws %zu (need %zu); nothing launched\n", n_in, n_in > 0 ? in_sizes[0] : -1, out_size, ws_size, (size_t)WS_END); grid = -1; return; }
        int dev = 0, cus = 0, per_cu = 0;
        if (hipGetDevice(&dev) != hipSuccess || hipDeviceGetAttribute(&cus, hipDeviceAttributeMultiprocessorCount, dev) != hipSuccess) { grid = -1; return; }
        if (hipFuncSetAttribute((const void*)hymba_fwd, hipFuncAttributeMaxDynamicSharedMemorySize, LDS_BYTES) != hipSuccess) { fprintf(stderr, "kernel_launch: hipFuncSetAttribute failed\n"); grid = -1; return; }
        if (hipOccupancyMaxActiveBlocksPerMultiprocessor(&per_cu, (const void*)hymba_fwd, NWAVES * 64, LDS_BYTES) != hipSuccess || per_cu < 1)
            fprintf(stderr, "kernel_launch: note: occupancy query reports %d workgroups per CU\n", per_cu);
        (void)hipGetLastError();
        grid = cus;
        grid -= grid % 8;
        if (grid < 8) { grid = -1; return; }
    }
    if (grid < 0) return;
    if (hipMemsetAsync((char*)d_ws + WS_CTL, 0, CTL_ZERO_BYTES, stream) != hipSuccess) return;
    Args a{};
    for (int i = 0; i < 20; ++i) a.in[i] = d_in[i];
    a.out = (float*)d_out; a.ws = (unsigned char*)d_ws;
    for (int li = 0; li < N_LAUNCHES; ++li) {
        a.ph_lo = (N_LAUNCHES == 1) ? 0 : li; a.ph_hi = (N_LAUNCHES == 1) ? NPHASE : li + 1; a.li = li; a.pad = 0;
        hipLaunchKernelGGL(hymba_fwd, dim3(grid), dim3(NWAVES * 64), LDS_BYTES, stream, a);
        const hipError_t le = hipPeekAtLastError();
        if (le != hipSuccess) { fprintf(stderr, "kernel_launch: launch %d failed: %s\n", li, hipGetErrorName(le)); break; }
    }
}
```

```cpp
#include <hip/hip_runtime.h>
#include <hip/hip_bf16.h>
#include <cstdio>
#include <cstdint>
#include <cmath>
#define MK_N_LAUNCHES 1
namespace pg8 {
#define PG8_LAS __attribute__((address_space(3)))
typedef unsigned short bf16_t;
typedef short bf16x8 __attribute__((ext_vector_type(8)));
typedef float f32x4 __attribute__((ext_vector_type(4)));
typedef unsigned u32x4 __attribute__((ext_vector_type(4)));
constexpr int BM = 256, BK = 64, HALF = 128, HTB = HALF * BK * 2  , STAGE_BYTES = 8 * HTB, NXCD = 8, WGM = 8;

__host__ __device__ __forceinline__ int lds_byte(int r, int c) { const int st = (r >> 4) * 2 + (c >> 5), rr = r & 15, cc = c & 31, ob = rr * 64 + cc * 2; return st * 1024 + (ob ^ (((ob >> 9) & 1) << 5)); }
__host__ __device__ __forceinline__ void stage_rc(int b, int& R, int& C) { const int st = b / 1024, sb = b % 1024, swz = sb ^ (((sb >> 9) & 1) << 5); R = (st >> 1) * 16 + swz / 64; C = (st & 1) * 32 + (swz % 64) / 2; }
__host__ __device__ __forceinline__ int perm32(int rho) { const int n = rho >> 4, i = rho & 15; return 8 * (i >> 2) + 4 * n + (i & 3); }

struct Unit { int pm, pn; };
struct Gemm { const bf16_t* A; const bf16_t* Bt; int M, N, K; };

struct StaticOrder {
    int nM, nN, nwg, G, c;
    __host__ __device__ void init(int M, int N, int G_, int c_) { nM = M / BM; nN = N / BM; nwg = nM * nN; G = G_; c = c_; }
    __host__ __device__ bool next(int i, Unit& u) const {
        const long L = (long)i * G + c; if (L >= nwg) return false;
        int wgid = (int)L; { const int q = nwg / NXCD, r = nwg % NXCD, xcd = wgid % NXCD, off = wgid / NXCD; wgid = (xcd < r ? xcd * (q + 1) : r * (q + 1) + (xcd - r) * q) + off; }
        const int nig = WGM * nN, gid = wgid / nig, fm = gid * WGM, gsz = (nM - fm) < WGM ? (nM - fm) : WGM;
        u.pm = fm + ((wgid % nig) % gsz); u.pn = (wgid % nig) / gsz; return true;
    }
    __device__ __forceinline__ void a_ready(const Unit&) const {}
    __device__ __forceinline__ void done(const Unit&) const {}
};

__device__ __forceinline__ unsigned cvt_pk_bf16(float lo, float hi) { unsigned r; asm volatile("v_cvt_pk_bf16_f32 %0, %1, %2" : "=v"(r) : "v"(lo), "v"(hi)); return r; }
typedef float f32x2 __attribute__((ext_vector_type(2)));
__device__ __forceinline__ f32x2 gelu_pk(f32x2 v) {
    const f32x2 av = __builtin_elementwise_abs(v), d = av * 0.2316418882f + 1.0f;
    f32x2 t; t.x = __builtin_amdgcn_rcpf(d.x); t.y = __builtin_amdgcn_rcpf(d.y);
    f32x2 q = t * 0.5307027145f + (-0.7265760135f); q = q * t + 0.7107068705f; q = q * t + (-0.142248368f); q = q * t + 0.127414796f; q = q * t;
    const f32x2 s = (v * v) * (-0.72134752044f);
    f32x2 e; e.x = __builtin_amdgcn_exp2f(s.x); e.y = __builtin_amdgcn_exp2f(s.y);
    const f32x2 m = v * (q * e), r = v - m;
    f32x2 o; o.x = v.x < 0.f ? m.x : r.x; o.y = v.y < 0.f ? m.y : r.y; return o;
}

template <int ACT  > struct EpiBf16 {
    static constexpr bool PERM = true, AFTER_DRAIN = false; static_assert(ACT == 0 || ACT == 1, "EpiBf16: ACT is 0 (none) or 1 (gelu_pk)");
    bf16_t* O; int ldc; const float* bias; int split_cols; size_t split_stride; float scale0;
    __device__ __forceinline__ void operator()(const f32x4 (&acc)[2][2][4][2], const Unit& u, int wr, int wc, int fr, int fq) const {
        const int row0 = u.pm * BM + wr * 64 + fr; int colt = u.pn * BM; bf16_t* base = O;
        float sc = 1.f; if (split_cols) { const int t = colt / split_cols; base += (size_t)t * split_stride; colt -= t * split_cols; if (t == 0) sc = scale0; }
        const int col0 = colt + wc * 32 + 8 * fq, bcol0 = u.pn * BM + wc * 32 + 8 * fq;
        f32x4 bv[2][2];
#pragma unroll
        for (int bj = 0; bj < 2; ++bj)
#pragma unroll
            for (int n = 0; n < 2; ++n) bv[bj][n] = bias ? *(const f32x4*)(bias + bcol0 + bj * HALF + 4 * n) : (f32x4){0.f, 0.f, 0.f, 0.f};
#pragma unroll
        for (int ai = 0; ai < 2; ++ai)
#pragma unroll
            for (int m = 0; m < 4; ++m) { bf16_t* rowp = base + (size_t)(row0 + ai * HALF + m * 16) * ldc + col0;
#pragma unroll
                for (int bj = 0; bj < 2; ++bj) { f32x4 v0 = acc[ai][bj][m][0] + bv[bj][0], v1 = acc[ai][bj][m][1] + bv[bj][1];
                    if (ACT == 1) { f32x2 a = gelu_pk((f32x2){v0[0], v0[1]}), b = gelu_pk((f32x2){v0[2], v0[3]}), c = gelu_pk((f32x2){v1[0], v1[1]}), d = gelu_pk((f32x2){v1[2], v1[3]});
                        v0 = (f32x4){a.x, a.y, b.x, b.y}; v1 = (f32x4){c.x, c.y, d.x, d.y}; }
                    v0 = v0 * sc; v1 = v1 * sc; u32x4 w; w.x = cvt_pk_bf16(v0[0], v0[1]); w.y = cvt_pk_bf16(v0[2], v0[3]); w.z = cvt_pk_bf16(v1[0], v1[1]); w.w = cvt_pk_bf16(v1[2], v1[3]);
                    *(u32x4*)(rowp + bj * HALF) = w; } }
    }
};
struct EpiResF32 {
    static constexpr bool PERM = true, AFTER_DRAIN = false;
    const float* X; float* O; int ldc;
    __device__ __forceinline__ void operator()(const f32x4 (&acc)[2][2][4][2], const Unit& u, int wr, int wc, int fr, int fq) const {
        const int row0 = u.pm * BM + wr * 64 + fr, col0 = u.pn * BM + wc * 32 + 8 * fq;
#pragma unroll
        for (int ai = 0; ai < 2; ++ai)
#pragma unroll
            for (int m = 0; m < 4; ++m) { const size_t ro = (size_t)(row0 + ai * HALF + m * 16) * ldc + col0;
#pragma unroll
                for (int bj = 0; bj < 2; ++bj) { const size_t off = ro + bj * HALF;
                    const f32x4 x0 = *(const f32x4*)(X + off), x1 = *(const f32x4*)(X + off + 4);
                    *(f32x4*)(O + off) = x0 + acc[ai][bj][m][0]; *(f32x4*)(O + off + 4) = x1 + acc[ai][bj][m][1]; } }
    }
};
struct EpiResF32X {
    static constexpr bool PERM = true, AFTER_DRAIN = false;
    const float* X; int ldc; bf16_t* HB; unsigned char* X8; float* SSP; int tok;
    static __device__ __forceinline__ unsigned pk8(float a, float b, float c, float d) { int w = __builtin_amdgcn_cvt_pk_fp8_f32(a, b, 0, false); w = __builtin_amdgcn_cvt_pk_fp8_f32(c, d, w, true); return (unsigned)w; }
    __device__ __forceinline__ void operator()(const f32x4 (&acc)[2][2][4][2], const Unit& u, int wr, int wc, int fr, int fq) const {
        const int row0 = u.pm * BM + wr * 64 + fr, col0 = u.pn * BM + wc * 32 + 8 * fq;
#pragma unroll
        for (int ai = 0; ai < 2; ++ai) {
            f32x4 xv[4][2][2];
#pragma unroll
            for (int m = 0; m < 4; ++m)
#pragma unroll
                for (int bj = 0; bj < 2; ++bj) { const size_t off = (size_t)(row0 + ai * HALF + m * 16) * ldc + col0 + bj * HALF; xv[m][bj][0] = *(const f32x4*)(X + off); xv[m][bj][1] = *(const f32x4*)(X + off + 4); }
#pragma unroll
            for (int m = 0; m < 4; ++m) { const int row = row0 + ai * HALF + m * 16; const size_t ro = (size_t)row * ldc + col0; float ss = 0.f;
#pragma unroll
                for (int bj = 0; bj < 2; ++bj) { const size_t off = ro + bj * HALF;
                    const f32x4 h0 = xv[m][bj][0] + acc[ai][bj][m][0], h1 = xv[m][bj][1] + acc[ai][bj][m][1];
                    ss += (h0.x * h0.x + h0.y * h0.y) + (h0.z * h0.z + h0.w * h0.w) + (h1.x * h1.x + h1.y * h1.y) + (h1.z * h1.z + h1.w * h1.w);
                    u32x4 w; w.x = cvt_pk_bf16(h0.x, h0.y); w.y = cvt_pk_bf16(h0.z, h0.w); w.z = cvt_pk_bf16(h1.x, h1.y); w.w = cvt_pk_bf16(h1.z, h1.w);
                    *(u32x4*)(HB + off) = w;
                    typedef unsigned u32x2 __attribute__((ext_vector_type(2)));
                    const u32x2 q = {pk8(h0.x, h0.y, h0.z, h0.w), pk8(h1.x, h1.y, h1.z, h1.w)};
                    *(u32x2*)(X8 + ((size_t)((col0 + bj * HALF) >> 3) * tok + row) * 8) = q; }
                ss += __shfl_xor(ss, 16); ss += __shfl_xor(ss, 32);
                if (fq == 0) SSP[(size_t)row * 16 + u.pn * 4 + wc] = ss; } }
    }
};
struct EpiBf16Row {
    static constexpr bool PERM = true, AFTER_DRAIN = false;
    bf16_t* O; int ldc; const float* SSP; float* RSTD; float eps, inv_n;
    __device__ __forceinline__ void operator()(const f32x4 (&acc)[2][2][4][2], const Unit& u, int wr, int wc, int fr, int fq) const {
        const int row0 = u.pm * BM + wr * 64 + fr, col0 = u.pn * BM + wc * 32 + 8 * fq;
#pragma unroll
        for (int ai = 0; ai < 2; ++ai) {
            float rs[4];
#pragma unroll
            for (int m = 0; m < 4; ++m) { const f32x4* sp = (const f32x4*)(SSP + (size_t)(row0 + ai * HALF + m * 16) * 16);
                const f32x4 s4 = (sp[0] + sp[1]) + (sp[2] + sp[3]); rs[m] = 1.f / sqrtf(((s4.x + s4.y) + (s4.z + s4.w)) * inv_n + eps); }
#pragma unroll
            for (int m = 0; m < 4; ++m) { const int row = row0 + ai * HALF + m * 16; bf16_t* rowp = O + (size_t)row * ldc + col0;
                const float rstd = rs[m];
                if (u.pn == 0 && wc == 0 && fq == 0) RSTD[row] = rstd;
#pragma unroll
                for (int bj = 0; bj < 2; ++bj) { const f32x4 v0 = acc[ai][bj][m][0] * rstd, v1 = acc[ai][bj][m][1] * rstd;
                    u32x4 w; w.x = cvt_pk_bf16(v0[0], v0[1]); w.y = cvt_pk_bf16(v0[2], v0[3]); w.z = cvt_pk_bf16(v1[0], v1[1]); w.w = cvt_pk_bf16(v1[2], v1[3]);
                    *(u32x4*)(rowp + bj * HALF) = w; } } }
    }
};
template <class Epi, class Sched, bool ALIGN_EPI = false, bool SP2 = false>
__device__ __forceinline__ void gemm_phase(PG8_LAS unsigned char* lds, const Gemm g, const Sched& S, const Epi& E) {
    const int tid = threadIdx.x, wid = __builtin_amdgcn_readfirstlane(tid >> 6), lane = tid & 63, wr = wid >> 2, wc = wid & 3, fr = lane & 15, fq = lane >> 4;
    const int K = g.K, nt = K / BK;
    unsigned voffA[2], voffB[2];
#pragma unroll
    for (int i = 0; i < 2; ++i) { int R, C; stage_rc(tid * 16 + i * 8192, R, C); const int Rb = Epi::PERM ? ((R & ~31) + perm32(R & 31)) : R;
        voffA[i] = (unsigned)(R * K + C) * 2u; voffB[i] = (unsigned)(Rb * K + C) * 2u; }
    const size_t kstep = (size_t)(BK * 2);
    const size_t hstep = (size_t)HALF * K * 2;
    const size_t tstep = 2 * hstep;
    const unsigned ldsw = (unsigned)wid * 1024u;
    const int aoff = lds_byte(wr * 64 + fr, fq * 8), boff = lds_byte(wc * 32 + fr, fq * 8);
#define PG8_SA(b, h) (((b) * 2 + (h)) * HTB)
#define PG8_SB(b, h) ((4 + (b) * 2 + (h)) * HTB)
#define PG8_STAGE(bufoff, gbase, voff) do { _Pragma("unroll") for (int _i = 0; _i < 2; ++_i) \
        __builtin_amdgcn_global_load_lds((const unsigned*)((const char*)(gbase) + (voff)[_i]), (PG8_LAS unsigned*)(lds + (bufoff) + ldsw + _i * 8192), 16, 0, 0); } while (0)
#define PG8_LDA(dst, b, h) do { _Pragma("unroll") for (int m = 0; m < 4; ++m) _Pragma("unroll") for (int k = 0; k < 2; ++k) dst[m][k] = *(const PG8_LAS bf16x8*)(lds + PG8_SA(b, h) + aoff + m * 2048 + k * 1024); } while (0)
#define PG8_LDB(dst, b, h) do { _Pragma("unroll") for (int n = 0; n < 2; ++n) _Pragma("unroll") for (int k = 0; k < 2; ++k) dst[n][k] = *(const PG8_LAS bf16x8*)(lds + PG8_SB(b, h) + boff + n * 2048 + k * 1024); } while (0)
#define PG8_MMA(ai, bj, At, Bt) do { __builtin_amdgcn_s_setprio(1); _Pragma("unroll") for (int m = 0; m < 4; ++m) _Pragma("unroll") for (int n = 0; n < 2; ++n) _Pragma("unroll") for (int k = 0; k < 2; ++k) \
        acc[ai][bj][m][n] = __builtin_amdgcn_mfma_f32_16x16x32_bf16(Bt[n][k], At[m][k], acc[ai][bj][m][n], 0, 0, 0); __builtin_amdgcn_s_setprio(0); } while (0)
#define PG8_WAIT_V(n) asm volatile("s_waitcnt vmcnt(" #n ")" ::: "memory")
#define PG8_WAIT_L(n) asm volatile("s_waitcnt lgkmcnt(" #n ")" ::: "memory")
#define PG8_BAR __builtin_amdgcn_s_barrier()
#define PG8_SCHED __builtin_amdgcn_sched_barrier(0)
    Unit cur, nxt; int ui = 0;
    if (!S.next(0, cur)) return;
    f32x4 acc[2][2][4][2];
#pragma unroll
    for (int a = 0; a < 2; ++a)
#pragma unroll
        for (int b = 0; b < 2; ++b)
#pragma unroll
            for (int m = 0; m < 4; ++m)
#pragma unroll
                for (int n = 0; n < 2; ++n) acc[a][b][m][n] = (f32x4){0.f, 0.f, 0.f, 0.f};
    bf16x8 At[4][2], B0[2][2], B1[2][2];
    const char* cA = (const char*)g.A + (size_t)cur.pm * tstep; const char* cB = (const char*)g.Bt + (size_t)cur.pn * tstep;
    S.a_ready(cur);
    if constexpr (SP2) {
        PG8_STAGE(PG8_SB(0, 0), cB, voffB); PG8_STAGE(PG8_SB(0, 1), cB + hstep, voffB); PG8_STAGE(PG8_SA(0, 0), cA, voffA); PG8_STAGE(PG8_SA(0, 1), cA + hstep, voffA);
        if (wr == 1) PG8_BAR;
        PG8_WAIT_V(2); PG8_BAR;
        PG8_STAGE(PG8_SB(1, 0), cB + kstep, voffB); PG8_STAGE(PG8_SA(1, 0), cA + kstep, voffA); PG8_STAGE(PG8_SB(1, 1), cB + hstep + kstep, voffB);
        PG8_WAIT_V(6); PG8_BAR;
    } else {
        PG8_STAGE(PG8_SB(0, 0), cB, voffB); PG8_STAGE(PG8_SA(0, 0), cA, voffA); PG8_STAGE(PG8_SB(0, 1), cB + hstep, voffB); PG8_STAGE(PG8_SA(0, 1), cA + hstep, voffA);
        if (wr == 1) PG8_BAR;
        PG8_WAIT_V(4); PG8_BAR;
        PG8_STAGE(PG8_SB(1, 0), cB + kstep, voffB); PG8_STAGE(PG8_SA(1, 0), cA + kstep, voffA); PG8_STAGE(PG8_SB(1, 1), cB + hstep + kstep, voffB);
        PG8_WAIT_V(6); PG8_BAR;
    }
    for (;;) {
        const bool has_next = S.next(ui + 1, nxt);
        const char* nA = has_next ? (const char*)g.A + (size_t)nxt.pm * tstep : cA; const char* nB = has_next ? (const char*)g.Bt + (size_t)nxt.pn * tstep : cB;
        for (int t = 0; t < nt; t += 2) {
            const bool last = (t == nt - 2);
            const char* a1 = cA + (size_t)(t + 1) * kstep;
            const char* a2 = last ? nA : cA + (size_t)(t + 2) * kstep; const char* b2 = last ? nB : cB + (size_t)(t + 2) * kstep;
            const char* a3 = a2 + kstep; const char* b3 = b2 + kstep;
            if (last && has_next) S.a_ready(nxt);
            if constexpr (SP2) {
            PG8_LDB(B0, 0, 0); PG8_LDB(B1, 0, 1); PG8_SCHED; PG8_LDA(At, 0, 0); PG8_STAGE(PG8_SA(1, 1), a1 + hstep, voffA);
            PG8_WAIT_V(8); PG8_WAIT_L(0); PG8_BAR; PG8_MMA(0, 0, At, B0); PG8_MMA(0, 1, At, B1); PG8_BAR; PG8_SCHED;
            PG8_LDA(At, 0, 1); PG8_STAGE(PG8_SB(0, 0), b2, voffB); PG8_STAGE(PG8_SB(0, 1), b2 + hstep, voffB); PG8_STAGE(PG8_SA(0, 0), a2, voffA);
            PG8_WAIT_V(8); PG8_WAIT_L(0); PG8_BAR; PG8_MMA(1, 0, At, B0); PG8_MMA(1, 1, At, B1); PG8_BAR; PG8_SCHED;
            PG8_LDB(B0, 1, 0); PG8_LDB(B1, 1, 1); PG8_SCHED; PG8_LDA(At, 1, 0); PG8_STAGE(PG8_SA(0, 1), a2 + hstep, voffA);
            PG8_WAIT_V(8); PG8_WAIT_L(0); PG8_BAR; PG8_MMA(0, 0, At, B0); PG8_MMA(0, 1, At, B1); PG8_BAR; PG8_SCHED;
            PG8_LDA(At, 1, 1); PG8_STAGE(PG8_SB(1, 0), b3, voffB); PG8_STAGE(PG8_SB(1, 1), b3 + hstep, voffB); PG8_STAGE(PG8_SA(1, 0), a3, voffA);
            PG8_WAIT_V(8); PG8_WAIT_L(0); PG8_BAR; PG8_MMA(1, 0, At, B0); PG8_MMA(1, 1, At, B1); PG8_BAR; PG8_SCHED;
            } else {
            PG8_LDB(B0, 0, 0); PG8_SCHED; PG8_LDA(At, 0, 0); PG8_STAGE(PG8_SA(1, 1), a1 + hstep, voffA);
            PG8_WAIT_L(8); PG8_BAR; PG8_WAIT_L(0); PG8_MMA(0, 0, At, B0); PG8_BAR; PG8_SCHED;
            PG8_LDB(B1, 0, 1); PG8_STAGE(PG8_SB(0, 0), b2, voffB);
            PG8_BAR; PG8_WAIT_L(0); PG8_MMA(0, 1, At, B1); PG8_BAR;
            PG8_LDA(At, 0, 1); PG8_STAGE(PG8_SA(0, 0), a2, voffA);
            PG8_BAR; PG8_WAIT_L(0); PG8_MMA(1, 0, At, B0); PG8_BAR; PG8_SCHED;
            PG8_STAGE(PG8_SB(0, 1), b2 + hstep, voffB);
            PG8_WAIT_V(6); PG8_BAR; PG8_MMA(1, 1, At, B1); PG8_BAR;
            PG8_LDB(B0, 1, 0); PG8_SCHED; PG8_LDA(At, 1, 0); PG8_STAGE(PG8_SA(0, 1), a2 + hstep, voffA);
            PG8_WAIT_L(8); PG8_BAR; PG8_WAIT_L(0); PG8_MMA(0, 0, At, B0); PG8_BAR; PG8_SCHED;
            PG8_LDB(B1, 1, 1); PG8_STAGE(PG8_SB(1, 0), b3, voffB);
            PG8_BAR; PG8_WAIT_L(0); PG8_MMA(0, 1, At, B1); PG8_BAR;
            PG8_LDA(At, 1, 1); PG8_STAGE(PG8_SA(1, 0), a3, voffA);
            PG8_BAR; PG8_WAIT_L(0); PG8_MMA(1, 0, At, B0); PG8_BAR; PG8_SCHED;
            PG8_STAGE(PG8_SB(1, 1), b3 + hstep, voffB);
            PG8_WAIT_V(6); PG8_BAR; PG8_MMA(1, 1, At, B1); PG8_BAR;
            }
        }
        if constexpr (ALIGN_EPI) { if (wr == 0) PG8_BAR; }
        if constexpr (!Epi::AFTER_DRAIN) { E(acc, cur, wr, wc, fr, fq); S.done(cur); }
        if (!has_next) break;
#pragma unroll
        for (int a = 0; a < 2; ++a)
#pragma unroll
            for (int b = 0; b < 2; ++b)
#pragma unroll
                for (int m = 0; m < 4; ++m)
#pragma unroll
                    for (int n = 0; n < 2; ++n) acc[a][b][m][n] = (f32x4){0.f, 0.f, 0.f, 0.f};
        cur = nxt; cA = nA; cB = nB; ++ui;
        if constexpr (ALIGN_EPI) { if (wr == 1) PG8_BAR; }
    }
    PG8_WAIT_V(0);
    if constexpr (!ALIGN_EPI) { if (wr == 0) PG8_BAR; }
    PG8_BAR;
    if constexpr (Epi::AFTER_DRAIN) { E.fused(acc, cur, wr, wc, fr, fq, lds, wid, lane); S.done(cur); }
#undef PG8_SA
#undef PG8_SB
#undef PG8_STAGE
#undef PG8_LDA
#undef PG8_LDB
#undef PG8_MMA
#undef PG8_WAIT_V
#undef PG8_WAIT_L
#undef PG8_BAR
#undef PG8_SCHED
}
}

#ifndef PG8_SP2
#define PG8_SP2 true
#endif
#ifndef PG8_ALIGN
#define PG8_ALIGN true
#endif
#include <hip/hip_bf16.h>
#include <cmath>
namespace attn_body {
using bf16=__hip_bfloat16;
using bf16x8=__attribute__((ext_vector_type(8)))short;
using s16x4=__attribute__((ext_vector_type(4)))short;
using f32x16=__attribute__((ext_vector_type(16)))float;
using u32x4=__attribute__((ext_vector_type(4)))unsigned;
constexpr int SEQ=8192,D=64,PQ=3328,PK=3328,PV=3328,PO=2048;
constexpr int NW=8,QBLK=32,QB=QBLK*NW,KVBLK=64,NQB=SEQ/QB;
constexpr int ATTN_UNIT_ROWS=QB;
__device__ __forceinline__ int crow(int r,int hi){return (r&3)+8*(r>>2)+4*hi;}
#define SBAR() __builtin_amdgcn_sched_barrier(0)
__device__ __forceinline__ void cmask(f32x16&p0,f32x16&p1,int jb,int qrel,int hi){
  const float NEG=-INFINITY; int kb=64*jb+4*hi;
  #pragma unroll
  for(int r=0;r<16;++r){int kv=kb+(r&3)+8*(r>>2); if(kv>qrel)p0[r]=NEG; if(kv+32>qrel)p1[r]=NEG;}
}

constexpr int NSLOT=3, SLOTB=8192;
constexpr int LDS_K=0, LDS_V=NSLOT*SLOTB, LDS_WS=2*NSLOT*SLOTB, LDS_OST=LDS_WS+NW*64*4, LDS_BYTES=LDS_OST+NW*4096;
constexpr float C2=0.125f*1.4426950408889634f;
__device__ __forceinline__ void glds16(const void*gsrc,unsigned lds_dst){unsigned keep;
  asm volatile("s_mov_b32 %0, m0\n\ts_mov_b32 m0, %2\n\ts_nop 0\n\tglobal_load_lds_dwordx4 %1, off\n\ts_mov_b32 m0, %0":"=&s"(keep):"v"(gsrc),"s"(lds_dst):"memory");}
__device__ __forceinline__ float max3f(float a,float b,float c){float r;asm("v_max3_f32 %0, %1, %2, %3":"=v"(r):"v"(a),"v"(b),"v"(c));return r;}
__device__ __forceinline__ float max2f(float a,float b){float r;asm("v_max_f32_e32 %0, %1, %2":"=v"(r):"v"(a),"v"(b));return r;}
__device__ __forceinline__ float fadd_s(float a,float b){float r;asm("v_add_f32_e32 %0, %1, %2":"=v"(r):"v"(a),"v"(b));return r;}
__device__ __forceinline__ float fsub_s(float a,float b){float r;asm("v_sub_f32_e32 %0, %1, %2":"=v"(r):"v"(a),"v"(b));return r;}
typedef float f32x2_t __attribute__((ext_vector_type(2))); typedef __bf16 bf16x2_t __attribute__((ext_vector_type(2)));
__device__ __forceinline__ unsigned cvtpk_s(float lo,float hi){f32x2_t v={lo,hi};bf16x2_t b=__builtin_convertvector(v,bf16x2_t);return __builtin_bit_cast(unsigned,b);}
#define WAIT_BAR(N) asm volatile("s_waitcnt vmcnt(" #N ") lgkmcnt(0)\n\ts_barrier":::"memory")

__device__ __forceinline__ void qkt(f32x16&p0,f32x16&p1,const char*Kslot,const bf16x8*qr,const f32x16&negm,int r32,int hi){
  const char*kb=Kslot+hi*1024+r32*16;
  #pragma unroll
  for(int d0=0;d0<4;++d0){
    const bf16x8 b0=*reinterpret_cast<const bf16x8*>(kb+d0*2048);
    const bf16x8 b1=*reinterpret_cast<const bf16x8*>(kb+d0*2048+512);
    if(d0==0){p0=__builtin_amdgcn_mfma_f32_32x32x16_bf16(b0,qr[0],negm,0,0,0);p1=__builtin_amdgcn_mfma_f32_32x32x16_bf16(b1,qr[0],negm,0,0,0);}
    else{p0=__builtin_amdgcn_mfma_f32_32x32x16_bf16(b0,qr[d0],p0,0,0,0);p1=__builtin_amdgcn_mfma_f32_32x32x16_bf16(b1,qr[d0],p1,0,0,0);}}
}
typedef __attribute__((address_space(3))) const char* lds_cptr;
typedef short v4i16_t __attribute__((ext_vector_type(4)));
__device__ __forceinline__ void kload8(bf16x8*kf,lds_cptr kp){
  kf[0]=*(const __attribute__((address_space(3))) bf16x8*)(kp);      kf[1]=*(const __attribute__((address_space(3))) bf16x8*)(kp+512);
  kf[2]=*(const __attribute__((address_space(3))) bf16x8*)(kp+2048); kf[3]=*(const __attribute__((address_space(3))) bf16x8*)(kp+2560);
  kf[4]=*(const __attribute__((address_space(3))) bf16x8*)(kp+4096); kf[5]=*(const __attribute__((address_space(3))) bf16x8*)(kp+4608);
  kf[6]=*(const __attribute__((address_space(3))) bf16x8*)(kp+6144); kf[7]=*(const __attribute__((address_space(3))) bf16x8*)(kp+6656);
}
__device__ __forceinline__ void kload2(bf16x8*kf,lds_cptr kp,int j){ kf[2*j]=*(const __attribute__((address_space(3))) bf16x8*)(kp+j*2048); kf[2*j+1]=*(const __attribute__((address_space(3))) bf16x8*)(kp+j*2048+512); }
__device__ __forceinline__ s16x4 vtr(lds_cptr p){ return __builtin_bit_cast(s16x4,__builtin_amdgcn_ds_read_tr16_b64_v4i16((__attribute__((address_space(3))) v4i16_t*)p)); }
__device__ __forceinline__ float rowmax(const f32x16&p0,const f32x16&p1){
  float a=max3f(p0[0],p0[1],p1[0]),b=max3f(p0[2],p0[3],p1[1]);a=max3f(a,p1[2],p1[3]);
  #pragma unroll
  for(int r=4;r<16;r+=4){a=max3f(a,p0[r],p0[r+1]);b=max3f(b,p0[r+2],p0[r+3]);a=max3f(a,p1[r],p1[r+1]);b=max3f(b,p1[r+2],p1[r+3]);}
  const float m=max2f(a,b);
  auto rr=__builtin_amdgcn_permlane32_swap(__float_as_uint(m),__float_as_uint(m),false,false);
  return max2f(__uint_as_float(rr[0]),__uint_as_float(rr[1]));
}
__device__ __forceinline__ void pv(f32x16*o,int vb,bf16x8 pa0,bf16x8 pa1,bf16x8 pa2,bf16x8 pa3){
  #pragma unroll
  for(int d0=0;d0<2;++d0){s16x4 lo[4],hi[4];
    #pragma unroll
    for(int ks=0;ks<4;++ks){
      asm volatile("ds_read_b64_tr_b16 %0,%1 offset:%c2":"=&v"(lo[ks]):"v"(vb),"i"(d0*4096+ks*1024):"memory");
      asm volatile("ds_read_b64_tr_b16 %0,%1 offset:%c2":"=&v"(hi[ks]):"v"(vb),"i"(d0*4096+ks*1024+512):"memory");}
    asm volatile("s_waitcnt lgkmcnt(0)":::"memory");SBAR();
    #define PK(k) (bf16x8){lo[k][0],lo[k][1],lo[k][2],lo[k][3],hi[k][0],hi[k][1],hi[k][2],hi[k][3]}
    o[d0]=__builtin_amdgcn_mfma_f32_32x32x16_bf16(pa0,PK(0),o[d0],0,0,0);
    o[d0]=__builtin_amdgcn_mfma_f32_32x32x16_bf16(pa1,PK(1),o[d0],0,0,0);
    o[d0]=__builtin_amdgcn_mfma_f32_32x32x16_bf16(pa2,PK(2),o[d0],0,0,0);
    o[d0]=__builtin_amdgcn_mfma_f32_32x32x16_bf16(pa3,PK(3),o[d0],0,0,0);
    #undef PK
  }
}

#ifndef ATTN_STORE16
#define ATTN_STORE16(p,v) (*(u32x4*)(p)=(v))
#endif
template<int THRL> __device__ __forceinline__ void attn_unit(int b,int qcol,int kcol,int vcol,int ocol,int qb,const bf16*Q,const bf16*__restrict__ K,const bf16*__restrict__ V,bf16*O,char*shm){
  int tid=threadIdx.x; asm volatile("":"+v"(tid));
  const int lane=tid&63,r32=lane&31,hi=lane>>5; const int wid=__builtin_amdgcn_readfirstlane(tid>>6);
  const long rowbase=(long)b*SEQ; const int q0=qb*QB;
  const bf16*Qw=Q+(rowbase+q0+wid*QBLK)*PQ+qcol;
  const bf16*Kh=K+rowbase*PK+kcol,*Vh=V+rowbase*PV+vcol;
  const unsigned lds0=(unsigned)(uintptr_t)shm;
  float*wsf=(float*)(shm+LDS_WS)+wid*64;
  const bf16*ksrc=Kh+(long)lane*PK+wid*8;
  const bf16*vsrc=Vh+(long)(16*(wid&3)+(lane>>2))*PV+(wid>>2)*32+(lane&3)*8;
  const unsigned kdst=lds0+LDS_K+wid*1024, vdst=lds0+LDS_V+wid*1024;
  #define DMA_K(t,slot) glds16(ksrc+(long)(t)*KVBLK*PK,(unsigned)__builtin_amdgcn_readfirstlane(kdst+(slot)))
  #define DMA_V(t,slot) glds16(vsrc+(long)(t)*KVBLK*PV,(unsigned)__builtin_amdgcn_readfirstlane(vdst+(slot)))
  const int vb0=(int)(lds0+LDS_V)+((lane>>4)&1)*32+(lane&3)*8+(4*hi+((lane&15)>>2))*64;
  const char*Kbase=shm+LDS_K; bf16x8 kf[8];
  const lds_cptr shm3=(lds_cptr)shm; const lds_cptr kp0=shm3+LDS_K+hi*1024+r32*16; const lds_cptr vp0=shm3+LDS_V+((lane>>4)&1)*32+(lane&3)*8+(4*hi+((lane&15)>>2))*64;
  const int NT=(q0+QB)/KVBLK;
  DMA_K(0,0);DMA_V(0,0);DMA_K(1,SLOTB);
  bf16x8 qr[4];
  #pragma unroll
  for(int d0=0;d0<4;++d0)qr[d0]=*reinterpret_cast<const bf16x8*>(&Qw[(long)r32*PQ+d0*16+hi*8]);
  float mhat=0.f,l_reg=0.f;f32x16 o[2];o[0]=f32x16{};o[1]=f32x16{};f32x16 negm=f32x16{};asm volatile("":"+v"(negm));
  const int qrel=wid*QBLK+r32;
  #define CMASK(P0,P1,t) do{int jb_=(t)-(NT-4); if(jb_>=0)cmask(P0,P1,jb_,qrel,hi);}while(0)
  bool resc=false;
  #define START(P0,P1) do{ const float rm=rowmax(P0,P1); resc=false; \
    { const float dl=rm; mhat=fadd_s(mhat,dl); \
      _Pragma("unroll") for(int r=0;r<16;++r){P0[r]=fsub_s(P0[r],dl);P1[r]=fsub_s(P1[r],dl);} \
      _Pragma("unroll") for(int r=0;r<16;++r)negm[r]=-mhat; asm volatile("":"+v"(negm)); } \
    _Pragma("unroll") for(int r=0;r<16;++r)P0[r]=__builtin_amdgcn_exp2f(P0[r]); }while(0)
  #define RESC() do{ if(resc){ asm volatile("s_waitcnt lgkmcnt(0)":::"memory"); \
      _Pragma("unroll") for(int d_=0;d_<2;++d_) _Pragma("unroll") for(int r=0;r<16;++r)o[d_][r]*=wsf[crow(r,hi)]; } }while(0)
  f32x16 pA0,pA1,pB0,pB1;
  int sl_prev=0,sl_cur=0,sl_next=SLOTB;
  #define ROT() do{sl_prev=sl_cur;sl_cur=sl_next;sl_next=(sl_next==(NSLOT-1)*SLOTB)?0:sl_next+SLOTB;}while(0)
  DMA_K(2,2*SLOTB);
  WAIT_BAR(3);
  qkt(pA0,pA1,Kbase,qr,negm,r32,hi);asm volatile("s_nop 15\n\ts_nop 7":"+v"(pA0),"+v"(pA1));CMASK(pA0,pA1,0);
  START(pA0,pA1);
  _Pragma("unroll") for(int r=0;r<16;++r)pA1[r]=__builtin_amdgcn_exp2f(pA1[r]);
  WAIT_BAR(0);
  DMA_K(3,0);DMA_V(1,SLOTB);
  ROT();
  kload8(kf,kp0+sl_cur);
  WAIT_BAR(2);
  s16x4 vlo[8],vhi[8]; u32x4 pw0,pw1,pw2,pw3;
  #define PKW(P,B) cvtpk_s(P[B],P[B+1])
  #define PAF(k) __builtin_bit_cast(bf16x8,pw##k)
  #define VFR(i) (bf16x8){vlo[i][0],vlo[i][1],vlo[i][2],vlo[i][3],vhi[i][0],vhi[i][1],vhi[i][2],vhi[i][3]}
  #define PIN(x) asm volatile("":"+v"(x))
  #define MX3(a,b,c) __builtin_fmaxf(__builtin_fmaxf((a),(b)),(c))
  #define GAPA(MF,A0,A1,A2,A3,W0,W1,PW) do{ MF; sacc+=A0; sacc+=A1; sacc+=A2; sacc+=A3; PIN(sacc); W0; W1; PIN(PW); SBAR(); }while(0)
  #define EX(v) __builtin_amdgcn_exp2f(v)
  #define GAPB(MF,X,B) do{ MF; X[B]=EX(X[B]); X[B+1]=EX(X[B+1]); X[B+2]=EX(X[B+2]); X[B+3]=EX(X[B+3]); PIN(X); SBAR(); }while(0)
  #define VRD(i) do{ vlo[i]=vtr(vp_+(((i)>>2)*4096+((i)&3)*1024)); vhi[i]=vtr(vp_+(((i)>>2)*4096+((i)&3)*1024+512)); }while(0)
  #define KRD(G,j) do{ if(G){ kload2(kf,kp0+sl_next,j); SBAR(); } }while(0)
  #define STEP(C0,C1,P0,P1,t,GK,GV,GL) do{ SBAR(); \
    const lds_cptr vp_=vp0+sl_prev; \
    VRD(0); SBAR(); float sacc=(P0[0]+P0[1]); \
    GAPA(C0=__builtin_amdgcn_mfma_f32_32x32x16_bf16(kf[0],qr[0],negm,0,0,0), P0[2],P0[3],P0[4],P0[5],     pw0[0]=PKW(P0,0), pw0[1]=PKW(P0,2), pw0); \
    VRD(4); SBAR(); GAPA(C1=__builtin_amdgcn_mfma_f32_32x32x16_bf16(kf[1],qr[0],negm,0,0,0), P0[6],P0[7],P0[8],P0[9],     pw0[2]=PKW(P0,4), pw0[3]=PKW(P0,6), pw0); \
    VRD(1); SBAR(); GAPA(C0=__builtin_amdgcn_mfma_f32_32x32x16_bf16(kf[2],qr[1],C0,0,0,0),   P0[10],P0[11],P0[12],P0[13], pw1[0]=PKW(P0,8), pw1[1]=PKW(P0,10), pw1); \
    VRD(5); SBAR(); GAPA(C1=__builtin_amdgcn_mfma_f32_32x32x16_bf16(kf[3],qr[1],C1,0,0,0),   P0[14],P0[15],P1[0],P1[1],   pw1[2]=PKW(P0,12),pw1[3]=PKW(P0,14), pw1); \
    VRD(2); SBAR(); GAPA(C0=__builtin_amdgcn_mfma_f32_32x32x16_bf16(kf[4],qr[2],C0,0,0,0),   P1[2],P1[3],P1[4],P1[5],     pw2[0]=PKW(P1,0), pw2[1]=PKW(P1,2), pw2); \
    VRD(6); SBAR(); GAPA(C1=__builtin_amdgcn_mfma_f32_32x32x16_bf16(kf[5],qr[2],C1,0,0,0),   P1[6],P1[7],P1[8],P1[9],     pw2[2]=PKW(P1,4), pw2[3]=PKW(P1,6), pw2); \
    VRD(3); SBAR(); GAPA(C0=__builtin_amdgcn_mfma_f32_32x32x16_bf16(kf[6],qr[3],C0,0,0,0),   P1[10],P1[11],P1[12],P1[13], pw3[0]=PKW(P1,8), pw3[1]=PKW(P1,10), pw3); \
    VRD(7); SBAR(); GAPA(C1=__builtin_amdgcn_mfma_f32_32x32x16_bf16(kf[7],qr[3],C1,0,0,0),   P1[14],P1[15],0.f,0.f,       pw3[2]=PKW(P1,12),pw3[3]=PKW(P1,14), pw3); \
    l_reg+=sacc; \
    if(GK){DMA_K((t)+3,sl_cur);} if(GV){DMA_V((t)+1,sl_next);} \
    CMASK(C0,C1,t); \
    { float a=MX3(C0[0],C0[1],C1[0]),b=MX3(C0[2],C0[3],C1[1]); a=MX3(a,C1[2],C1[3]); \
      _Pragma("unroll") for(int r=4;r<16;r+=4){a=MX3(a,C0[r],C0[r+1]);b=MX3(b,C0[r+2],C0[r+3]);a=MX3(a,C1[r],C1[r+1]);b=MX3(b,C1[r+2],C1[r+3]);} \
      float rm=__builtin_fmaxf(a,b); { auto rr=__builtin_amdgcn_permlane32_swap(__float_as_uint(rm),__float_as_uint(rm),false,false); rm=__builtin_fmaxf(__uint_as_float(rr[0]),__uint_as_float(rr[1])); } \
      resc=false; \
      if(__builtin_expect(__any(rm>(float)THRL),0)){ const float dl=__builtin_fmaxf(rm,0.f); mhat+=dl; \
        _Pragma("unroll") for(int r=0;r<16;++r){C0[r]-=dl;C1[r]-=dl;} \
        _Pragma("unroll") for(int r=0;r<16;++r)negm[r]=-mhat; asm volatile("":"+v"(negm)); \
        const float f=__builtin_amdgcn_exp2f(-dl); l_reg*=f; if(hi==0)wsf[r32]=f; resc=true; } } \
    SBAR(); \
    GAPB(o[0]=__builtin_amdgcn_mfma_f32_32x32x16_bf16(PAF(0),VFR(0),o[0],0,0,0), C0,0); \
    GAPB(o[1]=__builtin_amdgcn_mfma_f32_32x32x16_bf16(PAF(0),VFR(4),o[1],0,0,0), C0,4); \
    KRD(GL,0); GAPB(o[0]=__builtin_amdgcn_mfma_f32_32x32x16_bf16(PAF(1),VFR(1),o[0],0,0,0), C0,8); \
    KRD(GL,1); GAPB(o[1]=__builtin_amdgcn_mfma_f32_32x32x16_bf16(PAF(1),VFR(5),o[1],0,0,0), C0,12); \
    KRD(GL,2); GAPB(o[0]=__builtin_amdgcn_mfma_f32_32x32x16_bf16(PAF(2),VFR(2),o[0],0,0,0), C1,0); \
    KRD(GL,3); GAPB(o[1]=__builtin_amdgcn_mfma_f32_32x32x16_bf16(PAF(2),VFR(6),o[1],0,0,0), C1,4); \
    GAPB(o[0]=__builtin_amdgcn_mfma_f32_32x32x16_bf16(PAF(3),VFR(3),o[0],0,0,0), C1,8); \
    GAPB(o[1]=__builtin_amdgcn_mfma_f32_32x32x16_bf16(PAF(3),VFR(7),o[1],0,0,0), C1,12); \
    }while(0)
  int t=1;
  #undef CMASK
  #define CMASK(P0,P1,t) do{}while(0)
  for(;t+5<NT;t+=2){
    STEP(pB0,pB1,pA0,pA1,t,true,true,true);     WAIT_BAR(2); RESC(); ROT();
    STEP(pA0,pA1,pB0,pB1,t+1,true,true,true);   WAIT_BAR(2); RESC(); ROT();
  }
  #undef CMASK
  #define CMASK(P0,P1,t) do{int jb_=(t)-(NT-4); if(jb_>=0)cmask(P0,P1,jb_,qrel,hi);}while(0)
  #define ENDW(tt) do{ if((tt)+3<NT){WAIT_BAR(2);} else if((tt)+2<NT){WAIT_BAR(1);} else {WAIT_BAR(0);} }while(0)
  for(;t+1<NT;t+=2){
    STEP(pB0,pB1,pA0,pA1,t,(t+3<NT),(t+1<NT),(t+1<NT));       ENDW(t);   RESC(); ROT();
    STEP(pA0,pA1,pB0,pB1,t+1,(t+4<NT),(t+2<NT),(t+2<NT));     ENDW(t+1); RESC(); ROT();
  }
  STEP(pB0,pB1,pA0,pA1,NT-1,false,false,false); RESC();
  { float sacc=pB0[0]+pB0[1]; _Pragma("unroll") for(int r=2;r<16;++r)sacc+=pB0[r]; _Pragma("unroll") for(int r=0;r<16;++r)sacc+=pB1[r]; l_reg+=sacc;
    pw0=(u32x4){PKW(pB0,0),PKW(pB0,2),PKW(pB0,4),PKW(pB0,6)};pw1=(u32x4){PKW(pB0,8),PKW(pB0,10),PKW(pB0,12),PKW(pB0,14)};pw2=(u32x4){PKW(pB1,0),PKW(pB1,2),PKW(pB1,4),PKW(pB1,6)};pw3=(u32x4){PKW(pB1,8),PKW(pB1,10),PKW(pB1,12),PKW(pB1,14)};
    SBAR(); pv(o,vb0+sl_cur,PAF(0),PAF(1),PAF(2),PAF(3)); }
  #undef PKW
  #undef PAF
  #undef VFR
  #undef PIN
  #undef MX3
  #undef GAPA
  #undef GAPB
  #undef EX
  #undef VRD
  #undef KRD
  #undef STEP
  #undef ENDW
  {auto rr=__builtin_amdgcn_permlane32_swap(__float_as_uint(l_reg),__float_as_uint(l_reg),false,false);l_reg=__uint_as_float(rr[0])+__uint_as_float(rr[1]);}
  if(hi==0)wsf[32+r32]=l_reg;asm volatile("s_waitcnt lgkmcnt(0)":::"memory");
  float rli[16];
  #pragma unroll
  for(int r=0;r<16;++r)rli[r]=__builtin_amdgcn_rcpf(wsf[32+crow(r,hi)]);
  bf16*Ow=O+(rowbase+q0+wid*QBLK)*PO+ocol;
  { bf16*stg=(bf16*)(shm+LDS_OST)+wid*2048;
    #pragma unroll
    for(int r=0;r<16;++r){const int orow=crow(r,hi);
      #pragma unroll
      for(int d0=0;d0<2;++d0)stg[orow*64+d0*32+r32]=__float2bfloat16(o[d0][r]*rli[r]);}
    asm volatile("s_waitcnt lgkmcnt(0)":::"memory");
    #pragma unroll
    for(int i=0;i<4;++i){const int row=i*8+(lane>>3),ch=lane&7; const u32x4 v=*(const u32x4*)(stg+row*64+ch*8); ATTN_STORE16(Ow+(long)row*PO+ch*8,v);} }
  asm volatile("s_waitcnt lgkmcnt(0)\n\ts_barrier":::"memory");
  #undef DMA_K
  #undef DMA_V
  #undef CMASK
  #undef START
  #undef RESC
  #undef ROT
}
constexpr int ATTN_LDS_BYTES=LDS_BYTES;
#undef SBAR
#undef WAIT_BAR
}
#include <hip/hip_bf16.h>
#include <cmath>
namespace attn_body2 {
using bf16=__hip_bfloat16;
using bf16x8=__attribute__((ext_vector_type(8)))short;
using s16x4=__attribute__((ext_vector_type(4)))short;
using f32x16=__attribute__((ext_vector_type(16)))float;
using u32x4=__attribute__((ext_vector_type(4)))unsigned;
constexpr int SEQ=8192,D=64,PQ=3328,PK=3328,PV=3328,PO=2048;
constexpr int NW=8,QBLK=32,QB=QBLK*NW,KVBLK=64,NQB=SEQ/QB;
constexpr int ATTN_UNIT_ROWS=QB;
__device__ __forceinline__ int crow(int r,int hi){return (r&3)+8*(r>>2)+4*hi;}
#define SBAR() __builtin_amdgcn_sched_barrier(0)
__device__ __forceinline__ void cmask(f32x16&p0,f32x16&p1,int jb,int qrel,int hi){
  const float NEG=-INFINITY; int kb=64*jb+4*hi;
  #pragma unroll
  for(int r=0;r<16;++r){int kv=kb+(r&3)+8*(r>>2); if(kv>qrel)p0[r]=NEG; if(kv+32>qrel)p1[r]=NEG;}
}

constexpr int NSLOT=3, SLOTB=8192, VSLOT=16384;
constexpr int LDS_K=0, LDS_V=NSLOT*SLOTB, LDS_WS=LDS_V+NSLOT*VSLOT, LDS_OST=LDS_WS+NW*64*4, LDS_BYTES=LDS_OST+NW*8192;
constexpr float C2=0.125f*1.4426950408889634f;
__device__ __forceinline__ void glds16(const void*gsrc,unsigned lds_dst){unsigned keep;
  asm volatile("s_mov_b32 %0, m0\n\ts_mov_b32 m0, %2\n\ts_nop 0\n\tglobal_load_lds_dwordx4 %1, off\n\ts_mov_b32 m0, %0":"=&s"(keep):"v"(gsrc),"s"(lds_dst):"memory");}
__device__ __forceinline__ float max3f(float a,float b,float c){float r;asm("v_max3_f32 %0, %1, %2, %3":"=v"(r):"v"(a),"v"(b),"v"(c));return r;}
__device__ __forceinline__ float max2f(float a,float b){float r;asm("v_max_f32_e32 %0, %1, %2":"=v"(r):"v"(a),"v"(b));return r;}
__device__ __forceinline__ float fadd_s(float a,float b){float r;asm("v_add_f32_e32 %0, %1, %2":"=v"(r):"v"(a),"v"(b));return r;}
__device__ __forceinline__ float fsub_s(float a,float b){float r;asm("v_sub_f32_e32 %0, %1, %2":"=v"(r):"v"(a),"v"(b));return r;}
typedef float f32x2_t __attribute__((ext_vector_type(2))); typedef __bf16 bf16x2_t __attribute__((ext_vector_type(2)));
__device__ __forceinline__ unsigned cvtpk_s(float lo,float hi){f32x2_t v={lo,hi};bf16x2_t b=__builtin_convertvector(v,bf16x2_t);return __builtin_bit_cast(unsigned,b);}
#define WAIT_BAR(N) asm volatile("s_waitcnt vmcnt(" #N ") lgkmcnt(0)\n\ts_barrier":::"memory")

__device__ __forceinline__ void qkt(f32x16&p0,f32x16&p1,const char*Kslot,const bf16x8*qr,const f32x16&negm,int r32,int hi){
  const char*kb=Kslot+hi*1024+r32*16;
  #pragma unroll
  for(int d0=0;d0<4;++d0){
    const bf16x8 b0=*reinterpret_cast<const bf16x8*>(kb+d0*2048);
    const bf16x8 b1=*reinterpret_cast<const bf16x8*>(kb+d0*2048+512);
    if(d0==0){p0=__builtin_amdgcn_mfma_f32_32x32x16_bf16(b0,qr[0],negm,0,0,0);p1=__builtin_amdgcn_mfma_f32_32x32x16_bf16(b1,qr[0],negm,0,0,0);}
    else{p0=__builtin_amdgcn_mfma_f32_32x32x16_bf16(b0,qr[d0],p0,0,0,0);p1=__builtin_amdgcn_mfma_f32_32x32x16_bf16(b1,qr[d0],p1,0,0,0);}}
}
typedef __attribute__((address_space(3))) const char* lds_cptr;
typedef short v4i16_t __attribute__((ext_vector_type(4)));
__device__ __forceinline__ void kload8(bf16x8*kf,lds_cptr kp){
  kf[0]=*(const __attribute__((address_space(3))) bf16x8*)(kp);      kf[1]=*(const __attribute__((address_space(3))) bf16x8*)(kp+512);
  kf[2]=*(const __attribute__((address_space(3))) bf16x8*)(kp+2048); kf[3]=*(const __attribute__((address_space(3))) bf16x8*)(kp+2560);
  kf[4]=*(const __attribute__((address_space(3))) bf16x8*)(kp+4096); kf[5]=*(const __attribute__((address_space(3))) bf16x8*)(kp+4608);
  kf[6]=*(const __attribute__((address_space(3))) bf16x8*)(kp+6144); kf[7]=*(const __attribute__((address_space(3))) bf16x8*)(kp+6656);
}
__device__ __forceinline__ void kload2(bf16x8*kf,lds_cptr kp,int j){ kf[2*j]=*(const __attribute__((address_space(3))) bf16x8*)(kp+j*2048); kf[2*j+1]=*(const __attribute__((address_space(3))) bf16x8*)(kp+j*2048+512); }
__device__ __forceinline__ s16x4 vtr(lds_cptr p){ return __builtin_bit_cast(s16x4,__builtin_amdgcn_ds_read_tr16_b64_v4i16((__attribute__((address_space(3))) v4i16_t*)p)); }
__device__ __forceinline__ float rowmax(const f32x16&p0,const f32x16&p1){
  float a=max3f(p0[0],p0[1],p1[0]),b=max3f(p0[2],p0[3],p1[1]);a=max3f(a,p1[2],p1[3]);
  #pragma unroll
  for(int r=4;r<16;r+=4){a=max3f(a,p0[r],p0[r+1]);b=max3f(b,p0[r+2],p0[r+3]);a=max3f(a,p1[r],p1[r+1]);b=max3f(b,p1[r+2],p1[r+3]);}
  const float m=max2f(a,b);
  auto rr=__builtin_amdgcn_permlane32_swap(__float_as_uint(m),__float_as_uint(m),false,false);
  return max2f(__uint_as_float(rr[0]),__uint_as_float(rr[1]));
}
__device__ __forceinline__ void pv(f32x16*o,int vb,bf16x8 pa0,bf16x8 pa1,bf16x8 pa2,bf16x8 pa3){
  #pragma unroll
  for(int d0=0;d0<4;++d0){s16x4 lo[4],hi[4];
    #pragma unroll
    for(int ks=0;ks<4;++ks){
      asm volatile("ds_read_b64_tr_b16 %0,%1 offset:%c2":"=&v"(lo[ks]):"v"(vb),"i"(d0*4096+ks*1024):"memory");
      asm volatile("ds_read_b64_tr_b16 %0,%1 offset:%c2":"=&v"(hi[ks]):"v"(vb),"i"(d0*4096+ks*1024+512):"memory");}
    asm volatile("s_waitcnt lgkmcnt(0)":::"memory");SBAR();
    #define PK(k) (bf16x8){lo[k][0],lo[k][1],lo[k][2],lo[k][3],hi[k][0],hi[k][1],hi[k][2],hi[k][3]}
    o[d0]=__builtin_amdgcn_mfma_f32_32x32x16_bf16(pa0,PK(0),o[d0],0,0,0);
    o[d0]=__builtin_amdgcn_mfma_f32_32x32x16_bf16(pa1,PK(1),o[d0],0,0,0);
    o[d0]=__builtin_amdgcn_mfma_f32_32x32x16_bf16(pa2,PK(2),o[d0],0,0,0);
    o[d0]=__builtin_amdgcn_mfma_f32_32x32x16_bf16(pa3,PK(3),o[d0],0,0,0);
    #undef PK
  }
}

#ifndef ATTN_STORE16
#define ATTN_STORE16(p,v) (*(u32x4*)(p)=(v))
#endif
template<int THRL> __device__ __forceinline__ void attn_unit(int b,int qcol,int kcol,int vcol,int ocol,int qb,const bf16*Q,const bf16*__restrict__ K,const bf16*__restrict__ V,bf16*O,char*shm){
  int tid=threadIdx.x; asm volatile("":"+v"(tid));
  const int lane=tid&63,r32=lane&31,hi=lane>>5; const int wid=__builtin_amdgcn_readfirstlane(tid>>6);
  const long rowbase=(long)b*SEQ; const int q0=qb*QB;
  const bf16*Qw=Q+(rowbase+q0+wid*QBLK)*PQ+qcol;
  const bf16*Kh=K+rowbase*PK+kcol,*Vh=V+rowbase*PV+vcol;
  const unsigned lds0=(unsigned)(uintptr_t)shm;
  float*wsf=(float*)(shm+LDS_WS)+wid*64;
  const bf16*ksrc=Kh+(long)lane*PK+wid*8;
  const bf16*vsrc=Vh+(long)(16*(wid&3)+(lane>>2))*PV+(wid>>2)*32+(lane&3)*8;
  const unsigned kdst=lds0+LDS_K+wid*1024, vdst=lds0+LDS_V+wid*1024;
  #define DMA_K(t,slot) glds16(ksrc+(long)(t)*KVBLK*PK,(unsigned)__builtin_amdgcn_readfirstlane(kdst+(slot)))
  #define DMA_V(t,slot) do{ glds16(vsrc+(long)(t)*KVBLK*PV,(unsigned)__builtin_amdgcn_readfirstlane(vdst+2*(slot))); glds16(vsrc+64+(long)(t)*KVBLK*PV,(unsigned)__builtin_amdgcn_readfirstlane(vdst+2*(slot)+8192)); }while(0)
  const int vb0=(int)(lds0+LDS_V)+((lane>>4)&1)*32+(lane&3)*8+(4*hi+((lane&15)>>2))*64;
  const char*Kbase=shm+LDS_K; bf16x8 kf[8];
  const lds_cptr shm3=(lds_cptr)shm; const lds_cptr kp0=shm3+LDS_K+hi*1024+r32*16; const lds_cptr vp0=shm3+LDS_V+((lane>>4)&1)*32+(lane&3)*8+(4*hi+((lane&15)>>2))*64;
  const int NT=(q0+QB)/KVBLK;
  DMA_K(0,0);DMA_V(0,0);DMA_K(1,SLOTB);
  bf16x8 qr[4];
  #pragma unroll
  for(int d0=0;d0<4;++d0)qr[d0]=*reinterpret_cast<const bf16x8*>(&Qw[(long)r32*PQ+d0*16+hi*8]);
  { u32x4*qst_=(u32x4*)(shm+LDS_OST+wid*8192);
    _Pragma("unroll") for(int d0=0;d0<4;++d0)qst_[d0*64+lane]=__builtin_bit_cast(u32x4,qr[d0]); }
  const lds_cptr qsp=(lds_cptr)shm+LDS_OST+wid*8192+lane*16;
  float mhat=0.f,l_reg=0.f;f32x16 o[4];o[0]=f32x16{};o[1]=f32x16{};o[2]=f32x16{};o[3]=f32x16{};const f32x16 ZR=f32x16{};
  const int qrel=wid*QBLK+r32;
  #define CMASK(P0,P1,t) do{int jb_=(t)-(NT-4); if(jb_>=0)cmask(P0,P1,jb_,qrel,hi);}while(0)
  bool resc=false;
  #define START(P0,P1) do{ const float rm=rowmax(P0,P1); resc=false; \
    { const float dl=rm; mhat=fadd_s(mhat,dl); \
      _Pragma("unroll") for(int r=0;r<16;++r){P0[r]=fsub_s(P0[r],dl);P1[r]=fsub_s(P1[r],dl);} \
      } \
    _Pragma("unroll") for(int r=0;r<16;++r)P0[r]=__builtin_amdgcn_exp2f(P0[r]); }while(0)
  #define RESC() do{ if(resc){ asm volatile("s_waitcnt lgkmcnt(0)":::"memory"); \
      _Pragma("unroll") for(int d_=0;d_<4;++d_) _Pragma("unroll") for(int r=0;r<16;++r)o[d_][r]*=wsf[crow(r,hi)]; } }while(0)
  f32x16 pA0,pA1,pB0,pB1;
  int sl_prev=0,sl_cur=0,sl_next=SLOTB;
  #define ROT() do{sl_prev=sl_cur;sl_cur=sl_next;sl_next=(sl_next==(NSLOT-1)*SLOTB)?0:sl_next+SLOTB;}while(0)
  DMA_K(2,2*SLOTB);
  WAIT_BAR(4);
  qkt(pA0,pA1,Kbase,qr,ZR,r32,hi);asm volatile("s_nop 15\n\ts_nop 7":"+v"(pA0),"+v"(pA1));CMASK(pA0,pA1,0);
  START(pA0,pA1);
  _Pragma("unroll") for(int r=0;r<16;++r)pA1[r]=__builtin_amdgcn_exp2f(pA1[r]);
  WAIT_BAR(0);
  DMA_K(3,0);DMA_V(1,SLOTB);
  ROT();
  kload8(kf,kp0+sl_cur);
  WAIT_BAR(3);
  s16x4 vlo[8],vhi[8]; u32x4 pw0,pw1,pw2,pw3;
  #define PKW(P,B) cvtpk_s(P[B],P[B+1])
  #define PAF(k) __builtin_bit_cast(bf16x8,pw##k)
  #define VFR(i) (bf16x8){vlo[i][0],vlo[i][1],vlo[i][2],vlo[i][3],vhi[i][0],vhi[i][1],vhi[i][2],vhi[i][3]}
  #define PIN(x) asm volatile("":"+v"(x))
  #define MX3(a,b,c) __builtin_fmaxf(__builtin_fmaxf((a),(b)),(c))
  #define GAPA(MF,A0,A1,A2,A3,W0,W1,PW) do{ MF; sacc+=A0; sacc+=A1; sacc+=A2; sacc+=A3; PIN(sacc); W0; W1; PIN(PW); SBAR(); }while(0)
  #define EX(v) __builtin_amdgcn_exp2f(v)
  #define GAPB(MF,X,B) do{ MF; X[B]=EX(X[B]); X[B+1]=EX(X[B+1]); X[B+2]=EX(X[B+2]); X[B+3]=EX(X[B+3]); PIN(X); SBAR(); }while(0)
  #define VRD(i) do{ vlo[i]=vtr(vp_+(((i)>>2)*4096+((i)&3)*1024)); vhi[i]=vtr(vp_+(((i)>>2)*4096+((i)&3)*1024+512)); }while(0)
  #define VRD2(i) do{ vlo[i]=vtr(vp_+((((i)>>2)+2)*4096+((i)&3)*1024)); vhi[i]=vtr(vp_+((((i)>>2)+2)*4096+((i)&3)*1024+512)); }while(0)
  #define GAPB2(MF,X,B,RD) do{ MF; X[B]=__builtin_amdgcn_exp2f(X[B]); X[B+1]=__builtin_amdgcn_exp2f(X[B+1]); asm volatile("":"+v"(X)); RD; SBAR(); }while(0)
  #define KRD(G,j) do{ if(G){ kload2(kf,kp0+sl_next,j); SBAR(); } }while(0)
  #define STEP(C0,C1,P0,P1,t,GK,GV,GL) do{ SBAR(); \
    const lds_cptr vp_=vp0+2*sl_prev; \
    _Pragma("unroll") for(int d0=0;d0<4;++d0)qr[d0]=*(const __attribute__((address_space(3))) bf16x8*)(qsp+d0*1024); SBAR(); \
    float sacc=(P0[0]+P0[1]); \
    GAPA(C0=__builtin_amdgcn_mfma_f32_32x32x16_bf16(kf[0],qr[0],ZR,0,0,0), P0[2],P0[3],P0[4],P0[5],     pw0[0]=PKW(P0,0), pw0[1]=PKW(P0,2), pw0); VRD(0); SBAR(); \
    GAPA(C1=__builtin_amdgcn_mfma_f32_32x32x16_bf16(kf[1],qr[0],ZR,0,0,0), P0[6],P0[7],P0[8],P0[9],     pw0[2]=PKW(P0,4), pw0[3]=PKW(P0,6), pw0); VRD(4); SBAR(); \
    GAPA(C0=__builtin_amdgcn_mfma_f32_32x32x16_bf16(kf[2],qr[1],C0,0,0,0),   P0[10],P0[11],P0[12],P0[13], pw1[0]=PKW(P0,8), pw1[1]=PKW(P0,10), pw1); VRD(1); SBAR(); \
    GAPA(C1=__builtin_amdgcn_mfma_f32_32x32x16_bf16(kf[3],qr[1],C1,0,0,0),   P0[14],P0[15],P1[0],P1[1],   pw1[2]=PKW(P0,12),pw1[3]=PKW(P0,14), pw1); VRD(5); SBAR(); \
    GAPA(C0=__builtin_amdgcn_mfma_f32_32x32x16_bf16(kf[4],qr[2],C0,0,0,0),   P1[2],P1[3],P1[4],P1[5],     pw2[0]=PKW(P1,0), pw2[1]=PKW(P1,2), pw2); VRD(2); SBAR(); \
    GAPA(C1=__builtin_amdgcn_mfma_f32_32x32x16_bf16(kf[5],qr[2],C1,0,0,0),   P1[6],P1[7],P1[8],P1[9],     pw2[2]=PKW(P1,4), pw2[3]=PKW(P1,6), pw2); VRD(6); SBAR(); \
    GAPA(C0=__builtin_amdgcn_mfma_f32_32x32x16_bf16(kf[6],qr[3],C0,0,0,0),   P1[10],P1[11],P1[12],P1[13], pw3[0]=PKW(P1,8), pw3[1]=PKW(P1,10), pw3); VRD(3); SBAR(); \
    GAPA(C1=__builtin_amdgcn_mfma_f32_32x32x16_bf16(kf[7],qr[3],C1,0,0,0),   P1[14],P1[15],0.f,0.f,       pw3[2]=PKW(P1,12),pw3[3]=PKW(P1,14), pw3); VRD(7); SBAR(); \
    _Pragma("unroll") for(int r=0;r<16;++r){C0[r]-=mhat;C1[r]-=mhat;} \
    l_reg+=sacc; \
    if(GK){DMA_K((t)+3,sl_cur);} if(GV){DMA_V((t)+1,sl_next);} \
    CMASK(C0,C1,t); \
    { float a=MX3(C0[0],C0[1],C1[0]),b=MX3(C0[2],C0[3],C1[1]); a=MX3(a,C1[2],C1[3]); \
      _Pragma("unroll") for(int r=4;r<16;r+=4){a=MX3(a,C0[r],C0[r+1]);b=MX3(b,C0[r+2],C0[r+3]);a=MX3(a,C1[r],C1[r+1]);b=MX3(b,C1[r+2],C1[r+3]);} \
      float rm=__builtin_fmaxf(a,b); { auto rr=__builtin_amdgcn_permlane32_swap(__float_as_uint(rm),__float_as_uint(rm),false,false); rm=__builtin_fmaxf(__uint_as_float(rr[0]),__uint_as_float(rr[1])); } \
      resc=false; \
      if(__builtin_expect(__any(rm>(float)THRL),0)){ const float dl=__builtin_fmaxf(rm,0.f); mhat+=dl; \
        _Pragma("unroll") for(int r=0;r<16;++r){C0[r]-=dl;C1[r]-=dl;} \
        const float f=__builtin_amdgcn_exp2f(-dl); l_reg*=f; if(hi==0)wsf[r32]=f; resc=true; } } \
    SBAR(); \
      \
    GAPB2(o[0]=__builtin_amdgcn_mfma_f32_32x32x16_bf16(PAF(0),VFR(0),o[0],0,0,0), C0,0,  VRD2(0)); \
    GAPB2(o[1]=__builtin_amdgcn_mfma_f32_32x32x16_bf16(PAF(0),VFR(4),o[1],0,0,0), C0,2,  VRD2(4)); \
    GAPB2(o[0]=__builtin_amdgcn_mfma_f32_32x32x16_bf16(PAF(1),VFR(1),o[0],0,0,0), C0,4,  VRD2(1)); \
    GAPB2(o[1]=__builtin_amdgcn_mfma_f32_32x32x16_bf16(PAF(1),VFR(5),o[1],0,0,0), C0,6,  VRD2(5)); \
    GAPB2(o[0]=__builtin_amdgcn_mfma_f32_32x32x16_bf16(PAF(2),VFR(2),o[0],0,0,0), C0,8,  VRD2(2)); \
    GAPB2(o[1]=__builtin_amdgcn_mfma_f32_32x32x16_bf16(PAF(2),VFR(6),o[1],0,0,0), C0,10, VRD2(6)); \
    GAPB2(o[0]=__builtin_amdgcn_mfma_f32_32x32x16_bf16(PAF(3),VFR(3),o[0],0,0,0), C0,12, VRD2(3)); \
    GAPB2(o[1]=__builtin_amdgcn_mfma_f32_32x32x16_bf16(PAF(3),VFR(7),o[1],0,0,0), C0,14, VRD2(7)); \
      \
    GAPB2(o[2]=__builtin_amdgcn_mfma_f32_32x32x16_bf16(PAF(0),VFR(0),o[2],0,0,0), C1,0,  (void)0); \
    GAPB2(o[3]=__builtin_amdgcn_mfma_f32_32x32x16_bf16(PAF(0),VFR(4),o[3],0,0,0), C1,2,  (void)0); \
    KRD(GL,0); GAPB2(o[2]=__builtin_amdgcn_mfma_f32_32x32x16_bf16(PAF(1),VFR(1),o[2],0,0,0), C1,4,  (void)0); \
    KRD(GL,1); GAPB2(o[3]=__builtin_amdgcn_mfma_f32_32x32x16_bf16(PAF(1),VFR(5),o[3],0,0,0), C1,6,  (void)0); \
    KRD(GL,2); GAPB2(o[2]=__builtin_amdgcn_mfma_f32_32x32x16_bf16(PAF(2),VFR(2),o[2],0,0,0), C1,8,  (void)0); \
    KRD(GL,3); GAPB2(o[3]=__builtin_amdgcn_mfma_f32_32x32x16_bf16(PAF(2),VFR(6),o[3],0,0,0), C1,10, (void)0); \
    GAPB2(o[2]=__builtin_amdgcn_mfma_f32_32x32x16_bf16(PAF(3),VFR(3),o[2],0,0,0), C1,12, (void)0); \
    GAPB2(o[3]=__builtin_amdgcn_mfma_f32_32x32x16_bf16(PAF(3),VFR(7),o[3],0,0,0), C1,14, (void)0); \
    }while(0)
  int t=1;
  #undef CMASK
  #define CMASK(P0,P1,t) do{}while(0)
  for(;t+5<NT;t+=2){
    STEP(pB0,pB1,pA0,pA1,t,true,true,true);     WAIT_BAR(3); RESC(); ROT();
    STEP(pA0,pA1,pB0,pB1,t+1,true,true,true);   WAIT_BAR(3); RESC(); ROT();
  }
  #undef CMASK
  #define CMASK(P0,P1,t) do{int jb_=(t)-(NT-4); if(jb_>=0)cmask(P0,P1,jb_,qrel,hi);}while(0)
  #define ENDW(tt) do{ if((tt)+3<NT){WAIT_BAR(3);} else if((tt)+2<NT){WAIT_BAR(2);} else {WAIT_BAR(0);} }while(0)
  for(;t+1<NT;t+=2){
    STEP(pB0,pB1,pA0,pA1,t,(t+3<NT),(t+1<NT),(t+1<NT));       ENDW(t);   RESC(); ROT();
    STEP(pA0,pA1,pB0,pB1,t+1,(t+4<NT),(t+2<NT),(t+2<NT));     ENDW(t+1); RESC(); ROT();
  }
  STEP(pB0,pB1,pA0,pA1,NT-1,false,false,false); RESC();
  { float sacc=pB0[0]+pB0[1]; _Pragma("unroll") for(int r=2;r<16;++r)sacc+=pB0[r]; _Pragma("unroll") for(int r=0;r<16;++r)sacc+=pB1[r]; l_reg+=sacc;
    pw0=(u32x4){PKW(pB0,0),PKW(pB0,2),PKW(pB0,4),PKW(pB0,6)};pw1=(u32x4){PKW(pB0,8),PKW(pB0,10),PKW(pB0,12),PKW(pB0,14)};pw2=(u32x4){PKW(pB1,0),PKW(pB1,2),PKW(pB1,4),PKW(pB1,6)};pw3=(u32x4){PKW(pB1,8),PKW(pB1,10),PKW(pB1,12),PKW(pB1,14)};
    SBAR(); pv(o,vb0+2*sl_cur,PAF(0),PAF(1),PAF(2),PAF(3)); }
  #undef PKW
  #undef PAF
  #undef VFR
  #undef PIN
  #undef MX3
  #undef GAPA
  #undef GAPB
  #undef EX
  #undef VRD
  #undef VRD2
  #undef GAPB2
  #undef KRD
  #undef STEP
  #undef ENDW
  {auto rr=__builtin_amdgcn_permlane32_swap(__float_as_uint(l_reg),__float_as_uint(l_reg),false,false);l_reg=__uint_as_float(rr[0])+__uint_as_float(rr[1]);}
  if(hi==0)wsf[32+r32]=l_reg;asm volatile("s_waitcnt lgkmcnt(0)":::"memory");
  float rli[16];
  #pragma unroll
  for(int r=0;r<16;++r)rli[r]=__builtin_amdgcn_rcpf(wsf[32+crow(r,hi)]);
  bf16*Ow=O+(rowbase+q0+wid*QBLK)*PO+ocol;
  { bf16*stg=(bf16*)(shm+LDS_OST)+wid*4096;
    #pragma unroll
    for(int r=0;r<16;++r){const int orow=crow(r,hi);
      #pragma unroll
      for(int d0=0;d0<4;++d0)stg[orow*128+d0*32+r32]=__float2bfloat16(o[d0][r]*rli[r]);}
    asm volatile("s_waitcnt lgkmcnt(0)":::"memory");
    #pragma unroll
    for(int i=0;i<8;++i){const int row=i*4+(lane>>4),ch=lane&15; const u32x4 v=*(const u32x4*)(stg+row*128+ch*8); ATTN_STORE16(Ow+(long)row*PO+ch*8,v);} }
  asm volatile("s_waitcnt lgkmcnt(0)\n\ts_barrier":::"memory");
  #undef DMA_K
  #undef DMA_V
  #undef CMASK
  #undef START
  #undef RESC
  #undef ROT
}
constexpr int ATTN_LDS_BYTES=LDS_BYTES;
#undef SBAR
#undef WAIT_BAR
}
constexpr int NWAVES = 8;
#ifndef MK_N_LAUNCHES
#define MK_N_LAUNCHES 1
#endif
constexpr int NPHASE = 13;
constexpr int N_LAUNCHES = MK_N_LAUNCHES;

constexpr int NB = 4, SEQL = 8192, DMODEL = 1024, TOK = NB * SEQL;
constexpr int IN_W = 3088;
constexpr int NPROJ = 3328;
constexpr int C_GQ = 0, C_GK = 256, C_GV = 512, C_GZ = 1024, C_GR = 1280, C_DQ = 1792, C_DK = 2304, C_DV = 2816;
constexpr int NUNIT = 2048;
constexpr int PEER_N = 16384, NQP = 2048;
constexpr float RMS_EPS = 1e-6f;
constexpr float LAMBDA_INIT = 0.2f;

constexpr size_t MiB = 1u << 20;
constexpr size_t WS_CTL = 0, CTL_ZERO_BYTES = 65536;
constexpr size_t WS_WIN = 1 * MiB, WS_WOUT = 8 * MiB, WS_WQ = 10 * MiB, WS_KEYS = 14 * MiB;
constexpr size_t WS_KVT = 16 * MiB, WS_VT = 48 * MiB;
constexpr size_t WS_U = 16 * MiB, WS_V = 48 * MiB;
constexpr size_t WS_SGE = 80 * MiB, WS_AE = 96 * MiB, WS_OFFS = 112 * MiB;
constexpr size_t WS_XT = 384 * MiB;
constexpr size_t WS_AE2 = 208 * MiB, WS_CNT = 113 * MiB;
constexpr size_t WS_XN = 80 * MiB, WS_MIX = 80 * MiB;
constexpr size_t WS_PROJ = 144 * MiB;
constexpr size_t WS_XN2 = 144 * MiB, WS_QP = 208 * MiB;
constexpr size_t WS_O = 352 * MiB;
constexpr size_t WS_IDX = 352 * MiB;
constexpr size_t WS_KTT = 480 * MiB;
constexpr size_t WS_DEC = 496 * MiB;
constexpr size_t WS_ROPE = 497 * MiB;
constexpr size_t WS_SSP = 499 * MiB, WS_RSTD = 501 * MiB;
constexpr size_t WS_END = 502 * MiB;
constexpr int CW_BAR = 4096;

constexpr int RING_OFF = 0, RING_BYTES = 131072;
constexpr int LDSCTL_OFF = 163840 - 512, MISC_OFF = LDSCTL_OFF + 320;
constexpr int LDS_BYTES = 163840;
static_assert(MISC_OFF + 128 <= LDS_BYTES, "LDS map");

#define GAS __attribute__((address_space(1)))
#define LAS __attribute__((address_space(3)))
typedef unsigned short bf16;
typedef unsigned v4u __attribute__((ext_vector_type(4)));
typedef unsigned v2u __attribute__((ext_vector_type(2)));
typedef float f32x4 __attribute__((ext_vector_type(4)));
typedef float f32x16 __attribute__((ext_vector_type(16)));
typedef short bf16x8 __attribute__((ext_vector_type(8)));
typedef short s16x4 __attribute__((ext_vector_type(4)));
typedef GAS unsigned gu32;
typedef _Float16 h2 __attribute__((ext_vector_type(2)));
typedef _Float16 f16x8 __attribute__((ext_vector_type(8)));
#define RLX_AGENT __ATOMIC_RELAXED, __HIP_MEMORY_SCOPE_AGENT
#define LDS_WAIT() asm volatile("s_waitcnt lgkmcnt(0)" ::: "memory")
#define VM_WAIT() asm volatile("s_waitcnt vmcnt(0)" ::: "memory")
__device__ __forceinline__ unsigned f2bf(float f) { unsigned u = __builtin_bit_cast(unsigned, f); return (u + 0x7fffu + ((u >> 16) & 1u)) >> 16; }
__device__ __forceinline__ unsigned pk2(float lo, float hi) { return f2bf(lo) | (f2bf(hi) << 16); }
__device__ __forceinline__ unsigned pkh(float lo, float hi) { h2 v; v.x = (_Float16)lo; v.y = (_Float16)hi; return __builtin_bit_cast(unsigned, v); }
__device__ __forceinline__ h2 u2h(unsigned u) { return __builtin_bit_cast(h2, u); }
__device__ __forceinline__ void fma_mix_lo(float& acc, unsigned hb, float a) { asm("v_fma_mix_f32 %0, %1, %2, %0 op_sel_hi:[1,0,0]" : "+v"(acc) : "v"(hb), "v"(a)); }
__device__ __forceinline__ void fma_mix_hi(float& acc, unsigned hb, float a) { asm("v_fma_mix_f32 %0, %1, %2, %0 op_sel:[1,0,0] op_sel_hi:[1,0,0]" : "+v"(acc) : "v"(hb), "v"(a)); }
__device__ __forceinline__ f16x8 v2f16x8(v4u v) { return __builtin_bit_cast(f16x8, v); }
__device__ __forceinline__ long v2l(v2u v) { return __builtin_bit_cast(long, v); }
__device__ __forceinline__ unsigned pk8(float a, float b, float c, float d) { int w = __builtin_amdgcn_cvt_pk_fp8_f32(a, b, 0, false); w = __builtin_amdgcn_cvt_pk_fp8_f32(c, d, w, true); return (unsigned)w; }
__device__ __forceinline__ float bf2f(unsigned b) { return __builtin_bit_cast(float, b << 16); }
__device__ __forceinline__ float bflo(unsigned w) { return __builtin_bit_cast(float, w << 16); }
__device__ __forceinline__ float bfhi(unsigned w) { return __builtin_bit_cast(float, w & 0xffff0000u); }
__device__ __forceinline__ int crow(int r, int hi) { return (r & 3) + 8 * (r >> 2) + 4 * hi; }
__device__ __forceinline__ float wave_sum(float v) {
#pragma unroll
    for (int o = 1; o < 64; o <<= 1) v += __shfl_xor(v, o);
    return v;
}
__device__ __forceinline__ float fmax_s(float a, float b) { float r; asm("v_max_f32_e32 %0, %1, %2" : "=v"(r) : "v"(a), "v"(b)); return r; }
__device__ __forceinline__ float fmin_s(float a, float b) { float r; asm("v_min_f32_e32 %0, %1, %2" : "=v"(r) : "v"(a), "v"(b)); return r; }

#define XB_TMO      128
#define XB_XCNT(j)  (256  + 64 * (j))
#define XB_XSUB(j)  (1280 + 64 * (j))
#define XB_XGEN(j)  (2304 + 64 * (j))
#define XB_TOP      3328
#define XB_TOPGEN   3392
#define XCD_BAR_WORDS 3456
#define XB_SPIN_CAP (1u << 18)

__device__ __forceinline__ unsigned xb_ld(unsigned* p)              { return __hip_atomic_load(p, __ATOMIC_RELAXED, __HIP_MEMORY_SCOPE_AGENT); }
__device__ __forceinline__ unsigned xb_add(unsigned* p, unsigned v) { return __hip_atomic_fetch_add(p, v, __ATOMIC_RELAXED, __HIP_MEMORY_SCOPE_AGENT); }
__device__ __forceinline__ unsigned xb_xcc_id() { return (unsigned)__builtin_amdgcn_s_getreg((3 << 11) | 20) & 0xFu; }
#define XB_SPIN(cond, bar) do { unsigned _sp = 0; while (cond) { __builtin_amdgcn_s_sleep(1); \
    if ((++_sp & 255u) == 0u) { if (xb_ld(&(bar)[XB_TMO])) break; if (_sp > XB_SPIN_CAP) { atomicAdd(&(bar)[XB_TMO], 1u); break; } } } } while (0)

struct XcdBarrier {
    unsigned* bar; unsigned x;
    volatile LAS unsigned* st;
};

__device__ __forceinline__ XcdBarrier xcd_barrier_post(unsigned* bar, volatile LAS unsigned* st) {
    XcdBarrier b; b.bar = bar; b.x = xb_xcc_id(); b.st = st;
    if (threadIdx.x == 0) (void)xb_add(&bar[XB_XCNT(b.x)], 1u);
    return b;
}
__device__ __forceinline__ void xcd_barrier_complete(unsigned* bar, unsigned x, unsigned& nloc, unsigned& nx) {
    const unsigned G = gridDim.x * gridDim.y * gridDim.z;
    unsigned sum, cnt, mine, sp = 0u;
    for (;;) {
        sum = 0u; cnt = 0u; mine = 0u;
#pragma unroll
        for (unsigned j = 0; j < 16; ++j) { const unsigned c = xb_ld(&bar[XB_XCNT(j)]); sum += c; cnt += (c > 0u) ? 1u : 0u; mine = (j == x) ? c : mine; }
        if (sum == G) break;
        __builtin_amdgcn_s_sleep(1);
        if ((++sp & 255u) == 0u) { if (xb_ld(&bar[XB_TMO])) break; if (sp > XB_SPIN_CAP) { atomicAdd(&bar[XB_TMO], 1u); break; } }
    }
    nloc = mine > 0u ? mine : 1u; nx = cnt > 0u ? cnt : 1u;
}

__device__ __forceinline__ void xcd_barrier(const XcdBarrier& b) {
    asm volatile("s_waitcnt vmcnt(0)" ::: "memory");
    __syncthreads();
    if (threadIdx.x == 0) {
        unsigned* bar = b.bar;
        __builtin_amdgcn_s_waitcnt(0);
        unsigned nloc = b.st[0], nx = b.st[1];
        if (nloc == 0u) { xcd_barrier_complete(bar, b.x, nloc, nx); b.st[0] = nloc; b.st[1] = nx; }
        const unsigned old = xb_add(&bar[XB_XSUB(b.x)], 1u);
        const unsigned gen = old / nloc;
        if (old + 1u == (gen + 1u) * nloc) {
            __builtin_amdgcn_fence(__ATOMIC_RELEASE, "agent");
            asm volatile("s_waitcnt vmcnt(0)" ::: "memory");
            const unsigned og = xb_add(&bar[XB_TOP], 1u);
            const unsigned tg = og / nx;
            if (og + 1u == (tg + 1u) * nx) xb_add(&bar[XB_TOPGEN], 1u);
            else XB_SPIN(xb_ld(&bar[XB_TOPGEN]) == tg, bar);
            __builtin_amdgcn_fence(__ATOMIC_ACQUIRE, "agent");
            xb_add(&bar[XB_XGEN(b.x)], 1u);
            asm volatile("s_waitcnt vmcnt(0)" ::: "memory");
        } else {
            XB_SPIN(xb_ld(&bar[XB_XGEN(b.x)]) == gen, bar);
            __builtin_amdgcn_fence(__ATOMIC_ACQUIRE, "agent");
            asm volatile("s_waitcnt vmcnt(0)" ::: "memory");
        }
    }
    __syncthreads();
}


__device__ __forceinline__ void transpose_item(const float* W, int pitch, int K, bf16* WT, int row_off, LAS float* scr, int kb, int nb, int lane, const float* ksc = nullptr) {
    const int k0 = 64 * kb, n0 = 32 * nb;
#pragma unroll 8
    for (int i = 0; i < 32; ++i) { const int kk = 2 * i + (lane >> 5); const float w_ = W[(size_t)(k0 + kk) * pitch + n0 + (lane & 31)]; scr[kk * 33 + (lane & 31)] = ksc ? w_ * ksc[k0 + kk] : w_; }
    LDS_WAIT(); asm volatile("" ::: "memory");
    const int c = lane & 7;
#pragma unroll
    for (int j = 0; j < 4; ++j) { const int n = (lane >> 3) + 8 * j; const LAS float* s = scr + (8 * c) * 33 + n;
        v4u o; o.x = pk2(s[0 * 33], s[1 * 33]); o.y = pk2(s[2 * 33], s[3 * 33]); o.z = pk2(s[4 * 33], s[5 * 33]); o.w = pk2(s[6 * 33], s[7 * 33]);
        *(GAS v4u*)(WT + (size_t)(row_off + n0 + n) * K + k0 + 8 * c) = o; }
    LDS_WAIT(); asm volatile("" ::: "memory");
}
template <bool HALF_COPY> __device__ __forceinline__ void rms_row_to_bf16(const float* xrow, const float* gain, bf16* orow, LAS unsigned char* hrow, int lane) {
    const GAS f32x4* xr = (const GAS f32x4*)xrow + lane; const GAS f32x4* gr = (const GAS f32x4*)gain + lane;
    f32x4 v[4]; float s = 0.f;
#pragma unroll
    for (int j = 0; j < 4; ++j) { v[j] = xr[64 * j]; s += (v[j].x * v[j].x + v[j].y * v[j].y) + (v[j].z * v[j].z + v[j].w * v[j].w); }
    const float rstd = 1.f / sqrtf(wave_sum(s) * (1.f / DMODEL) + RMS_EPS);
    GAS unsigned long long* o8 = (GAS unsigned long long*)orow + lane;
#pragma unroll
    for (int j = 0; j < 4; ++j) { const f32x4 g = gr[64 * j];
        o8[64 * j] = (unsigned long long)pk2(v[j].x * rstd * g.x, v[j].y * rstd * g.y) | ((unsigned long long)pk2(v[j].z * rstd * g.z, v[j].w * rstd * g.w) << 32);
        if (HALF_COPY) ((LAS unsigned*)hrow + lane)[64 * j] = pk8(v[j].x * rstd * g.x, v[j].y * rstd * g.y, v[j].z * rstd * g.z, v[j].w * rstd * g.w); }
}

template <int S> __device__ __forceinline__ int shfl_xor_c(int v) {
    if constexpr (S == 1) return __builtin_amdgcn_mov_dpp(v, 0xB1, 0xF, 0xF, true);
    else if constexpr (S == 2) return __builtin_amdgcn_mov_dpp(v, 0x4E, 0xF, 0xF, true);
    else if constexpr (S == 4) return __builtin_amdgcn_mov_dpp(__builtin_amdgcn_mov_dpp(v, 0x1B, 0xF, 0xF, true), 0x141, 0xF, 0xF, true);
    else if constexpr (S == 8) return __builtin_amdgcn_mov_dpp(__builtin_amdgcn_mov_dpp(v, 0x141, 0xF, 0xF, true), 0x140, 0xF, 0xF, true);
    else return __shfl_xor(v, S);
}
template <int SIZE, int STRIDE> __device__ __forceinline__ void sort128_level(int& k0, int& k1, int lane) {
    if constexpr (STRIDE == 64) { const int mn = min(k0, k1), mxv = max(k0, k1); k0 = mn; k1 = mxv; }
    else {
        const bool lower = (lane & STRIDE) == 0;
        { const int o = shfl_xor_c<STRIDE>(k0); const bool up = ((lane & SIZE) == 0); k0 = (lower == up) ? min(k0, o) : max(k0, o); }
        { const int o = shfl_xor_c<STRIDE>(k1); const bool up = (((64 + lane) & SIZE) == 0); k1 = (lower == up) ? min(k1, o) : max(k1, o); }
    }
}
template <int SIZE, int STRIDE> __device__ __forceinline__ void sort128_merge(int& k0, int& k1, int lane) {
    sort128_level<SIZE, STRIDE>(k0, k1, lane);
    if constexpr (STRIDE > 1) sort128_merge<SIZE, STRIDE / 2>(k0, k1, lane);
}
template <int SIZE> __device__ __forceinline__ void sort128_from(int& k0, int& k1, int lane) {
    sort128_merge<SIZE, SIZE / 2>(k0, k1, lane);
    if constexpr (SIZE < 128) sort128_from<SIZE * 2>(k0, k1, lane);
}

__device__ __forceinline__ void ce_desc(float& a, float& b) { const float mx = fmax_s(a, b), mn = fmin_s(a, b); a = mx; b = mn; }
__device__ __forceinline__ void sort16_desc(float (&v)[16]) {
#pragma unroll
    for (int k = 2; k <= 16; k <<= 1) {
#pragma unroll
        for (int j = k >> 1; j > 0; j >>= 1) {
#pragma unroll
            for (int i = 0; i < 16; ++i) { const int l = i ^ j; if (l > i) { if ((i & k) == 0) ce_desc(v[i], v[l]); else ce_desc(v[l], v[i]); } }
        }
    }
}
__device__ __forceinline__ void merge16_desc(float (&a)[16], const float (&b)[16]) {
#pragma unroll
    for (int i = 0; i < 16; ++i) a[i] = fmax_s(a[i], b[15 - i]);
#pragma unroll
    for (int j = 8; j > 0; j >>= 1) {
#pragma unroll
        for (int i = 0; i < 16; ++i) { const int l = i ^ j; if (l > i) ce_desc(a[i], a[l]); }
    }
}
__device__ __forceinline__ float gelu_erf(float v) {
    const float av = fabsf(v), t = __builtin_amdgcn_rcpf(av * 0.2316418882f + 1.0f);
    float q = t * 0.5307027145f + (-0.7265760135f); q = q * t + 0.7107068705f; q = q * t + (-0.142248368f); q = q * t + 0.127414796f; q = q * t;
    const float e = __builtin_amdgcn_exp2f((v * v) * (-0.72134752044f));
    const float m = v * (q * e);
    return v < 0.f ? m : v - m;
}

struct Args { const void* in[20]; float* out; unsigned char* ws; int ph_lo, ph_hi, li, pad; };
__global__ void __launch_bounds__(NWAVES * 64, 2) hymba_fwd(Args args) {
    extern __shared__ __attribute__((aligned(16))) unsigned char lds[];
    LAS unsigned char* const ldsl = (LAS unsigned char*)lds;
    volatile LAS unsigned* const MISC = (volatile LAS unsigned*)(ldsl + MISC_OFF);
    const int tid = threadIdx.x, lane = tid & 63, wave = __builtin_amdgcn_readfirstlane(tid >> 6);
    const int G = gridDim.x; const int bx = blockIdx.x; const int vcu = (G % 8 == 0) ? (bx % 8) * (G / 8) + bx / 8 : bx;
    const int gw = vcu * NWAVES + wave, NGW = G * NWAVES;
    const int gt = vcu * (NWAVES * 64) + tid, NGT = G * NWAVES * 64;
    const int r32 = lane & 31, hi = lane >> 5;
#define PHASE_LOCALS int tid_o_ = threadIdx.x; asm volatile("" : "+v"(tid_o_)); const int tid = tid_o_, lane = tid & 63, r32 = lane & 31, hi = lane >> 5; const int gt = vcu * (NWAVES * 64) + tid; (void)r32; (void)hi; (void)gt; (void)lane;
    unsigned char* const ws = args.ws;
    gu32* const ctl = (gu32*)(ws + WS_CTL);
    const float* x = (const float*)args.in[0]; const int* positions = (const int*)args.in[1]; const float* g_mix = (const float*)args.in[2]; const float* w_in = (const float*)args.in[3];
    const float* w_gate = (const float*)args.in[4]; const float* b_gate = (const float*)args.in[5]; const float* g_gla_out = (const float*)args.in[6]; const float* g_q = (const float*)args.in[7];
    const float* g_k = (const float*)args.in[8]; const float* lq1 = (const float*)args.in[9]; const float* lk1 = (const float*)args.in[10]; const float* lq2 = (const float*)args.in[11];
    const float* lk2 = (const float*)args.in[12]; const float* g_sub = (const float*)args.in[13]; const float* w_out = (const float*)args.in[14]; const float* g_ffn = (const float*)args.in[15];
    const float* w_pq = (const float*)args.in[16]; const float* sub_keys = (const float*)args.in[17]; const float* peer_u = (const float*)args.in[18]; const float* peer_v = (const float*)args.in[19];
    float* const out = args.out;
    bf16* const Win_t = (bf16*)(ws + WS_WIN); bf16* const Wout_t = (bf16*)(ws + WS_WOUT); bf16* const Wq_t = (bf16*)(ws + WS_WQ); bf16* const KEYS = (bf16*)(ws + WS_KEYS);
    bf16* const KVT = (bf16*)(ws + WS_KVT); bf16* const VT = (bf16*)(ws + WS_VT); bf16* const UB = (bf16*)(ws + WS_U); bf16* const VB = (bf16*)(ws + WS_V);
    bf16* const XN = (bf16*)(ws + WS_XN); bf16* const MIX = (bf16*)(ws + WS_MIX); bf16* const PROJ = (bf16*)(ws + WS_PROJ); bf16* const XN2 = (bf16*)(ws + WS_XN2);
    bf16* const QP = (bf16*)(ws + WS_QP); bf16* const OAT = (bf16*)(ws + WS_O); int* const IDX = (int*)(ws + WS_IDX);
    unsigned* const SGE = (unsigned*)(ws + WS_SGE); unsigned* const AE = (unsigned*)(ws + WS_AE); unsigned char* const OFFS = ws + WS_OFFS; bf16* const XT = (bf16*)(ws + WS_XT); unsigned* const AE2 = (unsigned*)(ws + WS_AE2); unsigned char* const CNT = ws + WS_CNT;
    bf16* const UH = UB; bf16* const VH = VB;
    float* const SSP = (float*)(ws + WS_SSP); float* const RSTD = (float*)(ws + WS_RSTD);
    bf16* const KTT = (bf16*)(ws + WS_KTT); float* const DEC = (float*)(ws + WS_DEC); float* const ROPE_C = (float*)(ws + WS_ROPE); float* const ROPE_S = ROPE_C + TOK * 8;

    for (int u = tid; u < (LDS_BYTES - LDSCTL_OFF) / 4; u += NWAVES * 64) ((LAS unsigned*)(ldsl + LDSCTL_OFF))[u] = 0u;
    __syncthreads();
    XcdBarrier bar; bar.bar = (unsigned*)(ctl + CW_BAR); bar.x = 0; bar.st = nullptr;
    if (N_LAUNCHES == 1) bar = xcd_barrier_post((unsigned*)(ctl + CW_BAR), MISC + 8);
#define GRID_BAR() do { if (N_LAUNCHES == 1) { xcd_barrier(bar); } } while (0)
    const int lo = args.ph_lo, hi_ph = args.ph_hi;
#ifndef PHASE_MASK
#define PHASE_MASK 0x1fff
#endif
#define IN(k) (((PHASE_MASK >> (k)) & 1) && lo <= (k) && (k) < hi_ph)
#define BOTH(k) (IN(k) && IN((k) + 1))

    if (IN(0)) {
        PHASE_LOCALS
        LAS float* scr = (LAS float*)(ldsl + RING_OFF + wave * 16384);
        for (int it = gw; it < 3072; it += NGW) {
            int r = it;
            if (r < 512) { transpose_item(w_in, IN_W, DMODEL, Win_t, 0, scr, r >> 5, r & 31, lane); continue; } r -= 512;
            if (r < 1024) { transpose_item(w_in + 1040, IN_W, DMODEL, Win_t, 1280, scr, r >> 6, r & 63, lane); continue; } r -= 1024;
            if (r < 512) { transpose_item(w_out, DMODEL, DMODEL, Wout_t, 0, scr, r >> 5, r & 31, lane); continue; } r -= 512;
            transpose_item(w_pq, NQP, DMODEL, Wq_t, 0, scr, r >> 6, r & 63, lane, g_ffn);
        }
        for (int task = gt; task < 32768; task += NGT) {
            const int n = task >> 7, k0 = (task & 127) * 8;
            float wg[16];
#pragma unroll
            for (int r = 0; r < 16; ++r) wg[r] = w_gate[r * 256 + n];
            float acc[8];
#pragma unroll
            for (int j = 0; j < 8; ++j) { const f32x4* wr = (const f32x4*)(w_in + (size_t)(k0 + j) * IN_W + 1024); float a = 0.f;
#pragma unroll
                for (int q = 0; q < 4; ++q) { const f32x4 w4 = wr[q]; a += w4.x * wg[4 * q] + w4.y * wg[4 * q + 1] + w4.z * wg[4 * q + 2] + w4.w * wg[4 * q + 3]; }
                acc[j] = a; }
            v4u o; o.x = pk2(acc[0], acc[1]); o.y = pk2(acc[2], acc[3]); o.z = pk2(acc[4], acc[5]); o.w = pk2(acc[6], acc[7]);
            *(v4u*)(Win_t + (size_t)(1024 + n) * DMODEL + k0) = o;
        }
        for (int task = gt; task < 32768; task += NGT) {
            const f32x4 a = ((const f32x4*)sub_keys)[2 * task], b = ((const f32x4*)sub_keys)[2 * task + 1];
            v4u o; o.x = pk2(a.x, a.y); o.y = pk2(a.z, a.w); o.z = pk2(b.x, b.y); o.w = pk2(b.z, b.w); ((v4u*)KEYS)[task] = o;
        }
        for (int task = gt; task < TOK * 8; task += NGT) {
            const int t = task >> 3, i = task & 7;
            const double invf[8] = {1.0, 0.19392274474868576, 0.03760603093086393, 0.007292664737217109, 0.001414213562373095, 0.0002742481756762073, 5.318295896944988e-05, 1.031338537721246e-05};
            double inv = invf[0];
#pragma unroll
            for (int q = 1; q < 8; ++q) inv = (i == q) ? invf[q] : inv;
            const double ang = (double)positions[t] * inv;
            const double rr = ang - 6.283185307179586 * rint(ang * 0.15915494309189535);
            const float rf = (float)rr;
            ROPE_C[task] = cosf(rf); ROPE_S[task] = sinf(rf);
        }
        {
            f32x4 gg[4], vn[4];
#pragma unroll
            for (int j = 0; j < 4; ++j) { gg[j] = ((const f32x4*)g_mix)[lane + 64 * j]; vn[j] = ((const f32x4*)(x + (size_t)gw * DMODEL))[lane + 64 * j]; }
            for (int m = gw; m < TOK; m += NGW) {
                f32x4 v[4]; float sq = 0.f;
#pragma unroll
                for (int j = 0; j < 4; ++j) { v[j] = vn[j]; sq += (v[j].x * v[j].x + v[j].y * v[j].y) + (v[j].z * v[j].z + v[j].w * v[j].w); }
                const int mn = (m + NGW < TOK) ? m + NGW : m;
#pragma unroll
                for (int j = 0; j < 4; ++j) vn[j] = ((const f32x4*)(x + (size_t)mn * DMODEL))[lane + 64 * j];
                const float rstd = 1.f / sqrtf(wave_sum(sq) * (1.f / DMODEL) + RMS_EPS);
                unsigned long long* o8 = (unsigned long long*)(XN + (size_t)m * DMODEL) + lane;
#pragma unroll
                for (int j = 0; j < 4; ++j) o8[64 * j] = (unsigned long long)pk2(v[j].x * rstd * gg[j].x, v[j].y * rstd * gg[j].y) | ((unsigned long long)pk2(v[j].z * rstd * gg[j].z, v[j].w * rstd * gg[j].w) << 32);
            }
        }
        if (BOTH(0)) GRID_BAR();
    }

    if (IN(1)) {
        PHASE_LOCALS
        pg8::Gemm g{XN, Win_t, TOK, NPROJ, DMODEL}; pg8::StaticOrder S; S.init(TOK, NPROJ, G, (int)blockIdx.x);
        pg8::EpiBf16<0> E{PROJ, NPROJ, nullptr, 0, 0, 1.f};
        pg8::gemm_phase<pg8::EpiBf16<0>, pg8::StaticOrder, PG8_ALIGN, PG8_SP2>(ldsl + RING_OFF, g, S, E);
        if (BOTH(1)) GRID_BAR();
    }

    if (IN(2)) {
        PHASE_LOCALS
        for (int u = gw; u < NUNIT; u += NGW) {
            const int g = u >> 2, h = u & 3; const int su = ((g >> 7) * 4 + h) * 128 + (g & 127);
            bf16* const rowp = PROJ + (size_t)(g * 64) * NPROJ;
            const float bg = b_gate[h * 64 + lane];
            float bsum = 0.f;
            unsigned ktt[32], vt0[32], vt1[32];
#pragma unroll
            for (int c0 = 0; c0 < 64; c0 += 16) {
                unsigned zz[16], qq[16], kk[16], va[16], vb[16];
#pragma unroll
                for (int j = 0; j < 16; ++j) { const bf16* const r = rowp + (size_t)(c0 + j) * NPROJ;
                    zz[j] = r[C_GZ + h * 64 + lane]; qq[j] = r[C_GQ + h * 64 + lane]; kk[j] = r[C_GK + h * 64 + lane]; va[j] = r[C_GV + h * 128 + lane]; vb[j] = r[C_GV + h * 128 + 64 + lane]; }
#pragma unroll
                for (int j = 0; j < 16; ++j) { const int c = c0 + j;
                    bf16* const r = rowp + (size_t)c * NPROJ;
                    const float z = bf2f(zz[j]) + bg;
                    const float ls = fminf(z, 0.f) - __logf(1.f + __expf(-fabsf(z)));
                    bsum += ls * (1.f / 16.f);
                    const float eb = __expf(bsum), ebi = __expf(-bsum);
                    const float q = bf2f(qq[j]) * 0.125f * eb;
                    const float kt = bf2f(kk[j]) * ebi;
                    const unsigned ktb = f2bf(kt);
                    r[C_GQ + h * 64 + lane] = (bf16)f2bf(q); r[C_GK + h * 64 + lane] = (bf16)ktb;
                    const unsigned v0 = va[j], v1 = vb[j];
                    if (c & 1) { ktt[c >> 1] |= ktb << 16; vt0[c >> 1] |= v0 << 16; vt1[c >> 1] |= v1 << 16; }
                    else { ktt[c >> 1] = ktb; vt0[c >> 1] = v0; vt1[c >> 1] = v1; }
                }
            }
            DEC[su * 64 + lane] = __expf(bsum);
            v4u* kp = (v4u*)(KTT + ((size_t)u * 64 + lane) * 64); v4u* vp0 = (v4u*)(VT + ((size_t)u * 128 + lane) * 64); v4u* vp1 = (v4u*)(VT + ((size_t)u * 128 + 64 + lane) * 64);
#pragma unroll
            for (int q = 0; q < 8; ++q) { kp[q] = (v4u){ktt[4 * q], ktt[4 * q + 1], ktt[4 * q + 2], ktt[4 * q + 3]};
                vp0[q] = (v4u){vt0[4 * q], vt0[4 * q + 1], vt0[4 * q + 2], vt0[4 * q + 3]}; vp1[q] = (v4u){vt1[4 * q], vt1[4 * q + 1], vt1[4 * q + 2], vt1[4 * q + 3]}; }
        }
        {
            const int v = lane >> 2, qd = lane & 3;
            const int col = (v < 8 ? C_DQ + v * 64 : C_DK + (v - 8) * 64) + qd * 16;
            const float* gp = (v < 8 ? g_q : g_k) + qd * 16;
            float gn[16];
#pragma unroll
            for (int i = 0; i < 16; ++i) gn[i] = gp[i];
            const float osc = (v < 8) ? attn_body::C2 : 1.f;
            v4u w0 = ((const v4u*)(PROJ + (size_t)gw * NPROJ + col))[0], w1 = ((const v4u*)(PROJ + (size_t)gw * NPROJ + col))[1];
            f32x4 rc0 = *(const f32x4*)(ROPE_C + gw * 8), rc1 = *(const f32x4*)(ROPE_C + gw * 8 + 4), rs0 = *(const f32x4*)(ROPE_S + gw * 8), rs1 = *(const f32x4*)(ROPE_S + gw * 8 + 4);
            for (int t = gw; t < TOK; t += NGW) {
                v4u* p = (v4u*)(PROJ + (size_t)t * NPROJ + col);
                const int tn = (t + NGW < TOK) ? t + NGW : t;
                const v4u* pn = (const v4u*)(PROJ + (size_t)tn * NPROJ + col);
                const v4u n0 = pn[0], n1 = pn[1];
                const f32x4 c0 = rc0, c1 = rc1, s0 = rs0, s1 = rs1;
                rc0 = *(const f32x4*)(ROPE_C + tn * 8); rc1 = *(const f32x4*)(ROPE_C + tn * 8 + 4); rs0 = *(const f32x4*)(ROPE_S + tn * 8); rs1 = *(const f32x4*)(ROPE_S + tn * 8 + 4);
                float y[16];
                y[0] = bflo(w0.x); y[1] = bfhi(w0.x); y[2] = bflo(w0.y); y[3] = bfhi(w0.y); y[4] = bflo(w0.z); y[5] = bfhi(w0.z); y[6] = bflo(w0.w); y[7] = bfhi(w0.w);
                y[8] = bflo(w1.x); y[9] = bfhi(w1.x); y[10] = bflo(w1.y); y[11] = bfhi(w1.y); y[12] = bflo(w1.z); y[13] = bfhi(w1.z); y[14] = bflo(w1.w); y[15] = bfhi(w1.w);
                float ss = 0.f;
#pragma unroll
                for (int i = 0; i < 16; ++i) ss += y[i] * y[i];
                ss += __shfl_xor(ss, 1); ss += __shfl_xor(ss, 2);
                const float rstd = 1.f / sqrtf(ss * (1.f / 64.f) + RMS_EPS);
#pragma unroll
                for (int i = 0; i < 16; ++i) y[i] = y[i] * rstd * gn[i];
                if (qd == 0) {
                    const float cs[8] = {c0.x, c0.y, c0.z, c0.w, c1.x, c1.y, c1.z, c1.w}, sn[8] = {s0.x, s0.y, s0.z, s0.w, s1.x, s1.y, s1.z, s1.w};
#pragma unroll
                    for (int i = 0; i < 8; ++i) { const float a = y[i], b = y[i + 8]; y[i] = a * cs[i] - b * sn[i]; y[i + 8] = b * cs[i] + a * sn[i]; }
                }
#pragma unroll
                for (int i = 0; i < 16; ++i) y[i] *= osc;
                p[0] = (v4u){pk2(y[0], y[1]), pk2(y[2], y[3]), pk2(y[4], y[5]), pk2(y[6], y[7])};
                p[1] = (v4u){pk2(y[8], y[9]), pk2(y[10], y[11]), pk2(y[12], y[13]), pk2(y[14], y[15])};
                w0 = n0; w1 = n1;
            }
        }
        if (BOTH(2)) GRID_BAR();
    }

    if (IN(3)) {
        PHASE_LOCALS
        for (int L = vcu; L < 1024; L += G) {
            const int vv = L & 255, i = L >> 8, s = vv & 7, bh = vv >> 3;
            const int qb = (i == 0) ? s : (i == 1) ? 15 - s : (i == 2) ? 16 + s : 31 - s;
            const int b = bh >> 3, hh = (bh & 7) >> 1, mp = bh & 1;
            attn_body2::attn_unit<8>(b, C_DQ + (hh * 2 + mp) * 64, C_DK + (hh * 2 + mp) * 64, C_DV + hh * 128, (hh * 2 + mp) * 128, qb,
                                     (const attn_body2::bf16*)PROJ, (const attn_body2::bf16*)PROJ, (const attn_body2::bf16*)PROJ, (attn_body2::bf16*)OAT, (char*)lds + RING_OFF);
        }
        for (int u = gw; u < NUNIT; u += NGW) {
            const int g = u >> 2, h = u & 3; const int su = ((g >> 7) * 4 + h) * 128 + (g & 127);
            const bf16* vt = VT + (size_t)u * 8192; const bf16* kt = KTT + (size_t)u * 4096;
            f32x16 acc[4][2];
#pragma unroll
            for (int a = 0; a < 4; ++a) { acc[a][0] = f32x16{}; acc[a][1] = f32x16{}; }
#pragma unroll
            for (int k2 = 0; k2 < 4; k2 += 2) {
                bf16x8 af[2][4], bfr[2][2];
#pragma unroll
                for (int kq = 0; kq < 2; ++kq) { const int ks = k2 + kq;
#pragma unroll
                    for (int et = 0; et < 4; ++et) af[kq][et] = *(const bf16x8*)(vt + (et * 32 + r32) * 64 + ks * 16 + hi * 8);
#pragma unroll
                    for (int dt = 0; dt < 2; ++dt) bfr[kq][dt] = *(const bf16x8*)(kt + (dt * 32 + r32) * 64 + ks * 16 + hi * 8); }
                __builtin_amdgcn_sched_barrier(0);
#pragma unroll
                for (int kq = 0; kq < 2; ++kq)
#pragma unroll
                    for (int et = 0; et < 4; ++et)
#pragma unroll
                        for (int dt = 0; dt < 2; ++dt) acc[et][dt] = __builtin_amdgcn_mfma_f32_32x32x16_bf16(af[kq][et], bfr[kq][dt], acc[et][dt], 0, 0, 0);
            }
            bf16* const kv = KVT + (size_t)su * 8192;
#pragma unroll
            for (int dt = 0; dt < 2; ++dt) { const float dc = DEC[su * 64 + dt * 32 + r32];
#pragma unroll
                for (int et = 0; et < 4; ++et)
#pragma unroll
                    for (int r = 0; r < 16; ++r) kv[(et * 32 + crow(r, hi)) * 64 + dt * 32 + r32] = (bf16)f2bf(acc[et][dt][r] * dc); }
        }
        if (BOTH(3)) GRID_BAR();
    }

    if (IN(4)) {
        PHASE_LOCALS
        for (int el = gt; el < 16 * 8192; el += NGT) {
            const int bh = el >> 13, ed = el & 8191, d = ed & 63;
            bf16* p = KVT + (size_t)bh * 128 * 8192 + ed; const float* dp = DEC + bh * 128 * 64 + d;
            float s = 0.f;
            unsigned kva[16], kvb[16]; float dca[16], dcb[16];
#define SCAN_LOAD(KV_, DC_, n0_) do { _Pragma("unroll") for (int j = 0; j < 16; ++j) { KV_[j] = p[(size_t)((n0_) + j) * 8192]; DC_[j] = dp[((n0_) + j) * 64]; } } while (0)
#define SCAN_RUN(KV_, DC_, n0_) do { _Pragma("unroll") for (int j = 0; j < 16; ++j) { const float o = s; s = DC_[j] * s + bf2f(KV_[j]); p[(size_t)((n0_) + j) * 8192] = (bf16)f2bf(o); } } while (0)
            SCAN_LOAD(kva, dca, 0);
#pragma unroll 1
            for (int n0 = 0; n0 < 128; n0 += 32) {
                SCAN_LOAD(kvb, dcb, n0 + 16);
                SCAN_RUN(kva, dca, n0);
                if (n0 + 32 < 128) SCAN_LOAD(kva, dca, n0 + 32);
                SCAN_RUN(kvb, dcb, n0 + 16);
            }
#undef SCAN_LOAD
#undef SCAN_RUN
        }
        if (BOTH(4)) GRID_BAR();
    }

    if (IN(5)) {
        PHASE_LOCALS
        for (int u = gw; u < NUNIT; u += NGW) {
            const int g = u >> 2, h = u & 3; const int su = ((g >> 7) * 4 + h) * 128 + (g & 127);
            const bf16* vt = VT + (size_t)u * 8192; const bf16* st = KVT + (size_t)su * 8192;
            const bf16* qtp = PROJ + (size_t)(g * 64) * NPROJ + C_GQ + h * 64; const bf16* ktp = PROJ + (size_t)(g * 64) * NPROJ + C_GK + h * 64;
#pragma unroll
            for (int ct = 0; ct < 2; ++ct) {
                bf16x8 qf[4];
#pragma unroll
                for (int ks = 0; ks < 4; ++ks) qf[ks] = *(const bf16x8*)(qtp + (size_t)(ct * 32 + r32) * NPROJ + ks * 16 + hi * 8);
                f32x16 o[4];
#pragma unroll
                for (int et = 0; et < 4; ++et) o[et] = f32x16{};
                bf16x8 sf[4][4], kfa[2][4];
#pragma unroll
                for (int ks = 0; ks < 4; ++ks)
#pragma unroll
                    for (int et = 0; et < 4; ++et) sf[ks][et] = *(const bf16x8*)(st + (et * 32 + r32) * 64 + ks * 16 + hi * 8);
#pragma unroll
                for (int stl = 0; stl <= ct; ++stl)
#pragma unroll
                    for (int ks = 0; ks < 4; ++ks) kfa[stl][ks] = *(const bf16x8*)(ktp + (size_t)(stl * 32 + r32) * NPROJ + ks * 16 + hi * 8);
                __builtin_amdgcn_sched_barrier(0);
#pragma unroll
                for (int ks = 0; ks < 4; ++ks)
#pragma unroll
                    for (int et = 0; et < 4; ++et) o[et] = __builtin_amdgcn_mfma_f32_32x32x16_bf16(sf[ks][et], qf[ks], o[et], 0, 0, 0);
#pragma unroll
                for (int stl = 0; stl <= ct; ++stl) {
                    v4u vfa[2][4];
#pragma unroll
                    for (int kk = 0; kk < 2; ++kk)
#pragma unroll
                        for (int et = 0; et < 4; ++et) { const bf16* ap = vt + (et * 32 + r32) * 64 + stl * 32 + 16 * kk + 4 * hi;
                            const v2u a0 = *(const v2u*)ap, a1 = *(const v2u*)(ap + 8); vfa[kk][et] = (v4u){a0.x, a0.y, a1.x, a1.y}; }
                    __builtin_amdgcn_sched_barrier(0);
                    f32x16 xx = f32x16{};
#pragma unroll
                    for (int ks = 0; ks < 4; ++ks) xx = __builtin_amdgcn_mfma_f32_32x32x16_bf16(kfa[stl][ks], qf[ks], xx, 0, 0, 0);
                    if (stl == ct) {
#pragma unroll
                        for (int r = 0; r < 16; ++r) if (crow(r, hi) > r32) xx[r] = 0.f;
                    }
#pragma unroll
                    for (int kk = 0; kk < 2; ++kk) {
                        v4u w; w.x = pk2(xx[8 * kk], xx[8 * kk + 1]); w.y = pk2(xx[8 * kk + 2], xx[8 * kk + 3]); w.z = pk2(xx[8 * kk + 4], xx[8 * kk + 5]); w.w = pk2(xx[8 * kk + 6], xx[8 * kk + 7]);
                        const bf16x8 pb = __builtin_bit_cast(bf16x8, w);
#pragma unroll
                        for (int et = 0; et < 4; ++et) o[et] = __builtin_amdgcn_mfma_f32_32x32x16_bf16(__builtin_bit_cast(bf16x8, vfa[kk][et]), pb, o[et], 0, 0, 0);
                    }
                }
                float ss = 0.f;
#pragma unroll
                for (int et = 0; et < 4; ++et)
#pragma unroll
                    for (int r = 0; r < 16; ++r) ss += o[et][r] * o[et][r];
                ss += __shfl_xor(ss, 32);
                const float rstd = 1.f / sqrtf(ss * (1.f / 128.f) + RMS_EPS);
                const int t = g * 64 + ct * 32 + r32;
                v2u gwa[16]; f32x4 goa[16];
#pragma unroll
                for (int i = 0; i < 16; ++i) { const int e0 = (i >> 2) * 32 + 8 * (i & 3) + 4 * hi; gwa[i] = *(const v2u*)(PROJ + (size_t)t * NPROJ + C_GR + h * 128 + e0); goa[i] = *(const f32x4*)(g_gla_out + e0); }
#pragma unroll
                for (int et = 0; et < 4; ++et)
#pragma unroll
                    for (int q4 = 0; q4 < 4; ++q4) {
                        const int e0 = et * 32 + 8 * q4 + 4 * hi;
                        const v2u gw2 = gwa[et * 4 + q4];
                        const f32x4 go = goa[et * 4 + q4];
                        const float gr0 = bflo(gw2.x), gr1 = bfhi(gw2.x), gr2 = bflo(gw2.y), gr3 = bfhi(gw2.y);
                        const float y0 = o[et][4 * q4] * rstd * go.x * (gr0 / (1.f + __expf(-gr0)));
                        const float y1 = o[et][4 * q4 + 1] * rstd * go.y * (gr1 / (1.f + __expf(-gr1)));
                        const float y2 = o[et][4 * q4 + 2] * rstd * go.z * (gr2 / (1.f + __expf(-gr2)));
                        const float y3 = o[et][4 * q4 + 3] * rstd * go.w * (gr3 / (1.f + __expf(-gr3)));
                        *(v2u*)(MIX + (size_t)t * DMODEL + h * 128 + e0) = (v2u){pk2(y0, y1), pk2(y2, y3)};
                    }
            }
        }
        {
            const float s1 = wave_sum(lq1[lane] * lk1[lane]), s2 = wave_sum(lq2[lane] * lk2[lane]);
            const float lam = expf(s1) - expf(s2) + LAMBDA_INIT;
            const int hh = lane >> 4, e0 = (lane & 15) * 8;
            const f32x4 ga = *(const f32x4*)(g_sub + e0), gb = *(const f32x4*)(g_sub + e0 + 4);
            const float gs[8] = {ga.x, ga.y, ga.z, ga.w, gb.x, gb.y, gb.z, gb.w};
            v4u a = *(const v4u*)(OAT + (size_t)gw * 2048 + (hh * 2) * 128 + e0), b = *(const v4u*)(OAT + (size_t)gw * 2048 + (hh * 2 + 1) * 128 + e0);
            for (int t = gw; t < TOK; t += NGW) {
                const int tn = (t + NGW < TOK) ? t + NGW : t;
                const v4u an = *(const v4u*)(OAT + (size_t)tn * 2048 + (hh * 2) * 128 + e0), bn = *(const v4u*)(OAT + (size_t)tn * 2048 + (hh * 2 + 1) * 128 + e0);
                float y[8];
                y[0] = bflo(a.x) - lam * bflo(b.x); y[1] = bfhi(a.x) - lam * bfhi(b.x); y[2] = bflo(a.y) - lam * bflo(b.y); y[3] = bfhi(a.y) - lam * bfhi(b.y);
                y[4] = bflo(a.z) - lam * bflo(b.z); y[5] = bfhi(a.z) - lam * bfhi(b.z); y[6] = bflo(a.w) - lam * bflo(b.w); y[7] = bfhi(a.w) - lam * bfhi(b.w);
                float ss = 0.f;
#pragma unroll
                for (int i = 0; i < 8; ++i) ss += y[i] * y[i];
                ss += __shfl_xor(ss, 1); ss += __shfl_xor(ss, 2); ss += __shfl_xor(ss, 4); ss += __shfl_xor(ss, 8);
                const float rstd = (1.f - LAMBDA_INIT) / sqrtf(ss * (1.f / 128.f) + RMS_EPS);
#pragma unroll
                for (int i = 0; i < 8; ++i) y[i] = y[i] * rstd * gs[i];
                *(v4u*)(MIX + (size_t)t * DMODEL + 512 + hh * 128 + e0) = (v4u){pk2(y[0], y[1]), pk2(y[2], y[3]), pk2(y[4], y[5]), pk2(y[6], y[7])};
                a = an; b = bn;
            }
        }
        if (BOTH(5)) GRID_BAR();
    }

    if (IN(6)) {
        PHASE_LOCALS
        constexpr int NVT = PEER_N * DMODEL / 8, NUT = PEER_N * DMODEL / 16;
        for (int task0 = gt; task0 < NVT; task0 += 4 * NGT) {
            f32x4 a[4], b[4]; int oo[4];
#pragma unroll
            for (int j = 0; j < 4; ++j) { const int o = task0 + j * NGT; oo[j] = o; if (o < NVT) { const int sl_ = o >> 17, r_ = (o >> 3) & (PEER_N - 1), c_ = o & 7;
                const int e_ = ((((r_ >> 7) - (r_ & 127)) & 127) << 7) | (r_ & 127);
                const f32x4* src = (const f32x4*)peer_v + (size_t)e_ * 256 + (sl_ * 8 + c_) * 2; a[j] = src[0]; b[j] = src[1]; } }
#pragma unroll
            for (int j = 0; j < 4; ++j) if (oo[j] < NVT) ((v4u*)VB)[oo[j]] = (v4u){pkh(a[j].x, a[j].y), pkh(a[j].z, a[j].w), pkh(b[j].x, b[j].y), pkh(b[j].z, b[j].w)};
        }
        for (int task0 = gt; task0 < NUT; task0 += 2 * NGT) {
            f32x4 a[2], b[2], c[2], d[2], ga[2], gb[2], gc[2], gd[2]; int oo[2];
#pragma unroll
            for (int j = 0; j < 2; ++j) { const int o = task0 + j * NGT; oo[j] = o; if (o < NUT) { const int sl_ = o >> 16, r_ = (o >> 2) & (PEER_N - 1), c_ = o & 3;
                const int e_ = ((((r_ >> 7) - (r_ & 127)) & 127) << 7) | (r_ & 127);
                const f32x4* src = (const f32x4*)peer_u + (size_t)e_ * 256 + (sl_ * 4 + c_) * 4; const f32x4* gs_ = (const f32x4*)g_ffn + (sl_ * 4 + c_) * 4;
                a[j] = src[0]; b[j] = src[1]; c[j] = src[2]; d[j] = src[3]; ga[j] = gs_[0]; gb[j] = gs_[1]; gc[j] = gs_[2]; gd[j] = gs_[3]; } }
#pragma unroll
            for (int j = 0; j < 2; ++j) if (oo[j] < NUT) { const f32x4 a_ = a[j] * 32.f * ga[j], b_ = b[j] * 32.f * gb[j], c_ = c[j] * 32.f * gc[j], d_ = d[j] * 32.f * gd[j];
                ((v4u*)UB)[oo[j]] = (v4u){pk8(a_.x, a_.y, a_.z, a_.w), pk8(b_.x, b_.y, b_.z, b_.w), pk8(c_.x, c_.y, c_.z, c_.w), pk8(d_.x, d_.y, d_.z, d_.w)}; }
        }
        pg8::Gemm g{MIX, Wout_t, TOK, DMODEL, DMODEL}; pg8::StaticOrder S; S.init(TOK, DMODEL, G, (int)blockIdx.x);
        pg8::EpiResF32X E{x, DMODEL, XN2, (unsigned char*)XT, SSP, TOK};
        pg8::gemm_phase<pg8::EpiResF32X, pg8::StaticOrder, PG8_ALIGN, PG8_SP2>(ldsl + RING_OFF, g, S, E);
        if (BOTH(6)) GRID_BAR();
    }


    if (IN(8)) {
        PHASE_LOCALS
        pg8::Gemm g{XN2, Wq_t, TOK, NQP, DMODEL}; pg8::StaticOrder S; S.init(TOK, NQP, G, (int)blockIdx.x);
        pg8::EpiBf16Row E{QP, NQP, SSP, RSTD, RMS_EPS, 1.f / DMODEL};
        pg8::gemm_phase<pg8::EpiBf16Row, pg8::StaticOrder, PG8_ALIGN, PG8_SP2>(ldsl + RING_OFF, g, S, E);
        if (BOTH(8)) GRID_BAR();
    }

    if (IN(9)) {
        PHASE_LOCALS
        const int nper = G / 8;
        const int head = vcu % 8, part = vcu / 8;
        for (int c = tid; c < 4096; c += NWAVES * 64) {
            const int p = c >> 11, row = (c >> 4) & 127, ch = c & 15;
            const v4u v = *(const v4u*)(KEYS + ((size_t)(head * 2 + p) * 128 + row) * 128 + ch * 8);
            *(LAS v4u*)(ldsl + p * 32768 + row * 256 + ((ch ^ (row & 15)) * 16)) = v;
        }
        __syncthreads();
        LAS unsigned* const lscr = (LAS unsigned*)(ldsl + 65536 + wave * 8192);
        for (int tg = part * NWAVES + wave; tg < TOK / 32; tg += nper * NWAVES) {
            const int t0 = tg * 32;
            float top[2][16];
#pragma unroll
            for (int p = 0; p < 2; ++p) {
                bf16x8 qf[8];
#pragma unroll
                for (int ks = 0; ks < 8; ++ks) qf[ks] = *(const bf16x8*)(QP + (size_t)(t0 + r32) * NQP + head * 256 + p * 128 + ks * 16 + hi * 8);
                float sc[4][16];
#pragma unroll
                for (int tile = 0; tile < 4; ++tile) {
                    f32x16 acc = f32x16{};
#pragma unroll
                    for (int ks = 0; ks < 8; ++ks) {
                        const bf16x8 kf = *(const LAS bf16x8*)(ldsl + p * 32768 + (tile * 32 + r32) * 256 + (((2 * ks + hi) ^ (r32 & 15)) * 16));
                        acc = __builtin_amdgcn_mfma_f32_32x32x16_bf16(kf, qf[ks], acc, 0, 0, 0);
                    }
#pragma unroll
                    for (int r = 0; r < 16; ++r) { const unsigned kid = (unsigned)(tile * 32 + crow(r, hi));
                        const float av = acc[r];
                        sc[tile][r] = __uint_as_float((__float_as_uint(av) & 0xffffff80u) | (127u - kid)); }
                    sort16_desc(sc[tile]);
                }
                merge16_desc(sc[0], sc[1]); merge16_desc(sc[2], sc[3]); merge16_desc(sc[0], sc[2]);
                float ot[16];
#pragma unroll
                for (int i = 0; i < 16; ++i) ot[i] = __shfl_xor(sc[0][i], 32);
                merge16_desc(sc[0], ot);
#pragma unroll
                for (int i = 0; i < 16; ++i) top[p][i] = sc[0][i];
            }
#pragma unroll
            for (int i = 0; i < 16; ++i) { lscr[i * 64 + lane] = 127u - (__float_as_uint(top[0][i]) & 127u); lscr[(16 + i) * 64 + lane] = 127u - (__float_as_uint(top[1][i]) & 127u); }
            float v0[16], v1[16];
#pragma unroll
            for (int i = 0; i < 16; ++i) { v0[i] = __uint_as_float(__float_as_uint(top[0][i]) & 0xffffff80u); v1[i] = __uint_as_float(__float_as_uint(top[1][i]) & 0xffffff80u); }
#define CAND(i, j) __uint_as_float((__float_as_uint(v0[i] + v1[j]) & 0xffffff00u) | (255u - (unsigned)((i) * 16 + (j))))
            const float NEGB = -3.0e38f;
            float cA[16], cB[16], cC[16], cD[16];
#pragma unroll
            for (int j = 0; j < 16; ++j) cA[j] = CAND(0, j);
#pragma unroll
            for (int j = 0; j < 8; ++j) cB[j] = CAND(1, j);
#pragma unroll
            for (int j = 0; j < 5; ++j) cB[8 + j] = CAND(2, j);
            cB[13] = NEGB; cB[14] = NEGB; cB[15] = NEGB;
#pragma unroll
            for (int j = 0; j < 4; ++j) cC[j] = CAND(3, j);
#pragma unroll
            for (int j = 0; j < 3; ++j) cC[4 + j] = CAND(4, j);
            cC[7] = CAND(5, 0); cC[8] = CAND(5, 1); cC[9] = CAND(6, 0); cC[10] = CAND(6, 1); cC[11] = CAND(7, 0); cC[12] = CAND(7, 1);
            cC[13] = NEGB; cC[14] = NEGB; cC[15] = NEGB;
            cD[0] = CAND(8, 0); cD[1] = CAND(9, 0); cD[2] = CAND(10, 0); cD[3] = CAND(11, 0); cD[4] = CAND(12, 0); cD[5] = CAND(13, 0); cD[6] = CAND(14, 0); cD[7] = CAND(15, 0);
#pragma unroll
            for (int j = 8; j < 16; ++j) cD[j] = NEGB;
#undef CAND
            sort16_desc(cB); sort16_desc(cC); sort16_desc(cD);
            merge16_desc(cA, cB); merge16_desc(cC, cD); merge16_desc(cA, cC);
            LDS_WAIT();
            float gv[16]; int ex[16]; float gsum = 0.f;
            const float mx = __uint_as_float(__float_as_uint(cA[0]) & 0xffffff00u);
#pragma unroll
            for (int w = 0; w < 16; ++w) {
                const unsigned bits = __float_as_uint(cA[w]); const unsigned code = 255u - (bits & 255u);
                const float val = __uint_as_float(bits & 0xffffff00u);
                gv[w] = __expf(val - mx); gsum += gv[w];
                const unsigned e0 = lscr[(code >> 4) * 64 + lane], e1 = lscr[(16 + (code & 15)) * 64 + lane];
                ex[w] = (int)(e0 * 128u + e1);
            }
            const float ginv = 1.f / gsum;
            const size_t ob = (size_t)(t0 + r32) * 128 + head * 16;
#pragma unroll
            for (int q = 0; q < 4; ++q) if ((q >> 1) == hi)
                *(v4u*)(IDX + ob + 4 * q) = (v4u){(f2bf(gv[4 * q] * ginv) << 16) | (unsigned)ex[4 * q], (f2bf(gv[4 * q + 1] * ginv) << 16) | (unsigned)ex[4 * q + 1],
                                                  (f2bf(gv[4 * q + 2] * ginv) << 16) | (unsigned)ex[4 * q + 2], (f2bf(gv[4 * q + 3] * ginv) << 16) | (unsigned)ex[4 * q + 3]};
            LDS_WAIT();
        }
        if (BOTH(9)) GRID_BAR();
    }

    if (IN(10)) {
        PHASE_LOCALS
        LAS int* const hst = (LAS int*)(ldsl + wave * 256);
        int w0n = IDX[(size_t)gw * 128 + lane], w1n = IDX[(size_t)gw * 128 + 64 + lane];
        for (int t = gw; t < TOK; t += NGW) {
            const int w0 = w0n, w1 = w1n;
            { const int tn = (t + NGW < TOK) ? t + NGW : t; w0n = IDX[(size_t)tn * 128 + lane]; w1n = IDX[(size_t)tn * 128 + 64 + lane]; }
            const int x0 = w0 & 0xffff, x1 = w1 & 0xffff;
            const int r0 = ((((x0 >> 7) + (x0 & 127)) & 127) << 7) | (x0 & 127), r1 = ((((x1 >> 7) + (x1 & 127)) & 127) << 7) | (x1 & 127);
            const int b0 = r0 >> 9, b1 = r1 >> 9;
            if (lane < 32) hst[lane] = 0;
            const int rk0 = __hip_atomic_fetch_add(hst + b0, 1, __ATOMIC_RELAXED, __HIP_MEMORY_SCOPE_WORKGROUP);
            const int rk1 = __hip_atomic_fetch_add(hst + b1, 1, __ATOMIC_RELAXED, __HIP_MEMORY_SCOPE_WORKGROUP);
            const int myc = __hip_atomic_load(hst + (lane & 31), __ATOMIC_RELAXED, __HIP_MEMORY_SCOPE_WORKGROUP);
            int incl = myc;
#pragma unroll
            for (int o = 1; o < 32; o <<= 1) { const int v = __shfl_up(incl, o); if ((lane & 31) >= o) incl += v; }
            if (lane < 32) { OFFS[(size_t)t * 32 + lane] = (unsigned char)(incl - myc); __hip_atomic_store(hst + 32 + lane, incl - myc, __ATOMIC_RELAXED, __HIP_MEMORY_SCOPE_WORKGROUP); }
            const int o0 = __hip_atomic_load(hst + 32 + b0, __ATOMIC_RELAXED, __HIP_MEMORY_SCOPE_WORKGROUP), o1 = __hip_atomic_load(hst + 32 + b1, __ATOMIC_RELAXED, __HIP_MEMORY_SCOPE_WORKGROUP);
            SGE[(size_t)t * 128 + o0 + rk0] = ((unsigned)w0 & 0xffff0000u) | (unsigned)r0; SGE[(size_t)t * 128 + o1 + rk1] = ((unsigned)w1 & 0xffff0000u) | (unsigned)r1;
        }
        if (BOTH(10)) GRID_BAR();
    }

    if (IN(11)) {
        PHASE_LOCALS
        constexpr int NC = 112, NTL = 7;
        LAS unsigned* const GCOL = (LAS unsigned*)(ldsl + 132096);
        LAS unsigned* const GW = (LAS unsigned*)(ldsl + 132096 + 32 * NC * 4);
        LAS int* const gcnt = (LAS int*)(ldsl + 132096 + 2 * 32 * NC * 4);
        const unsigned lds0 = (unsigned)(uintptr_t)lds;
        const unsigned u_lane_off = (unsigned)(lane >> 2) * 64u + (unsigned)(((lane & 3) ^ ((lane >> 4) & 3)) * 16);
        for (int k = 0; k < 2048; k += 1) {
            int tb, eb;
            if (G == 256) { if (k >= 8) break; eb = vcu & 31; tb = 8 * (vcu >> 5) + (((vcu & 31) + k) & 7); }
            else { const int task = vcu + k * G; if (task >= 2048) break; tb = task >> 5; eb = task & 31; }
            const int t = tb * 512 + tid;
            const unsigned char* usrc = (const unsigned char*)UH + (size_t)eb * 512 * 64;
            const unsigned char* xsrc = (const unsigned char*)XT + ((size_t)tb * 512) * 8;
#define DMA_UX(hs_, buf_) do { unsigned ulo_ = u_lane_off, xlo_ = (unsigned)lane * 16u; asm volatile("" : "+v"(ulo_), "+v"(xlo_)); _Pragma("unroll") for (int q_ = 0; q_ < 4; ++q_) { const int j_ = wave + 8 * q_; \
                attn_body::glds16(usrc + ulo_ + (size_t)(hs_) * (PEER_N * 64) + (size_t)j_ * 1024, (unsigned)__builtin_amdgcn_readfirstlane(lds0 + (buf_) * 32768 + j_ * 1024)); \
                attn_body::glds16(xsrc + xlo_ + (size_t)((hs_) * 8 + (j_ >> 2)) * ((size_t)TOK * 8) + (size_t)(j_ & 3) * 1024, (unsigned)__builtin_amdgcn_readfirstlane(lds0 + 65536 + (buf_) * 32896 + (j_ >> 2) * 4112 + (j_ & 3) * 1024)); } } while (0)
            DMA_UX(0, 0);
            for (int c = tid; c < 32 * NC; c += NWAVES * 64) GCOL[c] = 0u;
            if (tid < 32) gcnt[tid] = 0;
            const int p0 = OFFS[(size_t)t * 32 + eb]; const int p1 = (eb < 31) ? (int)OFFS[(size_t)t * 32 + eb + 1] : 128; const int n = p1 - p0;
            unsigned ent[16];
#pragma unroll
            for (int i = 0; i < 16; ++i) ent[i] = (i < n) ? SGE[(size_t)t * 128 + p0 + i] : 0u;
            unsigned tid_o = (unsigned)tid; asm volatile("" : "+v"(tid_o));
            unsigned char* const a2u = (unsigned char*)AE2 + ((size_t)(tb * 32 + eb) * 12) * 2048; const unsigned toff4 = tid_o * 4u;
            CNT[(size_t)(tb * 32 + eb) * 512 + tid] = (unsigned char)n;
            __syncthreads();
            unsigned ovmask = 0u;
#pragma unroll
            for (int i = 0; i < 16; ++i) if (i < n) { const unsigned r = ent[i] & 0xffffu; const int g = (int)((r >> 4) & 31u);
                const int c = __hip_atomic_fetch_add(gcnt + g, 1, __ATOMIC_RELAXED, __HIP_MEMORY_SCOPE_WORKGROUP);
                if (c < NC) { GCOL[g * NC + c] = ((unsigned)tid << 15) | ((unsigned)(p0 + i) << 8) | ((unsigned)i << 4) | (r & 15u); GW[g * NC + c] = ent[i]; } else ovmask |= 1u << i; }
            __syncthreads();
            int cg[4]; unsigned tko[4][NTL]; f32x4 acc[4][NTL];
            const unsigned aoff = (unsigned)((4 * wave) * 16 + (lane & 15)) * 64u + (unsigned)((((lane >> 5) & 1) ^ ((lane >> 2) & 3)) * 16) + (unsigned)((lane >> 4) & 1) * 8u;
#pragma unroll
            for (int gi = 0; gi < 4; ++gi) { const int cc = gcnt[4 * wave + gi]; cg[gi] = __builtin_amdgcn_readfirstlane(cc < NC ? cc : NC);
#pragma unroll
                for (int ct = 0; ct < NTL; ++ct) { tko[gi][ct] = 65536u + (unsigned)(lane >> 4) * 4112u + (GCOL[(4 * wave + gi) * NC + ct * 16 + (lane & 15)] >> 15) * 8u;     acc[gi][ct] = (f32x4){0.f, 0.f, 0.f, 0.f}; } }
#define UPM_COMPUTE(buf_) do { _Pragma("unroll") for (int gi = 0; gi < 4; ++gi) { if (cg[gi] > 0) { \
                const long af0_ = v2l(*(const LAS v2u*)(ldsl + aoff + gi * 1024 + (buf_) * 32768)), af1_ = v2l(*(const LAS v2u*)(ldsl + (aoff ^ 32u) + gi * 1024 + (buf_) * 32768)); \
                _Pragma("unroll") for (int ct = 0; ct < NTL; ++ct) { if (ct * 16 < cg[gi]) { \
                    const long bf0_ = v2l(*(const LAS v2u*)(ldsl + tko[gi][ct] + (buf_) * 32896)), bf1_ = v2l(*(const LAS v2u*)(ldsl + tko[gi][ct] + 16448 + (buf_) * 32896)); \
                    acc[gi][ct] = __builtin_amdgcn_mfma_f32_16x16x32_fp8_fp8(af0_, bf0_, acc[gi][ct], 0, 0, 0); \
                    acc[gi][ct] = __builtin_amdgcn_mfma_f32_16x16x32_fp8_fp8(af1_, bf1_, acc[gi][ct], 0, 0, 0); } } } } } while (0)
#pragma unroll 1
            for (int hs = 0; hs < 16; hs += 2) {
                __builtin_amdgcn_s_waitcnt(0x0F70); __syncthreads();
                DMA_UX(hs + 1, 1);
                UPM_COMPUTE(0);
                __builtin_amdgcn_s_waitcnt(0x0F70); __syncthreads();
                if (hs + 2 < 16) DMA_UX(hs + 2, 0);
                UPM_COMPUTE(1);
            }
#undef UPM_COMPUTE
#undef DMA_UX
#pragma unroll
            for (int gi = 0; gi < 4; ++gi)
#pragma unroll
                for (int ct = 0; ct < NTL; ++ct) if (ct * 16 < cg[gi]) {
                    const int c = ct * 16 + (lane & 15); const unsigned en = GCOL[(4 * wave + gi) * NC + c], gw = GW[(4 * wave + gi) * NC + c];
                    const unsigned row = en & 15u; const f32x4 av = acc[gi][ct];
                    const float hsel = (row & 2u) ? ((row & 1u) ? av.w : av.z) : ((row & 1u) ? av.y : av.x);
                    if (c < cg[gi] && (int)(row >> 2) == (lane >> 4)) {
                        const unsigned tk = en >> 15, pp = (en >> 8) & 127u, ii = (en >> 4) & 15u;
                        const unsigned w = (f2bf(gelu_erf(hsel * (1.f / 32.f) * RSTD[tb * 512 + (int)tk]) * __uint_as_float(gw & 0xffff0000u)) << 16) | (gw & 0xffffu);
                        if (ii < 12u) *(unsigned*)(a2u + (size_t)ii * 2048 + tk * 4u) = w; else AE[((size_t)tb * 512 + tk) * 128 + pp] = w;
                    }
                    __builtin_amdgcn_sched_barrier(0);
                }
            if (__any(n > 16 || ovmask != 0u)) {
                for (int i = 0; i < n; ++i) if (i >= 16 || ((ovmask >> i) & 1u)) { const unsigned en = SGE[(size_t)t * 128 + p0 + i]; const unsigned rr_ = en & 0xffffu; float a_ = 0.f;
                    for (int c = 0; c < 128; ++c) {
                        const v2u r_ = *(const v2u*)((const unsigned char*)UH + ((size_t)(c >> 3) * PEER_N + rr_) * 64 + (c & 7) * 8), x_ = *(const v2u*)((const unsigned char*)XT + ((size_t)c * TOK + t) * 8);
                        const int r0 = (int)r_.x, r1 = (int)r_.y, x0 = (int)x_.x, x1 = (int)x_.y;
                        a_ += __builtin_amdgcn_cvt_f32_fp8(r0, 0) * __builtin_amdgcn_cvt_f32_fp8(x0, 0) + __builtin_amdgcn_cvt_f32_fp8(r0, 1) * __builtin_amdgcn_cvt_f32_fp8(x0, 1)
                            + __builtin_amdgcn_cvt_f32_fp8(r0, 2) * __builtin_amdgcn_cvt_f32_fp8(x0, 2) + __builtin_amdgcn_cvt_f32_fp8(r0, 3) * __builtin_amdgcn_cvt_f32_fp8(x0, 3)
                            + __builtin_amdgcn_cvt_f32_fp8(r1, 0) * __builtin_amdgcn_cvt_f32_fp8(x1, 0) + __builtin_amdgcn_cvt_f32_fp8(r1, 1) * __builtin_amdgcn_cvt_f32_fp8(x1, 1)
                            + __builtin_amdgcn_cvt_f32_fp8(r1, 2) * __builtin_amdgcn_cvt_f32_fp8(x1, 2) + __builtin_amdgcn_cvt_f32_fp8(r1, 3) * __builtin_amdgcn_cvt_f32_fp8(x1, 3); }
                    const unsigned w_ = (f2bf(gelu_erf(a_ * (1.f / 32.f) * RSTD[t]) * __uint_as_float(en & 0xffff0000u)) << 16) | (en & 0xffffu); if (i < 12) *(unsigned*)(a2u + (size_t)i * 2048 + toff4) = w_; else AE[(size_t)t * 128 + p0 + i] = w_; }
            }
            __syncthreads();
        }
        if (BOTH(11)) GRID_BAR();
    }

#define DMA_T(src, ds_, buf_) do { _Pragma("unroll") for (int q_ = 0; q_ < 8; ++q_) { const int j_ = wave + 8 * q_; \
                attn_body::glds16((src) + (size_t)j_ * 1024 + (size_t)(ds_) * (PEER_N * 128), (unsigned)__builtin_amdgcn_readfirstlane(lds0 + (buf_) * 65536 + j_ * 1024)); } } while (0)
#define ROW_READ(R_, ew_, buf_) do { unsigned ea_ = (ew_); asm volatile("" : "+v"(ea_)); const unsigned el_ = ea_ & 511u; \
                const unsigned ra_ = (lds0 + (unsigned)((buf_) * 65536) + el_ * 128u) | l7s;     \
                _Pragma("unroll") for (int c = 0; c < 8; ++c) R_[c] = *(const LAS v4u*)(uintptr_t)(ra_ ^ (unsigned)(c * 16)); } while (0)
    if (IN(12)) {
        PHASE_LOCALS
        const unsigned lds0 = (unsigned)(uintptr_t)lds;
        const unsigned dma_lane_off = (unsigned)lane * 16u;
        unsigned l7 = (unsigned)lane & 7u; asm volatile("" : "+v"(l7));
        unsigned l7s = ((unsigned)lane & 7u) << 4; asm volatile("" : "+v"(l7s));
        for (int k = 0; k < 512; ++k) {
            int tb2, ds;
            if (G == 256) { if (k >= 2) break; const int c_ = vcu & 31; ds = c_ & 15; tb2 = 4 * (vcu >> 5) + (((c_ >> 4) + 2 * k) & 3); }
            else { const int task = vcu + k * G; if (task >= 512) break; tb2 = task >> 4; ds = task & 15; }
            const int tA = tb2 * 1024 + tid, tB = tA + 512;
            h2 accA[32], accB[32];
#pragma unroll
            for (int d = 0; d < 32; ++d) { accA[d] = (h2){(_Float16)0.f, (_Float16)0.f}; accB[d] = (h2){(_Float16)0.f, (_Float16)0.f}; }
            const unsigned char* vsrc = (const unsigned char*)VH + (size_t)ds * (PEER_N * 128) + dma_lane_off;
            const unsigned char* const a2uA = (const unsigned char*)AE2 + ((size_t)(tb2 * 2 * 32) * 12) * 2048;
            const unsigned char* const a2uB = a2uA + (size_t)(32 * 12) * 2048;
            const unsigned char* const cnuA = CNT + (size_t)(tb2 * 2 * 32) * 512; const unsigned char* const cnuB = cnuA + 32 * 512;
            unsigned tid_o = (unsigned)tid; asm volatile("" : "+v"(tid_o));
            const unsigned toff4 = tid_o * 4u, toff1 = tid_o;
#define DN_FMA(ACC_, R_, ew_) do { const _Float16 ah_ = (_Float16)__uint_as_float((ew_) & 0xffff0000u); const h2 a2_ = (h2){ah_, ah_}; _Pragma("unroll") for (int c = 0; c < 8; ++c) { \
                ACC_[4 * c + 0] = u2h(R_[c].x) * a2_ + ACC_[4 * c + 0]; ACC_[4 * c + 1] = u2h(R_[c].y) * a2_ + ACC_[4 * c + 1]; \
                ACC_[4 * c + 2] = u2h(R_[c].z) * a2_ + ACC_[4 * c + 2]; ACC_[4 * c + 3] = u2h(R_[c].w) * a2_ + ACC_[4 * c + 3]; } } while (0)
#define LOAD_ENT(a2u_, cnu_, E_, n_, sb_) do { n_ = *((cnu_) + (size_t)(sb_) * 512 + toff1); _Pragma("unroll") for (int i = 0; i < 12; ++i) E_[i] = *(const unsigned*)((a2u_) + (size_t)((sb_) * 12 + i) * 2048 + toff4); } while (0)
#define DN_BODY(ACC_, tt_, E_, n_, sb_, buf_) do { \
                  _Pragma("unroll") for (int i = 0; i < 12; i += 2) { if (__any(i < n_)) { \
                    e1_ = (i + 1 < n_) ? E_[i + 1] : 0u; ROW_READ(R1, e1_, buf_); \
                    DN_FMA(ACC_, R0, e0_); \
                    if (i + 2 < 12) { e0_ = (i + 2 < n_) ? E_[i + 2] : 0u; ROW_READ(R0, e0_, buf_); } \
                    DN_FMA(ACC_, R1, e1_); } } \
                  if (__any(n_ > 12)) { if (n_ > 12) { const unsigned* ao_ = AE + (size_t)(tt_) * 128 + OFFS[(size_t)(tt_) * 32 + (sb_)]; \
                      for (int i = 12; i < n_; ++i) { const unsigned en_ = ao_[i]; ROW_READ(R0, en_, buf_); DN_FMA(ACC_, R0, en_); } } } } while (0)
#define DN_STEP2(EA_, nA_, EB_, nB_, sb_, buf_, EAn_, nAn_, EBn_, nBn_, has_next_) do { \
                  unsigned e0_ = (0 < nA_) ? EA_[0] : 0u, e1_ = 0u; ROW_READ(R0, e0_, buf_);     \
                  if (has_next_) { DMA_T(vsrc + (size_t)((sb_) + 1) * (512 * 128), 0, 1 - (buf_)); LOAD_ENT(a2uA, cnuA, EAn_, nAn_, (sb_) + 1); LOAD_ENT(a2uB, cnuB, EBn_, nBn_, (sb_) + 1); } \
                  DN_BODY(accA, tA, EA_, nA_, sb_, buf_); \
                  e0_ = (0 < nB_) ? EB_[0] : 0u; ROW_READ(R0, e0_, buf_); \
                  DN_BODY(accB, tB, EB_, nB_, sb_, buf_); } while (0)
            unsigned eA0[12], eB0[12], eA1[12], eB1[12]; int nA0, nB0, nA1, nB1; v4u R0[8], R1[8];
#pragma unroll
            for (int c = 0; c < 8; ++c) { R0[c] = (v4u){0u, 0u, 0u, 0u}; R1[c] = (v4u){0u, 0u, 0u, 0u}; }
            DMA_T(vsrc, 0, 0); LOAD_ENT(a2uA, cnuA, eA0, nA0, 0); LOAD_ENT(a2uB, cnuB, eB0, nB0, 0);
#pragma unroll 1
            for (int sb = 0; sb < 32; sb += 2) {
                __builtin_amdgcn_s_waitcnt(0x0F70); __syncthreads();
                DN_STEP2(eA0, nA0, eB0, nB0, sb, 0, eA1, nA1, eB1, nB1, true);
                __builtin_amdgcn_s_waitcnt(0x0F70); __syncthreads();
                DN_STEP2(eA1, nA1, eB1, nB1, sb + 1, 1, eA0, nA0, eB0, nB0, (sb + 2 < 32));
            }
#undef DN_STEP2
#undef DN_BODY
#undef LOAD_ENT
#undef DN_FMA
#define DN_FINAL(ACC_, tt_) do { int tq_ = (tt_); unsigned l7 = l7o; asm volatile("" : "+v"(tq_), "+v"(l7));     \
            f32x4* op = (f32x4*)(out + (size_t)tq_ * DMODEL + ds * 64); const v4u* hp = (const v4u*)(XN2 + (size_t)tq_ * DMODEL + ds * 64);     \
            v4u hba[8];                                               \
            _Pragma("unroll") for (int c = 0; c < 8; ++c) hba[c] = hp[(unsigned)c ^ l7]; \
            _Pragma("unroll") for (int c = 0; c < 8; ++c) { const unsigned cc = (unsigned)c ^ l7; const v4u hb = hba[c]; \
                f32x4 o0, o1; o0.x = bflo(hb.x) + (float)ACC_[4 * c].x; o0.y = bfhi(hb.x) + (float)ACC_[4 * c].y; o0.z = bflo(hb.y) + (float)ACC_[4 * c + 1].x; o0.w = bfhi(hb.y) + (float)ACC_[4 * c + 1].y; \
                o1.x = bflo(hb.z) + (float)ACC_[4 * c + 2].x; o1.y = bfhi(hb.z) + (float)ACC_[4 * c + 2].y; o1.z = bflo(hb.w) + (float)ACC_[4 * c + 3].x; o1.w = bfhi(hb.w) + (float)ACC_[4 * c + 3].y; \
                op[2 * cc] = o0; op[2 * cc + 1] = o1; } } while (0)
            { const unsigned l7o = l7; DN_FINAL(accA, tA); DN_FINAL(accB, tB); }
#undef DN_FINAL
        }
#undef ROW_READ
#undef DMA_T
    }
#undef IN
#undef BOTH
#undef GRID_BAR
}

extern "C" void kernel_launch(void* const* d_in, const int* in_sizes, int n_in, void* d_out, int out_size, void* d_ws, size_t ws_size, hipStream_t stream) {
    static int grid = 0;
    if (grid == 0) {
        if (n_in != 20 || in_sizes[0] != TOK * DMODEL || out_size != TOK * DMODEL || ws_size < WS_END) {
            fprintf(stderr, "kernel_launch: unexpected shapes: n_in %d in0 %d out %d ws %zu (need %zu); nothing launched\n", n_in, n_in > 0 ? in_sizes[0] : -1, out_size, ws_size, (size_t)WS_END); grid = -1; return; }
        int dev = 0, cus = 0, per_cu = 0;
        if (hipGetDevice(&dev) != hipSuccess || hipDeviceGetAttribute(&cus, hipDeviceAttributeMultiprocessorCount, dev) != hipSuccess) { grid = -1; return; }
        if (hipFuncSetAttribute((const void*)hymba_fwd, hipFuncAttributeMaxDynamicSharedMemorySize, LDS_BYTES) != hipSuccess) { fprintf(stderr, "kernel_launch: hipFuncSetAttribute failed\n"); grid = -1; return; }
        if (hipOccupancyMaxActiveBlocksPerMultiprocessor(&per_cu, (const void*)hymba_fwd, NWAVES * 64, LDS_BYTES) != hipSuccess || per_cu < 1)
            fprintf(stderr, "kernel_launch: note: occupancy query reports %d workgroups per CU\n", per_cu);
        (void)hipGetLastError();
        grid = cus;
        grid -= grid % 8;
        if (grid < 8) { grid = -1; return; }
    }
    if (grid < 0) return;
    if (hipMemsetAsync((char*)d_ws + WS_CTL, 0, CTL_ZERO_BYTES, stream) != hipSuccess) return;
    Args a{};
    for (int i = 0; i < 20; ++i) a.in[i] = d_in[i];
    a.out = (float*)d_out; a.ws = (unsigned char*)d_ws;
    for (int li = 0; li < N_LAUNCHES; ++li) {
        a.ph_lo = (N_LAUNCHES == 1) ? 0 : li; a.ph_hi = (N_LAUNCHES == 1) ? NPHASE : li + 1; a.li = li; a.pad = 0;
        hipLaunchKernelGGL(hymba_fwd, dim3(grid), dim3(NWAVES * 64), LDS_BYTES, stream, a);
        const hipError_t le = hipPeekAtLastError();
        if (le != hipSuccess) { fprintf(stderr, "kernel_launch: launch %d failed: %s\n", li, hipGetErrorName(le)); break; }
    }
}
```

```cpp
#include <hip/hip_runtime.h>
#include <hip/hip_bf16.h>
#include <cstdio>
#include <cstdint>
#include <cmath>
#define MK_N_LAUNCHES 1
namespace pg8 {
#define PG8_LAS __attribute__((address_space(3)))
typedef unsigned short bf16_t;
typedef short bf16x8 __attribute__((ext_vector_type(8)));
typedef float f32x4 __attribute__((ext_vector_type(4)));
typedef unsigned u32x4 __attribute__((ext_vector_type(4)));
constexpr int BM = 256, BK = 64, HALF = 128, HTB = HALF * BK * 2  , STAGE_BYTES = 8 * HTB, NXCD = 8, WGM = 8;

__host__ __device__ __forceinline__ int lds_byte(int r, int c) { const int st = (r >> 4) * 2 + (c >> 5), rr = r & 15, cc = c & 31, ob = rr * 64 + cc * 2; return st * 1024 + (ob ^ (((ob >> 9) & 1) << 5)); }
__host__ __device__ __forceinline__ void stage_rc(int b, int& R, int& C) { const int st = b / 1024, sb = b % 1024, swz = sb ^ (((sb >> 9) & 1) << 5); R = (st >> 1) * 16 + swz / 64; C = (st & 1) * 32 + (swz % 64) / 2; }
__host__ __device__ __forceinline__ int perm32(int rho) { const int n = rho >> 4, i = rho & 15; return 8 * (i >> 2) + 4 * n + (i & 3); }

struct Unit { int pm, pn; };
struct Gemm { const bf16_t* A; const bf16_t* Bt; int M, N, K; };

struct StaticOrder {
    int nM, nN, nwg, G, c;
    __host__ __device__ void init(int M, int N, int G_, int c_) { nM = M / BM; nN = N / BM; nwg = nM * nN; G = G_; c = c_; }
    __host__ __device__ bool next(int i, Unit& u) const {
        const long L = (long)i * G + c; if (L >= nwg) return false;
        int wgid = (int)L; { const int q = nwg / NXCD, r = nwg % NXCD, xcd = wgid % NXCD, off = wgid / NXCD; wgid = (xcd < r ? xcd * (q + 1) : r * (q + 1) + (xcd - r) * q) + off; }
        const int nig = WGM * nN, gid = wgid / nig, fm = gid * WGM, gsz = (nM - fm) < WGM ? (nM - fm) : WGM;
        u.pm = fm + ((wgid % nig) % gsz); u.pn = (wgid % nig) / gsz; return true;
    }
    __device__ __forceinline__ void a_ready(const Unit&) const {}
    __device__ __forceinline__ void done(const Unit&) const {}
};

__device__ __forceinline__ unsigned cvt_pk_bf16(float lo, float hi) { unsigned r; asm volatile("v_cvt_pk_bf16_f32 %0, %1, %2" : "=v"(r) : "v"(lo), "v"(hi)); return r; }
typedef float f32x2 __attribute__((ext_vector_type(2)));
__device__ __forceinline__ f32x2 gelu_pk(f32x2 v) {
    const f32x2 av = __builtin_elementwise_abs(v), d = av * 0.2316418882f + 1.0f;
    f32x2 t; t.x = __builtin_amdgcn_rcpf(d.x); t.y = __builtin_amdgcn_rcpf(d.y);
    f32x2 q = t * 0.5307027145f + (-0.7265760135f); q = q * t + 0.7107068705f; q = q * t + (-0.142248368f); q = q * t + 0.127414796f; q = q * t;
    const f32x2 s = (v * v) * (-0.72134752044f);
    f32x2 e; e.x = __builtin_amdgcn_exp2f(s.x); e.y = __builtin_amdgcn_exp2f(s.y);
    const f32x2 m = v * (q * e), r = v - m;
    f32x2 o; o.x = v.x < 0.f ? m.x : r.x; o.y = v.y < 0.f ? m.y : r.y; return o;
}

template <int ACT  > struct EpiBf16 {
    static constexpr bool PERM = true, AFTER_DRAIN = false; static_assert(ACT == 0 || ACT == 1, "EpiBf16: ACT is 0 (none) or 1 (gelu_pk)");
    bf16_t* O; int ldc; const float* bias; int split_cols; size_t split_stride; float scale0;
    __device__ __forceinline__ void operator()(const f32x4 (&acc)[2][2][4][2], const Unit& u, int wr, int wc, int fr, int fq) const {
        const int row0 = u.pm * BM + wr * 64 + fr; int colt = u.pn * BM; bf16_t* base = O;
        float sc = 1.f; if (split_cols) { const int t = colt / split_cols; base += (size_t)t * split_stride; colt -= t * split_cols; if (t == 0) sc = scale0; }
        const int col0 = colt + wc * 32 + 8 * fq, bcol0 = u.pn * BM + wc * 32 + 8 * fq;
        f32x4 bv[2][2];
#pragma unroll
        for (int bj = 0; bj < 2; ++bj)
#pragma unroll
            for (int n = 0; n < 2; ++n) bv[bj][n] = bias ? *(const f32x4*)(bias + bcol0 + bj * HALF + 4 * n) : (f32x4){0.f, 0.f, 0.f, 0.f};
#pragma unroll
        for (int ai = 0; ai < 2; ++ai)
#pragma unroll
            for (int m = 0; m < 4; ++m) { bf16_t* rowp = base + (size_t)(row0 + ai * HALF + m * 16) * ldc + col0;
#pragma unroll
                for (int bj = 0; bj < 2; ++bj) { f32x4 v0 = acc[ai][bj][m][0] + bv[bj][0], v1 = acc[ai][bj][m][1] + bv[bj][1];
                    if (ACT == 1) { f32x2 a = gelu_pk((f32x2){v0[0], v0[1]}), b = gelu_pk((f32x2){v0[2], v0[3]}), c = gelu_pk((f32x2){v1[0], v1[1]}), d = gelu_pk((f32x2){v1[2], v1[3]});
                        v0 = (f32x4){a.x, a.y, b.x, b.y}; v1 = (f32x4){c.x, c.y, d.x, d.y}; }
                    v0 = v0 * sc; v1 = v1 * sc; u32x4 w; w.x = cvt_pk_bf16(v0[0], v0[1]); w.y = cvt_pk_bf16(v0[2], v0[3]); w.z = cvt_pk_bf16(v1[0], v1[1]); w.w = cvt_pk_bf16(v1[2], v1[3]);
                    *(u32x4*)(rowp + bj * HALF) = w; } }
    }
};
struct EpiResF32 {
    static constexpr bool PERM = true, AFTER_DRAIN = false;
    const float* X; float* O; int ldc;
    __device__ __forceinline__ void operator()(const f32x4 (&acc)[2][2][4][2], const Unit& u, int wr, int wc, int fr, int fq) const {
        const int row0 = u.pm * BM + wr * 64 + fr, col0 = u.pn * BM + wc * 32 + 8 * fq;
#pragma unroll
        for (int ai = 0; ai < 2; ++ai)
#pragma unroll
            for (int m = 0; m < 4; ++m) { const size_t ro = (size_t)(row0 + ai * HALF + m * 16) * ldc + col0;
#pragma unroll
                for (int bj = 0; bj < 2; ++bj) { const size_t off = ro + bj * HALF;
                    const f32x4 x0 = *(const f32x4*)(X + off), x1 = *(const f32x4*)(X + off + 4);
                    *(f32x4*)(O + off) = x0 + acc[ai][bj][m][0]; *(f32x4*)(O + off + 4) = x1 + acc[ai][bj][m][1]; } }
    }
};
struct EpiResF32X {
    static constexpr bool PERM = true, AFTER_DRAIN = false;
    const float* X; int ldc; bf16_t* HB; unsigned char* X8; float* SSP; int tok;
    static __device__ __forceinline__ unsigned pk8(float a, float b, float c, float d) { int w = __builtin_amdgcn_cvt_pk_fp8_f32(a, b, 0, false); w = __builtin_amdgcn_cvt_pk_fp8_f32(c, d, w, true); return (unsigned)w; }
    __device__ __forceinline__ void operator()(const f32x4 (&acc)[2][2][4][2], const Unit& u, int wr, int wc, int fr, int fq) const {
        const int row0 = u.pm * BM + wr * 64 + fr, col0 = u.pn * BM + wc * 32 + 8 * fq;
#pragma unroll
        for (int ai = 0; ai < 2; ++ai) {
            f32x4 xv[4][2][2];
#pragma unroll
            for (int m = 0; m < 4; ++m)
#pragma unroll
                for (int bj = 0; bj < 2; ++bj) { const size_t off = (size_t)(row0 + ai * HALF + m * 16) * ldc + col0 + bj * HALF; xv[m][bj][0] = *(const f32x4*)(X + off); xv[m][bj][1] = *(const f32x4*)(X + off + 4); }
#pragma unroll
            for (int m = 0; m < 4; ++m) { const int row = row0 + ai * HALF + m * 16; const size_t ro = (size_t)row * ldc + col0; float ss = 0.f;
#pragma unroll
                for (int bj = 0; bj < 2; ++bj) { const size_t off = ro + bj * HALF;
                    const f32x4 h0 = xv[m][bj][0] + acc[ai][bj][m][0], h1 = xv[m][bj][1] + acc[ai][bj][m][1];
                    ss += (h0.x * h0.x + h0.y * h0.y) + (h0.z * h0.z + h0.w * h0.w) + (h1.x * h1.x + h1.y * h1.y) + (h1.z * h1.z + h1.w * h1.w);
                    u32x4 w; w.x = cvt_pk_bf16(h0.x, h0.y); w.y = cvt_pk_bf16(h0.z, h0.w); w.z = cvt_pk_bf16(h1.x, h1.y); w.w = cvt_pk_bf16(h1.z, h1.w);
                    *(u32x4*)(HB + off) = w;
                    typedef unsigned u32x2 __attribute__((ext_vector_type(2)));
                    const u32x2 q = {pk8(h0.x, h0.y, h0.z, h0.w), pk8(h1.x, h1.y, h1.z, h1.w)};
                    *(u32x2*)(X8 + ((size_t)((col0 + bj * HALF) >> 3) * tok + row) * 8) = q; }
                ss += __shfl_xor(ss, 16); ss += __shfl_xor(ss, 32);
                if (fq == 0) SSP[(size_t)row * 16 + u.pn * 4 + wc] = ss; } }
    }
};
struct EpiBf16Row {
    static constexpr bool PERM = true, AFTER_DRAIN = false;
    bf16_t* O; int ldc; const float* SSP; float* RSTD; float eps, inv_n;
    __device__ __forceinline__ void operator()(const f32x4 (&acc)[2][2][4][2], const Unit& u, int wr, int wc, int fr, int fq) const {
        const int row0 = u.pm * BM + wr * 64 + fr, col0 = u.pn * BM + wc * 32 + 8 * fq;
#pragma unroll
        for (int ai = 0; ai < 2; ++ai) {
            float rs[4];
#pragma unroll
            for (int m = 0; m < 4; ++m) { const f32x4* sp = (const f32x4*)(SSP + (size_t)(row0 + ai * HALF + m * 16) * 16);
                const f32x4 s4 = (sp[0] + sp[1]) + (sp[2] + sp[3]); rs[m] = 1.f / sqrtf(((s4.x + s4.y) + (s4.z + s4.w)) * inv_n + eps); }
#pragma unroll
            for (int m = 0; m < 4; ++m) { const int row = row0 + ai * HALF + m * 16; bf16_t* rowp = O + (size_t)row * ldc + col0;
                const float rstd = rs[m];
                if (u.pn == 0 && wc == 0 && fq == 0) RSTD[row] = rstd;
#pragma unroll
                for (int bj = 0; bj < 2; ++bj) { const f32x4 v0 = acc[ai][bj][m][0] * rstd, v1 = acc[ai][bj][m][1] * rstd;
                    u32x4 w; w.x = cvt_pk_bf16(v0[0], v0[1]); w.y = cvt_pk_bf16(v0[2], v0[3]); w.z = cvt_pk_bf16(v1[0], v1[1]); w.w = cvt_pk_bf16(v1[2], v1[3]);
                    *(u32x4*)(rowp + bj * HALF) = w; } } }
    }
};
template <class Epi, class Sched, bool ALIGN_EPI = false, bool SP2 = false>
__device__ __forceinline__ void gemm_phase(PG8_LAS unsigned char* lds, const Gemm g, const Sched& S, const Epi& E) {
    const int tid = threadIdx.x, wid = __builtin_amdgcn_readfirstlane(tid >> 6), lane = tid & 63, wr = wid >> 2, wc = wid & 3, fr = lane & 15, fq = lane >> 4;
    const int K = g.K, nt = K / BK;
    unsigned voffA[2], voffB[2];
#pragma unroll
    for (int i = 0; i < 2; ++i) { int R, C; stage_rc(tid * 16 + i * 8192, R, C); const int Rb = Epi::PERM ? ((R & ~31) + perm32(R & 31)) : R;
        voffA[i] = (unsigned)(R * K + C) * 2u; voffB[i] = (unsigned)(Rb * K + C) * 2u; }
    const size_t kstep = (size_t)(BK * 2);
    const size_t hstep = (size_t)HALF * K * 2;
    const size_t tstep = 2 * hstep;
    const unsigned ldsw = (unsigned)wid * 1024u;
    const int aoff = lds_byte(wr * 64 + fr, fq * 8), boff = lds_byte(wc * 32 + fr, fq * 8);
#define PG8_SA(b, h) (((b) * 2 + (h)) * HTB)
#define PG8_SB(b, h) ((4 + (b) * 2 + (h)) * HTB)
#define PG8_STAGE(bufoff, gbase, voff) do { _Pragma("unroll") for (int _i = 0; _i < 2; ++_i) \
        __builtin_amdgcn_global_load_lds((const unsigned*)((const char*)(gbase) + (voff)[_i]), (PG8_LAS unsigned*)(lds + (bufoff) + ldsw + _i * 8192), 16, 0, 0); } while (0)
#define PG8_LDA(dst, b, h) do { _Pragma("unroll") for (int m = 0; m < 4; ++m) _Pragma("unroll") for (int k = 0; k < 2; ++k) dst[m][k] = *(const PG8_LAS bf16x8*)(lds + PG8_SA(b, h) + aoff + m * 2048 + k * 1024); } while (0)
#define PG8_LDB(dst, b, h) do { _Pragma("unroll") for (int n = 0; n < 2; ++n) _Pragma("unroll") for (int k = 0; k < 2; ++k) dst[n][k] = *(const PG8_LAS bf16x8*)(lds + PG8_SB(b, h) + boff + n * 2048 + k * 1024); } while (0)
#define PG8_MMA(ai, bj, At, Bt) do { __builtin_amdgcn_s_setprio(1); _Pragma("unroll") for (int m = 0; m < 4; ++m) _Pragma("unroll") for (int n = 0; n < 2; ++n) _Pragma("unroll") for (int k = 0; k < 2; ++k) \
        acc[ai][bj][m][n] = __builtin_amdgcn_mfma_f32_16x16x32_bf16(Bt[n][k], At[m][k], acc[ai][bj][m][n], 0, 0, 0); __builtin_amdgcn_s_setprio(0); } while (0)
#define PG8_WAIT_V(n) asm volatile("s_waitcnt vmcnt(" #n ")" ::: "memory")
#define PG8_WAIT_L(n) asm volatile("s_waitcnt lgkmcnt(" #n ")" ::: "memory")
#define PG8_BAR __builtin_amdgcn_s_barrier()
#define PG8_SCHED __builtin_amdgcn_sched_barrier(0)
    Unit cur, nxt; int ui = 0;
    if (!S.next(0, cur)) return;
    f32x4 acc[2][2][4][2];
#pragma unroll
    for (int a = 0; a < 2; ++a)
#pragma unroll
        for (int b = 0; b < 2; ++b)
#pragma unroll
            for (int m = 0; m < 4; ++m)
#pragma unroll
                for (int n = 0; n < 2; ++n) acc[a][b][m][n] = (f32x4){0.f, 0.f, 0.f, 0.f};
    bf16x8 At[4][2], B0[2][2], B1[2][2];
    const char* cA = (const char*)g.A + (size_t)cur.pm * tstep; const char* cB = (const char*)g.Bt + (size_t)cur.pn * tstep;
    S.a_ready(cur);
    if constexpr (SP2) {
        PG8_STAGE(PG8_SB(0, 0), cB, voffB); PG8_STAGE(PG8_SB(0, 1), cB + hstep, voffB); PG8_STAGE(PG8_SA(0, 0), cA, voffA); PG8_STAGE(PG8_SA(0, 1), cA + hstep, voffA);
        if (wr == 1) PG8_BAR;
        PG8_WAIT_V(2); PG8_BAR;
        PG8_STAGE(PG8_SB(1, 0), cB + kstep, voffB); PG8_STAGE(PG8_SA(1, 0), cA + kstep, voffA); PG8_STAGE(PG8_SB(1, 1), cB + hstep + kstep, voffB);
        PG8_WAIT_V(6); PG8_BAR;
    } else {
        PG8_STAGE(PG8_SB(0, 0), cB, voffB); PG8_STAGE(PG8_SA(0, 0), cA, voffA); PG8_STAGE(PG8_SB(0, 1), cB + hstep, voffB); PG8_STAGE(PG8_SA(0, 1), cA + hstep, voffA);
        if (wr == 1) PG8_BAR;
        PG8_WAIT_V(4); PG8_BAR;
        PG8_STAGE(PG8_SB(1, 0), cB + kstep, voffB); PG8_STAGE(PG8_SA(1, 0), cA + kstep, voffA); PG8_STAGE(PG8_SB(1, 1), cB + hstep + kstep, voffB);
        PG8_WAIT_V(6); PG8_BAR;
    }
    for (;;) {
        const bool has_next = S.next(ui + 1, nxt);
        const char* nA = has_next ? (const char*)g.A + (size_t)nxt.pm * tstep : cA; const char* nB = has_next ? (const char*)g.Bt + (size_t)nxt.pn * tstep : cB;
        for (int t = 0; t < nt; t += 2) {
            const bool last = (t == nt - 2);
            const char* a1 = cA + (size_t)(t + 1) * kstep;
            const char* a2 = last ? nA : cA + (size_t)(t + 2) * kstep; const char* b2 = last ? nB : cB + (size_t)(t + 2) * kstep;
            const char* a3 = a2 + kstep; const char* b3 = b2 + kstep;
            if (last && has_next) S.a_ready(nxt);
            if constexpr (SP2) {
            PG8_LDB(B0, 0, 0); PG8_LDB(B1, 0, 1); PG8_SCHED; PG8_LDA(At, 0, 0); PG8_STAGE(PG8_SA(1, 1), a1 + hstep, voffA);
            PG8_WAIT_V(8); PG8_WAIT_L(0); PG8_BAR; PG8_MMA(0, 0, At, B0); PG8_MMA(0, 1, At, B1); PG8_BAR; PG8_SCHED;
            PG8_LDA(At, 0, 1); PG8_STAGE(PG8_SB(0, 0), b2, voffB); PG8_STAGE(PG8_SB(0, 1), b2 + hstep, voffB); PG8_STAGE(PG8_SA(0, 0), a2, voffA);
            PG8_WAIT_V(8); PG8_WAIT_L(0); PG8_BAR; PG8_MMA(1, 0, At, B0); PG8_MMA(1, 1, At, B1); PG8_BAR; PG8_SCHED;
            PG8_LDB(B0, 1, 0); PG8_LDB(B1, 1, 1); PG8_SCHED; PG8_LDA(At, 1, 0); PG8_STAGE(PG8_SA(0, 1), a2 + hstep, voffA);
            PG8_WAIT_V(8); PG8_WAIT_L(0); PG8_BAR; PG8_MMA(0, 0, At, B0); PG8_MMA(0, 1, At, B1); PG8_BAR; PG8_SCHED;
            PG8_LDA(At, 1, 1); PG8_STAGE(PG8_SB(1, 0), b3, voffB); PG8_STAGE(PG8_SB(1, 1), b3 + hstep, voffB); PG8_STAGE(PG8_SA(1, 0), a3, voffA);
            PG8_WAIT_V(8); PG8_WAIT_L(0); PG8_BAR; PG8_MMA(1, 0, At, B0); PG8_MMA(1, 1, At, B1); PG8_BAR; PG8_SCHED;
            } else {
            PG8_LDB(B0, 0, 0); PG8_SCHED; PG8_LDA(At, 0, 0); PG8_STAGE(PG8_SA(1, 1), a1 + hstep, voffA);
            PG8_WAIT_L(8); PG8_BAR; PG8_WAIT_L(0); PG8_MMA(0, 0, At, B0); PG8_BAR; PG8_SCHED;
            PG8_LDB(B1, 0, 1); PG8_STAGE(PG8_SB(0, 0), b2, voffB);
            PG8_BAR; PG8_WAIT_L(0); PG8_MMA(0, 1, At, B1); PG8_BAR;
            PG8_LDA(At, 0, 1); PG8_STAGE(PG8_SA(0, 0), a2, voffA);
            PG8_BAR; PG8_WAIT_L(0); PG8_MMA(1, 0, At, B0); PG8_BAR; PG8_SCHED;
            PG8_STAGE(PG8_SB(0, 1), b2 + hstep, voffB);
            PG8_WAIT_V(6); PG8_BAR; PG8_MMA(1, 1, At, B1); PG8_BAR;
            PG8_LDB(B0, 1, 0); PG8_SCHED; PG8_LDA(At, 1, 0); PG8_STAGE(PG8_SA(0, 1), a2 + hstep, voffA);
            PG8_WAIT_L(8); PG8_BAR; PG8_WAIT_L(0); PG8_MMA(0, 0, At, B0); PG8_BAR; PG8_SCHED;
            PG8_LDB(B1, 1, 1); PG8_STAGE(PG8_SB(1, 0), b3, voffB);
            PG8_BAR; PG8_WAIT_L(0); PG8_MMA(0, 1, At, B1); PG8_BAR;
            PG8_LDA(At, 1, 1); PG8_STAGE(PG8_SA(1, 0), a3, voffA);
            PG8_BAR; PG8_WAIT_L(0); PG8_MMA(1, 0, At, B0); PG8_BAR; PG8_SCHED;
            PG8_STAGE(PG8_SB(1, 1), b3 + hstep, voffB);
            PG8_WAIT_V(6); PG8_BAR; PG8_MMA(1, 1, At, B1); PG8_BAR;
            }
        }
        if constexpr (ALIGN_EPI) { if (wr == 0) PG8_BAR; }
        if constexpr (!Epi::AFTER_DRAIN) { E(acc, cur, wr, wc, fr, fq); S.done(cur); }
        if (!has_next) break;
#pragma unroll
        for (int a = 0; a < 2; ++a)
#pragma unroll
            for (int b = 0; b < 2; ++b)
#pragma unroll
                for (int m = 0; m < 4; ++m)
#pragma unroll
                    for (int n = 0; n < 2; ++n) acc[a][b][m][n] = (f32x4){0.f, 0.f, 0.f, 0.f};
        cur = nxt; cA = nA; cB = nB; ++ui;
        if constexpr (ALIGN_EPI) { if (wr == 1) PG8_BAR; }
    }
    PG8_WAIT_V(0);
    if constexpr (!ALIGN_EPI) { if (wr == 0) PG8_BAR; }
    PG8_BAR;
    if constexpr (Epi::AFTER_DRAIN) { E.fused(acc, cur, wr, wc, fr, fq, lds, wid, lane); S.done(cur); }
#undef PG8_SA
#undef PG8_SB
#undef PG8_STAGE
#undef PG8_LDA
#undef PG8_LDB
#undef PG8_MMA
#undef PG8_WAIT_V
#undef PG8_WAIT_L
#undef PG8_BAR
#undef PG8_SCHED
}
}

#ifndef PG8_SP2
#define PG8_SP2 true
#endif
#ifndef PG8_ALIGN
#define PG8_ALIGN true
#endif
#include <hip/hip_bf16.h>
#include <cmath>
namespace attn_body {
using bf16=__hip_bfloat16;
using bf16x8=__attribute__((ext_vector_type(8)))short;
using s16x4=__attribute__((ext_vector_type(4)))short;
using f32x16=__attribute__((ext_vector_type(16)))float;
using u32x4=__attribute__((ext_vector_type(4)))unsigned;
constexpr int SEQ=8192,D=64,PQ=3328,PK=3328,PV=3328,PO=2048;
constexpr int NW=8,QBLK=32,QB=QBLK*NW,KVBLK=64,NQB=SEQ/QB;
constexpr int ATTN_UNIT_ROWS=QB;
__device__ __forceinline__ int crow(int r,int hi){return (r&3)+8*(r>>2)+4*hi;}
#define SBAR() __builtin_amdgcn_sched_barrier(0)
__device__ __forceinline__ void cmask(f32x16&p0,f32x16&p1,int jb,int qrel,int hi){
  const float NEG=-INFINITY; int kb=64*jb+4*hi;
  #pragma unroll
  for(int r=0;r<16;++r){int kv=kb+(r&3)+8*(r>>2); if(kv>qrel)p0[r]=NEG; if(kv+32>qrel)p1[r]=NEG;}
}

constexpr int NSLOT=3, SLOTB=8192;
constexpr int LDS_K=0, LDS_V=NSLOT*SLOTB, LDS_WS=2*NSLOT*SLOTB, LDS_OST=LDS_WS+NW*64*4, LDS_BYTES=LDS_OST+NW*4096;
constexpr float C2=0.125f*1.4426950408889634f;
__device__ __forceinline__ void glds16(const void*gsrc,unsigned lds_dst){unsigned keep;
  asm volatile("s_mov_b32 %0, m0\n\ts_mov_b32 m0, %2\n\ts_nop 0\n\tglobal_load_lds_dwordx4 %1, off\n\ts_mov_b32 m0, %0":"=&s"(keep):"v"(gsrc),"s"(lds_dst):"memory");}
__device__ __forceinline__ float max3f(float a,float b,float c){float r;asm("v_max3_f32 %0, %1, %2, %3":"=v"(r):"v"(a),"v"(b),"v"(c));return r;}
__device__ __forceinline__ float max2f(float a,float b){float r;asm("v_max_f32_e32 %0, %1, %2":"=v"(r):"v"(a),"v"(b));return r;}
__device__ __forceinline__ float fadd_s(float a,float b){float r;asm("v_add_f32_e32 %0, %1, %2":"=v"(r):"v"(a),"v"(b));return r;}
__device__ __forceinline__ float fsub_s(float a,float b){float r;asm("v_sub_f32_e32 %0, %1, %2":"=v"(r):"v"(a),"v"(b));return r;}
typedef float f32x2_t __attribute__((ext_vector_type(2))); typedef __bf16 bf16x2_t __attribute__((ext_vector_type(2)));
__device__ __forceinline__ unsigned cvtpk_s(float lo,float hi){f32x2_t v={lo,hi};bf16x2_t b=__builtin_convertvector(v,bf16x2_t);return __builtin_bit_cast(unsigned,b);}
#define WAIT_BAR(N) asm volatile("s_waitcnt vmcnt(" #N ") lgkmcnt(0)\n\ts_barrier":::"memory")

__device__ __forceinline__ void qkt(f32x16&p0,f32x16&p1,const char*Kslot,const bf16x8*qr,const f32x16&negm,int r32,int hi){
  const char*kb=Kslot+hi*1024+r32*16;
  #pragma unroll
  for(int d0=0;d0<4;++d0){
    const bf16x8 b0=*reinterpret_cast<const bf16x8*>(kb+d0*2048);
    const bf16x8 b1=*reinterpret_cast<const bf16x8*>(kb+d0*2048+512);
    if(d0==0){p0=__builtin_amdgcn_mfma_f32_32x32x16_bf16(b0,qr[0],negm,0,0,0);p1=__builtin_amdgcn_mfma_f32_32x32x16_bf16(b1,qr[0],negm,0,0,0);}
    else{p0=__builtin_amdgcn_mfma_f32_32x32x16_bf16(b0,qr[d0],p0,0,0,0);p1=__builtin_amdgcn_mfma_f32_32x32x16_bf16(b1,qr[d0],p1,0,0,0);}}
}
typedef __attribute__((address_space(3))) const char* lds_cptr;
typedef short v4i16_t __attribute__((ext_vector_type(4)));
__device__ __forceinline__ void kload8(bf16x8*kf,lds_cptr kp){
  kf[0]=*(const __attribute__((address_space(3))) bf16x8*)(kp);      kf[1]=*(const __attribute__((address_space(3))) bf16x8*)(kp+512);
  kf[2]=*(const __attribute__((address_space(3))) bf16x8*)(kp+2048); kf[3]=*(const __attribute__((address_space(3))) bf16x8*)(kp+2560);
  kf[4]=*(const __attribute__((address_space(3))) bf16x8*)(kp+4096); kf[5]=*(const __attribute__((address_space(3))) bf16x8*)(kp+4608);
  kf[6]=*(const __attribute__((address_space(3))) bf16x8*)(kp+6144); kf[7]=*(const __attribute__((address_space(3))) bf16x8*)(kp+6656);
}
__device__ __forceinline__ void kload2(bf16x8*kf,lds_cptr kp,int j){ kf[2*j]=*(const __attribute__((address_space(3))) bf16x8*)(kp+j*2048); kf[2*j+1]=*(const __attribute__((address_space(3))) bf16x8*)(kp+j*2048+512); }
__device__ __forceinline__ s16x4 vtr(lds_cptr p){ return __builtin_bit_cast(s16x4,__builtin_amdgcn_ds_read_tr16_b64_v4i16((__attribute__((address_space(3))) v4i16_t*)p)); }
__device__ __forceinline__ float rowmax(const f32x16&p0,const f32x16&p1){
  float a=max3f(p0[0],p0[1],p1[0]),b=max3f(p0[2],p0[3],p1[1]);a=max3f(a,p1[2],p1[3]);
  #pragma unroll
  for(int r=4;r<16;r+=4){a=max3f(a,p0[r],p0[r+1]);b=max3f(b,p0[r+2],p0[r+3]);a=max3f(a,p1[r],p1[r+1]);b=max3f(b,p1[r+2],p1[r+3]);}
  const float m=max2f(a,b);
  auto rr=__builtin_amdgcn_permlane32_swap(__float_as_uint(m),__float_as_uint(m),false,false);
  return max2f(__uint_as_float(rr[0]),__uint_as_float(rr[1]));
}
__device__ __forceinline__ void pv(f32x16*o,int vb,bf16x8 pa0,bf16x8 pa1,bf16x8 pa2,bf16x8 pa3){
  #pragma unroll
  for(int d0=0;d0<2;++d0){s16x4 lo[4],hi[4];
    #pragma unroll
    for(int ks=0;ks<4;++ks){
      asm volatile("ds_read_b64_tr_b16 %0,%1 offset:%c2":"=&v"(lo[ks]):"v"(vb),"i"(d0*4096+ks*1024):"memory");
      asm volatile("ds_read_b64_tr_b16 %0,%1 offset:%c2":"=&v"(hi[ks]):"v"(vb),"i"(d0*4096+ks*1024+512):"memory");}
    asm volatile("s_waitcnt lgkmcnt(0)":::"memory");SBAR();
    #define PK(k) (bf16x8){lo[k][0],lo[k][1],lo[k][2],lo[k][3],hi[k][0],hi[k][1],hi[k][2],hi[k][3]}
    o[d0]=__builtin_amdgcn_mfma_f32_32x32x16_bf16(pa0,PK(0),o[d0],0,0,0);
    o[d0]=__builtin_amdgcn_mfma_f32_32x32x16_bf16(pa1,PK(1),o[d0],0,0,0);
    o[d0]=__builtin_amdgcn_mfma_f32_32x32x16_bf16(pa2,PK(2),o[d0],0,0,0);
    o[d0]=__builtin_amdgcn_mfma_f32_32x32x16_bf16(pa3,PK(3),o[d0],0,0,0);
    #undef PK
  }
}

#ifndef ATTN_STORE16
#define ATTN_STORE16(p,v) (*(u32x4*)(p)=(v))
#endif
template<int THRL> __device__ __forceinline__ void attn_unit(int b,int qcol,int kcol,int vcol,int ocol,int qb,const bf16*Q,const bf16*__restrict__ K,const bf16*__restrict__ V,bf16*O,char*shm){
  int tid=threadIdx.x; asm volatile("":"+v"(tid));
  const int lane=tid&63,r32=lane&31,hi=lane>>5; const int wid=__builtin_amdgcn_readfirstlane(tid>>6);
  const long rowbase=(long)b*SEQ; const int q0=qb*QB;
  const bf16*Qw=Q+(rowbase+q0+wid*QBLK)*PQ+qcol;
  const bf16*Kh=K+rowbase*PK+kcol,*Vh=V+rowbase*PV+vcol;
  const unsigned lds0=(unsigned)(uintptr_t)shm;
  float*wsf=(float*)(shm+LDS_WS)+wid*64;
  const bf16*ksrc=Kh+(long)lane*PK+wid*8;
  const bf16*vsrc=Vh+(long)(16*(wid&3)+(lane>>2))*PV+(wid>>2)*32+(lane&3)*8;
  const unsigned kdst=lds0+LDS_K+wid*1024, vdst=lds0+LDS_V+wid*1024;
  #define DMA_K(t,slot) glds16(ksrc+(long)(t)*KVBLK*PK,(unsigned)__builtin_amdgcn_readfirstlane(kdst+(slot)))
  #define DMA_V(t,slot) glds16(vsrc+(long)(t)*KVBLK*PV,(unsigned)__builtin_amdgcn_readfirstlane(vdst+(slot)))
  const int vb0=(int)(lds0+LDS_V)+((lane>>4)&1)*32+(lane&3)*8+(4*hi+((lane&15)>>2))*64;
  const char*Kbase=shm+LDS_K; bf16x8 kf[8];
  const lds_cptr shm3=(lds_cptr)shm; const lds_cptr kp0=shm3+LDS_K+hi*1024+r32*16; const lds_cptr vp0=shm3+LDS_V+((lane>>4)&1)*32+(lane&3)*8+(4*hi+((lane&15)>>2))*64;
  const int NT=(q0+QB)/KVBLK;
  DMA_K(0,0);DMA_V(0,0);DMA_K(1,SLOTB);
  bf16x8 qr[4];
  #pragma unroll
  for(int d0=0;d0<4;++d0)qr[d0]=*reinterpret_cast<const bf16x8*>(&Qw[(long)r32*PQ+d0*16+hi*8]);
  float mhat=0.f,l_reg=0.f;f32x16 o[2];o[0]=f32x16{};o[1]=f32x16{};f32x16 negm=f32x16{};asm volatile("":"+v"(negm));
  const int qrel=wid*QBLK+r32;
  #define CMASK(P0,P1,t) do{int jb_=(t)-(NT-4); if(jb_>=0)cmask(P0,P1,jb_,qrel,hi);}while(0)
  bool resc=false;
  #define START(P0,P1) do{ const float rm=rowmax(P0,P1); resc=false; \
    { const float dl=rm; mhat=fadd_s(mhat,dl); \
      _Pragma("unroll") for(int r=0;r<16;++r){P0[r]=fsub_s(P0[r],dl);P1[r]=fsub_s(P1[r],dl);} \
      _Pragma("unroll") for(int r=0;r<16;++r)negm[r]=-mhat; asm volatile("":"+v"(negm)); } \
    _Pragma("unroll") for(int r=0;r<16;++r)P0[r]=__builtin_amdgcn_exp2f(P0[r]); }while(0)
  #define RESC() do{ if(resc){ asm volatile("s_waitcnt lgkmcnt(0)":::"memory"); \
      _Pragma("unroll") for(int d_=0;d_<2;++d_) _Pragma("unroll") for(int r=0;r<16;++r)o[d_][r]*=wsf[crow(r,hi)]; } }while(0)
  f32x16 pA0,pA1,pB0,pB1;
  int sl_prev=0,sl_cur=0,sl_next=SLOTB;
  #define ROT() do{sl_prev=sl_cur;sl_cur=sl_next;sl_next=(sl_next==(NSLOT-1)*SLOTB)?0:sl_next+SLOTB;}while(0)
  DMA_K(2,2*SLOTB);
  WAIT_BAR(3);
  qkt(pA0,pA1,Kbase,qr,negm,r32,hi);asm volatile("s_nop 15\n\ts_nop 7":"+v"(pA0),"+v"(pA1));CMASK(pA0,pA1,0);
  START(pA0,pA1);
  _Pragma("unroll") for(int r=0;r<16;++r)pA1[r]=__builtin_amdgcn_exp2f(pA1[r]);
  WAIT_BAR(0);
  DMA_K(3,0);DMA_V(1,SLOTB);
  ROT();
  kload8(kf,kp0+sl_cur);
  WAIT_BAR(2);
  s16x4 vlo[8],vhi[8]; u32x4 pw0,pw1,pw2,pw3;
  #define PKW(P,B) cvtpk_s(P[B],P[B+1])
  #define PAF(k) __builtin_bit_cast(bf16x8,pw##k)
  #define VFR(i) (bf16x8){vlo[i][0],vlo[i][1],vlo[i][2],vlo[i][3],vhi[i][0],vhi[i][1],vhi[i][2],vhi[i][3]}
  #define PIN(x) asm volatile("":"+v"(x))
  #define MX3(a,b,c) __builtin_fmaxf(__builtin_fmaxf((a),(b)),(c))
  #define GAPA(MF,A0,A1,A2,A3,W0,W1,PW) do{ MF; sacc+=A0; sacc+=A1; sacc+=A2; sacc+=A3; PIN(sacc); W0; W1; PIN(PW); SBAR(); }while(0)
  #define EX(v) __builtin_amdgcn_exp2f(v)
  #define GAPB(MF,X,B) do{ MF; X[B]=EX(X[B]); X[B+1]=EX(X[B+1]); X[B+2]=EX(X[B+2]); X[B+3]=EX(X[B+3]); PIN(X); SBAR(); }while(0)
  #define VRD(i) do{ vlo[i]=vtr(vp_+(((i)>>2)*4096+((i)&3)*1024)); vhi[i]=vtr(vp_+(((i)>>2)*4096+((i)&3)*1024+512)); }while(0)
  #define KRD(G,j) do{ if(G){ kload2(kf,kp0+sl_next,j); SBAR(); } }while(0)
  #define STEP(C0,C1,P0,P1,t,GK,GV,GL) do{ SBAR(); \
    const lds_cptr vp_=vp0+sl_prev; \
    VRD(0); SBAR(); float sacc=(P0[0]+P0[1]); \
    GAPA(C0=__builtin_amdgcn_mfma_f32_32x32x16_bf16(kf[0],qr[0],negm,0,0,0), P0[2],P0[3],P0[4],P0[5],     pw0[0]=PKW(P0,0), pw0[1]=PKW(P0,2), pw0); \
    VRD(4); SBAR(); GAPA(C1=__builtin_amdgcn_mfma_f32_32x32x16_bf16(kf[1],qr[0],negm,0,0,0), P0[6],P0[7],P0[8],P0[9],     pw0[2]=PKW(P0,4), pw0[3]=PKW(P0,6), pw0); \
    VRD(1); SBAR(); GAPA(C0=__builtin_amdgcn_mfma_f32_32x32x16_bf16(kf[2],qr[1],C0,0,0,0),   P0[10],P0[11],P0[12],P0[13], pw1[0]=PKW(P0,8), pw1[1]=PKW(P0,10), pw1); \
    VRD(5); SBAR(); GAPA(C1=__builtin_amdgcn_mfma_f32_32x32x16_bf16(kf[3],qr[1],C1,0,0,0),   P0[14],P0[15],P1[0],P1[1],   pw1[2]=PKW(P0,12),pw1[3]=PKW(P0,14), pw1); \
    VRD(2); SBAR(); GAPA(C0=__builtin_amdgcn_mfma_f32_32x32x16_bf16(kf[4],qr[2],C0,0,0,0),   P1[2],P1[3],P1[4],P1[5],     pw2[0]=PKW(P1,0), pw2[1]=PKW(P1,2), pw2); \
    VRD(6); SBAR(); GAPA(C1=__builtin_amdgcn_mfma_f32_32x32x16_bf16(kf[5],qr[2],C1,0,0,0),   P1[6],P1[7],P1[8],P1[9],     pw2[2]=PKW(P1,4), pw2[3]=PKW(P1,6), pw2); \
    VRD(3); SBAR(); GAPA(C0=__builtin_amdgcn_mfma_f32_32x32x16_bf16(kf[6],qr[3],C0,0,0,0),   P1[10],P1[11],P1[12],P1[13], pw3[0]=PKW(P1,8), pw3[1]=PKW(P1,10), pw3); \
    VRD(7); SBAR(); GAPA(C1=__builtin_amdgcn_mfma_f32_32x32x16_bf16(kf[7],qr[3],C1,0,0,0),   P1[14],P1[15],0.f,0.f,       pw3[2]=PKW(P1,12),pw3[3]=PKW(P1,14), pw3); \
    l_reg+=sacc; \
    if(GK){DMA_K((t)+3,sl_cur);} if(GV){DMA_V((t)+1,sl_next);} \
    CMASK(C0,C1,t); \
    { float a=MX3(C0[0],C0[1],C1[0]),b=MX3(C0[2],C0[3],C1[1]); a=MX3(a,C1[2],C1[3]); \
      _Pragma("unroll") for(int r=4;r<16;r+=4){a=MX3(a,C0[r],C0[r+1]);b=MX3(b,C0[r+2],C0[r+3]);a=MX3(a,C1[r],C1[r+1]);b=MX3(b,C1[r+2],C1[r+3]);} \
      float rm=__builtin_fmaxf(a,b); { auto rr=__builtin_amdgcn_permlane32_swap(__float_as_uint(rm),__float_as_uint(rm),false,false); rm=__builtin_fmaxf(__uint_as_float(rr[0]),__uint_as_float(rr[1])); } \
      resc=false; \
      if(__builtin_expect(__any(rm>(float)THRL),0)){ const float dl=__builtin_fmaxf(rm,0.f); mhat+=dl; \
        _Pragma("unroll") for(int r=0;r<16;++r){C0[r]-=dl;C1[r]-=dl;} \
        _Pragma("unroll") for(int r=0;r<16;++r)negm[r]=-mhat; asm volatile("":"+v"(negm)); \
        const float f=__builtin_amdgcn_exp2f(-dl); l_reg*=f; if(hi==0)wsf[r32]=f; resc=true; } } \
    SBAR(); \
    GAPB(o[0]=__builtin_amdgcn_mfma_f32_32x32x16_bf16(PAF(0),VFR(0),o[0],0,0,0), C0,0); \
    GAPB(o[1]=__builtin_amdgcn_mfma_f32_32x32x16_bf16(PAF(0),VFR(4),o[1],0,0,0), C0,4); \
    KRD(GL,0); GAPB(o[0]=__builtin_amdgcn_mfma_f32_32x32x16_bf16(PAF(1),VFR(1),o[0],0,0,0), C0,8); \
    KRD(GL,1); GAPB(o[1]=__builtin_amdgcn_mfma_f32_32x32x16_bf16(PAF(1),VFR(5),o[1],0,0,0), C0,12); \
    KRD(GL,2); GAPB(o[0]=__builtin_amdgcn_mfma_f32_32x32x16_bf16(PAF(2),VFR(2),o[0],0,0,0), C1,0); \
    KRD(GL,3); GAPB(o[1]=__builtin_amdgcn_mfma_f32_32x32x16_bf16(PAF(2),VFR(6),o[1],0,0,0), C1,4); \
    GAPB(o[0]=__builtin_amdgcn_mfma_f32_32x32x16_bf16(PAF(3),VFR(3),o[0],0,0,0), C1,8); \
    GAPB(o[1]=__builtin_amdgcn_mfma_f32_32x32x16_bf16(PAF(3),VFR(7),o[1],0,0,0), C1,12); \
    }while(0)
  int t=1;
  #undef CMASK
  #define CMASK(P0,P1,t) do{}while(0)
  for(;t+5<NT;t+=2){
    STEP(pB0,pB1,pA0,pA1,t,true,true,true);     WAIT_BAR(2); RESC(); ROT();
    STEP(pA0,pA1,pB0,pB1,t+1,true,true,true);   WAIT_BAR(2); RESC(); ROT();
  }
  #undef CMASK
  #define CMASK(P0,P1,t) do{int jb_=(t)-(NT-4); if(jb_>=0)cmask(P0,P1,jb_,qrel,hi);}while(0)
  #define ENDW(tt) do{ if((tt)+3<NT){WAIT_BAR(2);} else if((tt)+2<NT){WAIT_BAR(1);} else {WAIT_BAR(0);} }while(0)
  for(;t+1<NT;t+=2){
    STEP(pB0,pB1,pA0,pA1,t,(t+3<NT),(t+1<NT),(t+1<NT));       ENDW(t);   RESC(); ROT();
    STEP(pA0,pA1,pB0,pB1,t+1,(t+4<NT),(t+2<NT),(t+2<NT));     ENDW(t+1); RESC(); ROT();
  }
  STEP(pB0,pB1,pA0,pA1,NT-1,false,false,false); RESC();
  { float sacc=pB0[0]+pB0[1]; _Pragma("unroll") for(int r=2;r<16;++r)sacc+=pB0[r]; _Pragma("unroll") for(int r=0;r<16;++r)sacc+=pB1[r]; l_reg+=sacc;
    pw0=(u32x4){PKW(pB0,0),PKW(pB0,2),PKW(pB0,4),PKW(pB0,6)};pw1=(u32x4){PKW(pB0,8),PKW(pB0,10),PKW(pB0,12),PKW(pB0,14)};pw2=(u32x4){PKW(pB1,0),PKW(pB1,2),PKW(pB1,4),PKW(pB1,6)};pw3=(u32x4){PKW(pB1,8),PKW(pB1,10),PKW(pB1,12),PKW(pB1,14)};
    SBAR(); pv(o,vb0+sl_cur,PAF(0),PAF(1),PAF(2),PAF(3)); }
  #undef PKW
  #undef PAF
  #undef VFR
  #undef PIN
  #undef MX3
  #undef GAPA
  #undef GAPB
  #undef EX
  #undef VRD
  #undef KRD
  #undef STEP
  #undef ENDW
  {auto rr=__builtin_amdgcn_permlane32_swap(__float_as_uint(l_reg),__float_as_uint(l_reg),false,false);l_reg=__uint_as_float(rr[0])+__uint_as_float(rr[1]);}
  if(hi==0)wsf[32+r32]=l_reg;asm volatile("s_waitcnt lgkmcnt(0)":::"memory");
  float rli[16];
  #pragma unroll
  for(int r=0;r<16;++r)rli[r]=__builtin_amdgcn_rcpf(wsf[32+crow(r,hi)]);
  bf16*Ow=O+(rowbase+q0+wid*QBLK)*PO+ocol;
  { bf16*stg=(bf16*)(shm+LDS_OST)+wid*2048;
    #pragma unroll
    for(int r=0;r<16;++r){const int orow=crow(r,hi);
      #pragma unroll
      for(int d0=0;d0<2;++d0)stg[orow*64+d0*32+r32]=__float2bfloat16(o[d0][r]*rli[r]);}
    asm volatile("s_waitcnt lgkmcnt(0)":::"memory");
    #pragma unroll
    for(int i=0;i<4;++i){const int row=i*8+(lane>>3),ch=lane&7; const u32x4 v=*(const u32x4*)(stg+row*64+ch*8); ATTN_STORE16(Ow+(long)row*PO+ch*8,v);} }
  asm volatile("s_waitcnt lgkmcnt(0)\n\ts_barrier":::"memory");
  #undef DMA_K
  #undef DMA_V
  #undef CMASK
  #undef START
  #undef RESC
  #undef ROT
}
constexpr int ATTN_LDS_BYTES=LDS_BYTES;
#undef SBAR
#undef WAIT_BAR
}
#include <hip/hip_bf16.h>
#include <cmath>
namespace attn_body2 {
using bf16=__hip_bfloat16;
using bf16x8=__attribute__((ext_vector_type(8)))short;
using s16x4=__attribute__((ext_vector_type(4)))short;
using f32x16=__attribute__((ext_vector_type(16)))float;
using u32x4=__attribute__((ext_vector_type(4)))unsigned;
constexpr int SEQ=8192,D=64,PQ=3328,PK=3328,PV=3328,PO=2048;
constexpr int NW=8,QBLK=32,QB=QBLK*NW,KVBLK=64,NQB=SEQ/QB;
constexpr int ATTN_UNIT_ROWS=QB;
__device__ __forceinline__ int crow(int r,int hi){return (r&3)+8*(r>>2)+4*hi;}
#define SBAR() __builtin_amdgcn_sched_barrier(0)
__device__ __forceinline__ void cmask(f32x16&p0,f32x16&p1,int jb,int qrel,int hi){
  const float NEG=-INFINITY; int kb=64*jb+4*hi;
  #pragma unroll
  for(int r=0;r<16;++r){int kv=kb+(r&3)+8*(r>>2); if(kv>qrel)p0[r]=NEG; if(kv+32>qrel)p1[r]=NEG;}
}

constexpr int NSLOT=3, SLOTB=8192, VSLOT=16384;
constexpr int LDS_K=0, LDS_V=NSLOT*SLOTB, LDS_WS=LDS_V+NSLOT*VSLOT, LDS_OST=LDS_WS+NW*64*4, LDS_BYTES=LDS_OST+NW*8192;
constexpr float C2=0.125f*1.4426950408889634f;
__device__ __forceinline__ void glds16(const void*gsrc,unsigned lds_dst){unsigned keep;
  asm volatile("s_mov_b32 %0, m0\n\ts_mov_b32 m0, %2\n\ts_nop 0\n\tglobal_load_lds_dwordx4 %1, off\n\ts_mov_b32 m0, %0":"=&s"(keep):"v"(gsrc),"s"(lds_dst):"memory");}
__device__ __forceinline__ float max3f(float a,float b,float c){float r;asm("v_max3_f32 %0, %1, %2, %3":"=v"(r):"v"(a),"v"(b),"v"(c));return r;}
__device__ __forceinline__ float max2f(float a,float b){float r;asm("v_max_f32_e32 %0, %1, %2":"=v"(r):"v"(a),"v"(b));return r;}
__device__ __forceinline__ float fadd_s(float a,float b){float r;asm("v_add_f32_e32 %0, %1, %2":"=v"(r):"v"(a),"v"(b));return r;}
__device__ __forceinline__ float fsub_s(float a,float b){float r;asm("v_sub_f32_e32 %0, %1, %2":"=v"(r):"v"(a),"v"(b));return r;}
typedef float f32x2_t __attribute__((ext_vector_type(2))); typedef __bf16 bf16x2_t __attribute__((ext_vector_type(2)));
__device__ __forceinline__ unsigned cvtpk_s(float lo,float hi){f32x2_t v={lo,hi};bf16x2_t b=__builtin_convertvector(v,bf16x2_t);return __builtin_bit_cast(unsigned,b);}
#define WAIT_BAR(N) asm volatile("s_waitcnt vmcnt(" #N ") lgkmcnt(0)\n\ts_barrier":::"memory")

__device__ __forceinline__ void qkt(f32x16&p0,f32x16&p1,const char*Kslot,const bf16x8*qr,const f32x16&negm,int r32,int hi){
  const char*kb=Kslot+hi*1024+r32*16;
  #pragma unroll
  for(int d0=0;d0<4;++d0){
    const bf16x8 b0=*reinterpret_cast<const bf16x8*>(kb+d0*2048);
    const bf16x8 b1=*reinterpret_cast<const bf16x8*>(kb+d0*2048+512);
    if(d0==0){p0=__builtin_amdgcn_mfma_f32_32x32x16_bf16(b0,qr[0],negm,0,0,0);p1=__builtin_amdgcn_mfma_f32_32x32x16_bf16(b1,qr[0],negm,0,0,0);}
    else{p0=__builtin_amdgcn_mfma_f32_32x32x16_bf16(b0,qr[d0],p0,0,0,0);p1=__builtin_amdgcn_mfma_f32_32x32x16_bf16(b1,qr[d0],p1,0,0,0);}}
}
typedef __attribute__((address_space(3))) const char* lds_cptr;
typedef short v4i16_t __attribute__((ext_vector_type(4)));
__device__ __forceinline__ void kload8(bf16x8*kf,lds_cptr kp){
  kf[0]=*(const __attribute__((address_space(3))) bf16x8*)(kp);      kf[1]=*(const __attribute__((address_space(3))) bf16x8*)(kp+512);
  kf[2]=*(const __attribute__((address_space(3))) bf16x8*)(kp+2048); kf[3]=*(const __attribute__((address_space(3))) bf16x8*)(kp+2560);
  kf[4]=*(const __attribute__((address_space(3))) bf16x8*)(kp+4096); kf[5]=*(const __attribute__((address_space(3))) bf16x8*)(kp+4608);
  kf[6]=*(const __attribute__((address_space(3))) bf16x8*)(kp+6144); kf[7]=*(const __attribute__((address_space(3))) bf16x8*)(kp+6656);
}
__device__ __forceinline__ void kload2(bf16x8*kf,lds_cptr kp,int j){ kf[2*j]=*(const __attribute__((address_space(3))) bf16x8*)(kp+j*2048); kf[2*j+1]=*(const __attribute__((address_space(3))) bf16x8*)(kp+j*2048+512); }
__device__ __forceinline__ s16x4 vtr(lds_cptr p){ return __builtin_bit_cast(s16x4,__builtin_amdgcn_ds_read_tr16_b64_v4i16((__attribute__((address_space(3))) v4i16_t*)p)); }
__device__ __forceinline__ float rowmax(const f32x16&p0,const f32x16&p1){
  float a=max3f(p0[0],p0[1],p1[0]),b=max3f(p0[2],p0[3],p1[1]);a=max3f(a,p1[2],p1[3]);
  #pragma unroll
  for(int r=4;r<16;r+=4){a=max3f(a,p0[r],p0[r+1]);b=max3f(b,p0[r+2],p0[r+3]);a=max3f(a,p1[r],p1[r+1]);b=max3f(b,p1[r+2],p1[r+3]);}
  const float m=max2f(a,b);
  auto rr=__builtin_amdgcn_permlane32_swap(__float_as_uint(m),__float_as_uint(m),false,false);
  return max2f(__uint_as_float(rr[0]),__uint_as_float(rr[1]));
}
__device__ __forceinline__ void pv(f32x16*o,int vb,bf16x8 pa0,bf16x8 pa1,bf16x8 pa2,bf16x8 pa3){
  #pragma unroll
  for(int d0=0;d0<4;++d0){s16x4 lo[4],hi[4];
    #pragma unroll
    for(int ks=0;ks<4;++ks){
      asm volatile("ds_read_b64_tr_b16 %0,%1 offset:%c2":"=&v"(lo[ks]):"v"(vb),"i"(d0*4096+ks*1024):"memory");
      asm volatile("ds_read_b64_tr_b16 %0,%1 offset:%c2":"=&v"(hi[ks]):"v"(vb),"i"(d0*4096+ks*1024+512):"memory");}
    asm volatile("s_waitcnt lgkmcnt(0)":::"memory");SBAR();
    #define PK(k) (bf16x8){lo[k][0],lo[k][1],lo[k][2],lo[k][3],hi[k][0],hi[k][1],hi[k][2],hi[k][3]}
    o[d0]=__builtin_amdgcn_mfma_f32_32x32x16_bf16(pa0,PK(0),o[d0],0,0,0);
    o[d0]=__builtin_amdgcn_mfma_f32_32x32x16_bf16(pa1,PK(1),o[d0],0,0,0);
    o[d0]=__builtin_amdgcn_mfma_f32_32x32x16_bf16(pa2,PK(2),o[d0],0,0,0);
    o[d0]=__builtin_amdgcn_mfma_f32_32x32x16_bf16(pa3,PK(3),o[d0],0,0,0);
    #undef PK
  }
}

#ifndef ATTN_STORE16
#define ATTN_STORE16(p,v) (*(u32x4*)(p)=(v))
#endif
template<int THRL> __device__ __forceinline__ void attn_unit(int b,int qcol,int kcol,int vcol,int ocol,int qb,const bf16*Q,const bf16*__restrict__ K,const bf16*__restrict__ V,bf16*O,char*shm){
  int tid=threadIdx.x; asm volatile("":"+v"(tid));
  const int lane=tid&63,r32=lane&31,hi=lane>>5; const int wid=__builtin_amdgcn_readfirstlane(tid>>6);
  const long rowbase=(long)b*SEQ; const int q0=qb*QB;
  const bf16*Qw=Q+(rowbase+q0+wid*QBLK)*PQ+qcol;
  const bf16*Kh=K+rowbase*PK+kcol,*Vh=V+rowbase*PV+vcol;
  const unsigned lds0=(unsigned)(uintptr_t)shm;
  float*wsf=(float*)(shm+LDS_WS)+wid*64;
  const bf16*ksrc=Kh+(long)lane*PK+wid*8;
  const bf16*vsrc=Vh+(long)(16*(wid&3)+(lane>>2))*PV+(wid>>2)*32+(lane&3)*8;
  const unsigned kdst=lds0+LDS_K+wid*1024, vdst=lds0+LDS_V+wid*1024;
  #define DMA_K(t,slot) glds16(ksrc+(long)(t)*KVBLK*PK,(unsigned)__builtin_amdgcn_readfirstlane(kdst+(slot)))
  #define DMA_V(t,slot) do{ glds16(vsrc+(long)(t)*KVBLK*PV,(unsigned)__builtin_amdgcn_readfirstlane(vdst+2*(slot))); glds16(vsrc+64+(long)(t)*KVBLK*PV,(unsigned)__builtin_amdgcn_readfirstlane(vdst+2*(slot)+8192)); }while(0)
  const int vb0=(int)(lds0+LDS_V)+((lane>>4)&1)*32+(lane&3)*8+(4*hi+((lane&15)>>2))*64;
  const char*Kbase=shm+LDS_K; bf16x8 kf[8];
  const lds_cptr shm3=(lds_cptr)shm; const lds_cptr kp0=shm3+LDS_K+hi*1024+r32*16; const lds_cptr vp0=shm3+LDS_V+((lane>>4)&1)*32+(lane&3)*8+(4*hi+((lane&15)>>2))*64;
  const int NT=(q0+QB)/KVBLK;
  DMA_K(0,0);DMA_V(0,0);DMA_K(1,SLOTB);
  bf16x8 qr[4];
  #pragma unroll
  for(int d0=0;d0<4;++d0)qr[d0]=*reinterpret_cast<const bf16x8*>(&Qw[(long)r32*PQ+d0*16+hi*8]);
  { u32x4*qst_=(u32x4*)(shm+LDS_OST+wid*8192);
    _Pragma("unroll") for(int d0=0;d0<4;++d0)qst_[d0*64+lane]=__builtin_bit_cast(u32x4,qr[d0]); }
  const lds_cptr qsp=(lds_cptr)shm+LDS_OST+wid*8192+lane*16;
  float mhat=0.f,l_reg=0.f;f32x16 o[4];o[0]=f32x16{};o[1]=f32x16{};o[2]=f32x16{};o[3]=f32x16{};const f32x16 ZR=f32x16{};
  const int qrel=wid*QBLK+r32;
  #define CMASK(P0,P1,t) do{int jb_=(t)-(NT-4); if(jb_>=0)cmask(P0,P1,jb_,qrel,hi);}while(0)
  bool resc=false;
  #define START(P0,P1) do{ const float rm=rowmax(P0,P1); resc=false; \
    { const float dl=rm; mhat=fadd_s(mhat,dl); \
      _Pragma("unroll") for(int r=0;r<16;++r){P0[r]=fsub_s(P0[r],dl);P1[r]=fsub_s(P1[r],dl);} \
      } \
    _Pragma("unroll") for(int r=0;r<16;++r)P0[r]=__builtin_amdgcn_exp2f(P0[r]); }while(0)
  #define RESC() do{ if(resc){ asm volatile("s_waitcnt lgkmcnt(0)":::"memory"); \
      _Pragma("unroll") for(int d_=0;d_<4;++d_) _Pragma("unroll") for(int r=0;r<16;++r)o[d_][r]*=wsf[crow(r,hi)]; } }while(0)
  f32x16 pA0,pA1,pB0,pB1;
  int sl_prev=0,sl_cur=0,sl_next=SLOTB;
  #define ROT() do{sl_prev=sl_cur;sl_cur=sl_next;sl_next=(sl_next==(NSLOT-1)*SLOTB)?0:sl_next+SLOTB;}while(0)
  DMA_K(2,2*SLOTB);
  WAIT_BAR(4);
  qkt(pA0,pA1,Kbase,qr,ZR,r32,hi);asm volatile("s_nop 15\n\ts_nop 7":"+v"(pA0),"+v"(pA1));CMASK(pA0,pA1,0);
  START(pA0,pA1);
  _Pragma("unroll") for(int r=0;r<16;++r)pA1[r]=__builtin_amdgcn_exp2f(pA1[r]);
  WAIT_BAR(0);
  DMA_K(3,0);DMA_V(1,SLOTB);
  ROT();
  kload8(kf,kp0+sl_cur);
  WAIT_BAR(3);
  s16x4 vlo[8],vhi[8]; u32x4 pw0,pw1,pw2,pw3;
  #define PKW(P,B) cvtpk_s(P[B],P[B+1])
  #define PAF(k) __builtin_bit_cast(bf16x8,pw##k)
  #define VFR(i) (bf16x8){vlo[i][0],vlo[i][1],vlo[i][2],vlo[i][3],vhi[i][0],vhi[i][1],vhi[i][2],vhi[i][3]}
  #define PIN(x) asm volatile("":"+v"(x))
  #define MX3(a,b,c) __builtin_fmaxf(__builtin_fmaxf((a),(b)),(c))
  #define GAPA(MF,A0,A1,A2,A3,W0,W1,PW) do{ MF; sacc+=A0; sacc+=A1; sacc+=A2; sacc+=A3; PIN(sacc); W0; W1; PIN(PW); SBAR(); }while(0)
  #define EX(v) __builtin_amdgcn_exp2f(v)
  #define GAPB(MF,X,B) do{ MF; X[B]=EX(X[B]); X[B+1]=EX(X[B+1]); X[B+2]=EX(X[B+2]); X[B+3]=EX(X[B+3]); PIN(X); SBAR(); }while(0)
  #define VRD(i) do{ vlo[i]=vtr(vp_+(((i)>>2)*4096+((i)&3)*1024)); vhi[i]=vtr(vp_+(((i)>>2)*4096+((i)&3)*1024+512)); }while(0)
  #define VRD2(i) do{ vlo[i]=vtr(vp_+((((i)>>2)+2)*4096+((i)&3)*1024)); vhi[i]=vtr(vp_+((((i)>>2)+2)*4096+((i)&3)*1024+512)); }while(0)
  #define GAPB2(MF,X,B,RD) do{ MF; X[B]=__builtin_amdgcn_exp2f(X[B]); X[B+1]=__builtin_amdgcn_exp2f(X[B+1]); asm volatile("":"+v"(X)); RD; SBAR(); }while(0)
  #define KRD(G,j) do{ if(G){ kload2(kf,kp0+sl_next,j); SBAR(); } }while(0)
  #define STEP(C0,C1,P0,P1,t,GK,GV,GL) do{ SBAR(); \
    const lds_cptr vp_=vp0+2*sl_prev; \
    _Pragma("unroll") for(int d0=0;d0<4;++d0)qr[d0]=*(const __attribute__((address_space(3))) bf16x8*)(qsp+d0*1024); SBAR(); \
    float sacc=(P0[0]+P0[1]); \
    GAPA(C0=__builtin_amdgcn_mfma_f32_32x32x16_bf16(kf[0],qr[0],ZR,0,0,0), P0[2],P0[3],P0[4],P0[5],     pw0[0]=PKW(P0,0), pw0[1]=PKW(P0,2), pw0); VRD(0); SBAR(); \
    GAPA(C1=__builtin_amdgcn_mfma_f32_32x32x16_bf16(kf[1],qr[0],ZR,0,0,0), P0[6],P0[7],P0[8],P0[9],     pw0[2]=PKW(P0,4), pw0[3]=PKW(P0,6), pw0); VRD(4); SBAR(); \
    GAPA(C0=__builtin_amdgcn_mfma_f32_32x32x16_bf16(kf[2],qr[1],C0,0,0,0),   P0[10],P0[11],P0[12],P0[13], pw1[0]=PKW(P0,8), pw1[1]=PKW(P0,10), pw1); VRD(1); SBAR(); \
    GAPA(C1=__builtin_amdgcn_mfma_f32_32x32x16_bf16(kf[3],qr[1],C1,0,0,0),   P0[14],P0[15],P1[0],P1[1],   pw1[2]=PKW(P0,12),pw1[3]=PKW(P0,14), pw1); VRD(5); SBAR(); \
    GAPA(C0=__builtin_amdgcn_mfma_f32_32x32x16_bf16(kf[4],qr[2],C0,0,0,0),   P1[2],P1[3],P1[4],P1[5],     pw2[0]=PKW(P1,0), pw2[1]=PKW(P1,2), pw2); VRD(2); SBAR(); \
    GAPA(C1=__builtin_amdgcn_mfma_f32_32x32x16_bf16(kf[5],qr[2],C1,0,0,0),   P1[6],P1[7],P1[8],P1[9],     pw2[2]=PKW(P1,4), pw2[3]=PKW(P1,6), pw2); VRD(6); SBAR(); \
    GAPA(C0=__builtin_amdgcn_mfma_f32_32x32x16_bf16(kf[6],qr[3],C0,0,0,0),   P1[10],P1[11],P1[12],P1[13], pw3[0]=PKW(P1,8), pw3[1]=PKW(P1,10), pw3); VRD(3); SBAR(); \
    GAPA(C1=__builtin_amdgcn_mfma_f32_32x32x16_bf16(kf[7],qr[3],C1,0,0,0),   P1[14],P1[15],0.f,0.f,       pw3[2]=PKW(P1,12),pw3[3]=PKW(P1,14), pw3); VRD(7); SBAR(); \
    _Pragma("unroll") for(int r=0;r<16;++r){C0[r]-=mhat;C1[r]-=mhat;} \
    l_reg+=sacc; \
    if(GK){DMA_K((t)+3,sl_cur);} if(GV){DMA_V((t)+1,sl_next);} \
    CMASK(C0,C1,t); \
    { float a=MX3(C0[0],C0[1],C1[0]),b=MX3(C0[2],C0[3],C1[1]); a=MX3(a,C1[2],C1[3]); \
      _Pragma("unroll") for(int r=4;r<16;r+=4){a=MX3(a,C0[r],C0[r+1]);b=MX3(b,C0[r+2],C0[r+3]);a=MX3(a,C1[r],C1[r+1]);b=MX3(b,C1[r+2],C1[r+3]);} \
      float rm=__builtin_fmaxf(a,b); { auto rr=__builtin_amdgcn_permlane32_swap(__float_as_uint(rm),__float_as_uint(rm),false,false); rm=__builtin_fmaxf(__uint_as_float(rr[0]),__uint_as_float(rr[1])); } \
      resc=false; \
      if(__builtin_expect(__any(rm>(float)THRL),0)){ const float dl=__builtin_fmaxf(rm,0.f); mhat+=dl; \
        _Pragma("unroll") for(int r=0;r<16;++r){C0[r]-=dl;C1[r]-=dl;} \
        const float f=__builtin_amdgcn_exp2f(-dl); l_reg*=f; if(hi==0)wsf[r32]=f; resc=true; } } \
    SBAR(); \
      \
    GAPB2(o[0]=__builtin_amdgcn_mfma_f32_32x32x16_bf16(PAF(0),VFR(0),o[0],0,0,0), C0,0,  VRD2(0)); \
    GAPB2(o[1]=__builtin_amdgcn_mfma_f32_32x32x16_bf16(PAF(0),VFR(4),o[1],0,0,0), C0,2,  VRD2(4)); \
    GAPB2(o[0]=__builtin_amdgcn_mfma_f32_32x32x16_bf16(PAF(1),VFR(1),o[0],0,0,0), C0,4,  VRD2(1)); \
    GAPB2(o[1]=__builtin_amdgcn_mfma_f32_32x32x16_bf16(PAF(1),VFR(5),o[1],0,0,0), C0,6,  VRD2(5)); \
    GAPB2(o[0]=__builtin_amdgcn_mfma_f32_32x32x16_bf16(PAF(2),VFR(2),o[0],0,0,0), C0,8,  VRD2(2)); \
    GAPB2(o[1]=__builtin_amdgcn_mfma_f32_32x32x16_bf16(PAF(2),VFR(6),o[1],0,0,0), C0,10, VRD2(6)); \
    GAPB2(o[0]=__builtin_amdgcn_mfma_f32_32x32x16_bf16(PAF(3),VFR(3),o[0],0,0,0), C0,12, VRD2(3)); \
    GAPB2(o[1]=__builtin_amdgcn_mfma_f32_32x32x16_bf16(PAF(3),VFR(7),o[1],0,0,0), C0,14, VRD2(7)); \
      \
    GAPB2(o[2]=__builtin_amdgcn_mfma_f32_32x32x16_bf16(PAF(0),VFR(0),o[2],0,0,0), C1,0,  (void)0); \
    GAPB2(o[3]=__builtin_amdgcn_mfma_f32_32x32x16_bf16(PAF(0),VFR(4),o[3],0,0,0), C1,2,  (void)0); \
    KRD(GL,0); GAPB2(o[2]=__builtin_amdgcn_mfma_f32_32x32x16_bf16(PAF(1),VFR(1),o[2],0,0,0), C1,4,  (void)0); \
    KRD(GL,1); GAPB2(o[3]=__builtin_amdgcn_mfma_f32_32x32x16_bf16(PAF(1),VFR(5),o[3],0,0,0), C1,6,  (void)0); \
    KRD(GL,2); GAPB2(o[2]=__builtin_amdgcn_mfma_f32_32x32x16_bf16(PAF(2),VFR(2),o[2],0,0,0), C1,8,  (void)0); \
    KRD(GL,3); GAPB2(o[3]=__builtin_amdgcn_mfma_f32_32x32x16_bf16(PAF(2),VFR(6),o[3],0,0,0), C1,10, (void)0); \
    GAPB2(o[2]=__builtin_amdgcn_mfma_f32_32x32x16_bf16(PAF(3),VFR(3),o[2],0,0,0), C1,12, (void)0); \
    GAPB2(o[3]=__builtin_amdgcn_mfma_f32_32x32x16_bf16(PAF(3),VFR(7),o[3],0,0,0), C1,14, (void)0); \
    }while(0)
  int t=1;
  #undef CMASK
  #define CMASK(P0,P1,t) do{}while(0)
  for(;t+5<NT;t+=2){
    STEP(pB0,pB1,pA0,pA1,t,true,true,true);     WAIT_BAR(3); RESC(); ROT();
    STEP(pA0,pA1,pB0,pB1,t+1,true,true,true);   WAIT_BAR(3); RESC(); ROT();
  }
  #undef CMASK
  #define CMASK(P0,P1,t) do{int jb_=(t)-(NT-4); if(jb_>=0)cmask(P0,P1,jb_,qrel,hi);}while(0)
  #define ENDW(tt) do{ if((tt)+3<NT){WAIT_BAR(3);} else if((tt)+2<NT){WAIT_BAR(2);} else {WAIT_BAR(0);} }while(0)
  for(;t+1<NT;t+=2){
    STEP(pB0,pB1,pA0,pA1,t,(t+3<NT),(t+1<NT),(t+1<NT));       ENDW(t);   RESC(); ROT();
    STEP(pA0,pA1,pB0,pB1,t+1,(t+4<NT),(t+2<NT),(t+2<NT));     ENDW(t+1); RESC(); ROT();
  }
  STEP(pB0,pB1,pA0,pA1,NT-1,false,false,false); RESC();
  { float sacc=pB0[0]+pB0[1]; _Pragma("unroll") for(int r=2;r<16;++r)sacc+=pB0[r]; _Pragma("unroll") for(int r=0;r<16;++r)sacc+=pB1[r]; l_reg+=sacc;
    pw0=(u32x4){PKW(pB0,0),PKW(pB0,2),PKW(pB0,4),PKW(pB0,6)};pw1=(u32x4){PKW(pB0,8),PKW(pB0,10),PKW(pB0,12),PKW(pB0,14)};pw2=(u32x4){PKW(pB1,0),PKW(pB1,2),PKW(pB1,4),PKW(pB1,6)};pw3=(u32x4){PKW(pB1,8),PKW(pB1,10),PKW(pB1,12),PKW(pB1,14)};
    SBAR(); pv(o,vb0+2*sl_cur,PAF(0),PAF(1),PAF(2),PAF(3)); }
  #undef PKW
  #undef PAF
  #undef VFR
  #undef PIN
  #undef MX3
  #undef GAPA
  #undef GAPB
  #undef EX
  #undef VRD
  #undef VRD2
  #undef GAPB2
  #undef KRD
  #undef STEP
  #undef ENDW
  {auto rr=__builtin_amdgcn_permlane32_swap(__float_as_uint(l_reg),__float_as_uint(l_reg),false,false);l_reg=__uint_as_float(rr[0])+__uint_as_float(rr[1]);}
  if(hi==0)wsf[32+r32]=l_reg;asm volatile("s_waitcnt lgkmcnt(0)":::"memory");
  float rli[16];
  #pragma unroll
  for(int r=0;r<16;++r)rli[r]=__builtin_amdgcn_rcpf(wsf[32+crow(r,hi)]);
  bf16*Ow=O+(rowbase+q0+wid*QBLK)*PO+ocol;
  { bf16*stg=(bf16*)(shm+LDS_OST)+wid*4096;
    #pragma unroll
    for(int r=0;r<16;++r){const int orow=crow(r,hi);
      #pragma unroll
      for(int d0=0;d0<4;++d0)stg[orow*128+d0*32+r32]=__float2bfloat16(o[d0][r]*rli[r]);}
    asm volatile("s_waitcnt lgkmcnt(0)":::"memory");
    #pragma unroll
    for(int i=0;i<8;++i){const int row=i*4+(lane>>4),ch=lane&15; const u32x4 v=*(const u32x4*)(stg+row*128+ch*8); ATTN_STORE16(Ow+(long)row*PO+ch*8,v);} }
  asm volatile("s_waitcnt lgkmcnt(0)\n\ts_barrier":::"memory");
  #undef DMA_K
  #undef DMA_V
  #undef CMASK
  #undef START
  #undef RESC
  #undef ROT
}
constexpr int ATTN_LDS_BYTES=LDS_BYTES;
#undef SBAR
#undef WAIT_BAR
}
constexpr int NWAVES = 8;
#ifndef MK_N_LAUNCHES
#define MK_N_LAUNCHES 1
#endif
constexpr int NPHASE = 13;
constexpr int N_LAUNCHES = MK_N_LAUNCHES;

constexpr int NB = 4, SEQL = 8192, DMODEL = 1024, TOK = NB * SEQL;
constexpr int IN_W = 3088;
constexpr int NPROJ = 3328;
constexpr int C_GQ = 0, C_GK = 256, C_GV = 512, C_GZ = 1024, C_GR = 1280, C_DQ = 1792, C_DK = 2304, C_DV = 2816;
constexpr int NUNIT = 2048;
constexpr int PEER_N = 16384, NQP = 2048;
constexpr float RMS_EPS = 1e-6f;
constexpr float LAMBDA_INIT = 0.2f;

constexpr size_t MiB = 1u << 20;
constexpr size_t WS_CTL = 0, CTL_ZERO_BYTES = 65536;
constexpr size_t WS_WIN = 1 * MiB, WS_WOUT = 8 * MiB, WS_WQ = 10 * MiB, WS_KEYS = 14 * MiB;
constexpr size_t WS_KVT = 16 * MiB, WS_VT = 48 * MiB;
constexpr size_t WS_U = 16 * MiB, WS_V = 48 * MiB;
constexpr size_t WS_SGE = 80 * MiB, WS_AE = 96 * MiB, WS_OFFS = 112 * MiB;
constexpr size_t WS_XT = 384 * MiB;
constexpr size_t WS_AE2 = 208 * MiB, WS_CNT = 113 * MiB;
constexpr size_t WS_XN = 80 * MiB, WS_MIX = 80 * MiB;
constexpr size_t WS_PROJ = 144 * MiB;
constexpr size_t WS_XN2 = 144 * MiB, WS_QP = 208 * MiB;
constexpr size_t WS_O = 352 * MiB;
constexpr size_t WS_IDX = 352 * MiB;
constexpr size_t WS_KTT = 480 * MiB;
constexpr size_t WS_DEC = 496 * MiB;
constexpr size_t WS_ROPE = 497 * MiB;
constexpr size_t WS_SSP = 499 * MiB, WS_RSTD = 501 * MiB;
constexpr size_t WS_END = 502 * MiB;
constexpr int CW_BAR = 4096;

constexpr int RING_OFF = 0, RING_BYTES = 131072;
constexpr int LDSCTL_OFF = 163840 - 512, MISC_OFF = LDSCTL_OFF + 320;
constexpr int LDS_BYTES = 163840;
static_assert(MISC_OFF + 128 <= LDS_BYTES, "LDS map");

#define GAS __attribute__((address_space(1)))
#define LAS __attribute__((address_space(3)))
typedef unsigned short bf16;
typedef unsigned v4u __attribute__((ext_vector_type(4)));
typedef unsigned v2u __attribute__((ext_vector_type(2)));
typedef float f32x4 __attribute__((ext_vector_type(4)));
typedef float f32x16 __attribute__((ext_vector_type(16)));
typedef short bf16x8 __attribute__((ext_vector_type(8)));
typedef short s16x4 __attribute__((ext_vector_type(4)));
typedef GAS unsigned gu32;
typedef _Float16 h2 __attribute__((ext_vector_type(2)));
typedef _Float16 f16x8 __attribute__((ext_vector_type(8)));
#define RLX_AGENT __ATOMIC_RELAXED, __HIP_MEMORY_SCOPE_AGENT
#define LDS_WAIT() asm volatile("s_waitcnt lgkmcnt(0)" ::: "memory")
#define VM_WAIT() asm volatile("s_waitcnt vmcnt(0)" ::: "memory")
__device__ __forceinline__ unsigned f2bf(float f) { unsigned u = __builtin_bit_cast(unsigned, f); return (u + 0x7fffu + ((u >> 16) & 1u)) >> 16; }
__device__ __forceinline__ unsigned pk2(float lo, float hi) { return f2bf(lo) | (f2bf(hi) << 16); }
__device__ __forceinline__ unsigned pkh(float lo, float hi) { h2 v; v.x = (_Float16)lo; v.y = (_Float16)hi; return __builtin_bit_cast(unsigned, v); }
__device__ __forceinline__ h2 u2h(unsigned u) { return __builtin_bit_cast(h2, u); }
__device__ __forceinline__ void fma_mix_lo(float& acc, unsigned hb, float a) { asm("v_fma_mix_f32 %0, %1, %2, %0 op_sel_hi:[1,0,0]" : "+v"(acc) : "v"(hb), "v"(a)); }
__device__ __forceinline__ void fma_mix_hi(float& acc, unsigned hb, float a) { asm("v_fma_mix_f32 %0, %1, %2, %0 op_sel:[1,0,0] op_sel_hi:[1,0,0]" : "+v"(acc) : "v"(hb), "v"(a)); }
__device__ __forceinline__ f16x8 v2f16x8(v4u v) { return __builtin_bit_cast(f16x8, v); }
__device__ __forceinline__ long v2l(v2u v) { return __builtin_bit_cast(long, v); }
__device__ __forceinline__ unsigned pk8(float a, float b, float c, float d) { int w = __builtin_amdgcn_cvt_pk_fp8_f32(a, b, 0, false); w = __builtin_amdgcn_cvt_pk_fp8_f32(c, d, w, true); return (unsigned)w; }
__device__ __forceinline__ float bf2f(unsigned b) { return __builtin_bit_cast(float, b << 16); }
__device__ __forceinline__ float bflo(unsigned w) { return __builtin_bit_cast(float, w << 16); }
__device__ __forceinline__ float bfhi(unsigned w) { return __builtin_bit_cast(float, w & 0xffff0000u); }
__device__ __forceinline__ int crow(int r, int hi) { return (r & 3) + 8 * (r >> 2) + 4 * hi; }
__device__ __forceinline__ float wave_sum(float v) {
#pragma unroll
    for (int o = 1; o < 64; o <<= 1) v += __shfl_xor(v, o);
    return v;
}
__device__ __forceinline__ float fmax_s(float a, float b) { float r; asm("v_max_f32_e32 %0, %1, %2" : "=v"(r) : "v"(a), "v"(b)); return r; }
__device__ __forceinline__ float fmin_s(float a, float b) { float r; asm("v_min_f32_e32 %0, %1, %2" : "=v"(r) : "v"(a), "v"(b)); return r; }

#define XB_TMO      128
#define XB_XCNT(j)  (256  + 64 * (j))
#define XB_XSUB(j)  (1280 + 64 * (j))
#define XB_XGEN(j)  (2304 + 64 * (j))
#define XB_TOP      3328
#define XB_TOPGEN   3392
#define XCD_BAR_WORDS 3456
#define XB_SPIN_CAP (1u << 18)

__device__ __forceinline__ unsigned xb_ld(unsigned* p)              { return __hip_atomic_load(p, __ATOMIC_RELAXED, __HIP_MEMORY_SCOPE_AGENT); }
__device__ __forceinline__ unsigned xb_add(unsigned* p, unsigned v) { return __hip_atomic_fetch_add(p, v, __ATOMIC_RELAXED, __HIP_MEMORY_SCOPE_AGENT); }
__device__ __forceinline__ unsigned xb_xcc_id() { return (unsigned)__builtin_amdgcn_s_getreg((3 << 11) | 20) & 0xFu; }
#define XB_SPIN(cond, bar) do { unsigned _sp = 0; while (cond) { __builtin_amdgcn_s_sleep(1); \
    if ((++_sp & 255u) == 0u) { if (xb_ld(&(bar)[XB_TMO])) break; if (_sp > XB_SPIN_CAP) { atomicAdd(&(bar)[XB_TMO], 1u); break; } } } } while (0)

struct XcdBarrier {
    unsigned* bar; unsigned x;
    volatile LAS unsigned* st;
};

__device__ __forceinline__ XcdBarrier xcd_barrier_post(unsigned* bar, volatile LAS unsigned* st) {
    XcdBarrier b; b.bar = bar; b.x = xb_xcc_id(); b.st = st;
    if (threadIdx.x == 0) (void)xb_add(&bar[XB_XCNT(b.x)], 1u);
    return b;
}
__device__ __forceinline__ void xcd_barrier_complete(unsigned* bar, unsigned x, unsigned& nloc, unsigned& nx) {
    const unsigned G = gridDim.x * gridDim.y * gridDim.z;
    unsigned sum, cnt, mine, sp = 0u;
    for (;;) {
        sum = 0u; cnt = 0u; mine = 0u;
#pragma unroll
        for (unsigned j = 0; j < 16; ++j) { const unsigned c = xb_ld(&bar[XB_XCNT(j)]); sum += c; cnt += (c > 0u) ? 1u : 0u; mine = (j == x) ? c : mine; }
        if (sum == G) break;
        __builtin_amdgcn_s_sleep(1);
        if ((++sp & 255u) == 0u) { if (xb_ld(&bar[XB_TMO])) break; if (sp > XB_SPIN_CAP) { atomicAdd(&bar[XB_TMO], 1u); break; } }
    }
    nloc = mine > 0u ? mine : 1u; nx = cnt > 0u ? cnt : 1u;
}

__device__ __forceinline__ void xcd_barrier(const XcdBarrier& b) {
    asm volatile("s_waitcnt vmcnt(0)" ::: "memory");
    __syncthreads();
    if (threadIdx.x == 0) {
        unsigned* bar = b.bar;
        __builtin_amdgcn_s_waitcnt(0);
        unsigned nloc = b.st[0], nx = b.st[1];
        if (nloc == 0u) { xcd_barrier_complete(bar, b.x, nloc, nx); b.st[0] = nloc; b.st[1] = nx; }
        const unsigned old = xb_add(&bar[XB_XSUB(b.x)], 1u);
        const unsigned gen = old / nloc;
        if (old + 1u == (gen + 1u) * nloc) {
            __builtin_amdgcn_fence(__ATOMIC_RELEASE, "agent");
            asm volatile("s_waitcnt vmcnt(0)" ::: "memory");
            const unsigned og = xb_add(&bar[XB_TOP], 1u);
            const unsigned tg = og / nx;
            if (og + 1u == (tg + 1u) * nx) xb_add(&bar[XB_TOPGEN], 1u);
            else XB_SPIN(xb_ld(&bar[XB_TOPGEN]) == tg, bar);
            __builtin_amdgcn_fence(__ATOMIC_ACQUIRE, "agent");
            xb_add(&bar[XB_XGEN(b.x)], 1u);
            asm volatile("s_waitcnt vmcnt(0)" ::: "memory");
        } else {
            XB_SPIN(xb_ld(&bar[XB_XGEN(b.x)]) == gen, bar);
            __builtin_amdgcn_fence(__ATOMIC_ACQUIRE, "agent");
            asm volatile("s_waitcnt vmcnt(0)" ::: "memory");
        }
    }
    __syncthreads();
}


__device__ __forceinline__ void transpose_item(const float* W, int pitch, int K, bf16* WT, int row_off, LAS float* scr, int kb, int nb, int lane, const float* ksc = nullptr) {
    const int k0 = 64 * kb, n0 = 32 * nb;
#pragma unroll 8
    for (int i = 0; i < 32; ++i) { const int kk = 2 * i + (lane >> 5); const float w_ = W[(size_t)(k0 + kk) * pitch + n0 + (lane & 31)]; scr[kk * 33 + (lane & 31)] = ksc ? w_ * ksc[k0 + kk] : w_; }
    LDS_WAIT(); asm volatile("" ::: "memory");
    const int c = lane & 7;
#pragma unroll
    for (int j = 0; j < 4; ++j) { const int n = (lane >> 3) + 8 * j; const LAS float* s = scr + (8 * c) * 33 + n;
        v4u o; o.x = pk2(s[0 * 33], s[1 * 33]); o.y = pk2(s[2 * 33], s[3 * 33]); o.z = pk2(s[4 * 33], s[5 * 33]); o.w = pk2(s[6 * 33], s[7 * 33]);
        *(GAS v4u*)(WT + (size_t)(row_off + n0 + n) * K + k0 + 8 * c) = o; }
    LDS_WAIT(); asm volatile("" ::: "memory");
}
template <bool HALF_COPY> __device__ __forceinline__ void rms_row_to_bf16(const float* xrow, const float* gain, bf16* orow, LAS unsigned char* hrow, int lane) {
    const GAS f32x4* xr = (const GAS f32x4*)xrow + lane; const GAS f32x4* gr = (const GAS f32x4*)gain + lane;
    f32x4 v[4]; float s = 0.f;
#pragma unroll
    for (int j = 0; j < 4; ++j) { v[j] = xr[64 * j]; s += (v[j].x * v[j].x + v[j].y * v[j].y) + (v[j].z * v[j].z + v[j].w * v[j].w); }
    const float rstd = 1.f / sqrtf(wave_sum(s) * (1.f / DMODEL) + RMS_EPS);
    GAS unsigned long long* o8 = (GAS unsigned long long*)orow + lane;
#pragma unroll
    for (int j = 0; j < 4; ++j) { const f32x4 g = gr[64 * j];
        o8[64 * j] = (unsigned long long)pk2(v[j].x * rstd * g.x, v[j].y * rstd * g.y) | ((unsigned long long)pk2(v[j].z * rstd * g.z, v[j].w * rstd * g.w) << 32);
        if (HALF_COPY) ((LAS unsigned*)hrow + lane)[64 * j] = pk8(v[j].x * rstd * g.x, v[j].y * rstd * g.y, v[j].z * rstd * g.z, v[j].w * rstd * g.w); }
}

template <int S> __device__ __forceinline__ int shfl_xor_c(int v) {
    if constexpr (S == 1) return __builtin_amdgcn_mov_dpp(v, 0xB1, 0xF, 0xF, true);
    else if constexpr (S == 2) return __builtin_amdgcn_mov_dpp(v, 0x4E, 0xF, 0xF, true);
    else if constexpr (S == 4) return __builtin_amdgcn_mov_dpp(__builtin_amdgcn_mov_dpp(v, 0x1B, 0xF, 0xF, true), 0x141, 0xF, 0xF, true);
    else if constexpr (S == 8) return __builtin_amdgcn_mov_dpp(__builtin_amdgcn_mov_dpp(v, 0x141, 0xF, 0xF, true), 0x140, 0xF, 0xF, true);
    else return __shfl_xor(v, S);
}
template <int SIZE, int STRIDE> __device__ __forceinline__ void sort128_level(int& k0, int& k1, int lane) {
    if constexpr (STRIDE == 64) { const int mn = min(k0, k1), mxv = max(k0, k1); k0 = mn; k1 = mxv; }
    else {
        const bool lower = (lane & STRIDE) == 0;
        { const int o = shfl_xor_c<STRIDE>(k0); const bool up = ((lane & SIZE) == 0); k0 = (lower == up) ? min(k0, o) : max(k0, o); }
        { const int o = shfl_xor_c<STRIDE>(k1); const bool up = (((64 + lane) & SIZE) == 0); k1 = (lower == up) ? min(k1, o) : max(k1, o); }
    }
}
template <int SIZE, int STRIDE> __device__ __forceinline__ void sort128_merge(int& k0, int& k1, int lane) {
    sort128_level<SIZE, STRIDE>(k0, k1, lane);
    if constexpr (STRIDE > 1) sort128_merge<SIZE, STRIDE / 2>(k0, k1, lane);
}
template <int SIZE> __device__ __forceinline__ void sort128_from(int& k0, int& k1, int lane) {
    sort128_merge<SIZE, SIZE / 2>(k0, k1, lane);
    if constexpr (SIZE < 128) sort128_from<SIZE * 2>(k0, k1, lane);
}

__device__ __forceinline__ void ce_desc(float& a, float& b) { const float mx = fmax_s(a, b), mn = fmin_s(a, b); a = mx; b = mn; }
__device__ __forceinline__ void sort16_desc(float (&v)[16]) {
#pragma unroll
    for (int k = 2; k <= 16; k <<= 1) {
#pragma unroll
        for (int j = k >> 1; j > 0; j >>= 1) {
#pragma unroll
            for (int i = 0; i < 16; ++i) { const int l = i ^ j; if (l > i) { if ((i & k) == 0) ce_desc(v[i], v[l]); else ce_desc(v[l], v[i]); } }
        }
    }
}
__device__ __forceinline__ void merge16_desc(float (&a)[16], const float (&b)[16]) {
#pragma unroll
    for (int i = 0; i < 16; ++i) a[i] = fmax_s(a[i], b[15 - i]);
#pragma unroll
    for (int j = 8; j > 0; j >>= 1) {
#pragma unroll
        for (int i = 0; i < 16; ++i) { const int l = i ^ j; if (l > i) ce_desc(a[i], a[l]); }
    }
}
__device__ __forceinline__ float gelu_erf(float v) {
    const float av = fabsf(v), t = __builtin_amdgcn_rcpf(av * 0.2316418882f + 1.0f);
    float q = t * 0.5307027145f + (-0.7265760135f); q = q * t + 0.7107068705f; q = q * t + (-0.142248368f); q = q * t + 0.127414796f; q = q * t;
    const float e = __builtin_amdgcn_exp2f((v * v) * (-0.72134752044f));
    const float m = v * (q * e);
    return v < 0.f ? m : v - m;
}

struct Args { const void* in[20]; float* out; unsigned char* ws; int ph_lo, ph_hi, li, pad; };
__global__ void __launch_bounds__(NWAVES * 64, 2) hymba_fwd(Args args) {
    extern __shared__ __attribute__((aligned(16))) unsigned char lds[];
    LAS unsigned char* const ldsl = (LAS unsigned char*)lds;
    volatile LAS unsigned* const MISC = (volatile LAS unsigned*)(ldsl + MISC_OFF);
    const int tid = threadIdx.x, lane = tid & 63, wave = __builtin_amdgcn_readfirstlane(tid >> 6);
    const int G = gridDim.x; const int bx = blockIdx.x; const int vcu = (G % 8 == 0) ? (bx % 8) * (G / 8) + bx / 8 : bx;
    const int gw = vcu * NWAVES + wave, NGW = G * NWAVES;
    const int gt = vcu * (NWAVES * 64) + tid, NGT = G * NWAVES * 64;
    const int r32 = lane & 31, hi = lane >> 5;
#define PHASE_LOCALS int tid_o_ = threadIdx.x; asm volatile("" : "+v"(tid_o_)); const int tid = tid_o_, lane = tid & 63, r32 = lane & 31, hi = lane >> 5; const int gt = vcu * (NWAVES * 64) + tid; (void)r32; (void)hi; (void)gt; (void)lane;
    unsigned char* const ws = args.ws;
    gu32* const ctl = (gu32*)(ws + WS_CTL);
    const float* x = (const float*)args.in[0]; const int* positions = (const int*)args.in[1]; const float* g_mix = (const float*)args.in[2]; const float* w_in = (const float*)args.in[3];
    const float* w_gate = (const float*)args.in[4]; const float* b_gate = (const float*)args.in[5]; const float* g_gla_out = (const float*)args.in[6]; const float* g_q = (const float*)args.in[7];
    const float* g_k = (const float*)args.in[8]; const float* lq1 = (const float*)args.in[9]; const float* lk1 = (const float*)args.in[10]; const float* lq2 = (const float*)args.in[11];
    const float* lk2 = (const float*)args.in[12]; const float* g_sub = (const float*)args.in[13]; const float* w_out = (const float*)args.in[14]; const float* g_ffn = (const float*)args.in[15];
    const float* w_pq = (const float*)args.in[16]; const float* sub_keys = (const float*)args.in[17]; const float* peer_u = (const float*)args.in[18]; const float* peer_v = (const float*)args.in[19];
    float* const out = args.out;
    bf16* const Win_t = (bf16*)(ws + WS_WIN); bf16* const Wout_t = (bf16*)(ws + WS_WOUT); bf16* const Wq_t = (bf16*)(ws + WS_WQ); bf16* const KEYS = (bf16*)(ws + WS_KEYS);
    bf16* const KVT = (bf16*)(ws + WS_KVT); bf16* const VT = (bf16*)(ws + WS_VT); bf16* const UB = (bf16*)(ws + WS_U); bf16* const VB = (bf16*)(ws + WS_V);
    bf16* const XN = (bf16*)(ws + WS_XN); bf16* const MIX = (bf16*)(ws + WS_MIX); bf16* const PROJ = (bf16*)(ws + WS_PROJ); bf16* const XN2 = (bf16*)(ws + WS_XN2);
    bf16* const QP = (bf16*)(ws + WS_QP); bf16* const OAT = (bf16*)(ws + WS_O); int* const IDX = (int*)(ws + WS_IDX);
    unsigned* const SGE = (unsigned*)(ws + WS_SGE); unsigned* const AE = (unsigned*)(ws + WS_AE); unsigned char* const OFFS = ws + WS_OFFS; bf16* const XT = (bf16*)(ws + WS_XT); unsigned* const AE2 = (unsigned*)(ws + WS_AE2); unsigned char* const CNT = ws + WS_CNT;
    bf16* const UH = UB; bf16* const VH = VB;
    float* const SSP = (float*)(ws + WS_SSP); float* const RSTD = (float*)(ws + WS_RSTD);
    bf16* const KTT = (bf16*)(ws + WS_KTT); float* const DEC = (float*)(ws + WS_DEC); float* const ROPE_C = (float*)(ws + WS_ROPE); float* const ROPE_S = ROPE_C + TOK * 8;

    for (int u = tid; u < (LDS_BYTES - LDSCTL_OFF) / 4; u += NWAVES * 64) ((LAS unsigned*)(ldsl + LDSCTL_OFF))[u] = 0u;
    __syncthreads();
    XcdBarrier bar; bar.bar = (unsigned*)(ctl + CW_BAR); bar.x = 0; bar.st = nullptr;
    if (N_LAUNCHES == 1) bar = xcd_barrier_post((unsigned*)(ctl + CW_BAR), MISC + 8);
#define GRID_BAR() do { if (N_LAUNCHES == 1) { xcd_barrier(bar); } } while (0)
    const int lo = args.ph_lo, hi_ph = args.ph_hi;
#ifndef PHASE_MASK
#define PHASE_MASK 0x1fff
#endif
#define IN(k) (((PHASE_MASK >> (k)) & 1) && lo <= (k) && (k) < hi_ph)
#define BOTH(k) (IN(k) && IN((k) + 1))

    if (IN(0)) {
        PHASE_LOCALS
        LAS float* scr = (LAS float*)(ldsl + RING_OFF + wave * 16384);
        for (int it = gw; it < 3072; it += NGW) {
            int r = it;
            if (r < 512) { transpose_item(w_in, IN_W, DMODEL, Win_t, 0, scr, r >> 5, r & 31, lane); continue; } r -= 512;
            if (r < 1024) { transpose_item(w_in + 1040, IN_W, DMODEL, Win_t, 1280, scr, r >> 6, r & 63, lane); continue; } r -= 1024;
            if (r < 512) { transpose_item(w_out, DMODEL, DMODEL, Wout_t, 0, scr, r >> 5, r & 31, lane); continue; } r -= 512;
            transpose_item(w_pq, NQP, DMODEL, Wq_t, 0, scr, r >> 6, r & 63, lane, g_ffn);
        }
        for (int task = gt; task < 32768; task += NGT) {
            const int n = task >> 7, k0 = (task & 127) * 8;
            float wg[16];
#pragma unroll
            for (int r = 0; r < 16; ++r) wg[r] = w_gate[r * 256 + n];
            float acc[8];
#pragma unroll
            for (int j = 0; j < 8; ++j) { const f32x4* wr = (const f32x4*)(w_in + (size_t)(k0 + j) * IN_W + 1024); float a = 0.f;
#pragma unroll
                for (int q = 0; q < 4; ++q) { const f32x4 w4 = wr[q]; a += w4.x * wg[4 * q] + w4.y * wg[4 * q + 1] + w4.z * wg[4 * q + 2] + w4.w * wg[4 * q + 3]; }
                acc[j] = a; }
            v4u o; o.x = pk2(acc[0], acc[1]); o.y = pk2(acc[2], acc[3]); o.z = pk2(acc[4], acc[5]); o.w = pk2(acc[6], acc[7]);
            *(v4u*)(Win_t + (size_t)(1024 + n) * DMODEL + k0) = o;
        }
        for (int task = gt; task < 32768; task += NGT) {
            const f32x4 a = ((const f32x4*)sub_keys)[2 * task], b = ((const f32x4*)sub_keys)[2 * task + 1];
            v4u o; o.x = pk2(a.x, a.y); o.y = pk2(a.z, a.w); o.z = pk2(b.x, b.y); o.w = pk2(b.z, b.w); ((v4u*)KEYS)[task] = o;
        }
        for (int task = gt; task < TOK * 8; task += NGT) {
            const int t = task >> 3, i = task & 7;
            const double invf[8] = {1.0, 0.19392274474868576, 0.03760603093086393, 0.007292664737217109, 0.001414213562373095, 0.0002742481756762073, 5.318295896944988e-05, 1.031338537721246e-05};
            double inv = invf[0];
#pragma unroll
            for (int q = 1; q < 8; ++q) inv = (i == q) ? invf[q] : inv;
            const double ang = (double)positions[t] * inv;
            const double rr = ang - 6.283185307179586 * rint(ang * 0.15915494309189535);
            const float rf = (float)rr;
            ROPE_C[task] = cosf(rf); ROPE_S[task] = sinf(rf);
        }
        {
            f32x4 gg[4], vn[4];
#pragma unroll
            for (int j = 0; j < 4; ++j) { gg[j] = ((const f32x4*)g_mix)[lane + 64 * j]; vn[j] = ((const f32x4*)(x + (size_t)gw * DMODEL))[lane + 64 * j]; }
            for (int m = gw; m < TOK; m += NGW) {
                f32x4 v[4]; float sq = 0.f;
#pragma unroll
                for (int j = 0; j < 4; ++j) { v[j] = vn[j]; sq += (v[j].x * v[j].x + v[j].y * v[j].y) + (v[j].z * v[j].z + v[j].w * v[j].w); }
                const int mn = (m + NGW < TOK) ? m + NGW : m;
#pragma unroll
                for (int j = 0; j < 4; ++j) vn[j] = ((const f32x4*)(x + (size_t)mn * DMODEL))[lane + 64 * j];
                const float rstd = 1.f / sqrtf(wave_sum(sq) * (1.f / DMODEL) + RMS_EPS);
                unsigned long long* o8 = (unsigned long long*)(XN + (size_t)m * DMODEL) + lane;
#pragma unroll
                for (int j = 0; j < 4; ++j) o8[64 * j] = (unsigned long long)pk2(v[j].x * rstd * gg[j].x, v[j].y * rstd * gg[j].y) | ((unsigned long long)pk2(v[j].z * rstd * gg[j].z, v[j].w * rstd * gg[j].w) << 32);
            }
        }
        if (BOTH(0)) GRID_BAR();
    }

    if (IN(1)) {
        PHASE_LOCALS
        pg8::Gemm g{XN, Win_t, TOK, NPROJ, DMODEL}; pg8::StaticOrder S; S.init(TOK, NPROJ, G, (int)blockIdx.x);
        pg8::EpiBf16<0> E{PROJ, NPROJ, nullptr, 0, 0, 1.f};
        pg8::gemm_phase<pg8::EpiBf16<0>, pg8::StaticOrder, PG8_ALIGN, PG8_SP2>(ldsl + RING_OFF, g, S, E);
        if (BOTH(1)) GRID_BAR();
    }

    if (IN(2)) {
        PHASE_LOCALS
        for (int u = gw; u < NUNIT; u += NGW) {
            const int g = u >> 2, h = u & 3; const int su = ((g >> 7) * 4 + h) * 128 + (g & 127);
            bf16* const rowp = PROJ + (size_t)(g * 64) * NPROJ;
            const float bg = b_gate[h * 64 + lane];
            float bsum = 0.f;
            unsigned ktt[32], vt0[32], vt1[32];
#pragma unroll
            for (int c0 = 0; c0 < 64; c0 += 16) {
                unsigned zz[16], qq[16], kk[16], va[16], vb[16];
#pragma unroll
                for (int j = 0; j < 16; ++j) { const bf16* const r = rowp + (size_t)(c0 + j) * NPROJ;
                    zz[j] = r[C_GZ + h * 64 + lane]; qq[j] = r[C_GQ + h * 64 + lane]; kk[j] = r[C_GK + h * 64 + lane]; va[j] = r[C_GV + h * 128 + lane]; vb[j] = r[C_GV + h * 128 + 64 + lane]; }
#pragma unroll
                for (int j = 0; j < 16; ++j) { const int c = c0 + j;
                    bf16* const r = rowp + (size_t)c * NPROJ;
                    const float z = bf2f(zz[j]) + bg;
                    const float ls = fminf(z, 0.f) - __logf(1.f + __expf(-fabsf(z)));
                    bsum += ls * (1.f / 16.f);
                    const float eb = __expf(bsum), ebi = __expf(-bsum);
                    const float q = bf2f(qq[j]) * 0.125f * eb;
                    const float kt = bf2f(kk[j]) * ebi;
                    const unsigned ktb = f2bf(kt);
                    r[C_GQ + h * 64 + lane] = (bf16)f2bf(q); r[C_GK + h * 64 + lane] = (bf16)ktb;
                    const unsigned v0 = va[j], v1 = vb[j];
                    if (c & 1) { ktt[c >> 1] |= ktb << 16; vt0[c >> 1] |= v0 << 16; vt1[c >> 1] |= v1 << 16; }
                    else { ktt[c >> 1] = ktb; vt0[c >> 1] = v0; vt1[c >> 1] = v1; }
                }
            }
            DEC[su * 64 + lane] = __expf(bsum);
            v4u* kp = (v4u*)(KTT + ((size_t)u * 64 + lane) * 64); v4u* vp0 = (v4u*)(VT + ((size_t)u * 128 + lane) * 64); v4u* vp1 = (v4u*)(VT + ((size_t)u * 128 + 64 + lane) * 64);
#pragma unroll
            for (int q = 0; q < 8; ++q) { kp[q] = (v4u){ktt[4 * q], ktt[4 * q + 1], ktt[4 * q + 2], ktt[4 * q + 3]};
                vp0[q] = (v4u){vt0[4 * q], vt0[4 * q + 1], vt0[4 * q + 2], vt0[4 * q + 3]}; vp1[q] = (v4u){vt1[4 * q], vt1[4 * q + 1], vt1[4 * q + 2], vt1[4 * q + 3]}; }
        }
        {
            const int v = lane >> 2, qd = lane & 3;
            const int col = (v < 8 ? C_DQ + v * 64 : C_DK + (v - 8) * 64) + qd * 16;
            const float* gp = (v < 8 ? g_q : g_k) + qd * 16;
            float gn[16];
#pragma unroll
            for (int i = 0; i < 16; ++i) gn[i] = gp[i];
            const float osc = (v < 8) ? attn_body::C2 : 1.f;
            v4u w0 = ((const v4u*)(PROJ + (size_t)gw * NPROJ + col))[0], w1 = ((const v4u*)(PROJ + (size_t)gw * NPROJ + col))[1];
            f32x4 rc0 = *(const f32x4*)(ROPE_C + gw * 8), rc1 = *(const f32x4*)(ROPE_C + gw * 8 + 4), rs0 = *(const f32x4*)(ROPE_S + gw * 8), rs1 = *(const f32x4*)(ROPE_S + gw * 8 + 4);
            for (int t = gw; t < TOK; t += NGW) {
                v4u* p = (v4u*)(PROJ + (size_t)t * NPROJ + col);
                const int tn = (t + NGW < TOK) ? t + NGW : t;
                const v4u* pn = (const v4u*)(PROJ + (size_t)tn * NPROJ + col);
                const v4u n0 = pn[0], n1 = pn[1];
                const f32x4 c0 = rc0, c1 = rc1, s0 = rs0, s1 = rs1;
                rc0 = *(const f32x4*)(ROPE_C + tn * 8); rc1 = *(const f32x4*)(ROPE_C + tn * 8 + 4); rs0 = *(const f32x4*)(ROPE_S + tn * 8); rs1 = *(const f32x4*)(ROPE_S + tn * 8 + 4);
                float y[16];
                y[0] = bflo(w0.x); y[1] = bfhi(w0.x); y[2] = bflo(w0.y); y[3] = bfhi(w0.y); y[4] = bflo(w0.z); y[5] = bfhi(w0.z); y[6] = bflo(w0.w); y[7] = bfhi(w0.w);
                y[8] = bflo(w1.x); y[9] = bfhi(w1.x); y[10] = bflo(w1.y); y[11] = bfhi(w1.y); y[12] = bflo(w1.z); y[13] = bfhi(w1.z); y[14] = bflo(w1.w); y[15] = bfhi(w1.w);
                float ss = 0.f;
#pragma unroll
                for (int i = 0; i < 16; ++i) ss += y[i] * y[i];
                ss += __shfl_xor(ss, 1); ss += __shfl_xor(ss, 2);
                const float rstd = 1.f / sqrtf(ss * (1.f / 64.f) + RMS_EPS);
#pragma unroll
                for (int i = 0; i < 16; ++i) y[i] = y[i] * rstd * gn[i];
                if (qd == 0) {
                    const float cs[8] = {c0.x, c0.y, c0.z, c0.w, c1.x, c1.y, c1.z, c1.w}, sn[8] = {s0.x, s0.y, s0.z, s0.w, s1.x, s1.y, s1.z, s1.w};
#pragma unroll
                    for (int i = 0; i < 8; ++i) { const float a = y[i], b = y[i + 8]; y[i] = a * cs[i] - b * sn[i]; y[i + 8] = b * cs[i] + a * sn[i]; }
                }
#pragma unroll
                for (int i = 0; i < 16; ++i) y[i] *= osc;
                p[0] = (v4u){pk2(y[0], y[1]), pk2(y[2], y[3]), pk2(y[4], y[5]), pk2(y[6], y[7])};
                p[1] = (v4u){pk2(y[8], y[9]), pk2(y[10], y[11]), pk2(y[12], y[13]), pk2(y[14], y[15])};
                w0 = n0; w1 = n1;
            }
        }
        if (BOTH(2)) GRID_BAR();
    }

    if (IN(3)) {
        PHASE_LOCALS
        for (int L = vcu; L < 1024; L += G) {
            const int vv = L & 255, i = L >> 8, s = vv & 7, bh = vv >> 3;
            const int qb = (i == 0) ? s : (i == 1) ? 15 - s : (i == 2) ? 16 + s : 31 - s;
            const int b = bh >> 3, hh = (bh & 7) >> 1, mp = bh & 1;
            attn_body2::attn_unit<8>(b, C_DQ + (hh * 2 + mp) * 64, C_DK + (hh * 2 + mp) * 64, C_DV + hh * 128, (hh * 2 + mp) * 128, qb,
                                     (const attn_body2::bf16*)PROJ, (const attn_body2::bf16*)PROJ, (const attn_body2::bf16*)PROJ, (attn_body2::bf16*)OAT, (char*)lds + RING_OFF);
        }
        for (int u = gw; u < NUNIT; u += NGW) {
            const int g = u >> 2, h = u & 3; const int su = ((g >> 7) * 4 + h) * 128 + (g & 127);
            const bf16* vt = VT + (size_t)u * 8192; const bf16* kt = KTT + (size_t)u * 4096;
            f32x16 acc[4][2];
#pragma unroll
            for (int a = 0; a < 4; ++a) { acc[a][0] = f32x16{}; acc[a][1] = f32x16{}; }
#pragma unroll
            for (int k2 = 0; k2 < 4; k2 += 2) {
                bf16x8 af[2][4], bfr[2][2];
#pragma unroll
                for (int kq = 0; kq < 2; ++kq) { const int ks = k2 + kq;
#pragma unroll
                    for (int et = 0; et < 4; ++et) af[kq][et] = *(const bf16x8*)(vt + (et * 32 + r32) * 64 + ks * 16 + hi * 8);
#pragma unroll
                    for (int dt = 0; dt < 2; ++dt) bfr[kq][dt] = *(const bf16x8*)(kt + (dt * 32 + r32) * 64 + ks * 16 + hi * 8); }
                __builtin_amdgcn_sched_barrier(0);
#pragma unroll
                for (int kq = 0; kq < 2; ++kq)
#pragma unroll
                    for (int et = 0; et < 4; ++et)
#pragma unroll
                        for (int dt = 0; dt < 2; ++dt) acc[et][dt] = __builtin_amdgcn_mfma_f32_32x32x16_bf16(af[kq][et], bfr[kq][dt], acc[et][dt], 0, 0, 0);
            }
            bf16* const kv = KVT + (size_t)su * 8192;
            const float dcv[2] = {DEC[su * 64 + r32], DEC[su * 64 + 32 + r32]};
#pragma unroll
            for (int dt = 0; dt < 2; ++dt) { const float dc = dcv[dt];
#pragma unroll
                for (int et = 0; et < 4; ++et)
#pragma unroll
                    for (int r = 0; r < 16; ++r) kv[(et * 32 + crow(r, hi)) * 64 + dt * 32 + r32] = (bf16)f2bf(acc[et][dt][r] * dc); }
        }
        if (BOTH(3)) GRID_BAR();
    }

    if (IN(4)) {
        PHASE_LOCALS
        for (int el = gt; el < 16 * 8192; el += NGT) {
            const int bh = el >> 13, ed = el & 8191, d = ed & 63;
            bf16* p = KVT + (size_t)bh * 128 * 8192 + ed; const float* dp = DEC + bh * 128 * 64 + d;
            float s = 0.f;
            unsigned kva[16], kvb[16]; float dca[16], dcb[16];
#define SCAN_LOAD(KV_, DC_, n0_) do { _Pragma("unroll") for (int j = 0; j < 16; ++j) { KV_[j] = p[(size_t)((n0_) + j) * 8192]; DC_[j] = dp[((n0_) + j) * 64]; } } while (0)
#define SCAN_RUN(KV_, DC_, n0_) do { _Pragma("unroll") for (int j = 0; j < 16; ++j) { const float o = s; s = DC_[j] * s + bf2f(KV_[j]); p[(size_t)((n0_) + j) * 8192] = (bf16)f2bf(o); } } while (0)
            SCAN_LOAD(kva, dca, 0);
#pragma unroll 1
            for (int n0 = 0; n0 < 128; n0 += 32) {
                SCAN_LOAD(kvb, dcb, n0 + 16);
                SCAN_RUN(kva, dca, n0);
                if (n0 + 32 < 128) SCAN_LOAD(kva, dca, n0 + 32);
                SCAN_RUN(kvb, dcb, n0 + 16);
            }
#undef SCAN_LOAD
#undef SCAN_RUN
        }
        if (BOTH(4)) GRID_BAR();
    }

    if (IN(5)) {
        PHASE_LOCALS
        for (int u = gw; u < NUNIT; u += NGW) {
            const int g = u >> 2, h = u & 3; const int su = ((g >> 7) * 4 + h) * 128 + (g & 127);
            const bf16* vt = VT + (size_t)u * 8192; const bf16* st = KVT + (size_t)su * 8192;
            const bf16* qtp = PROJ + (size_t)(g * 64) * NPROJ + C_GQ + h * 64; const bf16* ktp = PROJ + (size_t)(g * 64) * NPROJ + C_GK + h * 64;
#pragma unroll
            for (int ct = 0; ct < 2; ++ct) {
                bf16x8 qf[4];
#pragma unroll
                for (int ks = 0; ks < 4; ++ks) qf[ks] = *(const bf16x8*)(qtp + (size_t)(ct * 32 + r32) * NPROJ + ks * 16 + hi * 8);
                f32x16 o[4];
#pragma unroll
                for (int et = 0; et < 4; ++et) o[et] = f32x16{};
                bf16x8 sf[4][4], kfa[2][4];
#pragma unroll
                for (int ks = 0; ks < 4; ++ks)
#pragma unroll
                    for (int et = 0; et < 4; ++et) sf[ks][et] = *(const bf16x8*)(st + (et * 32 + r32) * 64 + ks * 16 + hi * 8);
#pragma unroll
                for (int stl = 0; stl <= ct; ++stl)
#pragma unroll
                    for (int ks = 0; ks < 4; ++ks) kfa[stl][ks] = *(const bf16x8*)(ktp + (size_t)(stl * 32 + r32) * NPROJ + ks * 16 + hi * 8);
                __builtin_amdgcn_sched_barrier(0);
#pragma unroll
                for (int ks = 0; ks < 4; ++ks)
#pragma unroll
                    for (int et = 0; et < 4; ++et) o[et] = __builtin_amdgcn_mfma_f32_32x32x16_bf16(sf[ks][et], qf[ks], o[et], 0, 0, 0);
#pragma unroll
                for (int stl = 0; stl <= ct; ++stl) {
                    v4u vfa[2][4];
#pragma unroll
                    for (int kk = 0; kk < 2; ++kk)
#pragma unroll
                        for (int et = 0; et < 4; ++et) { const bf16* ap = vt + (et * 32 + r32) * 64 + stl * 32 + 16 * kk + 4 * hi;
                            const v2u a0 = *(const v2u*)ap, a1 = *(const v2u*)(ap + 8); vfa[kk][et] = (v4u){a0.x, a0.y, a1.x, a1.y}; }
                    __builtin_amdgcn_sched_barrier(0);
                    f32x16 xx = f32x16{};
#pragma unroll
                    for (int ks = 0; ks < 4; ++ks) xx = __builtin_amdgcn_mfma_f32_32x32x16_bf16(kfa[stl][ks], qf[ks], xx, 0, 0, 0);
                    if (stl == ct) {
#pragma unroll
                        for (int r = 0; r < 16; ++r) if (crow(r, hi) > r32) xx[r] = 0.f;
                    }
#pragma unroll
                    for (int kk = 0; kk < 2; ++kk) {
                        v4u w; w.x = pk2(xx[8 * kk], xx[8 * kk + 1]); w.y = pk2(xx[8 * kk + 2], xx[8 * kk + 3]); w.z = pk2(xx[8 * kk + 4], xx[8 * kk + 5]); w.w = pk2(xx[8 * kk + 6], xx[8 * kk + 7]);
                        const bf16x8 pb = __builtin_bit_cast(bf16x8, w);
#pragma unroll
                        for (int et = 0; et < 4; ++et) o[et] = __builtin_amdgcn_mfma_f32_32x32x16_bf16(__builtin_bit_cast(bf16x8, vfa[kk][et]), pb, o[et], 0, 0, 0);
                    }
                }
                float ss = 0.f;
#pragma unroll
                for (int et = 0; et < 4; ++et)
#pragma unroll
                    for (int r = 0; r < 16; ++r) ss += o[et][r] * o[et][r];
                ss += __shfl_xor(ss, 32);
                const float rstd = 1.f / sqrtf(ss * (1.f / 128.f) + RMS_EPS);
                const int t = g * 64 + ct * 32 + r32;
                v2u gwa[16]; f32x4 goa[16];
#pragma unroll
                for (int i = 0; i < 16; ++i) { const int e0 = (i >> 2) * 32 + 8 * (i & 3) + 4 * hi; gwa[i] = *(const v2u*)(PROJ + (size_t)t * NPROJ + C_GR + h * 128 + e0); goa[i] = *(const f32x4*)(g_gla_out + e0); }
#pragma unroll
                for (int et = 0; et < 4; ++et)
#pragma unroll
                    for (int q4 = 0; q4 < 4; ++q4) {
                        const int e0 = et * 32 + 8 * q4 + 4 * hi;
                        const v2u gw2 = gwa[et * 4 + q4];
                        const f32x4 go = goa[et * 4 + q4];
                        const float gr0 = bflo(gw2.x), gr1 = bfhi(gw2.x), gr2 = bflo(gw2.y), gr3 = bfhi(gw2.y);
                        const float y0 = o[et][4 * q4] * rstd * go.x * (gr0 / (1.f + __expf(-gr0)));
                        const float y1 = o[et][4 * q4 + 1] * rstd * go.y * (gr1 / (1.f + __expf(-gr1)));
                        const float y2 = o[et][4 * q4 + 2] * rstd * go.z * (gr2 / (1.f + __expf(-gr2)));
                        const float y3 = o[et][4 * q4 + 3] * rstd * go.w * (gr3 / (1.f + __expf(-gr3)));
                        *(v2u*)(MIX + (size_t)t * DMODEL + h * 128 + e0) = (v2u){pk2(y0, y1), pk2(y2, y3)};
                    }
            }
        }
        {
            const float s1 = wave_sum(lq1[lane] * lk1[lane]), s2 = wave_sum(lq2[lane] * lk2[lane]);
            const float lam = expf(s1) - expf(s2) + LAMBDA_INIT;
            const int hh = lane >> 4, e0 = (lane & 15) * 8;
            const f32x4 ga = *(const f32x4*)(g_sub + e0), gb = *(const f32x4*)(g_sub + e0 + 4);
            const float gs[8] = {ga.x, ga.y, ga.z, ga.w, gb.x, gb.y, gb.z, gb.w};
            v4u a = *(const v4u*)(OAT + (size_t)gw * 2048 + (hh * 2) * 128 + e0), b = *(const v4u*)(OAT + (size_t)gw * 2048 + (hh * 2 + 1) * 128 + e0);
            for (int t = gw; t < TOK; t += NGW) {
                const int tn = (t + NGW < TOK) ? t + NGW : t;
                const v4u an = *(const v4u*)(OAT + (size_t)tn * 2048 + (hh * 2) * 128 + e0), bn = *(const v4u*)(OAT + (size_t)tn * 2048 + (hh * 2 + 1) * 128 + e0);
                float y[8];
                y[0] = bflo(a.x) - lam * bflo(b.x); y[1] = bfhi(a.x) - lam * bfhi(b.x); y[2] = bflo(a.y) - lam * bflo(b.y); y[3] = bfhi(a.y) - lam * bfhi(b.y);
                y[4] = bflo(a.z) - lam * bflo(b.z); y[5] = bfhi(a.z) - lam * bfhi(b.z); y[6] = bflo(a.w) - lam * bflo(b.w); y[7] = bfhi(a.w) - lam * bfhi(b.w);
                float ss = 0.f;
#pragma unroll
                for (int i = 0; i < 8; ++i) ss += y[i] * y[i];
                ss += __shfl_xor(ss, 1); ss += __shfl_xor(ss, 2); ss += __shfl_xor(ss, 4); ss += __shfl_xor(ss, 8);
                const float rstd = (1.f - LAMBDA_INIT) / sqrtf(ss * (1.f / 128.f) + RMS_EPS);
#pragma unroll
                for (int i = 0; i < 8; ++i) y[i] = y[i] * rstd * gs[i];
                *(v4u*)(MIX + (size_t)t * DMODEL + 512 + hh * 128 + e0) = (v4u){pk2(y[0], y[1]), pk2(y[2], y[3]), pk2(y[4], y[5]), pk2(y[6], y[7])};
                a = an; b = bn;
            }
        }
        if (BOTH(5)) GRID_BAR();
    }

    if (IN(6)) {
        PHASE_LOCALS
        constexpr int NVT = PEER_N * DMODEL / 8, NUT = PEER_N * DMODEL / 16;
        for (int task0 = gt; task0 < NVT; task0 += 4 * NGT) {
            f32x4 a[4], b[4]; int oo[4];
#pragma unroll
            for (int j = 0; j < 4; ++j) { const int o = task0 + j * NGT; oo[j] = o; if (o < NVT) { const int sl_ = o >> 17, r_ = (o >> 3) & (PEER_N - 1), c_ = o & 7;
                const int e_ = ((((r_ >> 7) - (r_ & 127)) & 127) << 7) | (r_ & 127);
                const f32x4* src = (const f32x4*)peer_v + (size_t)e_ * 256 + (sl_ * 8 + c_) * 2; a[j] = src[0]; b[j] = src[1]; } }
#pragma unroll
            for (int j = 0; j < 4; ++j) if (oo[j] < NVT) ((v4u*)VB)[oo[j]] = (v4u){pkh(a[j].x, a[j].y), pkh(a[j].z, a[j].w), pkh(b[j].x, b[j].y), pkh(b[j].z, b[j].w)};
        }
        for (int task0 = gt; task0 < NUT; task0 += 2 * NGT) {
            f32x4 a[2], b[2], c[2], d[2], ga[2], gb[2], gc[2], gd[2]; int oo[2];
#pragma unroll
            for (int j = 0; j < 2; ++j) { const int o = task0 + j * NGT; oo[j] = o; if (o < NUT) { const int sl_ = o >> 16, r_ = (o >> 2) & (PEER_N - 1), c_ = o & 3;
                const int e_ = ((((r_ >> 7) - (r_ & 127)) & 127) << 7) | (r_ & 127);
                const f32x4* src = (const f32x4*)peer_u + (size_t)e_ * 256 + (sl_ * 4 + c_) * 4; const f32x4* gs_ = (const f32x4*)g_ffn + (sl_ * 4 + c_) * 4;
                a[j] = src[0]; b[j] = src[1]; c[j] = src[2]; d[j] = src[3]; ga[j] = gs_[0]; gb[j] = gs_[1]; gc[j] = gs_[2]; gd[j] = gs_[3]; } }
#pragma unroll
            for (int j = 0; j < 2; ++j) if (oo[j] < NUT) { const f32x4 a_ = a[j] * 32.f * ga[j], b_ = b[j] * 32.f * gb[j], c_ = c[j] * 32.f * gc[j], d_ = d[j] * 32.f * gd[j];
                ((v4u*)UB)[oo[j]] = (v4u){pk8(a_.x, a_.y, a_.z, a_.w), pk8(b_.x, b_.y, b_.z, b_.w), pk8(c_.x, c_.y, c_.z, c_.w), pk8(d_.x, d_.y, d_.z, d_.w)}; }
        }
        pg8::Gemm g{MIX, Wout_t, TOK, DMODEL, DMODEL}; pg8::StaticOrder S; S.init(TOK, DMODEL, G, (int)blockIdx.x);
        pg8::EpiResF32X E{x, DMODEL, XN2, (unsigned char*)XT, SSP, TOK};
        pg8::gemm_phase<pg8::EpiResF32X, pg8::StaticOrder, PG8_ALIGN, PG8_SP2>(ldsl + RING_OFF, g, S, E);
        if (BOTH(6)) GRID_BAR();
    }


    if (IN(8)) {
        PHASE_LOCALS
        pg8::Gemm g{XN2, Wq_t, TOK, NQP, DMODEL}; pg8::StaticOrder S; S.init(TOK, NQP, G, (int)blockIdx.x);
        pg8::EpiBf16Row E{QP, NQP, SSP, RSTD, RMS_EPS, 1.f / DMODEL};
        pg8::gemm_phase<pg8::EpiBf16Row, pg8::StaticOrder, PG8_ALIGN, PG8_SP2>(ldsl + RING_OFF, g, S, E);
        if (BOTH(8)) GRID_BAR();
    }

    if (IN(9)) {
        PHASE_LOCALS
        const int nper = G / 8;
        const int head = vcu % 8, part = vcu / 8;
        for (int c = tid; c < 4096; c += NWAVES * 64) {
            const int p = c >> 11, row = (c >> 4) & 127, ch = c & 15;
            const v4u v = *(const v4u*)(KEYS + ((size_t)(head * 2 + p) * 128 + row) * 128 + ch * 8);
            *(LAS v4u*)(ldsl + p * 32768 + row * 256 + ((ch ^ (row & 15)) * 16)) = v;
        }
        __syncthreads();
        LAS unsigned* const lscr = (LAS unsigned*)(ldsl + 65536 + wave * 8192);
        for (int tg = part * NWAVES + wave; tg < TOK / 32; tg += nper * NWAVES) {
            const int t0 = tg * 32;
            float top[2][16];
#pragma unroll
            for (int p = 0; p < 2; ++p) {
                bf16x8 qf[8];
#pragma unroll
                for (int ks = 0; ks < 8; ++ks) qf[ks] = *(const bf16x8*)(QP + (size_t)(t0 + r32) * NQP + head * 256 + p * 128 + ks * 16 + hi * 8);
                float sc[4][16];
#pragma unroll
                for (int tile = 0; tile < 4; ++tile) {
                    f32x16 acc = f32x16{};
#pragma unroll
                    for (int ks = 0; ks < 8; ++ks) {
                        const bf16x8 kf = *(const LAS bf16x8*)(ldsl + p * 32768 + (tile * 32 + r32) * 256 + (((2 * ks + hi) ^ (r32 & 15)) * 16));
                        acc = __builtin_amdgcn_mfma_f32_32x32x16_bf16(kf, qf[ks], acc, 0, 0, 0);
                    }
#pragma unroll
                    for (int r = 0; r < 16; ++r) { const unsigned kid = (unsigned)(tile * 32 + crow(r, hi));
                        const float av = acc[r];
                        sc[tile][r] = __uint_as_float((__float_as_uint(av) & 0xffffff80u) | (127u - kid)); }
                    sort16_desc(sc[tile]);
                }
                merge16_desc(sc[0], sc[1]); merge16_desc(sc[2], sc[3]); merge16_desc(sc[0], sc[2]);
                float ot[16];
#pragma unroll
                for (int i = 0; i < 16; ++i) ot[i] = __shfl_xor(sc[0][i], 32);
                merge16_desc(sc[0], ot);
#pragma unroll
                for (int i = 0; i < 16; ++i) top[p][i] = sc[0][i];
            }
#pragma unroll
            for (int i = 0; i < 16; ++i) { lscr[i * 64 + lane] = 127u - (__float_as_uint(top[0][i]) & 127u); lscr[(16 + i) * 64 + lane] = 127u - (__float_as_uint(top[1][i]) & 127u); }
            float v0[16], v1[16];
#pragma unroll
            for (int i = 0; i < 16; ++i) { v0[i] = __uint_as_float(__float_as_uint(top[0][i]) & 0xffffff80u); v1[i] = __uint_as_float(__float_as_uint(top[1][i]) & 0xffffff80u); }
#define CAND(i, j) __uint_as_float((__float_as_uint(v0[i] + v1[j]) & 0xffffff00u) | (255u - (unsigned)((i) * 16 + (j))))
            const float NEGB = -3.0e38f;
            float cA[16], cB[16], cC[16], cD[16];
#pragma unroll
            for (int j = 0; j < 16; ++j) cA[j] = CAND(0, j);
#pragma unroll
            for (int j = 0; j < 8; ++j) cB[j] = CAND(1, j);
#pragma unroll
            for (int j = 0; j < 5; ++j) cB[8 + j] = CAND(2, j);
            cB[13] = NEGB; cB[14] = NEGB; cB[15] = NEGB;
#pragma unroll
            for (int j = 0; j < 4; ++j) cC[j] = CAND(3, j);
#pragma unroll
            for (int j = 0; j < 3; ++j) cC[4 + j] = CAND(4, j);
            cC[7] = CAND(5, 0); cC[8] = CAND(5, 1); cC[9] = CAND(6, 0); cC[10] = CAND(6, 1); cC[11] = CAND(7, 0); cC[12] = CAND(7, 1);
            cC[13] = NEGB; cC[14] = NEGB; cC[15] = NEGB;
            cD[0] = CAND(8, 0); cD[1] = CAND(9, 0); cD[2] = CAND(10, 0); cD[3] = CAND(11, 0); cD[4] = CAND(12, 0); cD[5] = CAND(13, 0); cD[6] = CAND(14, 0); cD[7] = CAND(15, 0);
#pragma unroll
            for (int j = 8; j < 16; ++j) cD[j] = NEGB;
#undef CAND
            sort16_desc(cB); sort16_desc(cC); sort16_desc(cD);
            merge16_desc(cA, cB); merge16_desc(cC, cD); merge16_desc(cA, cC);
            LDS_WAIT();
            float gv[16]; int ex[16]; float gsum = 0.f;
            const float mx = __uint_as_float(__float_as_uint(cA[0]) & 0xffffff00u);
#pragma unroll
            for (int w = 0; w < 16; ++w) {
                const unsigned bits = __float_as_uint(cA[w]); const unsigned code = 255u - (bits & 255u);
                const float val = __uint_as_float(bits & 0xffffff00u);
                gv[w] = __expf(val - mx); gsum += gv[w];
                const unsigned e0 = lscr[(code >> 4) * 64 + lane], e1 = lscr[(16 + (code & 15)) * 64 + lane];
                ex[w] = (int)(e0 * 128u + e1);
            }
            const float ginv = 1.f / gsum;
            const size_t ob = (size_t)(t0 + r32) * 128 + head * 16;
#pragma unroll
            for (int q = 0; q < 4; ++q) if ((q >> 1) == hi)
                *(v4u*)(IDX + ob + 4 * q) = (v4u){(f2bf(gv[4 * q] * ginv) << 16) | (unsigned)ex[4 * q], (f2bf(gv[4 * q + 1] * ginv) << 16) | (unsigned)ex[4 * q + 1],
                                                  (f2bf(gv[4 * q + 2] * ginv) << 16) | (unsigned)ex[4 * q + 2], (f2bf(gv[4 * q + 3] * ginv) << 16) | (unsigned)ex[4 * q + 3]};
            LDS_WAIT();
        }
        if (BOTH(9)) GRID_BAR();
    }

    if (IN(10)) {
        PHASE_LOCALS
        LAS int* const hst = (LAS int*)(ldsl + wave * 256);
        int w0n = IDX[(size_t)gw * 128 + lane], w1n = IDX[(size_t)gw * 128 + 64 + lane];
        for (int t = gw; t < TOK; t += NGW) {
            const int w0 = w0n, w1 = w1n;
            { const int tn = (t + NGW < TOK) ? t + NGW : t; w0n = IDX[(size_t)tn * 128 + lane]; w1n = IDX[(size_t)tn * 128 + 64 + lane]; }
            const int x0 = w0 & 0xffff, x1 = w1 & 0xffff;
            const int r0 = ((((x0 >> 7) + (x0 & 127)) & 127) << 7) | (x0 & 127), r1 = ((((x1 >> 7) + (x1 & 127)) & 127) << 7) | (x1 & 127);
            const int b0 = r0 >> 9, b1 = r1 >> 9;
            if (lane < 32) hst[lane] = 0;
            const int rk0 = __hip_atomic_fetch_add(hst + b0, 1, __ATOMIC_RELAXED, __HIP_MEMORY_SCOPE_WORKGROUP);
            const int rk1 = __hip_atomic_fetch_add(hst + b1, 1, __ATOMIC_RELAXED, __HIP_MEMORY_SCOPE_WORKGROUP);
            const int myc = __hip_atomic_load(hst + (lane & 31), __ATOMIC_RELAXED, __HIP_MEMORY_SCOPE_WORKGROUP);
            int incl = myc;
#pragma unroll
            for (int o = 1; o < 32; o <<= 1) { const int v = __shfl_up(incl, o); if ((lane & 31) >= o) incl += v; }
            if (lane < 32) { OFFS[(size_t)t * 32 + lane] = (unsigned char)(incl - myc); __hip_atomic_store(hst + 32 + lane, incl - myc, __ATOMIC_RELAXED, __HIP_MEMORY_SCOPE_WORKGROUP); }
            const int o0 = __hip_atomic_load(hst + 32 + b0, __ATOMIC_RELAXED, __HIP_MEMORY_SCOPE_WORKGROUP), o1 = __hip_atomic_load(hst + 32 + b1, __ATOMIC_RELAXED, __HIP_MEMORY_SCOPE_WORKGROUP);
            SGE[(size_t)t * 128 + o0 + rk0] = ((unsigned)w0 & 0xffff0000u) | (unsigned)r0; SGE[(size_t)t * 128 + o1 + rk1] = ((unsigned)w1 & 0xffff0000u) | (unsigned)r1;
        }
        if (BOTH(10)) GRID_BAR();
    }

    if (IN(11)) {
        PHASE_LOCALS
        constexpr int NC = 112, NTL = 7;
        LAS unsigned* const GCOL = (LAS unsigned*)(ldsl + 132096);
        LAS unsigned* const GW = (LAS unsigned*)(ldsl + 132096 + 32 * NC * 4);
        LAS int* const gcnt = (LAS int*)(ldsl + 132096 + 2 * 32 * NC * 4);
        const unsigned lds0 = (unsigned)(uintptr_t)lds;
        const unsigned u_lane_off = (unsigned)(lane >> 2) * 64u + (unsigned)(((lane & 3) ^ ((lane >> 4) & 3)) * 16);
        for (int k = 0; k < 2048; k += 1) {
            int tb, eb;
            if (G == 256) { if (k >= 8) break; eb = vcu & 31; tb = 8 * (vcu >> 5) + (((vcu & 31) + k) & 7); }
            else { const int task = vcu + k * G; if (task >= 2048) break; tb = task >> 5; eb = task & 31; }
            const int t = tb * 512 + tid;
            const unsigned char* usrc = (const unsigned char*)UH + (size_t)eb * 512 * 64;
            const unsigned char* xsrc = (const unsigned char*)XT + ((size_t)tb * 512) * 8;
#define DMA_UX(hs_, buf_) do { unsigned ulo_ = u_lane_off, xlo_ = (unsigned)lane * 16u; asm volatile("" : "+v"(ulo_), "+v"(xlo_)); _Pragma("unroll") for (int q_ = 0; q_ < 4; ++q_) { const int j_ = wave + 8 * q_; \
                attn_body::glds16(usrc + ulo_ + (size_t)(hs_) * (PEER_N * 64) + (size_t)j_ * 1024, (unsigned)__builtin_amdgcn_readfirstlane(lds0 + (buf_) * 32768 + j_ * 1024)); \
                attn_body::glds16(xsrc + xlo_ + (size_t)((hs_) * 8 + (j_ >> 2)) * ((size_t)TOK * 8) + (size_t)(j_ & 3) * 1024, (unsigned)__builtin_amdgcn_readfirstlane(lds0 + 65536 + (buf_) * 32896 + (j_ >> 2) * 4112 + (j_ & 3) * 1024)); } } while (0)
            DMA_UX(0, 0);
            for (int c = tid; c < 32 * NC; c += NWAVES * 64) GCOL[c] = 0u;
            if (tid < 32) gcnt[tid] = 0;
            const int p0 = OFFS[(size_t)t * 32 + eb]; const int p1 = (eb < 31) ? (int)OFFS[(size_t)t * 32 + eb + 1] : 128; const int n = p1 - p0;
            unsigned ent[16];
#pragma unroll
            for (int i = 0; i < 16; ++i) ent[i] = (i < n) ? SGE[(size_t)t * 128 + p0 + i] : 0u;
            unsigned tid_o = (unsigned)tid; asm volatile("" : "+v"(tid_o));
            unsigned char* const a2u = (unsigned char*)AE2 + ((size_t)(tb * 32 + eb) * 12) * 2048; const unsigned toff4 = tid_o * 4u;
            CNT[(size_t)(tb * 32 + eb) * 512 + tid] = (unsigned char)n;
            __syncthreads();
            unsigned ovmask = 0u;
#pragma unroll
            for (int i = 0; i < 16; ++i) if (i < n) { const unsigned r = ent[i] & 0xffffu; const int g = (int)((r >> 4) & 31u);
                const int c = __hip_atomic_fetch_add(gcnt + g, 1, __ATOMIC_RELAXED, __HIP_MEMORY_SCOPE_WORKGROUP);
                if (c < NC) { GCOL[g * NC + c] = ((unsigned)tid << 15) | ((unsigned)(p0 + i) << 8) | ((unsigned)i << 4) | (r & 15u); GW[g * NC + c] = ent[i]; } else ovmask |= 1u << i; }
            __syncthreads();
            int cg[4]; unsigned tko[4][NTL]; f32x4 acc[4][NTL];
            const unsigned aoff = (unsigned)((4 * wave) * 16 + (lane & 15)) * 64u + (unsigned)((((lane >> 5) & 1) ^ ((lane >> 2) & 3)) * 16) + (unsigned)((lane >> 4) & 1) * 8u;
#pragma unroll
            for (int gi = 0; gi < 4; ++gi) { const int cc = gcnt[4 * wave + gi]; cg[gi] = __builtin_amdgcn_readfirstlane(cc < NC ? cc : NC);
#pragma unroll
                for (int ct = 0; ct < NTL; ++ct) { tko[gi][ct] = 65536u + (unsigned)(lane >> 4) * 4112u + (GCOL[(4 * wave + gi) * NC + ct * 16 + (lane & 15)] >> 15) * 8u;     acc[gi][ct] = (f32x4){0.f, 0.f, 0.f, 0.f}; } }
#define UPM_COMPUTE(buf_) do { _Pragma("unroll") for (int gi = 0; gi < 4; ++gi) { if (cg[gi] > 0) { \
                const long af0_ = v2l(*(const LAS v2u*)(ldsl + aoff + gi * 1024 + (buf_) * 32768)), af1_ = v2l(*(const LAS v2u*)(ldsl + (aoff ^ 32u) + gi * 1024 + (buf_) * 32768)); \
                _Pragma("unroll") for (int ct = 0; ct < NTL; ++ct) { if (ct * 16 < cg[gi]) { \
                    const long bf0_ = v2l(*(const LAS v2u*)(ldsl + tko[gi][ct] + (buf_) * 32896)), bf1_ = v2l(*(const LAS v2u*)(ldsl + tko[gi][ct] + 16448 + (buf_) * 32896)); \
                    acc[gi][ct] = __builtin_amdgcn_mfma_f32_16x16x32_fp8_fp8(af0_, bf0_, acc[gi][ct], 0, 0, 0); \
                    acc[gi][ct] = __builtin_amdgcn_mfma_f32_16x16x32_fp8_fp8(af1_, bf1_, acc[gi][ct], 0, 0, 0); } } } } } while (0)
#pragma unroll 1
            for (int hs = 0; hs < 16; hs += 2) {
                __builtin_amdgcn_s_waitcnt(0x0F70); __syncthreads();
                DMA_UX(hs + 1, 1);
                UPM_COMPUTE(0);
                __builtin_amdgcn_s_waitcnt(0x0F70); __syncthreads();
                if (hs + 2 < 16) DMA_UX(hs + 2, 0);
                UPM_COMPUTE(1);
            }
#undef UPM_COMPUTE
#undef DMA_UX
#pragma unroll
            for (int gi = 0; gi < 4; ++gi)
#pragma unroll
                for (int ct = 0; ct < NTL; ++ct) if (ct * 16 < cg[gi]) {
                    const int c = ct * 16 + (lane & 15); const unsigned en = GCOL[(4 * wave + gi) * NC + c], gw = GW[(4 * wave + gi) * NC + c];
                    const unsigned row = en & 15u; const f32x4 av = acc[gi][ct];
                    const float hsel = (row & 2u) ? ((row & 1u) ? av.w : av.z) : ((row & 1u) ? av.y : av.x);
                    if (c < cg[gi] && (int)(row >> 2) == (lane >> 4)) {
                        const unsigned tk = en >> 15, pp = (en >> 8) & 127u, ii = (en >> 4) & 15u;
                        const unsigned w = (f2bf(gelu_erf(hsel * (1.f / 32.f) * RSTD[tb * 512 + (int)tk]) * __uint_as_float(gw & 0xffff0000u)) << 16) | (gw & 0xffffu);
                        if (ii < 12u) *(unsigned*)(a2u + (size_t)ii * 2048 + tk * 4u) = w; else AE[((size_t)tb * 512 + tk) * 128 + pp] = w;
                    }
                    __builtin_amdgcn_sched_barrier(0);
                }
            if (__any(n > 16 || ovmask != 0u)) {
                for (int i = 0; i < n; ++i) if (i >= 16 || ((ovmask >> i) & 1u)) { const unsigned en = SGE[(size_t)t * 128 + p0 + i]; const unsigned rr_ = en & 0xffffu; float a_ = 0.f;
                    for (int c = 0; c < 128; ++c) {
                        const v2u r_ = *(const v2u*)((const unsigned char*)UH + ((size_t)(c >> 3) * PEER_N + rr_) * 64 + (c & 7) * 8), x_ = *(const v2u*)((const unsigned char*)XT + ((size_t)c * TOK + t) * 8);
                        const int r0 = (int)r_.x, r1 = (int)r_.y, x0 = (int)x_.x, x1 = (int)x_.y;
                        a_ += __builtin_amdgcn_cvt_f32_fp8(r0, 0) * __builtin_amdgcn_cvt_f32_fp8(x0, 0) + __builtin_amdgcn_cvt_f32_fp8(r0, 1) * __builtin_amdgcn_cvt_f32_fp8(x0, 1)
                            + __builtin_amdgcn_cvt_f32_fp8(r0, 2) * __builtin_amdgcn_cvt_f32_fp8(x0, 2) + __builtin_amdgcn_cvt_f32_fp8(r0, 3) * __builtin_amdgcn_cvt_f32_fp8(x0, 3)
                            + __builtin_amdgcn_cvt_f32_fp8(r1, 0) * __builtin_amdgcn_cvt_f32_fp8(x1, 0) + __builtin_amdgcn_cvt_f32_fp8(r1, 1) * __builtin_amdgcn_cvt_f32_fp8(x1, 1)
                            + __builtin_amdgcn_cvt_f32_fp8(r1, 2) * __builtin_amdgcn_cvt_f32_fp8(x1, 2) + __builtin_amdgcn_cvt_f32_fp8(r1, 3) * __builtin_amdgcn_cvt_f32_fp8(x1, 3); }
                    const unsigned w_ = (f2bf(gelu_erf(a_ * (1.f / 32.f) * RSTD[t]) * __uint_as_float(en & 0xffff0000u)) << 16) | (en & 0xffffu); if (i < 12) *(unsigned*)(a2u + (size_t)i * 2048 + toff4) = w_; else AE[(size_t)t * 128 + p0 + i] = w_; }
            }
            __syncthreads();
        }
        if (BOTH(11)) GRID_BAR();
    }

#define DMA_T(src, ds_, buf_) do { _Pragma("unroll") for (int q_ = 0; q_ < 8; ++q_) { const int j_ = wave + 8 * q_; \
                attn_body::glds16((src) + (size_t)j_ * 1024 + (size_t)(ds_) * (PEER_N * 128), (unsigned)__builtin_amdgcn_readfirstlane(lds0 + (buf_) * 65536 + j_ * 1024)); } } while (0)
#define ROW_READ(R_, ew_, buf_) do { unsigned ea_ = (ew_); asm volatile("" : "+v"(ea_)); const unsigned el_ = ea_ & 511u; \
                const unsigned ra_ = (lds0 + (unsigned)((buf_) * 65536) + el_ * 128u) | l7s;     \
                _Pragma("unroll") for (int c = 0; c < 8; ++c) R_[c] = *(const LAS v4u*)(uintptr_t)(ra_ ^ (unsigned)(c * 16)); } while (0)
    if (IN(12)) {
        PHASE_LOCALS
        const unsigned lds0 = (unsigned)(uintptr_t)lds;
        const unsigned dma_lane_off = (unsigned)lane * 16u;
        unsigned l7 = (unsigned)lane & 7u; asm volatile("" : "+v"(l7));
        unsigned l7s = ((unsigned)lane & 7u) << 4; asm volatile("" : "+v"(l7s));
        for (int k = 0; k < 512; ++k) {
            int tb2, ds;
            if (G == 256) { if (k >= 2) break; const int c_ = vcu & 31; ds = c_ & 15; tb2 = 4 * (vcu >> 5) + (((c_ >> 4) + 2 * k) & 3); }
            else { const int task = vcu + k * G; if (task >= 512) break; tb2 = task >> 4; ds = task & 15; }
            const int tA = tb2 * 1024 + tid, tB = tA + 512;
            h2 accA[32], accB[32];
#pragma unroll
            for (int d = 0; d < 32; ++d) { accA[d] = (h2){(_Float16)0.f, (_Float16)0.f}; accB[d] = (h2){(_Float16)0.f, (_Float16)0.f}; }
            const unsigned char* vsrc = (const unsigned char*)VH + (size_t)ds * (PEER_N * 128) + dma_lane_off;
            const unsigned char* const a2uA = (const unsigned char*)AE2 + ((size_t)(tb2 * 2 * 32) * 12) * 2048;
            const unsigned char* const a2uB = a2uA + (size_t)(32 * 12) * 2048;
            const unsigned char* const cnuA = CNT + (size_t)(tb2 * 2 * 32) * 512; const unsigned char* const cnuB = cnuA + 32 * 512;
            unsigned tid_o = (unsigned)tid; asm volatile("" : "+v"(tid_o));
            const unsigned toff4 = tid_o * 4u, toff1 = tid_o;
#define DN_FMA(ACC_, R_, ew_) do { const _Float16 ah_ = (_Float16)__uint_as_float((ew_) & 0xffff0000u); const h2 a2_ = (h2){ah_, ah_}; _Pragma("unroll") for (int c = 0; c < 8; ++c) { \
                ACC_[4 * c + 0] = u2h(R_[c].x) * a2_ + ACC_[4 * c + 0]; ACC_[4 * c + 1] = u2h(R_[c].y) * a2_ + ACC_[4 * c + 1]; \
                ACC_[4 * c + 2] = u2h(R_[c].z) * a2_ + ACC_[4 * c + 2]; ACC_[4 * c + 3] = u2h(R_[c].w) * a2_ + ACC_[4 * c + 3]; } } while (0)
#define LOAD_ENT(a2u_, cnu_, E_, n_, sb_) do { n_ = *((cnu_) + (size_t)(sb_) * 512 + toff1); _Pragma("unroll") for (int i = 0; i < 12; ++i) E_[i] = *(const unsigned*)((a2u_) + (size_t)((sb_) * 12 + i) * 2048 + toff4); } while (0)
#define DN_BODY(ACC_, tt_, E_, n_, sb_, buf_) do { \
                  _Pragma("unroll") for (int i = 0; i < 12; i += 2) { if (__any(i < n_)) { \
                    e1_ = (i + 1 < n_) ? E_[i + 1] : 0u; ROW_READ(R1, e1_, buf_); \
                    DN_FMA(ACC_, R0, e0_); \
                    if (i + 2 < 12) { e0_ = (i + 2 < n_) ? E_[i + 2] : 0u; ROW_READ(R0, e0_, buf_); } \
                    DN_FMA(ACC_, R1, e1_); } } \
                  if (__any(n_ > 12)) { if (n_ > 12) { const unsigned* ao_ = AE + (size_t)(tt_) * 128 + OFFS[(size_t)(tt_) * 32 + (sb_)]; \
                      for (int i = 12; i < n_; ++i) { const unsigned en_ = ao_[i]; ROW_READ(R0, en_, buf_); DN_FMA(ACC_, R0, en_); } } } } while (0)
#define DN_STEP2(EA_, nA_, EB_, nB_, sb_, buf_, EAn_, nAn_, EBn_, nBn_, has_next_) do { \
                  unsigned e0_ = (0 < nA_) ? EA_[0] : 0u, e1_ = 0u; ROW_READ(R0, e0_, buf_);     \
                  if (has_next_) { DMA_T(vsrc + (size_t)((sb_) + 1) * (512 * 128), 0, 1 - (buf_)); LOAD_ENT(a2uA, cnuA, EAn_, nAn_, (sb_) + 1); LOAD_ENT(a2uB, cnuB, EBn_, nBn_, (sb_) + 1); } \
                  DN_BODY(accA, tA, EA_, nA_, sb_, buf_); \
                  e0_ = (0 < nB_) ? EB_[0] : 0u; ROW_READ(R0, e0_, buf_); \
                  DN_BODY(accB, tB, EB_, nB_, sb_, buf_); } while (0)
            unsigned eA0[12], eB0[12], eA1[12], eB1[12]; int nA0, nB0, nA1, nB1; v4u R0[8], R1[8];
#pragma unroll
            for (int c = 0; c < 8; ++c) { R0[c] = (v4u){0u, 0u, 0u, 0u}; R1[c] = (v4u){0u, 0u, 0u, 0u}; }
            DMA_T(vsrc, 0, 0); LOAD_ENT(a2uA, cnuA, eA0, nA0, 0); LOAD_ENT(a2uB, cnuB, eB0, nB0, 0);
#pragma unroll 1
            for (int sb = 0; sb < 32; sb += 2) {
                __builtin_amdgcn_s_waitcnt(0x0F70); __syncthreads();
                DN_STEP2(eA0, nA0, eB0, nB0, sb, 0, eA1, nA1, eB1, nB1, true);
                __builtin_amdgcn_s_waitcnt(0x0F70); __syncthreads();
                DN_STEP2(eA1, nA1, eB1, nB1, sb + 1, 1, eA0, nA0, eB0, nB0, (sb + 2 < 32));
            }
#undef DN_STEP2
#undef DN_BODY
#undef LOAD_ENT
#undef DN_FMA
#define DN_FINAL(ACC_, tt_) do { int tq_ = (tt_); unsigned l7 = l7o; asm volatile("" : "+v"(tq_), "+v"(l7));     \
            f32x4* op = (f32x4*)(out + (size_t)tq_ * DMODEL + ds * 64); const v4u* hp = (const v4u*)(XN2 + (size_t)tq_ * DMODEL + ds * 64);     \
            v4u hba[8];                                               \
            _Pragma("unroll") for (int c = 0; c < 8; ++c) hba[c] = hp[(unsigned)c ^ l7]; \
            _Pragma("unroll") for (int c = 0; c < 8; ++c) { const unsigned cc = (unsigned)c ^ l7; const v4u hb = hba[c]; \
                f32x4 o0, o1; o0.x = bflo(hb.x) + (float)ACC_[4 * c].x; o0.y = bfhi(hb.x) + (float)ACC_[4 * c].y; o0.z = bflo(hb.y) + (float)ACC_[4 * c + 1].x; o0.w = bfhi(hb.y) + (float)ACC_[4 * c + 1].y; \
                o1.x = bflo(hb.z) + (float)ACC_[4 * c + 2].x; o1.y = bfhi(hb.z) + (float)ACC_[4 * c + 2].y; o1.z = bflo(hb.w) + (float)ACC_[4 * c + 3].x; o1.w = bfhi(hb.w) + (float)ACC_[4 * c + 3].y; \
                op[2 * cc] = o0; op[2 * cc + 1] = o1; } } while (0)
            { const unsigned l7o = l7; DN_FINAL(accA, tA); DN_FINAL(accB, tB); }
#undef DN_FINAL
        }
#undef ROW_READ
#undef DMA_T
    }
#undef IN
#undef BOTH
#undef GRID_BAR
}

extern "C" void kernel_launch(void* const* d_in, const int* in_sizes, int n_in, void* d_out, int out_size, void* d_ws, size_t ws_size, hipStream_t stream) {
    static int grid = 0;
    if (grid == 0) {
        if (n_in != 20 || in_sizes[0] != TOK * DMODEL || out_size != TOK * DMODEL || ws_size < WS_END) {
            fprintf(stderr, "kernel_launch: unexpected shapes: n_in %d in0 %d out %d ws %zu (need %zu); nothing launched\n", n_in, n_in > 0 ? in_sizes[0] : -1, out_size, ws_size, (size_t)WS_END); grid = -1; return; }
        int dev = 0, cus = 0, per_cu = 0;
        if (hipGetDevice(&dev) != hipSuccess || hipDeviceGetAttribute(&cus, hipDeviceAttributeMultiprocessorCount, dev) != hipSuccess) { grid = -1; return; }
        if (hipFuncSetAttribute((const void*)hymba_fwd, hipFuncAttributeMaxDynamicSharedMemorySize, LDS_BYTES) != hipSuccess) { fprintf(stderr, "kernel_launch: hipFuncSetAttribute failed\n"); grid = -1; return; }
        if (hipOccupancyMaxActiveBlocksPerMultiprocessor(&per_cu, (const void*)hymba_fwd, NWAVES * 64, LDS_BYTES) != hipSuccess || per_cu < 1)
            fprintf(stderr, "kernel_launch: note: occupancy query reports %d workgroups per CU\n", per_cu);
        (void)hipGetLastError();
        grid = cus;
        grid -= grid % 8;
        if (grid < 8) { grid = -1; return; }
    }
    if (grid < 0) return;
    if (hipMemsetAsync((char*)d_ws + WS_CTL, 0, CTL_ZERO_BYTES, stream) != hipSuccess) return;
    Args a{};
    for (int i = 0; i < 20; ++i) a.in[i] = d_in[i];
    a.out = (float*)d_out; a.ws = (unsigned char*)d_ws;
    for (int li = 0; li < N_LAUNCHES; ++li) {
        a.ph_lo = (N_LAUNCHES == 1) ? 0 : li; a.ph_hi = (N_LAUNCHES == 1) ? NPHASE : li + 1; a.li = li; a.pad = 0;
        hipLaunchKernelGGL(hymba_fwd, dim3(grid), dim3(NWAVES * 64), LDS_BYTES, stream, a);
        const hipError_t le = hipPeekAtLastError();
        if (le != hipSuccess) { fprintf(stderr, "kernel_launch: launch %d failed: %s\n", li, hipGetErrorName(le)); break; }
    }
}
```

```cpp
#include <hip/hip_runtime.h>
#include <hip/hip_bf16.h>
#include <cstdio>
#include <cstdint>
#include <cmath>
#define MK_N_LAUNCHES 1
namespace pg8 {
#define PG8_LAS __attribute__((address_space(3)))
typedef unsigned short bf16_t;
typedef short bf16x8 __attribute__((ext_vector_type(8)));
typedef float f32x4 __attribute__((ext_vector_type(4)));
typedef unsigned u32x4 __attribute__((ext_vector_type(4)));
constexpr int BM = 256, BK = 64, HALF = 128, HTB = HALF * BK * 2  , STAGE_BYTES = 8 * HTB, NXCD = 8, WGM = 8;

__host__ __device__ __forceinline__ int lds_byte(int r, int c) { const int st = (r >> 4) * 2 + (c >> 5), rr = r & 15, cc = c & 31, ob = rr * 64 + cc * 2; return st * 1024 + (ob ^ (((ob >> 9) & 1) << 5)); }
__host__ __device__ __forceinline__ void stage_rc(int b, int& R, int& C) { const int st = b / 1024, sb = b % 1024, swz = sb ^ (((sb >> 9) & 1) << 5); R = (st >> 1) * 16 + swz / 64; C = (st & 1) * 32 + (swz % 64) / 2; }
__host__ __device__ __forceinline__ int perm32(int rho) { const int n = rho >> 4, i = rho & 15; return 8 * (i >> 2) + 4 * n + (i & 3); }

struct Unit { int pm, pn; };
struct Gemm { const bf16_t* A; const bf16_t* Bt; int M, N, K; };

struct StaticOrder {
    int nM, nN, nwg, G, c;
    __host__ __device__ void init(int M, int N, int G_, int c_) { nM = M / BM; nN = N / BM; nwg = nM * nN; G = G_; c = c_; }
    __host__ __device__ bool next(int i, Unit& u) const {
        const long L = (long)i * G + c; if (L >= nwg) return false;
        int wgid = (int)L; { const int q = nwg / NXCD, r = nwg % NXCD, xcd = wgid % NXCD, off = wgid / NXCD; wgid = (xcd < r ? xcd * (q + 1) : r * (q + 1) + (xcd - r) * q) + off; }
        const int nig = WGM * nN, gid = wgid / nig, fm = gid * WGM, gsz = (nM - fm) < WGM ? (nM - fm) : WGM;
        u.pm = fm + ((wgid % nig) % gsz); u.pn = (wgid % nig) / gsz; return true;
    }
    __device__ __forceinline__ void a_ready(const Unit&) const {}
    __device__ __forceinline__ void done(const Unit&) const {}
};

__device__ __forceinline__ unsigned cvt_pk_bf16(float lo, float hi) { unsigned r; asm volatile("v_cvt_pk_bf16_f32 %0, %1, %2" : "=v"(r) : "v"(lo), "v"(hi)); return r; }
typedef float f32x2 __attribute__((ext_vector_type(2)));
__device__ __forceinline__ f32x2 gelu_pk(f32x2 v) {
    const f32x2 av = __builtin_elementwise_abs(v), d = av * 0.2316418882f + 1.0f;
    f32x2 t; t.x = __builtin_amdgcn_rcpf(d.x); t.y = __builtin_amdgcn_rcpf(d.y);
    f32x2 q = t * 0.5307027145f + (-0.7265760135f); q = q * t + 0.7107068705f; q = q * t + (-0.142248368f); q = q * t + 0.127414796f; q = q * t;
    const f32x2 s = (v * v) * (-0.72134752044f);
    f32x2 e; e.x = __builtin_amdgcn_exp2f(s.x); e.y = __builtin_amdgcn_exp2f(s.y);
    const f32x2 m = v * (q * e), r = v - m;
    f32x2 o; o.x = v.x < 0.f ? m.x : r.x; o.y = v.y < 0.f ? m.y : r.y; return o;
}

template <int ACT  > struct EpiBf16 {
    static constexpr bool PERM = true, AFTER_DRAIN = false; static_assert(ACT == 0 || ACT == 1, "EpiBf16: ACT is 0 (none) or 1 (gelu_pk)");
    bf16_t* O; int ldc; const float* bias; int split_cols; size_t split_stride; float scale0;
    __device__ __forceinline__ void operator()(const f32x4 (&acc)[2][2][4][2], const Unit& u, int wr, int wc, int fr, int fq) const {
        const int row0 = u.pm * BM + wr * 64 + fr; int colt = u.pn * BM; bf16_t* base = O;
        float sc = 1.f; if (split_cols) { const int t = colt / split_cols; base += (size_t)t * split_stride; colt -= t * split_cols; if (t == 0) sc = scale0; }
        const int col0 = colt + wc * 32 + 8 * fq, bcol0 = u.pn * BM + wc * 32 + 8 * fq;
        f32x4 bv[2][2];
#pragma unroll
        for (int bj = 0; bj < 2; ++bj)
#pragma unroll
            for (int n = 0; n < 2; ++n) bv[bj][n] = bias ? *(const f32x4*)(bias + bcol0 + bj * HALF + 4 * n) : (f32x4){0.f, 0.f, 0.f, 0.f};
#pragma unroll
        for (int ai = 0; ai < 2; ++ai)
#pragma unroll
            for (int m = 0; m < 4; ++m) { bf16_t* rowp = base + (size_t)(row0 + ai * HALF + m * 16) * ldc + col0;
#pragma unroll
                for (int bj = 0; bj < 2; ++bj) { f32x4 v0 = acc[ai][bj][m][0] + bv[bj][0], v1 = acc[ai][bj][m][1] + bv[bj][1];
                    if (ACT == 1) { f32x2 a = gelu_pk((f32x2){v0[0], v0[1]}), b = gelu_pk((f32x2){v0[2], v0[3]}), c = gelu_pk((f32x2){v1[0], v1[1]}), d = gelu_pk((f32x2){v1[2], v1[3]});
                        v0 = (f32x4){a.x, a.y, b.x, b.y}; v1 = (f32x4){c.x, c.y, d.x, d.y}; }
                    v0 = v0 * sc; v1 = v1 * sc; u32x4 w; w.x = cvt_pk_bf16(v0[0], v0[1]); w.y = cvt_pk_bf16(v0[2], v0[3]); w.z = cvt_pk_bf16(v1[0], v1[1]); w.w = cvt_pk_bf16(v1[2], v1[3]);
                    *(u32x4*)(rowp + bj * HALF) = w; } }
    }
};
struct EpiResF32 {
    static constexpr bool PERM = true, AFTER_DRAIN = false;
    const float* X; float* O; int ldc;
    __device__ __forceinline__ void operator()(const f32x4 (&acc)[2][2][4][2], const Unit& u, int wr, int wc, int fr, int fq) const {
        const int row0 = u.pm * BM + wr * 64 + fr, col0 = u.pn * BM + wc * 32 + 8 * fq;
#pragma unroll
        for (int ai = 0; ai < 2; ++ai)
#pragma unroll
            for (int m = 0; m < 4; ++m) { const size_t ro = (size_t)(row0 + ai * HALF + m * 16) * ldc + col0;
#pragma unroll
                for (int bj = 0; bj < 2; ++bj) { const size_t off = ro + bj * HALF;
                    const f32x4 x0 = *(const f32x4*)(X + off), x1 = *(const f32x4*)(X + off + 4);
                    *(f32x4*)(O + off) = x0 + acc[ai][bj][m][0]; *(f32x4*)(O + off + 4) = x1 + acc[ai][bj][m][1]; } }
    }
};
struct EpiResF32X {
    static constexpr bool PERM = true, AFTER_DRAIN = false;
    const float* X; int ldc; bf16_t* HB; unsigned char* X8; float* SSP; int tok;
    static __device__ __forceinline__ unsigned pk8(float a, float b, float c, float d) { int w = __builtin_amdgcn_cvt_pk_fp8_f32(a, b, 0, false); w = __builtin_amdgcn_cvt_pk_fp8_f32(c, d, w, true); return (unsigned)w; }
    __device__ __forceinline__ void operator()(const f32x4 (&acc)[2][2][4][2], const Unit& u, int wr, int wc, int fr, int fq) const {
        const int row0 = u.pm * BM + wr * 64 + fr, col0 = u.pn * BM + wc * 32 + 8 * fq;
#pragma unroll
        for (int ai = 0; ai < 2; ++ai) {
            f32x4 xv[4][2][2];
#pragma unroll
            for (int m = 0; m < 4; ++m)
#pragma unroll
                for (int bj = 0; bj < 2; ++bj) { const size_t off = (size_t)(row0 + ai * HALF + m * 16) * ldc + col0 + bj * HALF; xv[m][bj][0] = *(const f32x4*)(X + off); xv[m][bj][1] = *(const f32x4*)(X + off + 4); }
#pragma unroll
            for (int m = 0; m < 4; ++m) { const int row = row0 + ai * HALF + m * 16; const size_t ro = (size_t)row * ldc + col0; float ss = 0.f;
#pragma unroll
                for (int bj = 0; bj < 2; ++bj) { const size_t off = ro + bj * HALF;
                    const f32x4 h0 = xv[m][bj][0] + acc[ai][bj][m][0], h1 = xv[m][bj][1] + acc[ai][bj][m][1];
                    ss += (h0.x * h0.x + h0.y * h0.y) + (h0.z * h0.z + h0.w * h0.w) + (h1.x * h1.x + h1.y * h1.y) + (h1.z * h1.z + h1.w * h1.w);
                    u32x4 w; w.x = cvt_pk_bf16(h0.x, h0.y); w.y = cvt_pk_bf16(h0.z, h0.w); w.z = cvt_pk_bf16(h1.x, h1.y); w.w = cvt_pk_bf16(h1.z, h1.w);
                    *(u32x4*)(HB + off) = w;
                    typedef unsigned u32x2 __attribute__((ext_vector_type(2)));
                    const u32x2 q = {pk8(h0.x, h0.y, h0.z, h0.w), pk8(h1.x, h1.y, h1.z, h1.w)};
                    *(u32x2*)(X8 + ((size_t)((col0 + bj * HALF) >> 3) * tok + row) * 8) = q; }
                ss += __shfl_xor(ss, 16); ss += __shfl_xor(ss, 32);
                if (fq == 0) SSP[(size_t)row * 16 + u.pn * 4 + wc] = ss; } }
    }
};
struct EpiBf16Row {
    static constexpr bool PERM = true, AFTER_DRAIN = false;
    bf16_t* O; int ldc; const float* SSP; float* RSTD; float eps, inv_n;
    __device__ __forceinline__ void operator()(const f32x4 (&acc)[2][2][4][2], const Unit& u, int wr, int wc, int fr, int fq) const {
        const int row0 = u.pm * BM + wr * 64 + fr, col0 = u.pn * BM + wc * 32 + 8 * fq;
#pragma unroll
        for (int ai = 0; ai < 2; ++ai) {
            float rs[4];
#pragma unroll
            for (int m = 0; m < 4; ++m) { const f32x4* sp = (const f32x4*)(SSP + (size_t)(row0 + ai * HALF + m * 16) * 16);
                const f32x4 s4 = (sp[0] + sp[1]) + (sp[2] + sp[3]); rs[m] = 1.f / sqrtf(((s4.x + s4.y) + (s4.z + s4.w)) * inv_n + eps); }
#pragma unroll
            for (int m = 0; m < 4; ++m) { const int row = row0 + ai * HALF + m * 16; bf16_t* rowp = O + (size_t)row * ldc + col0;
                const float rstd = rs[m];
                if (u.pn == 0 && wc == 0 && fq == 0) RSTD[row] = rstd;
#pragma unroll
                for (int bj = 0; bj < 2; ++bj) { const f32x4 v0 = acc[ai][bj][m][0] * rstd, v1 = acc[ai][bj][m][1] * rstd;
                    u32x4 w; w.x = cvt_pk_bf16(v0[0], v0[1]); w.y = cvt_pk_bf16(v0[2], v0[3]); w.z = cvt_pk_bf16(v1[0], v1[1]); w.w = cvt_pk_bf16(v1[2], v1[3]);
                    *(u32x4*)(rowp + bj * HALF) = w; } } }
    }
};
template <class Epi, class Sched, bool ALIGN_EPI = false, bool SP2 = false>
__device__ __forceinline__ void gemm_phase(PG8_LAS unsigned char* lds, const Gemm g, const Sched& S, const Epi& E) {
    const int tid = threadIdx.x, wid = __builtin_amdgcn_readfirstlane(tid >> 6), lane = tid & 63, wr = wid >> 2, wc = wid & 3, fr = lane & 15, fq = lane >> 4;
    const int K = g.K, nt = K / BK;
    unsigned voffA[2], voffB[2];
#pragma unroll
    for (int i = 0; i < 2; ++i) { int R, C; stage_rc(tid * 16 + i * 8192, R, C); const int Rb = Epi::PERM ? ((R & ~31) + perm32(R & 31)) : R;
        voffA[i] = (unsigned)(R * K + C) * 2u; voffB[i] = (unsigned)(Rb * K + C) * 2u; }
    const size_t kstep = (size_t)(BK * 2);
    const size_t hstep = (size_t)HALF * K * 2;
    const size_t tstep = 2 * hstep;
    const unsigned ldsw = (unsigned)wid * 1024u;
    const int aoff = lds_byte(wr * 64 + fr, fq * 8), boff = lds_byte(wc * 32 + fr, fq * 8);
#define PG8_SA(b, h) (((b) * 2 + (h)) * HTB)
#define PG8_SB(b, h) ((4 + (b) * 2 + (h)) * HTB)
#define PG8_STAGE(bufoff, gbase, voff) do { _Pragma("unroll") for (int _i = 0; _i < 2; ++_i) \
        __builtin_amdgcn_global_load_lds((const unsigned*)((const char*)(gbase) + (voff)[_i]), (PG8_LAS unsigned*)(lds + (bufoff) + ldsw + _i * 8192), 16, 0, 0); } while (0)
#define PG8_LDA(dst, b, h) do { _Pragma("unroll") for (int m = 0; m < 4; ++m) _Pragma("unroll") for (int k = 0; k < 2; ++k) dst[m][k] = *(const PG8_LAS bf16x8*)(lds + PG8_SA(b, h) + aoff + m * 2048 + k * 1024); } while (0)
#define PG8_LDB(dst, b, h) do { _Pragma("unroll") for (int n = 0; n < 2; ++n) _Pragma("unroll") for (int k = 0; k < 2; ++k) dst[n][k] = *(const PG8_LAS bf16x8*)(lds + PG8_SB(b, h) + boff + n * 2048 + k * 1024); } while (0)
#define PG8_MMA(ai, bj, At, Bt) do { __builtin_amdgcn_s_setprio(1); _Pragma("unroll") for (int m = 0; m < 4; ++m) _Pragma("unroll") for (int n = 0; n < 2; ++n) _Pragma("unroll") for (int k = 0; k < 2; ++k) \
        acc[ai][bj][m][n] = __builtin_amdgcn_mfma_f32_16x16x32_bf16(Bt[n][k], At[m][k], acc[ai][bj][m][n], 0, 0, 0); __builtin_amdgcn_s_setprio(0); } while (0)
#define PG8_WAIT_V(n) asm volatile("s_waitcnt vmcnt(" #n ")" ::: "memory")
#define PG8_WAIT_L(n) asm volatile("s_waitcnt lgkmcnt(" #n ")" ::: "memory")
#define PG8_BAR __builtin_amdgcn_s_barrier()
#define PG8_SCHED __builtin_amdgcn_sched_barrier(0)
    Unit cur, nxt; int ui = 0;
    if (!S.next(0, cur)) return;
    f32x4 acc[2][2][4][2];
#pragma unroll
    for (int a = 0; a < 2; ++a)
#pragma unroll
        for (int b = 0; b < 2; ++b)
#pragma unroll
            for (int m = 0; m < 4; ++m)
#pragma unroll
                for (int n = 0; n < 2; ++n) acc[a][b][m][n] = (f32x4){0.f, 0.f, 0.f, 0.f};
    bf16x8 At[4][2], B0[2][2], B1[2][2];
    const char* cA = (const char*)g.A + (size_t)cur.pm * tstep; const char* cB = (const char*)g.Bt + (size_t)cur.pn * tstep;
    S.a_ready(cur);
    if constexpr (SP2) {
        PG8_STAGE(PG8_SB(0, 0), cB, voffB); PG8_STAGE(PG8_SB(0, 1), cB + hstep, voffB); PG8_STAGE(PG8_SA(0, 0), cA, voffA); PG8_STAGE(PG8_SA(0, 1), cA + hstep, voffA);
        if (wr == 1) PG8_BAR;
        PG8_WAIT_V(2); PG8_BAR;
        PG8_STAGE(PG8_SB(1, 0), cB + kstep, voffB); PG8_STAGE(PG8_SA(1, 0), cA + kstep, voffA); PG8_STAGE(PG8_SB(1, 1), cB + hstep + kstep, voffB);
        PG8_WAIT_V(6); PG8_BAR;
    } else {
        PG8_STAGE(PG8_SB(0, 0), cB, voffB); PG8_STAGE(PG8_SA(0, 0), cA, voffA); PG8_STAGE(PG8_SB(0, 1), cB + hstep, voffB); PG8_STAGE(PG8_SA(0, 1), cA + hstep, voffA);
        if (wr == 1) PG8_BAR;
        PG8_WAIT_V(4); PG8_BAR;
        PG8_STAGE(PG8_SB(1, 0), cB + kstep, voffB); PG8_STAGE(PG8_SA(1, 0), cA + kstep, voffA); PG8_STAGE(PG8_SB(1, 1), cB + hstep + kstep, voffB);
        PG8_WAIT_V(6); PG8_BAR;
    }
    for (;;) {
        const bool has_next = S.next(ui + 1, nxt);
        const char* nA = has_next ? (const char*)g.A + (size_t)nxt.pm * tstep : cA; const char* nB = has_next ? (const char*)g.Bt + (size_t)nxt.pn * tstep : cB;
        for (int t = 0; t < nt; t += 2) {
            const bool last = (t == nt - 2);
            const char* a1 = cA + (size_t)(t + 1) * kstep;
            const char* a2 = last ? nA : cA + (size_t)(t + 2) * kstep; const char* b2 = last ? nB : cB + (size_t)(t + 2) * kstep;
            const char* a3 = a2 + kstep; const char* b3 = b2 + kstep;
            if (last && has_next) S.a_ready(nxt);
            if constexpr (SP2) {
            PG8_LDB(B0, 0, 0); PG8_LDB(B1, 0, 1); PG8_SCHED; PG8_LDA(At, 0, 0); PG8_STAGE(PG8_SA(1, 1), a1 + hstep, voffA);
            PG8_WAIT_V(8); PG8_WAIT_L(0); PG8_BAR; PG8_MMA(0, 0, At, B0); PG8_MMA(0, 1, At, B1); PG8_BAR; PG8_SCHED;
            PG8_LDA(At, 0, 1); PG8_STAGE(PG8_SB(0, 0), b2, voffB); PG8_STAGE(PG8_SB(0, 1), b2 + hstep, voffB); PG8_STAGE(PG8_SA(0, 0), a2, voffA);
            PG8_WAIT_V(8); PG8_WAIT_L(0); PG8_BAR; PG8_MMA(1, 0, At, B0); PG8_MMA(1, 1, At, B1); PG8_BAR; PG8_SCHED;
            PG8_LDB(B0, 1, 0); PG8_LDB(B1, 1, 1); PG8_SCHED; PG8_LDA(At, 1, 0); PG8_STAGE(PG8_SA(0, 1), a2 + hstep, voffA);
            PG8_WAIT_V(8); PG8_WAIT_L(0); PG8_BAR; PG8_MMA(0, 0, At, B0); PG8_MMA(0, 1, At, B1); PG8_BAR; PG8_SCHED;
            PG8_LDA(At, 1, 1); PG8_STAGE(PG8_SB(1, 0), b3, voffB); PG8_STAGE(PG8_SB(1, 1), b3 + hstep, voffB); PG8_STAGE(PG8_SA(1, 0), a3, voffA);
            PG8_WAIT_V(8); PG8_WAIT_L(0); PG8_BAR; PG8_MMA(1, 0, At, B0); PG8_MMA(1, 1, At, B1); PG8_BAR; PG8_SCHED;
            } else {
            PG8_LDB(B0, 0, 0); PG8_SCHED; PG8_LDA(At, 0, 0); PG8_STAGE(PG8_SA(1, 1), a1 + hstep, voffA);
            PG8_WAIT_L(8); PG8_BAR; PG8_WAIT_L(0); PG8_MMA(0, 0, At, B0); PG8_BAR; PG8_SCHED;
            PG8_LDB(B1, 0, 1); PG8_STAGE(PG8_SB(0, 0), b2, voffB);
            PG8_BAR; PG8_WAIT_L(0); PG8_MMA(0, 1, At, B1); PG8_BAR;
            PG8_LDA(At, 0, 1); PG8_STAGE(PG8_SA(0, 0), a2, voffA);
            PG8_BAR; PG8_WAIT_L(0); PG8_MMA(1, 0, At, B0); PG8_BAR; PG8_SCHED;
            PG8_STAGE(PG8_SB(0, 1), b2 + hstep, voffB);
            PG8_WAIT_V(6); PG8_BAR; PG8_MMA(1, 1, At, B1); PG8_BAR;
            PG8_LDB(B0, 1, 0); PG8_SCHED; PG8_LDA(At, 1, 0); PG8_STAGE(PG8_SA(0, 1), a2 + hstep, voffA);
            PG8_WAIT_L(8); PG8_BAR; PG8_WAIT_L(0); PG8_MMA(0, 0, At, B0); PG8_BAR; PG8_SCHED;
            PG8_LDB(B1, 1, 1); PG8_STAGE(PG8_SB(1, 0), b3, voffB);
            PG8_BAR; PG8_WAIT_L(0); PG8_MMA(0, 1, At, B1); PG8_BAR;
            PG8_LDA(At, 1, 1); PG8_STAGE(PG8_SA(1, 0), a3, voffA);
            PG8_BAR; PG8_WAIT_L(0); PG8_MMA(1, 0, At, B0); PG8_BAR; PG8_SCHED;
            PG8_STAGE(PG8_SB(1, 1), b3 + hstep, voffB);
            PG8_WAIT_V(6); PG8_BAR; PG8_MMA(1, 1, At, B1); PG8_BAR;
            }
        }
        if constexpr (ALIGN_EPI) { if (wr == 0) PG8_BAR; }
        if constexpr (!Epi::AFTER_DRAIN) { E(acc, cur, wr, wc, fr, fq); S.done(cur); }
        if (!has_next) break;
#pragma unroll
        for (int a = 0; a < 2; ++a)
#pragma unroll
            for (int b = 0; b < 2; ++b)
#pragma unroll
                for (int m = 0; m < 4; ++m)
#pragma unroll
                    for (int n = 0; n < 2; ++n) acc[a][b][m][n] = (f32x4){0.f, 0.f, 0.f, 0.f};
        cur = nxt; cA = nA; cB = nB; ++ui;
        if constexpr (ALIGN_EPI) { if (wr == 1) PG8_BAR; }
    }
    PG8_WAIT_V(0);
    if constexpr (!ALIGN_EPI) { if (wr == 0) PG8_BAR; }
    PG8_BAR;
    if constexpr (Epi::AFTER_DRAIN) { E.fused(acc, cur, wr, wc, fr, fq, lds, wid, lane); S.done(cur); }
#undef PG8_SA
#undef PG8_SB
#undef PG8_STAGE
#undef PG8_LDA
#undef PG8_LDB
#undef PG8_MMA
#undef PG8_WAIT_V
#undef PG8_WAIT_L
#undef PG8_BAR
#undef PG8_SCHED
}
}

#ifndef PG8_SP2
#define PG8_SP2 true
#endif
#ifndef PG8_ALIGN
#define PG8_ALIGN true
#endif
#include <hip/hip_bf16.h>
#include <cmath>
namespace attn_body {
using bf16=__hip_bfloat16;
using bf16x8=__attribute__((ext_vector_type(8)))short;
using s16x4=__attribute__((ext_vector_type(4)))short;
using f32x16=__attribute__((ext_vector_type(16)))float;
using u32x4=__attribute__((ext_vector_type(4)))unsigned;
constexpr int SEQ=8192,D=64,PQ=3328,PK=3328,PV=3328,PO=2048;
constexpr int NW=8,QBLK=32,QB=QBLK*NW,KVBLK=64,NQB=SEQ/QB;
constexpr int ATTN_UNIT_ROWS=QB;
__device__ __forceinline__ int crow(int r,int hi){return (r&3)+8*(r>>2)+4*hi;}
#define SBAR() __builtin_amdgcn_sched_barrier(0)
__device__ __forceinline__ void cmask(f32x16&p0,f32x16&p1,int jb,int qrel,int hi){
  const float NEG=-INFINITY; int kb=64*jb+4*hi;
  #pragma unroll
  for(int r=0;r<16;++r){int kv=kb+(r&3)+8*(r>>2); if(kv>qrel)p0[r]=NEG; if(kv+32>qrel)p1[r]=NEG;}
}

constexpr int NSLOT=3, SLOTB=8192;
constexpr int LDS_K=0, LDS_V=NSLOT*SLOTB, LDS_WS=2*NSLOT*SLOTB, LDS_OST=LDS_WS+NW*64*4, LDS_BYTES=LDS_OST+NW*4096;
constexpr float C2=0.125f*1.4426950408889634f;
__device__ __forceinline__ void glds16(const void*gsrc,unsigned lds_dst){unsigned keep;
  asm volatile("s_mov_b32 %0, m0\n\ts_mov_b32 m0, %2\n\ts_nop 0\n\tglobal_load_lds_dwordx4 %1, off\n\ts_mov_b32 m0, %0":"=&s"(keep):"v"(gsrc),"s"(lds_dst):"memory");}
__device__ __forceinline__ float max3f(float a,float b,float c){float r;asm("v_max3_f32 %0, %1, %2, %3":"=v"(r):"v"(a),"v"(b),"v"(c));return r;}
__device__ __forceinline__ float max2f(float a,float b){float r;asm("v_max_f32_e32 %0, %1, %2":"=v"(r):"v"(a),"v"(b));return r;}
__device__ __forceinline__ float fadd_s(float a,float b){float r;asm("v_add_f32_e32 %0, %1, %2":"=v"(r):"v"(a),"v"(b));return r;}
__device__ __forceinline__ float fsub_s(float a,float b){float r;asm("v_sub_f32_e32 %0, %1, %2":"=v"(r):"v"(a),"v"(b));return r;}
typedef float f32x2_t __attribute__((ext_vector_type(2))); typedef __bf16 bf16x2_t __attribute__((ext_vector_type(2)));
__device__ __forceinline__ unsigned cvtpk_s(float lo,float hi){f32x2_t v={lo,hi};bf16x2_t b=__builtin_convertvector(v,bf16x2_t);return __builtin_bit_cast(unsigned,b);}
#define WAIT_BAR(N) asm volatile("s_waitcnt vmcnt(" #N ") lgkmcnt(0)\n\ts_barrier":::"memory")

__device__ __forceinline__ void qkt(f32x16&p0,f32x16&p1,const char*Kslot,const bf16x8*qr,const f32x16&negm,int r32,int hi){
  const char*kb=Kslot+hi*1024+r32*16;
  #pragma unroll
  for(int d0=0;d0<4;++d0){
    const bf16x8 b0=*reinterpret_cast<const bf16x8*>(kb+d0*2048);
    const bf16x8 b1=*reinterpret_cast<const bf16x8*>(kb+d0*2048+512);
    if(d0==0){p0=__builtin_amdgcn_mfma_f32_32x32x16_bf16(b0,qr[0],negm,0,0,0);p1=__builtin_amdgcn_mfma_f32_32x32x16_bf16(b1,qr[0],negm,0,0,0);}
    else{p0=__builtin_amdgcn_mfma_f32_32x32x16_bf16(b0,qr[d0],p0,0,0,0);p1=__builtin_amdgcn_mfma_f32_32x32x16_bf16(b1,qr[d0],p1,0,0,0);}}
}
typedef __attribute__((address_space(3))) const char* lds_cptr;
typedef short v4i16_t __attribute__((ext_vector_type(4)));
__device__ __forceinline__ void kload8(bf16x8*kf,lds_cptr kp){
  kf[0]=*(const __attribute__((address_space(3))) bf16x8*)(kp);      kf[1]=*(const __attribute__((address_space(3))) bf16x8*)(kp+512);
  kf[2]=*(const __attribute__((address_space(3))) bf16x8*)(kp+2048); kf[3]=*(const __attribute__((address_space(3))) bf16x8*)(kp+2560);
  kf[4]=*(const __attribute__((address_space(3))) bf16x8*)(kp+4096); kf[5]=*(const __attribute__((address_space(3))) bf16x8*)(kp+4608);
  kf[6]=*(const __attribute__((address_space(3))) bf16x8*)(kp+6144); kf[7]=*(const __attribute__((address_space(3))) bf16x8*)(kp+6656);
}
__device__ __forceinline__ void kload2(bf16x8*kf,lds_cptr kp,int j){ kf[2*j]=*(const __attribute__((address_space(3))) bf16x8*)(kp+j*2048); kf[2*j+1]=*(const __attribute__((address_space(3))) bf16x8*)(kp+j*2048+512); }
__device__ __forceinline__ s16x4 vtr(lds_cptr p){ return __builtin_bit_cast(s16x4,__builtin_amdgcn_ds_read_tr16_b64_v4i16((__attribute__((address_space(3))) v4i16_t*)p)); }
__device__ __forceinline__ float rowmax(const f32x16&p0,const f32x16&p1){
  float a=max3f(p0[0],p0[1],p1[0]),b=max3f(p0[2],p0[3],p1[1]);a=max3f(a,p1[2],p1[3]);
  #pragma unroll
  for(int r=4;r<16;r+=4){a=max3f(a,p0[r],p0[r+1]);b=max3f(b,p0[r+2],p0[r+3]);a=max3f(a,p1[r],p1[r+1]);b=max3f(b,p1[r+2],p1[r+3]);}
  const float m=max2f(a,b);
  auto rr=__builtin_amdgcn_permlane32_swap(__float_as_uint(m),__float_as_uint(m),false,false);
  return max2f(__uint_as_float(rr[0]),__uint_as_float(rr[1]));
}
__device__ __forceinline__ void pv(f32x16*o,int vb,bf16x8 pa0,bf16x8 pa1,bf16x8 pa2,bf16x8 pa3){
  #pragma unroll
  for(int d0=0;d0<2;++d0){s16x4 lo[4],hi[4];
    #pragma unroll
    for(int ks=0;ks<4;++ks){
      asm volatile("ds_read_b64_tr_b16 %0,%1 offset:%c2":"=&v"(lo[ks]):"v"(vb),"i"(d0*4096+ks*1024):"memory");
      asm volatile("ds_read_b64_tr_b16 %0,%1 offset:%c2":"=&v"(hi[ks]):"v"(vb),"i"(d0*4096+ks*1024+512):"memory");}
    asm volatile("s_waitcnt lgkmcnt(0)":::"memory");SBAR();
    #define PK(k) (bf16x8){lo[k][0],lo[k][1],lo[k][2],lo[k][3],hi[k][0],hi[k][1],hi[k][2],hi[k][3]}
    o[d0]=__builtin_amdgcn_mfma_f32_32x32x16_bf16(pa0,PK(0),o[d0],0,0,0);
    o[d0]=__builtin_amdgcn_mfma_f32_32x32x16_bf16(pa1,PK(1),o[d0],0,0,0);
    o[d0]=__builtin_amdgcn_mfma_f32_32x32x16_bf16(pa2,PK(2),o[d0],0,0,0);
    o[d0]=__builtin_amdgcn_mfma_f32_32x32x16_bf16(pa3,PK(3),o[d0],0,0,0);
    #undef PK
  }
}

#ifndef ATTN_STORE16
#define ATTN_STORE16(p,v) (*(u32x4*)(p)=(v))
#endif
template<int THRL> __device__ __forceinline__ void attn_unit(int b,int qcol,int kcol,int vcol,int ocol,int qb,const bf16*Q,const bf16*__restrict__ K,const bf16*__restrict__ V,bf16*O,char*shm){
  int tid=threadIdx.x; asm volatile("":"+v"(tid));
  const int lane=tid&63,r32=lane&31,hi=lane>>5; const int wid=__builtin_amdgcn_readfirstlane(tid>>6);
  const long rowbase=(long)b*SEQ; const int q0=qb*QB;
  const bf16*Qw=Q+(rowbase+q0+wid*QBLK)*PQ+qcol;
  const bf16*Kh=K+rowbase*PK+kcol,*Vh=V+rowbase*PV+vcol;
  const unsigned lds0=(unsigned)(uintptr_t)shm;
  float*wsf=(float*)(shm+LDS_WS)+wid*64;
  const bf16*ksrc=Kh+(long)lane*PK+wid*8;
  const bf16*vsrc=Vh+(long)(16*(wid&3)+(lane>>2))*PV+(wid>>2)*32+(lane&3)*8;
  const unsigned kdst=lds0+LDS_K+wid*1024, vdst=lds0+LDS_V+wid*1024;
  #define DMA_K(t,slot) glds16(ksrc+(long)(t)*KVBLK*PK,(unsigned)__builtin_amdgcn_readfirstlane(kdst+(slot)))
  #define DMA_V(t,slot) glds16(vsrc+(long)(t)*KVBLK*PV,(unsigned)__builtin_amdgcn_readfirstlane(vdst+(slot)))
  const int vb0=(int)(lds0+LDS_V)+((lane>>4)&1)*32+(lane&3)*8+(4*hi+((lane&15)>>2))*64;
  const char*Kbase=shm+LDS_K; bf16x8 kf[8];
  const lds_cptr shm3=(lds_cptr)shm; const lds_cptr kp0=shm3+LDS_K+hi*1024+r32*16; const lds_cptr vp0=shm3+LDS_V+((lane>>4)&1)*32+(lane&3)*8+(4*hi+((lane&15)>>2))*64;
  const int NT=(q0+QB)/KVBLK;
  DMA_K(0,0);DMA_V(0,0);DMA_K(1,SLOTB);
  bf16x8 qr[4];
  #pragma unroll
  for(int d0=0;d0<4;++d0)qr[d0]=*reinterpret_cast<const bf16x8*>(&Qw[(long)r32*PQ+d0*16+hi*8]);
  float mhat=0.f,l_reg=0.f;f32x16 o[2];o[0]=f32x16{};o[1]=f32x16{};f32x16 negm=f32x16{};asm volatile("":"+v"(negm));
  const int qrel=wid*QBLK+r32;
  #define CMASK(P0,P1,t) do{int jb_=(t)-(NT-4); if(jb_>=0)cmask(P0,P1,jb_,qrel,hi);}while(0)
  bool resc=false;
  #define START(P0,P1) do{ const float rm=rowmax(P0,P1); resc=false; \
    { const float dl=rm; mhat=fadd_s(mhat,dl); \
      _Pragma("unroll") for(int r=0;r<16;++r){P0[r]=fsub_s(P0[r],dl);P1[r]=fsub_s(P1[r],dl);} \
      _Pragma("unroll") for(int r=0;r<16;++r)negm[r]=-mhat; asm volatile("":"+v"(negm)); } \
    _Pragma("unroll") for(int r=0;r<16;++r)P0[r]=__builtin_amdgcn_exp2f(P0[r]); }while(0)
  #define RESC() do{ if(resc){ asm volatile("s_waitcnt lgkmcnt(0)":::"memory"); \
      _Pragma("unroll") for(int d_=0;d_<2;++d_) _Pragma("unroll") for(int r=0;r<16;++r)o[d_][r]*=wsf[crow(r,hi)]; } }while(0)
  f32x16 pA0,pA1,pB0,pB1;
  int sl_prev=0,sl_cur=0,sl_next=SLOTB;
  #define ROT() do{sl_prev=sl_cur;sl_cur=sl_next;sl_next=(sl_next==(NSLOT-1)*SLOTB)?0:sl_next+SLOTB;}while(0)
  DMA_K(2,2*SLOTB);
  WAIT_BAR(3);
  qkt(pA0,pA1,Kbase,qr,negm,r32,hi);asm volatile("s_nop 15\n\ts_nop 7":"+v"(pA0),"+v"(pA1));CMASK(pA0,pA1,0);
  START(pA0,pA1);
  _Pragma("unroll") for(int r=0;r<16;++r)pA1[r]=__builtin_amdgcn_exp2f(pA1[r]);
  WAIT_BAR(0);
  DMA_K(3,0);DMA_V(1,SLOTB);
  ROT();
  kload8(kf,kp0+sl_cur);
  WAIT_BAR(2);
  s16x4 vlo[8],vhi[8]; u32x4 pw0,pw1,pw2,pw3;
  #define PKW(P,B) cvtpk_s(P[B],P[B+1])
  #define PAF(k) __builtin_bit_cast(bf16x8,pw##k)
  #define VFR(i) (bf16x8){vlo[i][0],vlo[i][1],vlo[i][2],vlo[i][3],vhi[i][0],vhi[i][1],vhi[i][2],vhi[i][3]}
  #define PIN(x) asm volatile("":"+v"(x))
  #define MX3(a,b,c) __builtin_fmaxf(__builtin_fmaxf((a),(b)),(c))
  #define GAPA(MF,A0,A1,A2,A3,W0,W1,PW) do{ MF; sacc+=A0; sacc+=A1; sacc+=A2; sacc+=A3; PIN(sacc); W0; W1; PIN(PW); SBAR(); }while(0)
  #define EX(v) __builtin_amdgcn_exp2f(v)
  #define GAPB(MF,X,B) do{ MF; X[B]=EX(X[B]); X[B+1]=EX(X[B+1]); X[B+2]=EX(X[B+2]); X[B+3]=EX(X[B+3]); PIN(X); SBAR(); }while(0)
  #define VRD(i) do{ vlo[i]=vtr(vp_+(((i)>>2)*4096+((i)&3)*1024)); vhi[i]=vtr(vp_+(((i)>>2)*4096+((i)&3)*1024+512)); }while(0)
  #define KRD(G,j) do{ if(G){ kload2(kf,kp0+sl_next,j); SBAR(); } }while(0)
  #define STEP(C0,C1,P0,P1,t,GK,GV,GL) do{ SBAR(); \
    const lds_cptr vp_=vp0+sl_prev; \
    VRD(0); SBAR(); float sacc=(P0[0]+P0[1]); \
    GAPA(C0=__builtin_amdgcn_mfma_f32_32x32x16_bf16(kf[0],qr[0],negm,0,0,0), P0[2],P0[3],P0[4],P0[5],     pw0[0]=PKW(P0,0), pw0[1]=PKW(P0,2), pw0); \
    VRD(4); SBAR(); GAPA(C1=__builtin_amdgcn_mfma_f32_32x32x16_bf16(kf[1],qr[0],negm,0,0,0), P0[6],P0[7],P0[8],P0[9],     pw0[2]=PKW(P0,4), pw0[3]=PKW(P0,6), pw0); \
    VRD(1); SBAR(); GAPA(C0=__builtin_amdgcn_mfma_f32_32x32x16_bf16(kf[2],qr[1],C0,0,0,0),   P0[10],P0[11],P0[12],P0[13], pw1[0]=PKW(P0,8), pw1[1]=PKW(P0,10), pw1); \
    VRD(5); SBAR(); GAPA(C1=__builtin_amdgcn_mfma_f32_32x32x16_bf16(kf[3],qr[1],C1,0,0,0),   P0[14],P0[15],P1[0],P1[1],   pw1[2]=PKW(P0,12),pw1[3]=PKW(P0,14), pw1); \
    VRD(2); SBAR(); GAPA(C0=__builtin_amdgcn_mfma_f32_32x32x16_bf16(kf[4],qr[2],C0,0,0,0),   P1[2],P1[3],P1[4],P1[5],     pw2[0]=PKW(P1,0), pw2[1]=PKW(P1,2), pw2); \
    VRD(6); SBAR(); GAPA(C1=__builtin_amdgcn_mfma_f32_32x32x16_bf16(kf[5],qr[2],C1,0,0,0),   P1[6],P1[7],P1[8],P1[9],     pw2[2]=PKW(P1,4), pw2[3]=PKW(P1,6), pw2); \
    VRD(3); SBAR(); GAPA(C0=__builtin_amdgcn_mfma_f32_32x32x16_bf16(kf[6],qr[3],C0,0,0,0),   P1[10],P1[11],P1[12],P1[13], pw3[0]=PKW(P1,8), pw3[1]=PKW(P1,10), pw3); \
    VRD(7); SBAR(); GAPA(C1=__builtin_amdgcn_mfma_f32_32x32x16_bf16(kf[7],qr[3],C1,0,0,0),   P1[14],P1[15],0.f,0.f,       pw3[2]=PKW(P1,12),pw3[3]=PKW(P1,14), pw3); \
    l_reg+=sacc; \
    if(GK){DMA_K((t)+3,sl_cur);} if(GV){DMA_V((t)+1,sl_next);} \
    CMASK(C0,C1,t); \
    { float a=MX3(C0[0],C0[1],C1[0]),b=MX3(C0[2],C0[3],C1[1]); a=MX3(a,C1[2],C1[3]); \
      _Pragma("unroll") for(int r=4;r<16;r+=4){a=MX3(a,C0[r],C0[r+1]);b=MX3(b,C0[r+2],C0[r+3]);a=MX3(a,C1[r],C1[r+1]);b=MX3(b,C1[r+2],C1[r+3]);} \
      float rm=__builtin_fmaxf(a,b); { auto rr=__builtin_amdgcn_permlane32_swap(__float_as_uint(rm),__float_as_uint(rm),false,false); rm=__builtin_fmaxf(__uint_as_float(rr[0]),__uint_as_float(rr[1])); } \
      resc=false; \
      if(__builtin_expect(__any(rm>(float)THRL),0)){ const float dl=__builtin_fmaxf(rm,0.f); mhat+=dl; \
        _Pragma("unroll") for(int r=0;r<16;++r){C0[r]-=dl;C1[r]-=dl;} \
        _Pragma("unroll") for(int r=0;r<16;++r)negm[r]=-mhat; asm volatile("":"+v"(negm)); \
        const float f=__builtin_amdgcn_exp2f(-dl); l_reg*=f; if(hi==0)wsf[r32]=f; resc=true; } } \
    SBAR(); \
    GAPB(o[0]=__builtin_amdgcn_mfma_f32_32x32x16_bf16(PAF(0),VFR(0),o[0],0,0,0), C0,0); \
    GAPB(o[1]=__builtin_amdgcn_mfma_f32_32x32x16_bf16(PAF(0),VFR(4),o[1],0,0,0), C0,4); \
    KRD(GL,0); GAPB(o[0]=__builtin_amdgcn_mfma_f32_32x32x16_bf16(PAF(1),VFR(1),o[0],0,0,0), C0,8); \
    KRD(GL,1); GAPB(o[1]=__builtin_amdgcn_mfma_f32_32x32x16_bf16(PAF(1),VFR(5),o[1],0,0,0), C0,12); \
    KRD(GL,2); GAPB(o[0]=__builtin_amdgcn_mfma_f32_32x32x16_bf16(PAF(2),VFR(2),o[0],0,0,0), C1,0); \
    KRD(GL,3); GAPB(o[1]=__builtin_amdgcn_mfma_f32_32x32x16_bf16(PAF(2),VFR(6),o[1],0,0,0), C1,4); \
    GAPB(o[0]=__builtin_amdgcn_mfma_f32_32x32x16_bf16(PAF(3),VFR(3),o[0],0,0,0), C1,8); \
    GAPB(o[1]=__builtin_amdgcn_mfma_f32_32x32x16_bf16(PAF(3),VFR(7),o[1],0,0,0), C1,12); \
    }while(0)
  int t=1;
  #undef CMASK
  #define CMASK(P0,P1,t) do{}while(0)
  for(;t+5<NT;t+=2){
    STEP(pB0,pB1,pA0,pA1,t,true,true,true);     WAIT_BAR(2); RESC(); ROT();
    STEP(pA0,pA1,pB0,pB1,t+1,true,true,true);   WAIT_BAR(2); RESC(); ROT();
  }
  #undef CMASK
  #define CMASK(P0,P1,t) do{int jb_=(t)-(NT-4); if(jb_>=0)cmask(P0,P1,jb_,qrel,hi);}while(0)
  #define ENDW(tt) do{ if((tt)+3<NT){WAIT_BAR(2);} else if((tt)+2<NT){WAIT_BAR(1);} else {WAIT_BAR(0);} }while(0)
  for(;t+1<NT;t+=2){
    STEP(pB0,pB1,pA0,pA1,t,(t+3<NT),(t+1<NT),(t+1<NT));       ENDW(t);   RESC(); ROT();
    STEP(pA0,pA1,pB0,pB1,t+1,(t+4<NT),(t+2<NT),(t+2<NT));     ENDW(t+1); RESC(); ROT();
  }
  STEP(pB0,pB1,pA0,pA1,NT-1,false,false,false); RESC();
  { float sacc=pB0[0]+pB0[1]; _Pragma("unroll") for(int r=2;r<16;++r)sacc+=pB0[r]; _Pragma("unroll") for(int r=0;r<16;++r)sacc+=pB1[r]; l_reg+=sacc;
    pw0=(u32x4){PKW(pB0,0),PKW(pB0,2),PKW(pB0,4),PKW(pB0,6)};pw1=(u32x4){PKW(pB0,8),PKW(pB0,10),PKW(pB0,12),PKW(pB0,14)};pw2=(u32x4){PKW(pB1,0),PKW(pB1,2),PKW(pB1,4),PKW(pB1,6)};pw3=(u32x4){PKW(pB1,8),PKW(pB1,10),PKW(pB1,12),PKW(pB1,14)};
    SBAR(); pv(o,vb0+sl_cur,PAF(0),PAF(1),PAF(2),PAF(3)); }
  #undef PKW
  #undef PAF
  #undef VFR
  #undef PIN
  #undef MX3
  #undef GAPA
  #undef GAPB
  #undef EX
  #undef VRD
  #undef KRD
  #undef STEP
  #undef ENDW
  {auto rr=__builtin_amdgcn_permlane32_swap(__float_as_uint(l_reg),__float_as_uint(l_reg),false,false);l_reg=__uint_as_float(rr[0])+__uint_as_float(rr[1]);}
  if(hi==0)wsf[32+r32]=l_reg;asm volatile("s_waitcnt lgkmcnt(0)":::"memory");
  float rli[16];
  #pragma unroll
  for(int r=0;r<16;++r)rli[r]=__builtin_amdgcn_rcpf(wsf[32+crow(r,hi)]);
  bf16*Ow=O+(rowbase+q0+wid*QBLK)*PO+ocol;
  { bf16*stg=(bf16*)(shm+LDS_OST)+wid*2048;
    #pragma unroll
    for(int r=0;r<16;++r){const int orow=crow(r,hi);
      #pragma unroll
      for(int d0=0;d0<2;++d0)stg[orow*64+d0*32+r32]=__float2bfloat16(o[d0][r]*rli[r]);}
    asm volatile("s_waitcnt lgkmcnt(0)":::"memory");
    #pragma unroll
    for(int i=0;i<4;++i){const int row=i*8+(lane>>3),ch=lane&7; const u32x4 v=*(const u32x4*)(stg+row*64+ch*8); ATTN_STORE16(Ow+(long)row*PO+ch*8,v);} }
  asm volatile("s_waitcnt lgkmcnt(0)\n\ts_barrier":::"memory");
  #undef DMA_K
  #undef DMA_V
  #undef CMASK
  #undef START
  #undef RESC
  #undef ROT
}
constexpr int ATTN_LDS_BYTES=LDS_BYTES;
#undef SBAR
#undef WAIT_BAR
}
#include <hip/hip_bf16.h>
#include <cmath>
namespace attn_body2 {
using bf16=__hip_bfloat16;
using bf16x8=__attribute__((ext_vector_type(8)))short;
using s16x4=__attribute__((ext_vector_type(4)))short;
using f32x16=__attribute__((ext_vector_type(16)))float;
using u32x4=__attribute__((ext_vector_type(4)))unsigned;
constexpr int SEQ=8192,D=64,PQ=3328,PK=3328,PV=3328,PO=2048;
constexpr int NW=8,QBLK=32,QB=QBLK*NW,KVBLK=64,NQB=SEQ/QB;
constexpr int ATTN_UNIT_ROWS=QB;
__device__ __forceinline__ int crow(int r,int hi){return (r&3)+8*(r>>2)+4*hi;}
#define SBAR() __builtin_amdgcn_sched_barrier(0)
__device__ __forceinline__ void cmask(f32x16&p0,f32x16&p1,int jb,int qrel,int hi){
  const float NEG=-INFINITY; int kb=64*jb+4*hi;
  #pragma unroll
  for(int r=0;r<16;++r){int kv=kb+(r&3)+8*(r>>2); if(kv>qrel)p0[r]=NEG; if(kv+32>qrel)p1[r]=NEG;}
}

constexpr int NSLOT=3, SLOTB=8192, VSLOT=16384;
constexpr int LDS_K=0, LDS_V=NSLOT*SLOTB, LDS_WS=LDS_V+NSLOT*VSLOT, LDS_OST=LDS_WS+NW*64*4, LDS_BYTES=LDS_OST+NW*8192;
constexpr float C2=0.125f*1.4426950408889634f;
__device__ __forceinline__ void glds16(const void*gsrc,unsigned lds_dst){unsigned keep;
  asm volatile("s_mov_b32 %0, m0\n\ts_mov_b32 m0, %2\n\ts_nop 0\n\tglobal_load_lds_dwordx4 %1, off\n\ts_mov_b32 m0, %0":"=&s"(keep):"v"(gsrc),"s"(lds_dst):"memory");}
__device__ __forceinline__ float max3f(float a,float b,float c){float r;asm("v_max3_f32 %0, %1, %2, %3":"=v"(r):"v"(a),"v"(b),"v"(c));return r;}
__device__ __forceinline__ float max2f(float a,float b){float r;asm("v_max_f32_e32 %0, %1, %2":"=v"(r):"v"(a),"v"(b));return r;}
__device__ __forceinline__ float fadd_s(float a,float b){float r;asm("v_add_f32_e32 %0, %1, %2":"=v"(r):"v"(a),"v"(b));return r;}
__device__ __forceinline__ float fsub_s(float a,float b){float r;asm("v_sub_f32_e32 %0, %1, %2":"=v"(r):"v"(a),"v"(b));return r;}
typedef float f32x2_t __attribute__((ext_vector_type(2))); typedef __bf16 bf16x2_t __attribute__((ext_vector_type(2)));
__device__ __forceinline__ unsigned cvtpk_s(float lo,float hi){f32x2_t v={lo,hi};bf16x2_t b=__builtin_convertvector(v,bf16x2_t);return __builtin_bit_cast(unsigned,b);}
#define WAIT_BAR(N) asm volatile("s_waitcnt vmcnt(" #N ") lgkmcnt(0)\n\ts_barrier":::"memory")

__device__ __forceinline__ void qkt(f32x16&p0,f32x16&p1,const char*Kslot,const bf16x8*qr,const f32x16&negm,int r32,int hi){
  const char*kb=Kslot+hi*1024+r32*16;
  #pragma unroll
  for(int d0=0;d0<4;++d0){
    const bf16x8 b0=*reinterpret_cast<const bf16x8*>(kb+d0*2048);
    const bf16x8 b1=*reinterpret_cast<const bf16x8*>(kb+d0*2048+512);
    if(d0==0){p0=__builtin_amdgcn_mfma_f32_32x32x16_bf16(b0,qr[0],negm,0,0,0);p1=__builtin_amdgcn_mfma_f32_32x32x16_bf16(b1,qr[0],negm,0,0,0);}
    else{p0=__builtin_amdgcn_mfma_f32_32x32x16_bf16(b0,qr[d0],p0,0,0,0);p1=__builtin_amdgcn_mfma_f32_32x32x16_bf16(b1,qr[d0],p1,0,0,0);}}
}
typedef __attribute__((address_space(3))) const char* lds_cptr;
typedef short v4i16_t __attribute__((ext_vector_type(4)));
__device__ __forceinline__ void kload8(bf16x8*kf,lds_cptr kp){
  kf[0]=*(const __attribute__((address_space(3))) bf16x8*)(kp);      kf[1]=*(const __attribute__((address_space(3))) bf16x8*)(kp+512);
  kf[2]=*(const __attribute__((address_space(3))) bf16x8*)(kp+2048); kf[3]=*(const __attribute__((address_space(3))) bf16x8*)(kp+2560);
  kf[4]=*(const __attribute__((address_space(3))) bf16x8*)(kp+4096); kf[5]=*(const __attribute__((address_space(3))) bf16x8*)(kp+4608);
  kf[6]=*(const __attribute__((address_space(3))) bf16x8*)(kp+6144); kf[7]=*(const __attribute__((address_space(3))) bf16x8*)(kp+6656);
}
__device__ __forceinline__ void kload2(bf16x8*kf,lds_cptr kp,int j){ kf[2*j]=*(const __attribute__((address_space(3))) bf16x8*)(kp+j*2048); kf[2*j+1]=*(const __attribute__((address_space(3))) bf16x8*)(kp+j*2048+512); }
__device__ __forceinline__ s16x4 vtr(lds_cptr p){ return __builtin_bit_cast(s16x4,__builtin_amdgcn_ds_read_tr16_b64_v4i16((__attribute__((address_space(3))) v4i16_t*)p)); }
__device__ __forceinline__ float rowmax(const f32x16&p0,const f32x16&p1){
  float a=max3f(p0[0],p0[1],p1[0]),b=max3f(p0[2],p0[3],p1[1]);a=max3f(a,p1[2],p1[3]);
  #pragma unroll
  for(int r=4;r<16;r+=4){a=max3f(a,p0[r],p0[r+1]);b=max3f(b,p0[r+2],p0[r+3]);a=max3f(a,p1[r],p1[r+1]);b=max3f(b,p1[r+2],p1[r+3]);}
  const float m=max2f(a,b);
  auto rr=__builtin_amdgcn_permlane32_swap(__float_as_uint(m),__float_as_uint(m),false,false);
  return max2f(__uint_as_float(rr[0]),__uint_as_float(rr[1]));
}
__device__ __forceinline__ void pv(f32x16*o,int vb,bf16x8 pa0,bf16x8 pa1,bf16x8 pa2,bf16x8 pa3){
  #pragma unroll
  for(int d0=0;d0<4;++d0){s16x4 lo[4],hi[4];
    #pragma unroll
    for(int ks=0;ks<4;++ks){
      asm volatile("ds_read_b64_tr_b16 %0,%1 offset:%c2":"=&v"(lo[ks]):"v"(vb),"i"(d0*4096+ks*1024):"memory");
      asm volatile("ds_read_b64_tr_b16 %0,%1 offset:%c2":"=&v"(hi[ks]):"v"(vb),"i"(d0*4096+ks*1024+512):"memory");}
    asm volatile("s_waitcnt lgkmcnt(0)":::"memory");SBAR();
    #define PK(k) (bf16x8){lo[k][0],lo[k][1],lo[k][2],lo[k][3],hi[k][0],hi[k][1],hi[k][2],hi[k][3]}
    o[d0]=__builtin_amdgcn_mfma_f32_32x32x16_bf16(pa0,PK(0),o[d0],0,0,0);
    o[d0]=__builtin_amdgcn_mfma_f32_32x32x16_bf16(pa1,PK(1),o[d0],0,0,0);
    o[d0]=__builtin_amdgcn_mfma_f32_32x32x16_bf16(pa2,PK(2),o[d0],0,0,0);
    o[d0]=__builtin_amdgcn_mfma_f32_32x32x16_bf16(pa3,PK(3),o[d0],0,0,0);
    #undef PK
  }
}

#ifndef ATTN_STORE16
#define ATTN_STORE16(p,v) (*(u32x4*)(p)=(v))
#endif
template<int THRL> __device__ __forceinline__ void attn_unit(int b,int qcol,int kcol,int vcol,int ocol,int qb,const bf16*Q,const bf16*__restrict__ K,const bf16*__restrict__ V,bf16*O,char*shm){
  int tid=threadIdx.x; asm volatile("":"+v"(tid));
  const int lane=tid&63,r32=lane&31,hi=lane>>5; const int wid=__builtin_amdgcn_readfirstlane(tid>>6);
  const long rowbase=(long)b*SEQ; const int q0=qb*QB;
  const bf16*Qw=Q+(rowbase+q0+wid*QBLK)*PQ+qcol;
  const bf16*Kh=K+rowbase*PK+kcol,*Vh=V+rowbase*PV+vcol;
  const unsigned lds0=(unsigned)(uintptr_t)shm;
  float*wsf=(float*)(shm+LDS_WS)+wid*64;
  const bf16*ksrc=Kh+(long)lane*PK+wid*8;
  const bf16*vsrc=Vh+(long)(16*(wid&3)+(lane>>2))*PV+(wid>>2)*32+(lane&3)*8;
  const unsigned kdst=lds0+LDS_K+wid*1024, vdst=lds0+LDS_V+wid*1024;
  #define DMA_K(t,slot) glds16(ksrc+(long)(t)*KVBLK*PK,(unsigned)__builtin_amdgcn_readfirstlane(kdst+(slot)))
  #define DMA_V(t,slot) do{ glds16(vsrc+(long)(t)*KVBLK*PV,(unsigned)__builtin_amdgcn_readfirstlane(vdst+2*(slot))); glds16(vsrc+64+(long)(t)*KVBLK*PV,(unsigned)__builtin_amdgcn_readfirstlane(vdst+2*(slot)+8192)); }while(0)
  const int vb0=(int)(lds0+LDS_V)+((lane>>4)&1)*32+(lane&3)*8+(4*hi+((lane&15)>>2))*64;
  const char*Kbase=shm+LDS_K; bf16x8 kf[8];
  const lds_cptr shm3=(lds_cptr)shm; const lds_cptr kp0=shm3+LDS_K+hi*1024+r32*16; const lds_cptr vp0=shm3+LDS_V+((lane>>4)&1)*32+(lane&3)*8+(4*hi+((lane&15)>>2))*64;
  const int NT=(q0+QB)/KVBLK;
  DMA_K(0,0);DMA_V(0,0);DMA_K(1,SLOTB);
  bf16x8 qr[4];
  #pragma unroll
  for(int d0=0;d0<4;++d0)qr[d0]=*reinterpret_cast<const bf16x8*>(&Qw[(long)r32*PQ+d0*16+hi*8]);
  { u32x4*qst_=(u32x4*)(shm+LDS_OST+wid*8192);
    _Pragma("unroll") for(int d0=0;d0<4;++d0)qst_[d0*64+lane]=__builtin_bit_cast(u32x4,qr[d0]); }
  const lds_cptr qsp=(lds_cptr)shm+LDS_OST+wid*8192+lane*16;
  float mhat=0.f,l_reg=0.f;f32x16 o[4];o[0]=f32x16{};o[1]=f32x16{};o[2]=f32x16{};o[3]=f32x16{};const f32x16 ZR=f32x16{};
  const int qrel=wid*QBLK+r32;
  #define CMASK(P0,P1,t) do{int jb_=(t)-(NT-4); if(jb_>=0)cmask(P0,P1,jb_,qrel,hi);}while(0)
  bool resc=false;
  #define START(P0,P1) do{ const float rm=rowmax(P0,P1); resc=false; \
    { const float dl=rm; mhat=fadd_s(mhat,dl); \
      _Pragma("unroll") for(int r=0;r<16;++r){P0[r]=fsub_s(P0[r],dl);P1[r]=fsub_s(P1[r],dl);} \
      } \
    _Pragma("unroll") for(int r=0;r<16;++r)P0[r]=__builtin_amdgcn_exp2f(P0[r]); }while(0)
  #define RESC() do{ if(resc){ asm volatile("s_waitcnt lgkmcnt(0)":::"memory"); \
      _Pragma("unroll") for(int d_=0;d_<4;++d_) _Pragma("unroll") for(int r=0;r<16;++r)o[d_][r]*=wsf[crow(r,hi)]; } }while(0)
  f32x16 pA0,pA1,pB0,pB1;
  int sl_prev=0,sl_cur=0,sl_next=SLOTB;
  #define ROT() do{sl_prev=sl_cur;sl_cur=sl_next;sl_next=(sl_next==(NSLOT-1)*SLOTB)?0:sl_next+SLOTB;}while(0)
  DMA_K(2,2*SLOTB);
  WAIT_BAR(4);
  qkt(pA0,pA1,Kbase,qr,ZR,r32,hi);asm volatile("s_nop 15\n\ts_nop 7":"+v"(pA0),"+v"(pA1));CMASK(pA0,pA1,0);
  START(pA0,pA1);
  _Pragma("unroll") for(int r=0;r<16;++r)pA1[r]=__builtin_amdgcn_exp2f(pA1[r]);
  WAIT_BAR(0);
  DMA_K(3,0);DMA_V(1,SLOTB);
  ROT();
  kload8(kf,kp0+sl_cur);
  WAIT_BAR(3);
  s16x4 vlo[8],vhi[8]; u32x4 pw0,pw1,pw2,pw3;
  #define PKW(P,B) cvtpk_s(P[B],P[B+1])
  #define PAF(k) __builtin_bit_cast(bf16x8,pw##k)
  #define VFR(i) (bf16x8){vlo[i][0],vlo[i][1],vlo[i][2],vlo[i][3],vhi[i][0],vhi[i][1],vhi[i][2],vhi[i][3]}
  #define PIN(x) asm volatile("":"+v"(x))
  #define MX3(a,b,c) __builtin_fmaxf(__builtin_fmaxf((a),(b)),(c))
  #define GAPA(MF,A0,A1,A2,A3,W0,W1,PW) do{ MF; sacc+=A0; sacc+=A1; sacc+=A2; sacc+=A3; PIN(sacc); W0; W1; PIN(PW); SBAR(); }while(0)
  #define EX(v) __builtin_amdgcn_exp2f(v)
  #define GAPB(MF,X,B) do{ MF; X[B]=EX(X[B]); X[B+1]=EX(X[B+1]); X[B+2]=EX(X[B+2]); X[B+3]=EX(X[B+3]); PIN(X); SBAR(); }while(0)
  #define VRD(i) do{ vlo[i]=vtr(vp_+(((i)>>2)*4096+((i)&3)*1024)); vhi[i]=vtr(vp_+(((i)>>2)*4096+((i)&3)*1024+512)); }while(0)
  #define VRD2(i) do{ vlo[i]=vtr(vp_+((((i)>>2)+2)*4096+((i)&3)*1024)); vhi[i]=vtr(vp_+((((i)>>2)+2)*4096+((i)&3)*1024+512)); }while(0)
  #define GAPB2(MF,X,B,RD) do{ MF; X[B]=__builtin_amdgcn_exp2f(X[B]); X[B+1]=__builtin_amdgcn_exp2f(X[B+1]); asm volatile("":"+v"(X)); RD; SBAR(); }while(0)
  #define KRD(G,j) do{ if(G){ kload2(kf,kp0+sl_next,j); SBAR(); } }while(0)
  #define STEP(C0,C1,P0,P1,t,GK,GV,GL) do{ SBAR(); \
    const lds_cptr vp_=vp0+2*sl_prev; \
    _Pragma("unroll") for(int d0=0;d0<4;++d0)qr[d0]=*(const __attribute__((address_space(3))) bf16x8*)(qsp+d0*1024); SBAR(); \
    float sacc=(P0[0]+P0[1]); \
    GAPA(C0=__builtin_amdgcn_mfma_f32_32x32x16_bf16(kf[0],qr[0],ZR,0,0,0), P0[2],P0[3],P0[4],P0[5],     pw0[0]=PKW(P0,0), pw0[1]=PKW(P0,2), pw0); VRD(0); SBAR(); \
    GAPA(C1=__builtin_amdgcn_mfma_f32_32x32x16_bf16(kf[1],qr[0],ZR,0,0,0), P0[6],P0[7],P0[8],P0[9],     pw0[2]=PKW(P0,4), pw0[3]=PKW(P0,6), pw0); VRD(4); SBAR(); \
    GAPA(C0=__builtin_amdgcn_mfma_f32_32x32x16_bf16(kf[2],qr[1],C0,0,0,0),   P0[10],P0[11],P0[12],P0[13], pw1[0]=PKW(P0,8), pw1[1]=PKW(P0,10), pw1); VRD(1); SBAR(); \
    GAPA(C1=__builtin_amdgcn_mfma_f32_32x32x16_bf16(kf[3],qr[1],C1,0,0,0),   P0[14],P0[15],P1[0],P1[1],   pw1[2]=PKW(P0,12),pw1[3]=PKW(P0,14), pw1); VRD(5); SBAR(); \
    GAPA(C0=__builtin_amdgcn_mfma_f32_32x32x16_bf16(kf[4],qr[2],C0,0,0,0),   P1[2],P1[3],P1[4],P1[5],     pw2[0]=PKW(P1,0), pw2[1]=PKW(P1,2), pw2); VRD(2); SBAR(); \
    GAPA(C1=__builtin_amdgcn_mfma_f32_32x32x16_bf16(kf[5],qr[2],C1,0,0,0),   P1[6],P1[7],P1[8],P1[9],     pw2[2]=PKW(P1,4), pw2[3]=PKW(P1,6), pw2); VRD(6); SBAR(); \
    GAPA(C0=__builtin_amdgcn_mfma_f32_32x32x16_bf16(kf[6],qr[3],C0,0,0,0),   P1[10],P1[11],P1[12],P1[13], pw3[0]=PKW(P1,8), pw3[1]=PKW(P1,10), pw3); VRD(3); SBAR(); \
    GAPA(C1=__builtin_amdgcn_mfma_f32_32x32x16_bf16(kf[7],qr[3],C1,0,0,0),   P1[14],P1[15],0.f,0.f,       pw3[2]=PKW(P1,12),pw3[3]=PKW(P1,14), pw3); VRD(7); SBAR(); \
    _Pragma("unroll") for(int r=0;r<16;++r){C0[r]-=mhat;C1[r]-=mhat;} \
    l_reg+=sacc; \
    if(GK){DMA_K((t)+3,sl_cur);} if(GV){DMA_V((t)+1,sl_next);} \
    CMASK(C0,C1,t); \
    { float a=MX3(C0[0],C0[1],C1[0]),b=MX3(C0[2],C0[3],C1[1]); a=MX3(a,C1[2],C1[3]); \
      _Pragma("unroll") for(int r=4;r<16;r+=4){a=MX3(a,C0[r],C0[r+1]);b=MX3(b,C0[r+2],C0[r+3]);a=MX3(a,C1[r],C1[r+1]);b=MX3(b,C1[r+2],C1[r+3]);} \
      float rm=__builtin_fmaxf(a,b); { auto rr=__builtin_amdgcn_permlane32_swap(__float_as_uint(rm),__float_as_uint(rm),false,false); rm=__builtin_fmaxf(__uint_as_float(rr[0]),__uint_as_float(rr[1])); } \
      resc=false; \
      if(__builtin_expect(__any(rm>(float)THRL),0)){ const float dl=__builtin_fmaxf(rm,0.f); mhat+=dl; \
        _Pragma("unroll") for(int r=0;r<16;++r){C0[r]-=dl;C1[r]-=dl;} \
        const float f=__builtin_amdgcn_exp2f(-dl); l_reg*=f; if(hi==0)wsf[r32]=f; resc=true; } } \
    SBAR(); \
      \
    GAPB2(o[0]=__builtin_amdgcn_mfma_f32_32x32x16_bf16(PAF(0),VFR(0),o[0],0,0,0), C0,0,  VRD2(0)); \
    GAPB2(o[1]=__builtin_amdgcn_mfma_f32_32x32x16_bf16(PAF(0),VFR(4),o[1],0,0,0), C0,2,  VRD2(4)); \
    GAPB2(o[0]=__builtin_amdgcn_mfma_f32_32x32x16_bf16(PAF(1),VFR(1),o[0],0,0,0), C0,4,  VRD2(1)); \
    GAPB2(o[1]=__builtin_amdgcn_mfma_f32_32x32x16_bf16(PAF(1),VFR(5),o[1],0,0,0), C0,6,  VRD2(5)); \
    GAPB2(o[0]=__builtin_amdgcn_mfma_f32_32x32x16_bf16(PAF(2),VFR(2),o[0],0,0,0), C0,8,  VRD2(2)); \
    GAPB2(o[1]=__builtin_amdgcn_mfma_f32_32x32x16_bf16(PAF(2),VFR(6),o[1],0,0,0), C0,10, VRD2(6)); \
    GAPB2(o[0]=__builtin_amdgcn_mfma_f32_32x32x16_bf16(PAF(3),VFR(3),o[0],0,0,0), C0,12, VRD2(3)); \
    GAPB2(o[1]=__builtin_amdgcn_mfma_f32_32x32x16_bf16(PAF(3),VFR(7),o[1],0,0,0), C0,14, VRD2(7)); \
      \
    GAPB2(o[2]=__builtin_amdgcn_mfma_f32_32x32x16_bf16(PAF(0),VFR(0),o[2],0,0,0), C1,0,  (void)0); \
    GAPB2(o[3]=__builtin_amdgcn_mfma_f32_32x32x16_bf16(PAF(0),VFR(4),o[3],0,0,0), C1,2,  (void)0); \
    KRD(GL,0); GAPB2(o[2]=__builtin_amdgcn_mfma_f32_32x32x16_bf16(PAF(1),VFR(1),o[2],0,0,0), C1,4,  (void)0); \
    KRD(GL,1); GAPB2(o[3]=__builtin_amdgcn_mfma_f32_32x32x16_bf16(PAF(1),VFR(5),o[3],0,0,0), C1,6,  (void)0); \
    KRD(GL,2); GAPB2(o[2]=__builtin_amdgcn_mfma_f32_32x32x16_bf16(PAF(2),VFR(2),o[2],0,0,0), C1,8,  (void)0); \
    KRD(GL,3); GAPB2(o[3]=__builtin_amdgcn_mfma_f32_32x32x16_bf16(PAF(2),VFR(6),o[3],0,0,0), C1,10, (void)0); \
    GAPB2(o[2]=__builtin_amdgcn_mfma_f32_32x32x16_bf16(PAF(3),VFR(3),o[2],0,0,0), C1,12, (void)0); \
    GAPB2(o[3]=__builtin_amdgcn_mfma_f32_32x32x16_bf16(PAF(3),VFR(7),o[3],0,0,0), C1,14, (void)0); \
    }while(0)
  int t=1;
  #undef CMASK
  #define CMASK(P0,P1,t) do{}while(0)
  for(;t+5<NT;t+=2){
    STEP(pB0,pB1,pA0,pA1,t,true,true,true);     WAIT_BAR(3); RESC(); ROT();
    STEP(pA0,pA1,pB0,pB1,t+1,true,true,true);   WAIT_BAR(3); RESC(); ROT();
  }
  #undef CMASK
  #define CMASK(P0,P1,t) do{int jb_=(t)-(NT-4); if(jb_>=0)cmask(P0,P1,jb_,qrel,hi);}while(0)
  #define ENDW(tt) do{ if((tt)+3<NT){WAIT_BAR(3);} else if((tt)+2<NT){WAIT_BAR(2);} else {WAIT_BAR(0);} }while(0)
  for(;t+1<NT;t+=2){
    STEP(pB0,pB1,pA0,pA1,t,(t+3<NT),(t+1<NT),(t+1<NT));       ENDW(t);   RESC(); ROT();
    STEP(pA0,pA1,pB0,pB1,t+1,(t+4<NT),(t+2<NT),(t+2<NT));     ENDW(t+1); RESC(); ROT();
  }
  STEP(pB0,pB1,pA0,pA1,NT-1,false,false,false); RESC();
  { float sacc=pB0[0]+pB0[1]; _Pragma("unroll") for(int r=2;r<16;++r)sacc+=pB0[r]; _Pragma("unroll") for(int r=0;r<16;++r)sacc+=pB1[r]; l_reg+=sacc;
    pw0=(u32x4){PKW(pB0,0),PKW(pB0,2),PKW(pB0,4),PKW(pB0,6)};pw1=(u32x4){PKW(pB0,8),PKW(pB0,10),PKW(pB0,12),PKW(pB0,14)};pw2=(u32x4){PKW(pB1,0),PKW(pB1,2),PKW(pB1,4),PKW(pB1,6)};pw3=(u32x4){PKW(pB1,8),PKW(pB1,10),PKW(pB1,12),PKW(pB1,14)};
    SBAR(); pv(o,vb0+2*sl_cur,PAF(0),PAF(1),PAF(2),PAF(3)); }
  #undef PKW
  #undef PAF
  #undef VFR
  #undef PIN
  #undef MX3
  #undef GAPA
  #undef GAPB
  #undef EX
  #undef VRD
  #undef VRD2
  #undef GAPB2
  #undef KRD
  #undef STEP
  #undef ENDW
  {auto rr=__builtin_amdgcn_permlane32_swap(__float_as_uint(l_reg),__float_as_uint(l_reg),false,false);l_reg=__uint_as_float(rr[0])+__uint_as_float(rr[1]);}
  if(hi==0)wsf[32+r32]=l_reg;asm volatile("s_waitcnt lgkmcnt(0)":::"memory");
  float rli[16];
  #pragma unroll
  for(int r=0;r<16;++r)rli[r]=__builtin_amdgcn_rcpf(wsf[32+crow(r,hi)]);
  bf16*Ow=O+(rowbase+q0+wid*QBLK)*PO+ocol;
  { bf16*stg=(bf16*)(shm+LDS_OST)+wid*4096;
    #pragma unroll
    for(int r=0;r<16;++r){const int orow=crow(r,hi);
      #pragma unroll
      for(int d0=0;d0<4;++d0)stg[orow*128+d0*32+r32]=__float2bfloat16(o[d0][r]*rli[r]);}
    asm volatile("s_waitcnt lgkmcnt(0)":::"memory");
    #pragma unroll
    for(int i=0;i<8;++i){const int row=i*4+(lane>>4),ch=lane&15; const u32x4 v=*(const u32x4*)(stg+row*128+ch*8); ATTN_STORE16(Ow+(long)row*PO+ch*8,v);} }
  asm volatile("s_waitcnt lgkmcnt(0)\n\ts_barrier":::"memory");
  #undef DMA_K
  #undef DMA_V
  #undef CMASK
  #undef START
  #undef RESC
  #undef ROT
}
constexpr int ATTN_LDS_BYTES=LDS_BYTES;
#undef SBAR
#undef WAIT_BAR
}
constexpr int NWAVES = 8;
#ifndef MK_N_LAUNCHES
#define MK_N_LAUNCHES 1
#endif
constexpr int NPHASE = 13;
constexpr int N_LAUNCHES = MK_N_LAUNCHES;

constexpr int NB = 4, SEQL = 8192, DMODEL = 1024, TOK = NB * SEQL;
constexpr int IN_W = 3088;
constexpr int NPROJ = 3328;
constexpr int C_GQ = 0, C_GK = 256, C_GV = 512, C_GZ = 1024, C_GR = 1280, C_DQ = 1792, C_DK = 2304, C_DV = 2816;
constexpr int NUNIT = 2048;
constexpr int PEER_N = 16384, NQP = 2048;
constexpr float RMS_EPS = 1e-6f;
constexpr float LAMBDA_INIT = 0.2f;

constexpr size_t MiB = 1u << 20;
constexpr size_t WS_CTL = 0, CTL_ZERO_BYTES = 65536;
constexpr size_t WS_WIN = 1 * MiB, WS_WOUT = 8 * MiB, WS_WQ = 10 * MiB, WS_KEYS = 14 * MiB;
constexpr size_t WS_KVT = 16 * MiB, WS_VT = 48 * MiB;
constexpr size_t WS_U = 16 * MiB, WS_V = 48 * MiB;
constexpr size_t WS_SGE = 80 * MiB, WS_AE = 96 * MiB, WS_OFFS = 112 * MiB;
constexpr size_t WS_XT = 384 * MiB;
constexpr size_t WS_AE2 = 208 * MiB, WS_CNT = 113 * MiB;
constexpr size_t WS_XN = 80 * MiB, WS_MIX = 80 * MiB;
constexpr size_t WS_PROJ = 144 * MiB;
constexpr size_t WS_XN2 = 144 * MiB, WS_QP = 208 * MiB;
constexpr size_t WS_O = 352 * MiB;
constexpr size_t WS_IDX = 352 * MiB;
constexpr size_t WS_KTT = 480 * MiB;
constexpr size_t WS_DEC = 496 * MiB;
constexpr size_t WS_ROPE = 497 * MiB;
constexpr size_t WS_SSP = 499 * MiB, WS_RSTD = 501 * MiB;
constexpr size_t WS_END = 502 * MiB;
constexpr int CW_BAR = 4096;

constexpr int RING_OFF = 0, RING_BYTES = 131072;
constexpr int LDSCTL_OFF = 163840 - 512, MISC_OFF = LDSCTL_OFF + 320;
constexpr int LDS_BYTES = 163840;
static_assert(MISC_OFF + 128 <= LDS_BYTES, "LDS map");

#define GAS __attribute__((address_space(1)))
#define LAS __attribute__((address_space(3)))
typedef unsigned short bf16;
typedef unsigned v4u __attribute__((ext_vector_type(4)));
typedef unsigned v2u __attribute__((ext_vector_type(2)));
typedef float f32x4 __attribute__((ext_vector_type(4)));
typedef float f32x16 __attribute__((ext_vector_type(16)));
typedef short bf16x8 __attribute__((ext_vector_type(8)));
typedef short s16x4 __attribute__((ext_vector_type(4)));
typedef GAS unsigned gu32;
typedef _Float16 h2 __attribute__((ext_vector_type(2)));
typedef _Float16 f16x8 __attribute__((ext_vector_type(8)));
#define RLX_AGENT __ATOMIC_RELAXED, __HIP_MEMORY_SCOPE_AGENT
#define LDS_WAIT() asm volatile("s_waitcnt lgkmcnt(0)" ::: "memory")
#define VM_WAIT() asm volatile("s_waitcnt vmcnt(0)" ::: "memory")
__device__ __forceinline__ unsigned f2bf(float f) { unsigned u = __builtin_bit_cast(unsigned, f); return (u + 0x7fffu + ((u >> 16) & 1u)) >> 16; }
__device__ __forceinline__ unsigned pk2(float lo, float hi) { return f2bf(lo) | (f2bf(hi) << 16); }
__device__ __forceinline__ unsigned pkh(float lo, float hi) { h2 v; v.x = (_Float16)lo; v.y = (_Float16)hi; return __builtin_bit_cast(unsigned, v); }
__device__ __forceinline__ h2 u2h(unsigned u) { return __builtin_bit_cast(h2, u); }
__device__ __forceinline__ void fma_mix_lo(float& acc, unsigned hb, float a) { asm("v_fma_mix_f32 %0, %1, %2, %0 op_sel_hi:[1,0,0]" : "+v"(acc) : "v"(hb), "v"(a)); }
__device__ __forceinline__ void fma_mix_hi(float& acc, unsigned hb, float a) { asm("v_fma_mix_f32 %0, %1, %2, %0 op_sel:[1,0,0] op_sel_hi:[1,0,0]" : "+v"(acc) : "v"(hb), "v"(a)); }
__device__ __forceinline__ f16x8 v2f16x8(v4u v) { return __builtin_bit_cast(f16x8, v); }
__device__ __forceinline__ long v2l(v2u v) { return __builtin_bit_cast(long, v); }
__device__ __forceinline__ unsigned pk8(float a, float b, float c, float d) { int w = __builtin_amdgcn_cvt_pk_fp8_f32(a, b, 0, false); w = __builtin_amdgcn_cvt_pk_fp8_f32(c, d, w, true); return (unsigned)w; }
__device__ __forceinline__ float bf2f(unsigned b) { return __builtin_bit_cast(float, b << 16); }
__device__ __forceinline__ float bflo(unsigned w) { return __builtin_bit_cast(float, w << 16); }
__device__ __forceinline__ float bfhi(unsigned w) { return __builtin_bit_cast(float, w & 0xffff0000u); }
__device__ __forceinline__ int crow(int r, int hi) { return (r & 3) + 8 * (r >> 2) + 4 * hi; }
__device__ __forceinline__ float wave_sum(float v) {
#pragma unroll
    for (int o = 1; o < 64; o <<= 1) v += __shfl_xor(v, o);
    return v;
}
__device__ __forceinline__ float fmax_s(float a, float b) { float r; asm("v_max_f32_e32 %0, %1, %2" : "=v"(r) : "v"(a), "v"(b)); return r; }
__device__ __forceinline__ float fmin_s(float a, float b) { float r; asm("v_min_f32_e32 %0, %1, %2" : "=v"(r) : "v"(a), "v"(b)); return r; }

#define XB_TMO      128
#define XB_XCNT(j)  (256  + 64 * (j))
#define XB_XSUB(j)  (1280 + 64 * (j))
#define XB_XGEN(j)  (2304 + 64 * (j))
#define XB_TOP      3328
#define XB_TOPGEN   3392
#define XCD_BAR_WORDS 3456
#define XB_SPIN_CAP (1u << 18)

__device__ __forceinline__ unsigned xb_ld(unsigned* p)              { return __hip_atomic_load(p, __ATOMIC_RELAXED, __HIP_MEMORY_SCOPE_AGENT); }
__device__ __forceinline__ unsigned xb_add(unsigned* p, unsigned v) { return __hip_atomic_fetch_add(p, v, __ATOMIC_RELAXED, __HIP_MEMORY_SCOPE_AGENT); }
__device__ __forceinline__ unsigned xb_xcc_id() { return (unsigned)__builtin_amdgcn_s_getreg((3 << 11) | 20) & 0xFu; }
#define XB_SPIN(cond, bar) do { unsigned _sp = 0; while (cond) { __builtin_amdgcn_s_sleep(1); \
    if ((++_sp & 255u) == 0u) { if (xb_ld(&(bar)[XB_TMO])) break; if (_sp > XB_SPIN_CAP) { atomicAdd(&(bar)[XB_TMO], 1u); break; } } } } while (0)

struct XcdBarrier {
    unsigned* bar; unsigned x;
    volatile LAS unsigned* st;
};

__device__ __forceinline__ XcdBarrier xcd_barrier_post(unsigned* bar, volatile LAS unsigned* st) {
    XcdBarrier b; b.bar = bar; b.x = xb_xcc_id(); b.st = st;
    if (threadIdx.x == 0) (void)xb_add(&bar[XB_XCNT(b.x)], 1u);
    return b;
}
__device__ __forceinline__ void xcd_barrier_complete(unsigned* bar, unsigned x, unsigned& nloc, unsigned& nx) {
    const unsigned G = gridDim.x * gridDim.y * gridDim.z;
    unsigned sum, cnt, mine, sp = 0u;
    for (;;) {
        sum = 0u; cnt = 0u; mine = 0u;
#pragma unroll
        for (unsigned j = 0; j < 16; ++j) { const unsigned c = xb_ld(&bar[XB_XCNT(j)]); sum += c; cnt += (c > 0u) ? 1u : 0u; mine = (j == x) ? c : mine; }
        if (sum == G) break;
        __builtin_amdgcn_s_sleep(1);
        if ((++sp & 255u) == 0u) { if (xb_ld(&bar[XB_TMO])) break; if (sp > XB_SPIN_CAP) { atomicAdd(&bar[XB_TMO], 1u); break; } }
    }
    nloc = mine > 0u ? mine : 1u; nx = cnt > 0u ? cnt : 1u;
}

__device__ __forceinline__ void xcd_barrier(const XcdBarrier& b) {
    asm volatile("s_waitcnt vmcnt(0)" ::: "memory");
    __syncthreads();
    if (threadIdx.x == 0) {
        unsigned* bar = b.bar;
        __builtin_amdgcn_s_waitcnt(0);
        unsigned nloc = b.st[0], nx = b.st[1];
        if (nloc == 0u) { xcd_barrier_complete(bar, b.x, nloc, nx); b.st[0] = nloc; b.st[1] = nx; }
        const unsigned old = xb_add(&bar[XB_XSUB(b.x)], 1u);
        const unsigned gen = old / nloc;
        if (old + 1u == (gen + 1u) * nloc) {
            __builtin_amdgcn_fence(__ATOMIC_RELEASE, "agent");
            asm volatile("s_waitcnt vmcnt(0)" ::: "memory");
            const unsigned og = xb_add(&bar[XB_TOP], 1u);
            const unsigned tg = og / nx;
            if (og + 1u == (tg + 1u) * nx) xb_add(&bar[XB_TOPGEN], 1u);
            else XB_SPIN(xb_ld(&bar[XB_TOPGEN]) == tg, bar);
            __builtin_amdgcn_fence(__ATOMIC_ACQUIRE, "agent");
            xb_add(&bar[XB_XGEN(b.x)], 1u);
            asm volatile("s_waitcnt vmcnt(0)" ::: "memory");
        } else {
            XB_SPIN(xb_ld(&bar[XB_XGEN(b.x)]) == gen, bar);
            __builtin_amdgcn_fence(__ATOMIC_ACQUIRE, "agent");
            asm volatile("s_waitcnt vmcnt(0)" ::: "memory");
        }
    }
    __syncthreads();
}


__device__ __forceinline__ void transpose_item(const float* W, int pitch, int K, bf16* WT, int row_off, LAS float* scr, int kb, int nb, int lane, const float* ksc = nullptr) {
    const int k0 = 64 * kb, n0 = 32 * nb;
#pragma unroll 8
    for (int i = 0; i < 32; ++i) { const int kk = 2 * i + (lane >> 5); const float w_ = W[(size_t)(k0 + kk) * pitch + n0 + (lane & 31)]; scr[kk * 33 + (lane & 31)] = ksc ? w_ * ksc[k0 + kk] : w_; }
    LDS_WAIT(); asm volatile("" ::: "memory");
    const int c = lane & 7;
#pragma unroll
    for (int j = 0; j < 4; ++j) { const int n = (lane >> 3) + 8 * j; const LAS float* s = scr + (8 * c) * 33 + n;
        v4u o; o.x = pk2(s[0 * 33], s[1 * 33]); o.y = pk2(s[2 * 33], s[3 * 33]); o.z = pk2(s[4 * 33], s[5 * 33]); o.w = pk2(s[6 * 33], s[7 * 33]);
        *(GAS v4u*)(WT + (size_t)(row_off + n0 + n) * K + k0 + 8 * c) = o; }
    LDS_WAIT(); asm volatile("" ::: "memory");
}
template <bool HALF_COPY> __device__ __forceinline__ void rms_row_to_bf16(const float* xrow, const float* gain, bf16* orow, LAS unsigned char* hrow, int lane) {
    const GAS f32x4* xr = (const GAS f32x4*)xrow + lane; const GAS f32x4* gr = (const GAS f32x4*)gain + lane;
    f32x4 v[4]; float s = 0.f;
#pragma unroll
    for (int j = 0; j < 4; ++j) { v[j] = xr[64 * j]; s += (v[j].x * v[j].x + v[j].y * v[j].y) + (v[j].z * v[j].z + v[j].w * v[j].w); }
    const float rstd = 1.f / sqrtf(wave_sum(s) * (1.f / DMODEL) + RMS_EPS);
    GAS unsigned long long* o8 = (GAS unsigned long long*)orow + lane;
#pragma unroll
    for (int j = 0; j < 4; ++j) { const f32x4 g = gr[64 * j];
        o8[64 * j] = (unsigned long long)pk2(v[j].x * rstd * g.x, v[j].y * rstd * g.y) | ((unsigned long long)pk2(v[j].z * rstd * g.z, v[j].w * rstd * g.w) << 32);
        if (HALF_COPY) ((LAS unsigned*)hrow + lane)[64 * j] = pk8(v[j].x * rstd * g.x, v[j].y * rstd * g.y, v[j].z * rstd * g.z, v[j].w * rstd * g.w); }
}

template <int S> __device__ __forceinline__ int shfl_xor_c(int v) {
    if constexpr (S == 1) return __builtin_amdgcn_mov_dpp(v, 0xB1, 0xF, 0xF, true);
    else if constexpr (S == 2) return __builtin_amdgcn_mov_dpp(v, 0x4E, 0xF, 0xF, true);
    else if constexpr (S == 4) return __builtin_amdgcn_mov_dpp(__builtin_amdgcn_mov_dpp(v, 0x1B, 0xF, 0xF, true), 0x141, 0xF, 0xF, true);
    else if constexpr (S == 8) return __builtin_amdgcn_mov_dpp(__builtin_amdgcn_mov_dpp(v, 0x141, 0xF, 0xF, true), 0x140, 0xF, 0xF, true);
    else return __shfl_xor(v, S);
}
template <int SIZE, int STRIDE> __device__ __forceinline__ void sort128_level(int& k0, int& k1, int lane) {
    if constexpr (STRIDE == 64) { const int mn = min(k0, k1), mxv = max(k0, k1); k0 = mn; k1 = mxv; }
    else {
        const bool lower = (lane & STRIDE) == 0;
        { const int o = shfl_xor_c<STRIDE>(k0); const bool up = ((lane & SIZE) == 0); k0 = (lower == up) ? min(k0, o) : max(k0, o); }
        { const int o = shfl_xor_c<STRIDE>(k1); const bool up = (((64 + lane) & SIZE) == 0); k1 = (lower == up) ? min(k1, o) : max(k1, o); }
    }
}
template <int SIZE, int STRIDE> __device__ __forceinline__ void sort128_merge(int& k0, int& k1, int lane) {
    sort128_level<SIZE, STRIDE>(k0, k1, lane);
    if constexpr (STRIDE > 1) sort128_merge<SIZE, STRIDE / 2>(k0, k1, lane);
}
template <int SIZE> __device__ __forceinline__ void sort128_from(int& k0, int& k1, int lane) {
    sort128_merge<SIZE, SIZE / 2>(k0, k1, lane);
    if constexpr (SIZE < 128) sort128_from<SIZE * 2>(k0, k1, lane);
}

__device__ __forceinline__ void ce_desc(float& a, float& b) { const float mx = fmax_s(a, b), mn = fmin_s(a, b); a = mx; b = mn; }
__device__ __forceinline__ void sort16_desc(float (&v)[16]) {
#pragma unroll
    for (int k = 2; k <= 16; k <<= 1) {
#pragma unroll
        for (int j = k >> 1; j > 0; j >>= 1) {
#pragma unroll
            for (int i = 0; i < 16; ++i) { const int l = i ^ j; if (l > i) { if ((i & k) == 0) ce_desc(v[i], v[l]); else ce_desc(v[l], v[i]); } }
        }
    }
}
__device__ __forceinline__ void merge16_desc(float (&a)[16], const float (&b)[16]) {
#pragma unroll
    for (int i = 0; i < 16; ++i) a[i] = fmax_s(a[i], b[15 - i]);
#pragma unroll
    for (int j = 8; j > 0; j >>= 1) {
#pragma unroll
        for (int i = 0; i < 16; ++i) { const int l = i ^ j; if (l > i) ce_desc(a[i], a[l]); }
    }
}
__device__ __forceinline__ float gelu_erf(float v) {
    const float av = fabsf(v), t = __builtin_amdgcn_rcpf(av * 0.2316418882f + 1.0f);
    float q = t * 0.5307027145f + (-0.7265760135f); q = q * t + 0.7107068705f; q = q * t + (-0.142248368f); q = q * t + 0.127414796f; q = q * t;
    const float e = __builtin_amdgcn_exp2f((v * v) * (-0.72134752044f));
    const float m = v * (q * e);
    return v < 0.f ? m : v - m;
}

struct Args { const void* in[20]; float* out; unsigned char* ws; int ph_lo, ph_hi, li, pad; };
__global__ void __launch_bounds__(NWAVES * 64, 2) hymba_fwd(Args args) {
    extern __shared__ __attribute__((aligned(16))) unsigned char lds[];
    LAS unsigned char* const ldsl = (LAS unsigned char*)lds;
    volatile LAS unsigned* const MISC = (volatile LAS unsigned*)(ldsl + MISC_OFF);
    const int tid = threadIdx.x, lane = tid & 63, wave = __builtin_amdgcn_readfirstlane(tid >> 6);
    const int G = gridDim.x; const int bx = blockIdx.x; const int vcu = (G % 8 == 0) ? (bx % 8) * (G / 8) + bx / 8 : bx;
    const int gw = vcu * NWAVES + wave, NGW = G * NWAVES;
    const int gt = vcu * (NWAVES * 64) + tid, NGT = G * NWAVES * 64;
    const int r32 = lane & 31, hi = lane >> 5;
#define PHASE_LOCALS int tid_o_ = threadIdx.x; asm volatile("" : "+v"(tid_o_)); const int tid = tid_o_, lane = tid & 63, r32 = lane & 31, hi = lane >> 5; const int gt = vcu * (NWAVES * 64) + tid; (void)r32; (void)hi; (void)gt; (void)lane;
    unsigned char* const ws = args.ws;
    gu32* const ctl = (gu32*)(ws + WS_CTL);
    const float* x = (const float*)args.in[0]; const int* positions = (const int*)args.in[1]; const float* g_mix = (const float*)args.in[2]; const float* w_in = (const float*)args.in[3];
    const float* w_gate = (const float*)args.in[4]; const float* b_gate = (const float*)args.in[5]; const float* g_gla_out = (const float*)args.in[6]; const float* g_q = (const float*)args.in[7];
    const float* g_k = (const float*)args.in[8]; const float* lq1 = (const float*)args.in[9]; const float* lk1 = (const float*)args.in[10]; const float* lq2 = (const float*)args.in[11];
    const float* lk2 = (const float*)args.in[12]; const float* g_sub = (const float*)args.in[13]; const float* w_out = (const float*)args.in[14]; const float* g_ffn = (const float*)args.in[15];
    const float* w_pq = (const float*)args.in[16]; const float* sub_keys = (const float*)args.in[17]; const float* peer_u = (const float*)args.in[18]; const float* peer_v = (const float*)args.in[19];
    float* const out = args.out;
    bf16* const Win_t = (bf16*)(ws + WS_WIN); bf16* const Wout_t = (bf16*)(ws + WS_WOUT); bf16* const Wq_t = (bf16*)(ws + WS_WQ); bf16* const KEYS = (bf16*)(ws + WS_KEYS);
    bf16* const KVT = (bf16*)(ws + WS_KVT); bf16* const VT = (bf16*)(ws + WS_VT); bf16* const UB = (bf16*)(ws + WS_U); bf16* const VB = (bf16*)(ws + WS_V);
    bf16* const XN = (bf16*)(ws + WS_XN); bf16* const MIX = (bf16*)(ws + WS_MIX); bf16* const PROJ = (bf16*)(ws + WS_PROJ); bf16* const XN2 = (bf16*)(ws + WS_XN2);
    bf16* const QP = (bf16*)(ws + WS_QP); bf16* const OAT = (bf16*)(ws + WS_O); int* const IDX = (int*)(ws + WS_IDX);
    unsigned* const SGE = (unsigned*)(ws + WS_SGE); unsigned* const AE = (unsigned*)(ws + WS_AE); unsigned char* const OFFS = ws + WS_OFFS; bf16* const XT = (bf16*)(ws + WS_XT); unsigned* const AE2 = (unsigned*)(ws + WS_AE2); unsigned char* const CNT = ws + WS_CNT;
    bf16* const UH = UB; bf16* const VH = VB;
    float* const SSP = (float*)(ws + WS_SSP); float* const RSTD = (float*)(ws + WS_RSTD);
    bf16* const KTT = (bf16*)(ws + WS_KTT); float* const DEC = (float*)(ws + WS_DEC); float* const ROPE_C = (float*)(ws + WS_ROPE); float* const ROPE_S = ROPE_C + TOK * 8;

    for (int u = tid; u < (LDS_BYTES - LDSCTL_OFF) / 4; u += NWAVES * 64) ((LAS unsigned*)(ldsl + LDSCTL_OFF))[u] = 0u;
    __syncthreads();
    XcdBarrier bar; bar.bar = (unsigned*)(ctl + CW_BAR); bar.x = 0; bar.st = nullptr;
    if (N_LAUNCHES == 1) bar = xcd_barrier_post((unsigned*)(ctl + CW_BAR), MISC + 8);
#define GRID_BAR() do { if (N_LAUNCHES == 1) { xcd_barrier(bar); } } while (0)
    const int lo = args.ph_lo, hi_ph = args.ph_hi;
#ifndef PHASE_MASK
#define PHASE_MASK 0x1fff
#endif
#define IN(k) (((PHASE_MASK >> (k)) & 1) && lo <= (k) && (k) < hi_ph)
#define BOTH(k) (IN(k) && IN((k) + 1))

    if (IN(0)) {
        PHASE_LOCALS
        LAS float* scr = (LAS float*)(ldsl + RING_OFF + wave * 16384);
        for (int it = gw; it < 3072; it += NGW) {
            int r = it;
            if (r < 512) { transpose_item(w_in, IN_W, DMODEL, Win_t, 0, scr, r >> 5, r & 31, lane); continue; } r -= 512;
            if (r < 1024) { transpose_item(w_in + 1040, IN_W, DMODEL, Win_t, 1280, scr, r >> 6, r & 63, lane); continue; } r -= 1024;
            if (r < 512) { transpose_item(w_out, DMODEL, DMODEL, Wout_t, 0, scr, r >> 5, r & 31, lane); continue; } r -= 512;
            transpose_item(w_pq, NQP, DMODEL, Wq_t, 0, scr, r >> 6, r & 63, lane, g_ffn);
        }
        for (int task = gt; task < 32768; task += NGT) {
            const int n = task >> 7, k0 = (task & 127) * 8;
            float wg[16];
#pragma unroll
            for (int r = 0; r < 16; ++r) wg[r] = w_gate[r * 256 + n];
            float acc[8];
#pragma unroll
            for (int j = 0; j < 8; ++j) { const f32x4* wr = (const f32x4*)(w_in + (size_t)(k0 + j) * IN_W + 1024); float a = 0.f;
#pragma unroll
                for (int q = 0; q < 4; ++q) { const f32x4 w4 = wr[q]; a += w4.x * wg[4 * q] + w4.y * wg[4 * q + 1] + w4.z * wg[4 * q + 2] + w4.w * wg[4 * q + 3]; }
                acc[j] = a; }
            v4u o; o.x = pk2(acc[0], acc[1]); o.y = pk2(acc[2], acc[3]); o.z = pk2(acc[4], acc[5]); o.w = pk2(acc[6], acc[7]);
            *(v4u*)(Win_t + (size_t)(1024 + n) * DMODEL + k0) = o;
        }
        for (int task = gt; task < 32768; task += NGT) {
            const f32x4 a = ((const f32x4*)sub_keys)[2 * task], b = ((const f32x4*)sub_keys)[2 * task + 1];
            v4u o; o.x = pk2(a.x, a.y); o.y = pk2(a.z, a.w); o.z = pk2(b.x, b.y); o.w = pk2(b.z, b.w); ((v4u*)KEYS)[task] = o;
        }
        for (int task = gt; task < TOK * 8; task += NGT) {
            const int t = task >> 3, i = task & 7;
            const double invf[8] = {1.0, 0.19392274474868576, 0.03760603093086393, 0.007292664737217109, 0.001414213562373095, 0.0002742481756762073, 5.318295896944988e-05, 1.031338537721246e-05};
            double inv = invf[0];
#pragma unroll
            for (int q = 1; q < 8; ++q) inv = (i == q) ? invf[q] : inv;
            const double ang = (double)positions[t] * inv;
            const double rr = ang - 6.283185307179586 * rint(ang * 0.15915494309189535);
            const float rf = (float)rr;
            ROPE_C[task] = cosf(rf); ROPE_S[task] = sinf(rf);
        }
        {
            f32x4 gg[4], vn[4];
#pragma unroll
            for (int j = 0; j < 4; ++j) { gg[j] = ((const f32x4*)g_mix)[lane + 64 * j]; vn[j] = ((const f32x4*)(x + (size_t)gw * DMODEL))[lane + 64 * j]; }
            for (int m = gw; m < TOK; m += NGW) {
                f32x4 v[4]; float sq = 0.f;
#pragma unroll
                for (int j = 0; j < 4; ++j) { v[j] = vn[j]; sq += (v[j].x * v[j].x + v[j].y * v[j].y) + (v[j].z * v[j].z + v[j].w * v[j].w); }
                const int mn = (m + NGW < TOK) ? m + NGW : m;
#pragma unroll
                for (int j = 0; j < 4; ++j) vn[j] = ((const f32x4*)(x + (size_t)mn * DMODEL))[lane + 64 * j];
                const float rstd = 1.f / sqrtf(wave_sum(sq) * (1.f / DMODEL) + RMS_EPS);
                unsigned long long* o8 = (unsigned long long*)(XN + (size_t)m * DMODEL) + lane;
#pragma unroll
                for (int j = 0; j < 4; ++j) o8[64 * j] = (unsigned long long)pk2(v[j].x * rstd * gg[j].x, v[j].y * rstd * gg[j].y) | ((unsigned long long)pk2(v[j].z * rstd * gg[j].z, v[j].w * rstd * gg[j].w) << 32);
            }
        }
        if (BOTH(0)) GRID_BAR();
    }

    if (IN(1)) {
        PHASE_LOCALS
        pg8::Gemm g{XN, Win_t, TOK, NPROJ, DMODEL}; pg8::StaticOrder S; S.init(TOK, NPROJ, G, (int)blockIdx.x);
        pg8::EpiBf16<0> E{PROJ, NPROJ, nullptr, 0, 0, 1.f};
        pg8::gemm_phase<pg8::EpiBf16<0>, pg8::StaticOrder, PG8_ALIGN, PG8_SP2>(ldsl + RING_OFF, g, S, E);
        if (BOTH(1)) GRID_BAR();
    }

    if (IN(2)) {
        PHASE_LOCALS
        for (int u = gw; u < NUNIT; u += NGW) {
            const int g = u >> 2, h = u & 3; const int su = ((g >> 7) * 4 + h) * 128 + (g & 127);
            bf16* const rowp = PROJ + (size_t)(g * 64) * NPROJ;
            const float bg = b_gate[h * 64 + lane];
            float bsum = 0.f;
            unsigned ktt[32], vt0[32], vt1[32];
#pragma unroll
            for (int c0 = 0; c0 < 64; c0 += 16) {
                unsigned zz[16], qq[16], kk[16], va[16], vb[16];
#pragma unroll
                for (int j = 0; j < 16; ++j) { const bf16* const r = rowp + (size_t)(c0 + j) * NPROJ;
                    zz[j] = r[C_GZ + h * 64 + lane]; qq[j] = r[C_GQ + h * 64 + lane]; kk[j] = r[C_GK + h * 64 + lane]; va[j] = r[C_GV + h * 128 + lane]; vb[j] = r[C_GV + h * 128 + 64 + lane]; }
#pragma unroll
                for (int j = 0; j < 16; ++j) { const int c = c0 + j;
                    bf16* const r = rowp + (size_t)c * NPROJ;
                    const float z = bf2f(zz[j]) + bg;
                    const float ls = fminf(z, 0.f) - __logf(1.f + __expf(-fabsf(z)));
                    bsum += ls * (1.f / 16.f);
                    const float eb = __expf(bsum), ebi = __expf(-bsum);
                    const float q = bf2f(qq[j]) * 0.125f * eb;
                    const float kt = bf2f(kk[j]) * ebi;
                    const unsigned ktb = f2bf(kt);
                    r[C_GQ + h * 64 + lane] = (bf16)f2bf(q); r[C_GK + h * 64 + lane] = (bf16)ktb;
                    const unsigned v0 = va[j], v1 = vb[j];
                    if (c & 1) { ktt[c >> 1] |= ktb << 16; vt0[c >> 1] |= v0 << 16; vt1[c >> 1] |= v1 << 16; }
                    else { ktt[c >> 1] = ktb; vt0[c >> 1] = v0; vt1[c >> 1] = v1; }
                }
            }
            DEC[su * 64 + lane] = __expf(bsum);
            v4u* kp = (v4u*)(KTT + ((size_t)u * 64 + lane) * 64); v4u* vp0 = (v4u*)(VT + ((size_t)u * 128 + lane) * 64); v4u* vp1 = (v4u*)(VT + ((size_t)u * 128 + 64 + lane) * 64);
#pragma unroll
            for (int q = 0; q < 8; ++q) { kp[q] = (v4u){ktt[4 * q], ktt[4 * q + 1], ktt[4 * q + 2], ktt[4 * q + 3]};
                vp0[q] = (v4u){vt0[4 * q], vt0[4 * q + 1], vt0[4 * q + 2], vt0[4 * q + 3]}; vp1[q] = (v4u){vt1[4 * q], vt1[4 * q + 1], vt1[4 * q + 2], vt1[4 * q + 3]}; }
        }
        {
            const int v = lane >> 2, qd = lane & 3;
            const int col = (v < 8 ? C_DQ + v * 64 : C_DK + (v - 8) * 64) + qd * 16;
            const float* gp = (v < 8 ? g_q : g_k) + qd * 16;
            float gn[16];
#pragma unroll
            for (int i = 0; i < 16; ++i) gn[i] = gp[i];
            const float osc = (v < 8) ? attn_body::C2 : 1.f;
            v4u w0 = ((const v4u*)(PROJ + (size_t)gw * NPROJ + col))[0], w1 = ((const v4u*)(PROJ + (size_t)gw * NPROJ + col))[1];
            f32x4 rc0 = *(const f32x4*)(ROPE_C + gw * 8), rc1 = *(const f32x4*)(ROPE_C + gw * 8 + 4), rs0 = *(const f32x4*)(ROPE_S + gw * 8), rs1 = *(const f32x4*)(ROPE_S + gw * 8 + 4);
            for (int t = gw; t < TOK; t += NGW) {
                v4u* p = (v4u*)(PROJ + (size_t)t * NPROJ + col);
                const int tn = (t + NGW < TOK) ? t + NGW : t;
                const v4u* pn = (const v4u*)(PROJ + (size_t)tn * NPROJ + col);
                const v4u n0 = pn[0], n1 = pn[1];
                const f32x4 c0 = rc0, c1 = rc1, s0 = rs0, s1 = rs1;
                rc0 = *(const f32x4*)(ROPE_C + tn * 8); rc1 = *(const f32x4*)(ROPE_C + tn * 8 + 4); rs0 = *(const f32x4*)(ROPE_S + tn * 8); rs1 = *(const f32x4*)(ROPE_S + tn * 8 + 4);
                float y[16];
                y[0] = bflo(w0.x); y[1] = bfhi(w0.x); y[2] = bflo(w0.y); y[3] = bfhi(w0.y); y[4] = bflo(w0.z); y[5] = bfhi(w0.z); y[6] = bflo(w0.w); y[7] = bfhi(w0.w);
                y[8] = bflo(w1.x); y[9] = bfhi(w1.x); y[10] = bflo(w1.y); y[11] = bfhi(w1.y); y[12] = bflo(w1.z); y[13] = bfhi(w1.z); y[14] = bflo(w1.w); y[15] = bfhi(w1.w);
                float ss = 0.f;
#pragma unroll
                for (int i = 0; i < 16; ++i) ss += y[i] * y[i];
                ss += __shfl_xor(ss, 1); ss += __shfl_xor(ss, 2);
                const float rstd = 1.f / sqrtf(ss * (1.f / 64.f) + RMS_EPS);
#pragma unroll
                for (int i = 0; i < 16; ++i) y[i] = y[i] * rstd * gn[i];
                if (qd == 0) {
                    const float cs[8] = {c0.x, c0.y, c0.z, c0.w, c1.x, c1.y, c1.z, c1.w}, sn[8] = {s0.x, s0.y, s0.z, s0.w, s1.x, s1.y, s1.z, s1.w};
#pragma unroll
                    for (int i = 0; i < 8; ++i) { const float a = y[i], b = y[i + 8]; y[i] = a * cs[i] - b * sn[i]; y[i + 8] = b * cs[i] + a * sn[i]; }
                }
#pragma unroll
                for (int i = 0; i < 16; ++i) y[i] *= osc;
                p[0] = (v4u){pk2(y[0], y[1]), pk2(y[2], y[3]), pk2(y[4], y[5]), pk2(y[6], y[7])};
                p[1] = (v4u){pk2(y[8], y[9]), pk2(y[10], y[11]), pk2(y[12], y[13]), pk2(y[14], y[15])};
                w0 = n0; w1 = n1;
            }
        }
        if (BOTH(2)) GRID_BAR();
    }

    if (IN(3)) {
        PHASE_LOCALS
        for (int L = vcu; L < 1024; L += G) {
            const int vv = L & 255, i = L >> 8, s = vv & 7, bh = vv >> 3;
            const int qb = (i == 0) ? s : (i == 1) ? 15 - s : (i == 2) ? 16 + s : 31 - s;
            const int b = bh >> 3, hh = (bh & 7) >> 1, mp = bh & 1;
            attn_body2::attn_unit<8>(b, C_DQ + (hh * 2 + mp) * 64, C_DK + (hh * 2 + mp) * 64, C_DV + hh * 128, (hh * 2 + mp) * 128, qb,
                                     (const attn_body2::bf16*)PROJ, (const attn_body2::bf16*)PROJ, (const attn_body2::bf16*)PROJ, (attn_body2::bf16*)OAT, (char*)lds + RING_OFF);
        }
        for (int u = gw; u < NUNIT; u += NGW) {
            const int g = u >> 2, h = u & 3; const int su = ((g >> 7) * 4 + h) * 128 + (g & 127);
            const bf16* vt = VT + (size_t)u * 8192; const bf16* kt = KTT + (size_t)u * 4096;
            f32x16 acc[4][2];
#pragma unroll
            for (int a = 0; a < 4; ++a) { acc[a][0] = f32x16{}; acc[a][1] = f32x16{}; }
#pragma unroll
            for (int k2 = 0; k2 < 4; k2 += 2) {
                bf16x8 af[2][4], bfr[2][2];
#pragma unroll
                for (int kq = 0; kq < 2; ++kq) { const int ks = k2 + kq;
#pragma unroll
                    for (int et = 0; et < 4; ++et) af[kq][et] = *(const bf16x8*)(vt + (et * 32 + r32) * 64 + ks * 16 + hi * 8);
#pragma unroll
                    for (int dt = 0; dt < 2; ++dt) bfr[kq][dt] = *(const bf16x8*)(kt + (dt * 32 + r32) * 64 + ks * 16 + hi * 8); }
                __builtin_amdgcn_sched_barrier(0);
#pragma unroll
                for (int kq = 0; kq < 2; ++kq)
#pragma unroll
                    for (int et = 0; et < 4; ++et)
#pragma unroll
                        for (int dt = 0; dt < 2; ++dt) acc[et][dt] = __builtin_amdgcn_mfma_f32_32x32x16_bf16(af[kq][et], bfr[kq][dt], acc[et][dt], 0, 0, 0);
            }
            bf16* const kv = KVT + (size_t)su * 8192;
            const float dcv[2] = {DEC[su * 64 + r32], DEC[su * 64 + 32 + r32]};
#pragma unroll
            for (int dt = 0; dt < 2; ++dt) { const float dc = dcv[dt];
#pragma unroll
                for (int et = 0; et < 4; ++et)
#pragma unroll
                    for (int r = 0; r < 16; ++r) kv[(et * 32 + crow(r, hi)) * 64 + dt * 32 + r32] = (bf16)f2bf(acc[et][dt][r] * dc); }
        }
        if (BOTH(3)) GRID_BAR();
    }

    if (IN(4)) {
        PHASE_LOCALS
        for (int el = gt; el < 16 * 8192; el += NGT) {
            const int bh = el >> 13, ed = el & 8191, d = ed & 63;
            bf16* p = KVT + (size_t)bh * 128 * 8192 + ed; const float* dp = DEC + bh * 128 * 64 + d;
            float s = 0.f;
            unsigned kva[16], kvb[16]; float dca[16], dcb[16];
#define SCAN_LOAD(KV_, DC_, n0_) do { _Pragma("unroll") for (int j = 0; j < 16; ++j) { KV_[j] = p[(size_t)((n0_) + j) * 8192]; DC_[j] = dp[((n0_) + j) * 64]; } } while (0)
#define SCAN_RUN(KV_, DC_, n0_) do { _Pragma("unroll") for (int j = 0; j < 16; ++j) { const float o = s; s = DC_[j] * s + bf2f(KV_[j]); p[(size_t)((n0_) + j) * 8192] = (bf16)f2bf(o); } } while (0)
            SCAN_LOAD(kva, dca, 0);
#pragma unroll 1
            for (int n0 = 0; n0 < 128; n0 += 32) {
                SCAN_LOAD(kvb, dcb, n0 + 16);
                SCAN_RUN(kva, dca, n0);
                if (n0 + 32 < 128) SCAN_LOAD(kva, dca, n0 + 32);
                SCAN_RUN(kvb, dcb, n0 + 16);
            }
#undef SCAN_LOAD
#undef SCAN_RUN
        }
        if (BOTH(4)) GRID_BAR();
    }

    if (IN(5)) {
        PHASE_LOCALS
        for (int u = gw; u < NUNIT; u += NGW) {
            const int g = u >> 2, h = u & 3; const int su = ((g >> 7) * 4 + h) * 128 + (g & 127);
            const bf16* vt = VT + (size_t)u * 8192; const bf16* st = KVT + (size_t)su * 8192;
            const bf16* qtp = PROJ + (size_t)(g * 64) * NPROJ + C_GQ + h * 64; const bf16* ktp = PROJ + (size_t)(g * 64) * NPROJ + C_GK + h * 64;
#pragma unroll
            for (int ct = 0; ct < 2; ++ct) {
                bf16x8 qf[4];
#pragma unroll
                for (int ks = 0; ks < 4; ++ks) qf[ks] = *(const bf16x8*)(qtp + (size_t)(ct * 32 + r32) * NPROJ + ks * 16 + hi * 8);
                f32x16 o[4];
#pragma unroll
                for (int et = 0; et < 4; ++et) o[et] = f32x16{};
                bf16x8 sf[4][4], kfa[2][4];
#pragma unroll
                for (int ks = 0; ks < 4; ++ks)
#pragma unroll
                    for (int et = 0; et < 4; ++et) sf[ks][et] = *(const bf16x8*)(st + (et * 32 + r32) * 64 + ks * 16 + hi * 8);
#pragma unroll
                for (int stl = 0; stl <= ct; ++stl)
#pragma unroll
                    for (int ks = 0; ks < 4; ++ks) kfa[stl][ks] = *(const bf16x8*)(ktp + (size_t)(stl * 32 + r32) * NPROJ + ks * 16 + hi * 8);
                __builtin_amdgcn_sched_barrier(0);
#pragma unroll
                for (int ks = 0; ks < 4; ++ks)
#pragma unroll
                    for (int et = 0; et < 4; ++et) o[et] = __builtin_amdgcn_mfma_f32_32x32x16_bf16(sf[ks][et], qf[ks], o[et], 0, 0, 0);
#pragma unroll
                for (int stl = 0; stl <= ct; ++stl) {
                    v4u vfa[2][4];
#pragma unroll
                    for (int kk = 0; kk < 2; ++kk)
#pragma unroll
                        for (int et = 0; et < 4; ++et) { const bf16* ap = vt + (et * 32 + r32) * 64 + stl * 32 + 16 * kk + 4 * hi;
                            const v2u a0 = *(const v2u*)ap, a1 = *(const v2u*)(ap + 8); vfa[kk][et] = (v4u){a0.x, a0.y, a1.x, a1.y}; }
                    __builtin_amdgcn_sched_barrier(0);
                    f32x16 xx = f32x16{};
#pragma unroll
                    for (int ks = 0; ks < 4; ++ks) xx = __builtin_amdgcn_mfma_f32_32x32x16_bf16(kfa[stl][ks], qf[ks], xx, 0, 0, 0);
                    if (stl == ct) {
#pragma unroll
                        for (int r = 0; r < 16; ++r) if (crow(r, hi) > r32) xx[r] = 0.f;
                    }
#pragma unroll
                    for (int kk = 0; kk < 2; ++kk) {
                        v4u w; w.x = pk2(xx[8 * kk], xx[8 * kk + 1]); w.y = pk2(xx[8 * kk + 2], xx[8 * kk + 3]); w.z = pk2(xx[8 * kk + 4], xx[8 * kk + 5]); w.w = pk2(xx[8 * kk + 6], xx[8 * kk + 7]);
                        const bf16x8 pb = __builtin_bit_cast(bf16x8, w);
#pragma unroll
                        for (int et = 0; et < 4; ++et) o[et] = __builtin_amdgcn_mfma_f32_32x32x16_bf16(__builtin_bit_cast(bf16x8, vfa[kk][et]), pb, o[et], 0, 0, 0);
                    }
                }
                float ss = 0.f;
#pragma unroll
                for (int et = 0; et < 4; ++et)
#pragma unroll
                    for (int r = 0; r < 16; ++r) ss += o[et][r] * o[et][r];
                ss += __shfl_xor(ss, 32);
                const float rstd = 1.f / sqrtf(ss * (1.f / 128.f) + RMS_EPS);
                const int t = g * 64 + ct * 32 + r32;
                LAS unsigned char* const stg = ldsl + wave * 8448;
                { v4u gt[8];
#pragma unroll
                  for (int i = 0; i < 8; ++i) { const int row = i * 4 + (lane >> 4), ch = lane & 15; gt[i] = *(const v4u*)(PROJ + (size_t)(g * 64 + ct * 32 + row) * NPROJ + C_GR + h * 128 + ch * 8); }
#pragma unroll
                  for (int i = 0; i < 8; ++i) { const int row = i * 4 + (lane >> 4), ch = lane & 15; LAS v2u* p = (LAS v2u*)(stg + row * 264 + ch * 16); p[0] = (v2u){gt[i].x, gt[i].y}; p[1] = (v2u){gt[i].z, gt[i].w}; } }
                f32x4 goa[16];
#pragma unroll
                for (int i = 0; i < 16; ++i) { const int e0 = (i >> 2) * 32 + 8 * (i & 3) + 4 * hi; goa[i] = *(const f32x4*)(g_gla_out + e0); }
#pragma unroll
                for (int et = 0; et < 4; ++et)
#pragma unroll
                    for (int q4 = 0; q4 < 4; ++q4) {
                        const int e0 = et * 32 + 8 * q4 + 4 * hi;
                        LAS v2u* const gp = (LAS v2u*)(stg + r32 * 264 + e0 * 2);
                        const v2u gw2 = *gp;
                        const f32x4 go = goa[et * 4 + q4];
                        const float gr0 = bflo(gw2.x), gr1 = bfhi(gw2.x), gr2 = bflo(gw2.y), gr3 = bfhi(gw2.y);
                        const float y0 = o[et][4 * q4] * rstd * go.x * (gr0 / (1.f + __expf(-gr0)));
                        const float y1 = o[et][4 * q4 + 1] * rstd * go.y * (gr1 / (1.f + __expf(-gr1)));
                        const float y2 = o[et][4 * q4 + 2] * rstd * go.z * (gr2 / (1.f + __expf(-gr2)));
                        const float y3 = o[et][4 * q4 + 3] * rstd * go.w * (gr3 / (1.f + __expf(-gr3)));
                        *gp = (v2u){pk2(y0, y1), pk2(y2, y3)};
                    }
#pragma unroll
                for (int i = 0; i < 8; ++i) { const int row = i * 4 + (lane >> 4), ch = lane & 15; const LAS v2u* p = (const LAS v2u*)(stg + row * 264 + ch * 16); const v2u a0 = p[0], a1 = p[1];
                    *(v4u*)(MIX + (size_t)(g * 64 + ct * 32 + row) * DMODEL + h * 128 + ch * 8) = (v4u){a0.x, a0.y, a1.x, a1.y}; }
            }
        }
        {
            const float s1 = wave_sum(lq1[lane] * lk1[lane]), s2 = wave_sum(lq2[lane] * lk2[lane]);
            const float lam = expf(s1) - expf(s2) + LAMBDA_INIT;
            const int hh = lane >> 4, e0 = (lane & 15) * 8;
            const f32x4 ga = *(const f32x4*)(g_sub + e0), gb = *(const f32x4*)(g_sub + e0 + 4);
            const float gs[8] = {ga.x, ga.y, ga.z, ga.w, gb.x, gb.y, gb.z, gb.w};
            v4u a = *(const v4u*)(OAT + (size_t)gw * 2048 + (hh * 2) * 128 + e0), b = *(const v4u*)(OAT + (size_t)gw * 2048 + (hh * 2 + 1) * 128 + e0);
            for (int t = gw; t < TOK; t += NGW) {
                const int tn = (t + NGW < TOK) ? t + NGW : t;
                const v4u an = *(const v4u*)(OAT + (size_t)tn * 2048 + (hh * 2) * 128 + e0), bn = *(const v4u*)(OAT + (size_t)tn * 2048 + (hh * 2 + 1) * 128 + e0);
                float y[8];
                y[0] = bflo(a.x) - lam * bflo(b.x); y[1] = bfhi(a.x) - lam * bfhi(b.x); y[2] = bflo(a.y) - lam * bflo(b.y); y[3] = bfhi(a.y) - lam * bfhi(b.y);
                y[4] = bflo(a.z) - lam * bflo(b.z); y[5] = bfhi(a.z) - lam * bfhi(b.z); y[6] = bflo(a.w) - lam * bflo(b.w); y[7] = bfhi(a.w) - lam * bfhi(b.w);
                float ss = 0.f;
#pragma unroll
                for (int i = 0; i < 8; ++i) ss += y[i] * y[i];
                ss += __shfl_xor(ss, 1); ss += __shfl_xor(ss, 2); ss += __shfl_xor(ss, 4); ss += __shfl_xor(ss, 8);
                const float rstd = (1.f - LAMBDA_INIT) / sqrtf(ss * (1.f / 128.f) + RMS_EPS);
#pragma unroll
                for (int i = 0; i < 8; ++i) y[i] = y[i] * rstd * gs[i];
                *(v4u*)(MIX + (size_t)t * DMODEL + 512 + hh * 128 + e0) = (v4u){pk2(y[0], y[1]), pk2(y[2], y[3]), pk2(y[4], y[5]), pk2(y[6], y[7])};
                a = an; b = bn;
            }
        }
        if (BOTH(5)) GRID_BAR();
    }

    if (IN(6)) {
        PHASE_LOCALS
        constexpr int NVT = PEER_N * DMODEL / 8, NUT = PEER_N * DMODEL / 16;
        for (int task0 = gt; task0 < NVT; task0 += 4 * NGT) {
            f32x4 a[4], b[4]; int oo[4];
#pragma unroll
            for (int j = 0; j < 4; ++j) { const int o = task0 + j * NGT; oo[j] = o; if (o < NVT) { const int sl_ = o >> 17, r_ = (o >> 3) & (PEER_N - 1), c_ = o & 7;
                const int e_ = ((((r_ >> 7) - (r_ & 127)) & 127) << 7) | (r_ & 127);
                const f32x4* src = (const f32x4*)peer_v + (size_t)e_ * 256 + (sl_ * 8 + c_) * 2; a[j] = src[0]; b[j] = src[1]; } }
#pragma unroll
            for (int j = 0; j < 4; ++j) if (oo[j] < NVT) ((v4u*)VB)[oo[j]] = (v4u){pkh(a[j].x, a[j].y), pkh(a[j].z, a[j].w), pkh(b[j].x, b[j].y), pkh(b[j].z, b[j].w)};
        }
        for (int task0 = gt; task0 < NUT; task0 += 2 * NGT) {
            f32x4 a[2], b[2], c[2], d[2], ga[2], gb[2], gc[2], gd[2]; int oo[2];
#pragma unroll
            for (int j = 0; j < 2; ++j) { const int o = task0 + j * NGT; oo[j] = o; if (o < NUT) { const int sl_ = o >> 16, r_ = (o >> 2) & (PEER_N - 1), c_ = o & 3;
                const int e_ = ((((r_ >> 7) - (r_ & 127)) & 127) << 7) | (r_ & 127);
                const f32x4* src = (const f32x4*)peer_u + (size_t)e_ * 256 + (sl_ * 4 + c_) * 4; const f32x4* gs_ = (const f32x4*)g_ffn + (sl_ * 4 + c_) * 4;
                a[j] = src[0]; b[j] = src[1]; c[j] = src[2]; d[j] = src[3]; ga[j] = gs_[0]; gb[j] = gs_[1]; gc[j] = gs_[2]; gd[j] = gs_[3]; } }
#pragma unroll
            for (int j = 0; j < 2; ++j) if (oo[j] < NUT) { const f32x4 a_ = a[j] * 32.f * ga[j], b_ = b[j] * 32.f * gb[j], c_ = c[j] * 32.f * gc[j], d_ = d[j] * 32.f * gd[j];
                ((v4u*)UB)[oo[j]] = (v4u){pk8(a_.x, a_.y, a_.z, a_.w), pk8(b_.x, b_.y, b_.z, b_.w), pk8(c_.x, c_.y, c_.z, c_.w), pk8(d_.x, d_.y, d_.z, d_.w)}; }
        }
        pg8::Gemm g{MIX, Wout_t, TOK, DMODEL, DMODEL}; pg8::StaticOrder S; S.init(TOK, DMODEL, G, (int)blockIdx.x);
        pg8::EpiResF32X E{x, DMODEL, XN2, (unsigned char*)XT, SSP, TOK};
        pg8::gemm_phase<pg8::EpiResF32X, pg8::StaticOrder, PG8_ALIGN, PG8_SP2>(ldsl + RING_OFF, g, S, E);
        if (BOTH(6)) GRID_BAR();
    }


    if (IN(8)) {
        PHASE_LOCALS
        pg8::Gemm g{XN2, Wq_t, TOK, NQP, DMODEL}; pg8::StaticOrder S; S.init(TOK, NQP, G, (int)blockIdx.x);
        pg8::EpiBf16Row E{QP, NQP, SSP, RSTD, RMS_EPS, 1.f / DMODEL};
        pg8::gemm_phase<pg8::EpiBf16Row, pg8::StaticOrder, PG8_ALIGN, PG8_SP2>(ldsl + RING_OFF, g, S, E);
        if (BOTH(8)) GRID_BAR();
    }

    if (IN(9)) {
        PHASE_LOCALS
        const int nper = G / 8;
        const int head = vcu % 8, part = vcu / 8;
        for (int c = tid; c < 4096; c += NWAVES * 64) {
            const int p = c >> 11, row = (c >> 4) & 127, ch = c & 15;
            const v4u v = *(const v4u*)(KEYS + ((size_t)(head * 2 + p) * 128 + row) * 128 + ch * 8);
            *(LAS v4u*)(ldsl + p * 32768 + row * 256 + ((ch ^ (row & 15)) * 16)) = v;
        }
        __syncthreads();
        LAS unsigned* const lscr = (LAS unsigned*)(ldsl + 65536 + wave * 8192);
        for (int tg = part * NWAVES + wave; tg < TOK / 32; tg += nper * NWAVES) {
            const int t0 = tg * 32;
            float top[2][16];
#pragma unroll
            for (int p = 0; p < 2; ++p) {
                bf16x8 qf[8];
#pragma unroll
                for (int ks = 0; ks < 8; ++ks) qf[ks] = *(const bf16x8*)(QP + (size_t)(t0 + r32) * NQP + head * 256 + p * 128 + ks * 16 + hi * 8);
                float sc[4][16];
#pragma unroll
                for (int tile = 0; tile < 4; ++tile) {
                    f32x16 acc = f32x16{};
#pragma unroll
                    for (int ks = 0; ks < 8; ++ks) {
                        const bf16x8 kf = *(const LAS bf16x8*)(ldsl + p * 32768 + (tile * 32 + r32) * 256 + (((2 * ks + hi) ^ (r32 & 15)) * 16));
                        acc = __builtin_amdgcn_mfma_f32_32x32x16_bf16(kf, qf[ks], acc, 0, 0, 0);
                    }
#pragma unroll
                    for (int r = 0; r < 16; ++r) { const unsigned kid = (unsigned)(tile * 32 + crow(r, hi));
                        const float av = acc[r];
                        sc[tile][r] = __uint_as_float((__float_as_uint(av) & 0xffffff80u) | (127u - kid)); }
                    sort16_desc(sc[tile]);
                }
                merge16_desc(sc[0], sc[1]); merge16_desc(sc[2], sc[3]); merge16_desc(sc[0], sc[2]);
                float ot[16];
#pragma unroll
                for (int i = 0; i < 16; ++i) ot[i] = __shfl_xor(sc[0][i], 32);
                merge16_desc(sc[0], ot);
#pragma unroll
                for (int i = 0; i < 16; ++i) top[p][i] = sc[0][i];
            }
#pragma unroll
            for (int i = 0; i < 16; ++i) { lscr[i * 64 + lane] = 127u - (__float_as_uint(top[0][i]) & 127u); lscr[(16 + i) * 64 + lane] = 127u - (__float_as_uint(top[1][i]) & 127u); }
            float v0[16], v1[16];
#pragma unroll
            for (int i = 0; i < 16; ++i) { v0[i] = __uint_as_float(__float_as_uint(top[0][i]) & 0xffffff80u); v1[i] = __uint_as_float(__float_as_uint(top[1][i]) & 0xffffff80u); }
#define CAND(i, j) __uint_as_float((__float_as_uint(v0[i] + v1[j]) & 0xffffff00u) | (255u - (unsigned)((i) * 16 + (j))))
            const float NEGB = -3.0e38f;
            float cA[16], cB[16], cC[16], cD[16];
#pragma unroll
            for (int j = 0; j < 16; ++j) cA[j] = CAND(0, j);
#pragma unroll
            for (int j = 0; j < 8; ++j) cB[j] = CAND(1, j);
#pragma unroll
            for (int j = 0; j < 5; ++j) cB[8 + j] = CAND(2, j);
            cB[13] = NEGB; cB[14] = NEGB; cB[15] = NEGB;
#pragma unroll
            for (int j = 0; j < 4; ++j) cC[j] = CAND(3, j);
#pragma unroll
            for (int j = 0; j < 3; ++j) cC[4 + j] = CAND(4, j);
            cC[7] = CAND(5, 0); cC[8] = CAND(5, 1); cC[9] = CAND(6, 0); cC[10] = CAND(6, 1); cC[11] = CAND(7, 0); cC[12] = CAND(7, 1);
            cC[13] = NEGB; cC[14] = NEGB; cC[15] = NEGB;
            cD[0] = CAND(8, 0); cD[1] = CAND(9, 0); cD[2] = CAND(10, 0); cD[3] = CAND(11, 0); cD[4] = CAND(12, 0); cD[5] = CAND(13, 0); cD[6] = CAND(14, 0); cD[7] = CAND(15, 0);
#pragma unroll
            for (int j = 8; j < 16; ++j) cD[j] = NEGB;
#undef CAND
            sort16_desc(cB); sort16_desc(cC); sort16_desc(cD);
            merge16_desc(cA, cB); merge16_desc(cC, cD); merge16_desc(cA, cC);
            LDS_WAIT();
            float gv[16]; int ex[16]; float gsum = 0.f;
            const float mx = __uint_as_float(__float_as_uint(cA[0]) & 0xffffff00u);
#pragma unroll
            for (int w = 0; w < 16; ++w) {
                const unsigned bits = __float_as_uint(cA[w]); const unsigned code = 255u - (bits & 255u);
                const float val = __uint_as_float(bits & 0xffffff00u);
                gv[w] = __expf(val - mx); gsum += gv[w];
                const unsigned e0 = lscr[(code >> 4) * 64 + lane], e1 = lscr[(16 + (code & 15)) * 64 + lane];
                ex[w] = (int)(e0 * 128u + e1);
            }
            const float ginv = 1.f / gsum;
            const size_t ob = (size_t)(t0 + r32) * 128 + head * 16;
#pragma unroll
            for (int q = 0; q < 4; ++q) if ((q >> 1) == hi)
                *(v4u*)(IDX + ob + 4 * q) = (v4u){(f2bf(gv[4 * q] * ginv) << 16) | (unsigned)ex[4 * q], (f2bf(gv[4 * q + 1] * ginv) << 16) | (unsigned)ex[4 * q + 1],
                                                  (f2bf(gv[4 * q + 2] * ginv) << 16) | (unsigned)ex[4 * q + 2], (f2bf(gv[4 * q + 3] * ginv) << 16) | (unsigned)ex[4 * q + 3]};
            LDS_WAIT();
        }
        if (BOTH(9)) GRID_BAR();
    }

    if (IN(10)) {
        PHASE_LOCALS
        LAS int* const hst = (LAS int*)(ldsl + wave * 256);
        int w0n = IDX[(size_t)gw * 128 + lane], w1n = IDX[(size_t)gw * 128 + 64 + lane];
        for (int t = gw; t < TOK; t += NGW) {
            const int w0 = w0n, w1 = w1n;
            { const int tn = (t + NGW < TOK) ? t + NGW : t; w0n = IDX[(size_t)tn * 128 + lane]; w1n = IDX[(size_t)tn * 128 + 64 + lane]; }
            const int x0 = w0 & 0xffff, x1 = w1 & 0xffff;
            const int r0 = ((((x0 >> 7) + (x0 & 127)) & 127) << 7) | (x0 & 127), r1 = ((((x1 >> 7) + (x1 & 127)) & 127) << 7) | (x1 & 127);
            const int b0 = r0 >> 9, b1 = r1 >> 9;
            if (lane < 32) hst[lane] = 0;
            const int rk0 = __hip_atomic_fetch_add(hst + b0, 1, __ATOMIC_RELAXED, __HIP_MEMORY_SCOPE_WORKGROUP);
            const int rk1 = __hip_atomic_fetch_add(hst + b1, 1, __ATOMIC_RELAXED, __HIP_MEMORY_SCOPE_WORKGROUP);
            const int myc = __hip_atomic_load(hst + (lane & 31), __ATOMIC_RELAXED, __HIP_MEMORY_SCOPE_WORKGROUP);
            int incl = myc;
#pragma unroll
            for (int o = 1; o < 32; o <<= 1) { const int v = __shfl_up(incl, o); if ((lane & 31) >= o) incl += v; }
            if (lane < 32) { OFFS[(size_t)t * 32 + lane] = (unsigned char)(incl - myc); __hip_atomic_store(hst + 32 + lane, incl - myc, __ATOMIC_RELAXED, __HIP_MEMORY_SCOPE_WORKGROUP); }
            const int o0 = __hip_atomic_load(hst + 32 + b0, __ATOMIC_RELAXED, __HIP_MEMORY_SCOPE_WORKGROUP), o1 = __hip_atomic_load(hst + 32 + b1, __ATOMIC_RELAXED, __HIP_MEMORY_SCOPE_WORKGROUP);
            SGE[(size_t)t * 128 + o0 + rk0] = ((unsigned)w0 & 0xffff0000u) | (unsigned)r0; SGE[(size_t)t * 128 + o1 + rk1] = ((unsigned)w1 & 0xffff0000u) | (unsigned)r1;
        }
        if (BOTH(10)) GRID_BAR();
    }

    if (IN(11)) {
        PHASE_LOCALS
        constexpr int NC = 112, NTL = 7;
        LAS unsigned* const GCOL = (LAS unsigned*)(ldsl + 132096);
        LAS unsigned* const GW = (LAS unsigned*)(ldsl + 132096 + 32 * NC * 4);
        LAS int* const gcnt = (LAS int*)(ldsl + 132096 + 2 * 32 * NC * 4);
        const unsigned lds0 = (unsigned)(uintptr_t)lds;
        const unsigned u_lane_off = (unsigned)(lane >> 2) * 64u + (unsigned)(((lane & 3) ^ ((lane >> 4) & 3)) * 16);
        for (int k = 0; k < 2048; k += 1) {
            int tb, eb;
            if (G == 256) { if (k >= 8) break; eb = vcu & 31; tb = 8 * (vcu >> 5) + (((vcu & 31) + k) & 7); }
            else { const int task = vcu + k * G; if (task >= 2048) break; tb = task >> 5; eb = task & 31; }
            const int t = tb * 512 + tid;
            const unsigned char* usrc = (const unsigned char*)UH + (size_t)eb * 512 * 64;
            const unsigned char* xsrc = (const unsigned char*)XT + ((size_t)tb * 512) * 8;
#define DMA_UX(hs_, buf_) do { unsigned ulo_ = u_lane_off, xlo_ = (unsigned)lane * 16u; asm volatile("" : "+v"(ulo_), "+v"(xlo_)); _Pragma("unroll") for (int q_ = 0; q_ < 4; ++q_) { const int j_ = wave + 8 * q_; \
                attn_body::glds16(usrc + ulo_ + (size_t)(hs_) * (PEER_N * 64) + (size_t)j_ * 1024, (unsigned)__builtin_amdgcn_readfirstlane(lds0 + (buf_) * 32768 + j_ * 1024)); \
                attn_body::glds16(xsrc + xlo_ + (size_t)((hs_) * 8 + (j_ >> 2)) * ((size_t)TOK * 8) + (size_t)(j_ & 3) * 1024, (unsigned)__builtin_amdgcn_readfirstlane(lds0 + 65536 + (buf_) * 32896 + (j_ >> 2) * 4112 + (j_ & 3) * 1024)); } } while (0)
            DMA_UX(0, 0);
            for (int c = tid; c < 32 * NC; c += NWAVES * 64) GCOL[c] = 0u;
            if (tid < 32) gcnt[tid] = 0;
            const int p0 = OFFS[(size_t)t * 32 + eb]; const int p1 = (eb < 31) ? (int)OFFS[(size_t)t * 32 + eb + 1] : 128; const int n = p1 - p0;
            unsigned ent[16];
#pragma unroll
            for (int i = 0; i < 16; ++i) ent[i] = (i < n) ? SGE[(size_t)t * 128 + p0 + i] : 0u;
            unsigned tid_o = (unsigned)tid; asm volatile("" : "+v"(tid_o));
            unsigned char* const a2u = (unsigned char*)AE2 + ((size_t)(tb * 32 + eb) * 12) * 2048; const unsigned toff4 = tid_o * 4u;
            CNT[(size_t)(tb * 32 + eb) * 512 + tid] = (unsigned char)n;
            __syncthreads();
            unsigned ovmask = 0u;
#pragma unroll
            for (int i = 0; i < 16; ++i) if (i < n) { const unsigned r = ent[i] & 0xffffu; const int g = (int)((r >> 4) & 31u);
                const int c = __hip_atomic_fetch_add(gcnt + g, 1, __ATOMIC_RELAXED, __HIP_MEMORY_SCOPE_WORKGROUP);
                if (c < NC) { GCOL[g * NC + c] = ((unsigned)tid << 15) | ((unsigned)(p0 + i) << 8) | ((unsigned)i << 4) | (r & 15u); GW[g * NC + c] = ent[i]; } else ovmask |= 1u << i; }
            __syncthreads();
            int cg[4]; unsigned tko[4][NTL]; f32x4 acc[4][NTL];
            const unsigned aoff = (unsigned)((4 * wave) * 16 + (lane & 15)) * 64u + (unsigned)((((lane >> 5) & 1) ^ ((lane >> 2) & 3)) * 16) + (unsigned)((lane >> 4) & 1) * 8u;
#pragma unroll
            for (int gi = 0; gi < 4; ++gi) { const int cc = gcnt[4 * wave + gi]; cg[gi] = __builtin_amdgcn_readfirstlane(cc < NC ? cc : NC);
#pragma unroll
                for (int ct = 0; ct < NTL; ++ct) { tko[gi][ct] = 65536u + (unsigned)(lane >> 4) * 4112u + (GCOL[(4 * wave + gi) * NC + ct * 16 + (lane & 15)] >> 15) * 8u;     acc[gi][ct] = (f32x4){0.f, 0.f, 0.f, 0.f}; } }
#define UPM_COMPUTE(buf_) do { _Pragma("unroll") for (int gi = 0; gi < 4; ++gi) { if (cg[gi] > 0) { \
                const long af0_ = v2l(*(const LAS v2u*)(ldsl + aoff + gi * 1024 + (buf_) * 32768)), af1_ = v2l(*(const LAS v2u*)(ldsl + (aoff ^ 32u) + gi * 1024 + (buf_) * 32768)); \
                _Pragma("unroll") for (int ct = 0; ct < NTL; ++ct) { if (ct * 16 < cg[gi]) { \
                    const long bf0_ = v2l(*(const LAS v2u*)(ldsl + tko[gi][ct] + (buf_) * 32896)), bf1_ = v2l(*(const LAS v2u*)(ldsl + tko[gi][ct] + 16448 + (buf_) * 32896)); \
                    acc[gi][ct] = __builtin_amdgcn_mfma_f32_16x16x32_fp8_fp8(af0_, bf0_, acc[gi][ct], 0, 0, 0); \
                    acc[gi][ct] = __builtin_amdgcn_mfma_f32_16x16x32_fp8_fp8(af1_, bf1_, acc[gi][ct], 0, 0, 0); } } } } } while (0)
#pragma unroll 1
            for (int hs = 0; hs < 16; hs += 2) {
                __builtin_amdgcn_s_waitcnt(0x0F70); __syncthreads();
                DMA_UX(hs + 1, 1);
                UPM_COMPUTE(0);
                __builtin_amdgcn_s_waitcnt(0x0F70); __syncthreads();
                if (hs + 2 < 16) DMA_UX(hs + 2, 0);
                UPM_COMPUTE(1);
            }
#undef UPM_COMPUTE
#undef DMA_UX
#pragma unroll
            for (int gi = 0; gi < 4; ++gi)
#pragma unroll
                for (int ct = 0; ct < NTL; ++ct) if (ct * 16 < cg[gi]) {
                    const int c = ct * 16 + (lane & 15); const unsigned en = GCOL[(4 * wave + gi) * NC + c], gw = GW[(4 * wave + gi) * NC + c];
                    const unsigned row = en & 15u; const f32x4 av = acc[gi][ct];
                    const float hsel = (row & 2u) ? ((row & 1u) ? av.w : av.z) : ((row & 1u) ? av.y : av.x);
                    if (c < cg[gi] && (int)(row >> 2) == (lane >> 4)) {
                        const unsigned tk = en >> 15, pp = (en >> 8) & 127u, ii = (en >> 4) & 15u;
                        const unsigned w = (f2bf(gelu_erf(hsel * (1.f / 32.f) * RSTD[tb * 512 + (int)tk]) * __uint_as_float(gw & 0xffff0000u)) << 16) | (gw & 0xffffu);
                        if (ii < 12u) *(unsigned*)(a2u + (size_t)ii * 2048 + tk * 4u) = w; else AE[((size_t)tb * 512 + tk) * 128 + pp] = w;
                    }
                    __builtin_amdgcn_sched_barrier(0);
                }
            if (__any(n > 16 || ovmask != 0u)) {
                for (int i = 0; i < n; ++i) if (i >= 16 || ((ovmask >> i) & 1u)) { const unsigned en = SGE[(size_t)t * 128 + p0 + i]; const unsigned rr_ = en & 0xffffu; float a_ = 0.f;
                    for (int c = 0; c < 128; ++c) {
                        const v2u r_ = *(const v2u*)((const unsigned char*)UH + ((size_t)(c >> 3) * PEER_N + rr_) * 64 + (c & 7) * 8), x_ = *(const v2u*)((const unsigned char*)XT + ((size_t)c * TOK + t) * 8);
                        const int r0 = (int)r_.x, r1 = (int)r_.y, x0 = (int)x_.x, x1 = (int)x_.y;
                        a_ += __builtin_amdgcn_cvt_f32_fp8(r0, 0) * __builtin_amdgcn_cvt_f32_fp8(x0, 0) + __builtin_amdgcn_cvt_f32_fp8(r0, 1) * __builtin_amdgcn_cvt_f32_fp8(x0, 1)
                            + __builtin_amdgcn_cvt_f32_fp8(r0, 2) * __builtin_amdgcn_cvt_f32_fp8(x0, 2) + __builtin_amdgcn_cvt_f32_fp8(r0, 3) * __builtin_amdgcn_cvt_f32_fp8(x0, 3)
                            + __builtin_amdgcn_cvt_f32_fp8(r1, 0) * __builtin_amdgcn_cvt_f32_fp8(x1, 0) + __builtin_amdgcn_cvt_f32_fp8(r1, 1) * __builtin_amdgcn_cvt_f32_fp8(x1, 1)
                            + __builtin_amdgcn_cvt_f32_fp8(r1, 2) * __builtin_amdgcn_cvt_f32_fp8(x1, 2) + __builtin_amdgcn_cvt_f32_fp8(r1, 3) * __builtin_amdgcn_cvt_f32_fp8(x1, 3); }
                    const unsigned w_ = (f2bf(gelu_erf(a_ * (1.f / 32.f) * RSTD[t]) * __uint_as_float(en & 0xffff0000u)) << 16) | (en & 0xffffu); if (i < 12) *(unsigned*)(a2u + (size_t)i * 2048 + toff4) = w_; else AE[(size_t)t * 128 + p0 + i] = w_; }
            }
            __syncthreads();
        }
        if (BOTH(11)) GRID_BAR();
    }

#define DMA_T(src, ds_, buf_) do { _Pragma("unroll") for (int q_ = 0; q_ < 8; ++q_) { const int j_ = wave + 8 * q_; \
                attn_body::glds16((src) + (size_t)j_ * 1024 + (size_t)(ds_) * (PEER_N * 128), (unsigned)__builtin_amdgcn_readfirstlane(lds0 + (buf_) * 65536 + j_ * 1024)); } } while (0)
#define ROW_READ(R_, ew_, buf_) do { unsigned ea_ = (ew_); asm volatile("" : "+v"(ea_)); const unsigned el_ = ea_ & 511u; \
                const unsigned ra_ = (lds0 + (unsigned)((buf_) * 65536) + el_ * 128u) | l7s;     \
                _Pragma("unroll") for (int c = 0; c < 8; ++c) R_[c] = *(const LAS v4u*)(uintptr_t)(ra_ ^ (unsigned)(c * 16)); } while (0)
    if (IN(12)) {
        PHASE_LOCALS
        const unsigned lds0 = (unsigned)(uintptr_t)lds;
        const unsigned dma_lane_off = (unsigned)lane * 16u;
        unsigned l7 = (unsigned)lane & 7u; asm volatile("" : "+v"(l7));
        unsigned l7s = ((unsigned)lane & 7u) << 4; asm volatile("" : "+v"(l7s));
        for (int k = 0; k < 512; ++k) {
            int tb2, ds;
            if (G == 256) { if (k >= 2) break; const int c_ = vcu & 31; ds = c_ & 15; tb2 = 4 * (vcu >> 5) + (((c_ >> 4) + 2 * k) & 3); }
            else { const int task = vcu + k * G; if (task >= 512) break; tb2 = task >> 4; ds = task & 15; }
            const int tA = tb2 * 1024 + tid, tB = tA + 512;
            h2 accA[32], accB[32];
#pragma unroll
            for (int d = 0; d < 32; ++d) { accA[d] = (h2){(_Float16)0.f, (_Float16)0.f}; accB[d] = (h2){(_Float16)0.f, (_Float16)0.f}; }
            const unsigned char* vsrc = (const unsigned char*)VH + (size_t)ds * (PEER_N * 128) + dma_lane_off;
            const unsigned char* const a2uA = (const unsigned char*)AE2 + ((size_t)(tb2 * 2 * 32) * 12) * 2048;
            const unsigned char* const a2uB = a2uA + (size_t)(32 * 12) * 2048;
            const unsigned char* const cnuA = CNT + (size_t)(tb2 * 2 * 32) * 512; const unsigned char* const cnuB = cnuA + 32 * 512;
            unsigned tid_o = (unsigned)tid; asm volatile("" : "+v"(tid_o));
            const unsigned toff4 = tid_o * 4u, toff1 = tid_o;
#define DN_FMA(ACC_, R_, ew_) do { const _Float16 ah_ = (_Float16)__uint_as_float((ew_) & 0xffff0000u); const h2 a2_ = (h2){ah_, ah_}; _Pragma("unroll") for (int c = 0; c < 8; ++c) { \
                ACC_[4 * c + 0] = u2h(R_[c].x) * a2_ + ACC_[4 * c + 0]; ACC_[4 * c + 1] = u2h(R_[c].y) * a2_ + ACC_[4 * c + 1]; \
                ACC_[4 * c + 2] = u2h(R_[c].z) * a2_ + ACC_[4 * c + 2]; ACC_[4 * c + 3] = u2h(R_[c].w) * a2_ + ACC_[4 * c + 3]; } } while (0)
#define LOAD_ENT(a2u_, cnu_, E_, n_, sb_) do { n_ = *((cnu_) + (size_t)(sb_) * 512 + toff1); _Pragma("unroll") for (int i = 0; i < 12; ++i) E_[i] = *(const unsigned*)((a2u_) + (size_t)((sb_) * 12 + i) * 2048 + toff4); } while (0)
#define DN_BODY(ACC_, tt_, E_, n_, sb_, buf_) do { \
                  _Pragma("unroll") for (int i = 0; i < 12; i += 2) { if (__any(i < n_)) { \
                    e1_ = (i + 1 < n_) ? E_[i + 1] : 0u; ROW_READ(R1, e1_, buf_); \
                    DN_FMA(ACC_, R0, e0_); \
                    if (i + 2 < 12) { e0_ = (i + 2 < n_) ? E_[i + 2] : 0u; ROW_READ(R0, e0_, buf_); } \
                    DN_FMA(ACC_, R1, e1_); } } \
                  if (__any(n_ > 12)) { if (n_ > 12) { const unsigned* ao_ = AE + (size_t)(tt_) * 128 + OFFS[(size_t)(tt_) * 32 + (sb_)]; \
                      for (int i = 12; i < n_; ++i) { const unsigned en_ = ao_[i]; ROW_READ(R0, en_, buf_); DN_FMA(ACC_, R0, en_); } } } } while (0)
#define DN_STEP2(EA_, nA_, EB_, nB_, sb_, buf_, EAn_, nAn_, EBn_, nBn_, has_next_) do { \
                  unsigned e0_ = (0 < nA_) ? EA_[0] : 0u, e1_ = 0u; ROW_READ(R0, e0_, buf_);     \
                  if (has_next_) { DMA_T(vsrc + (size_t)((sb_) + 1) * (512 * 128), 0, 1 - (buf_)); LOAD_ENT(a2uA, cnuA, EAn_, nAn_, (sb_) + 1); LOAD_ENT(a2uB, cnuB, EBn_, nBn_, (sb_) + 1); } \
                  DN_BODY(accA, tA, EA_, nA_, sb_, buf_); \
                  e0_ = (0 < nB_) ? EB_[0] : 0u; ROW_READ(R0, e0_, buf_); \
                  DN_BODY(accB, tB, EB_, nB_, sb_, buf_); } while (0)
            unsigned eA0[12], eB0[12], eA1[12], eB1[12]; int nA0, nB0, nA1, nB1; v4u R0[8], R1[8];
#pragma unroll
            for (int c = 0; c < 8; ++c) { R0[c] = (v4u){0u, 0u, 0u, 0u}; R1[c] = (v4u){0u, 0u, 0u, 0u}; }
            DMA_T(vsrc, 0, 0); LOAD_ENT(a2uA, cnuA, eA0, nA0, 0); LOAD_ENT(a2uB, cnuB, eB0, nB0, 0);
#pragma unroll 1
            for (int sb = 0; sb < 32; sb += 2) {
                __builtin_amdgcn_s_waitcnt(0x0F70); __syncthreads();
                DN_STEP2(eA0, nA0, eB0, nB0, sb, 0, eA1, nA1, eB1, nB1, true);
                __builtin_amdgcn_s_waitcnt(0x0F70); __syncthreads();
                DN_STEP2(eA1, nA1, eB1, nB1, sb + 1, 1, eA0, nA0, eB0, nB0, (sb + 2 < 32));
            }
#undef DN_STEP2
#undef DN_BODY
#undef LOAD_ENT
#undef DN_FMA
#define DN_FINAL(ACC_, tt_) do { int tq_ = (tt_); unsigned l7 = l7o; asm volatile("" : "+v"(tq_), "+v"(l7));     \
            f32x4* op = (f32x4*)(out + (size_t)tq_ * DMODEL + ds * 64); const v4u* hp = (const v4u*)(XN2 + (size_t)tq_ * DMODEL + ds * 64);     \
            v4u hba[8];                                               \
            _Pragma("unroll") for (int c = 0; c < 8; ++c) hba[c] = hp[(unsigned)c ^ l7]; \
            _Pragma("unroll") for (int c = 0; c < 8; ++c) { const unsigned cc = (unsigned)c ^ l7; const v4u hb = hba[c]; \
                f32x4 o0, o1; o0.x = bflo(hb.x) + (float)ACC_[4 * c].x; o0.y = bfhi(hb.x) + (float)ACC_[4 * c].y; o0.z = bflo(hb.y) + (float)ACC_[4 * c + 1].x; o0.w = bfhi(hb.y) + (float)ACC_[4 * c + 1].y; \
                o1.x = bflo(hb.z) + (float)ACC_[4 * c + 2].x; o1.y = bfhi(hb.z) + (float)ACC_[4 * c + 2].y; o1.z = bflo(hb.w) + (float)ACC_[4 * c + 3].x; o1.w = bfhi(hb.w) + (float)ACC_[4 * c + 3].y; \
                op[2 * cc] = o0; op[2 * cc + 1] = o1; } } while (0)
            { const unsigned l7o = l7; DN_FINAL(accA, tA); DN_FINAL(accB, tB); }
#undef DN_FINAL
        }
#undef ROW_READ
#undef DMA_T
    }
#undef IN
#undef BOTH
#undef GRID_BAR
}

extern "C" void kernel_launch(void* const* d_in, const int* in_sizes, int n_in, void* d_out, int out_size, void* d_ws, size_t ws_size, hipStream_t stream) {
    static int grid = 0;
    if (grid == 0) {
        if (n_in != 20 || in_sizes[0] != TOK * DMODEL || out_size != TOK * DMODEL || ws_size < WS_END) {
            fprintf(stderr, "kernel_launch: unexpected shapes: n_in %d in0 %d out %d ws %zu (need %zu); nothing launched\n", n_in, n_in > 0 ? in_sizes[0] : -1, out_size, ws_size, (size_t)WS_END); grid = -1; return; }
        int dev = 0, cus = 0, per_cu = 0;
        if (hipGetDevice(&dev) != hipSuccess || hipDeviceGetAttribute(&cus, hipDeviceAttributeMultiprocessorCount, dev) != hipSuccess) { grid = -1; return; }
        if (hipFuncSetAttribute((const void*)hymba_fwd, hipFuncAttributeMaxDynamicSharedMemorySize, LDS_BYTES) != hipSuccess) { fprintf(stderr, "kernel_launch: hipFuncSetAttribute failed\n"); grid = -1; return; }
        if (hipOccupancyMaxActiveBlocksPerMultiprocessor(&per_cu, (const void*)hymba_fwd, NWAVES * 64, LDS_BYTES) != hipSuccess || per_cu < 1)
            fprintf(stderr, "kernel_launch: note: occupancy query reports %d workgroups per CU\n", per_cu);
        (void)hipGetLastError();
        grid = cus;
        grid -= grid % 8;
        if (grid < 8) { grid = -1; return; }
    }
    if (grid < 0) return;
    if (hipMemsetAsync((char*)d_ws + WS_CTL, 0, CTL_ZERO_BYTES, stream) != hipSuccess) return;
    Args a{};
    for (int i = 0; i < 20; ++i) a.in[i] = d_in[i];
    a.out = (float*)d_out; a.ws = (unsigned char*)d_ws;
    for (int li = 0; li < N_LAUNCHES; ++li) {
        a.ph_lo = (N_LAUNCHES == 1) ? 0 : li; a.ph_hi = (N_LAUNCHES == 1) ? NPHASE : li + 1; a.li = li; a.pad = 0;
        hipLaunchKernelGGL(hymba_fwd, dim3(grid), dim3(NWAVES * 64), LDS_BYTES, stream, a);
        const hipError_t le = hipPeekAtLastError();
        if (le != hipSuccess) { fprintf(stderr, "kernel_launch: launch %d failed: %s\n", li, hipGetErrorName(le)); break; }
    }
}
```

```cpp
#include <hip/hip_runtime.h>
#include <hip/hip_bf16.h>
#include <cstdio>
#include <cstdint>
#include <cmath>
#define MK_N_LAUNCHES 1
namespace pg8 {
#define PG8_LAS __attribute__((address_space(3)))
typedef unsigned short bf16_t;
typedef short bf16x8 __attribute__((ext_vector_type(8)));
typedef float f32x4 __attribute__((ext_vector_type(4)));
typedef unsigned u32x4 __attribute__((ext_vector_type(4)));
constexpr int BM = 256, BK = 64, HALF = 128, HTB = HALF * BK * 2  , STAGE_BYTES = 8 * HTB, NXCD = 8, WGM = 8;

__host__ __device__ __forceinline__ int lds_byte(int r, int c) { const int st = (r >> 4) * 2 + (c >> 5), rr = r & 15, cc = c & 31, ob = rr * 64 + cc * 2; return st * 1024 + (ob ^ (((ob >> 9) & 1) << 5)); }
__host__ __device__ __forceinline__ void stage_rc(int b, int& R, int& C) { const int st = b / 1024, sb = b % 1024, swz = sb ^ (((sb >> 9) & 1) << 5); R = (st >> 1) * 16 + swz / 64; C = (st & 1) * 32 + (swz % 64) / 2; }
__host__ __device__ __forceinline__ int perm32(int rho) { const int n = rho >> 4, i = rho & 15; return 8 * (i >> 2) + 4 * n + (i & 3); }

struct Unit { int pm, pn; };
struct Gemm { const bf16_t* A; const bf16_t* Bt; int M, N, K; };

struct StaticOrder {
    int nM, nN, nwg, G, c;
    __host__ __device__ void init(int M, int N, int G_, int c_) { nM = M / BM; nN = N / BM; nwg = nM * nN; G = G_; c = c_; }
    __host__ __device__ bool next(int i, Unit& u) const {
        const long L = (long)i * G + c; if (L >= nwg) return false;
        int wgid = (int)L; { const int q = nwg / NXCD, r = nwg % NXCD, xcd = wgid % NXCD, off = wgid / NXCD; wgid = (xcd < r ? xcd * (q + 1) : r * (q + 1) + (xcd - r) * q) + off; }
        const int nig = WGM * nN, gid = wgid / nig, fm = gid * WGM, gsz = (nM - fm) < WGM ? (nM - fm) : WGM;
        u.pm = fm + ((wgid % nig) % gsz); u.pn = (wgid % nig) / gsz; return true;
    }
    __device__ __forceinline__ void a_ready(const Unit&) const {}
    __device__ __forceinline__ void done(const Unit&) const {}
};

__device__ __forceinline__ unsigned cvt_pk_bf16(float lo, float hi) { unsigned r; asm volatile("v_cvt_pk_bf16_f32 %0, %1, %2" : "=v"(r) : "v"(lo), "v"(hi)); return r; }
typedef float f32x2 __attribute__((ext_vector_type(2)));
__device__ __forceinline__ f32x2 gelu_pk(f32x2 v) {
    const f32x2 av = __builtin_elementwise_abs(v), d = av * 0.2316418882f + 1.0f;
    f32x2 t; t.x = __builtin_amdgcn_rcpf(d.x); t.y = __builtin_amdgcn_rcpf(d.y);
    f32x2 q = t * 0.5307027145f + (-0.7265760135f); q = q * t + 0.7107068705f; q = q * t + (-0.142248368f); q = q * t + 0.127414796f; q = q * t;
    const f32x2 s = (v * v) * (-0.72134752044f);
    f32x2 e; e.x = __builtin_amdgcn_exp2f(s.x); e.y = __builtin_amdgcn_exp2f(s.y);
    const f32x2 m = v * (q * e), r = v - m;
    f32x2 o; o.x = v.x < 0.f ? m.x : r.x; o.y = v.y < 0.f ? m.y : r.y; return o;
}

template <int ACT  > struct EpiBf16 {
    static constexpr bool PERM = true, AFTER_DRAIN = false; static_assert(ACT == 0 || ACT == 1, "EpiBf16: ACT is 0 (none) or 1 (gelu_pk)");
    bf16_t* O; int ldc; const float* bias; int split_cols; size_t split_stride; float scale0;
    __device__ __forceinline__ void operator()(const f32x4 (&acc)[2][2][4][2], const Unit& u, int wr, int wc, int fr, int fq) const {
        const int row0 = u.pm * BM + wr * 64 + fr; int colt = u.pn * BM; bf16_t* base = O;
        float sc = 1.f; if (split_cols) { const int t = colt / split_cols; base += (size_t)t * split_stride; colt -= t * split_cols; if (t == 0) sc = scale0; }
        const int col0 = colt + wc * 32 + 8 * fq, bcol0 = u.pn * BM + wc * 32 + 8 * fq;
        f32x4 bv[2][2];
#pragma unroll
        for (int bj = 0; bj < 2; ++bj)
#pragma unroll
            for (int n = 0; n < 2; ++n) bv[bj][n] = bias ? *(const f32x4*)(bias + bcol0 + bj * HALF + 4 * n) : (f32x4){0.f, 0.f, 0.f, 0.f};
#pragma unroll
        for (int ai = 0; ai < 2; ++ai)
#pragma unroll
            for (int m = 0; m < 4; ++m) { bf16_t* rowp = base + (size_t)(row0 + ai * HALF + m * 16) * ldc + col0;
#pragma unroll
                for (int bj = 0; bj < 2; ++bj) { f32x4 v0 = acc[ai][bj][m][0] + bv[bj][0], v1 = acc[ai][bj][m][1] + bv[bj][1];
                    if (ACT == 1) { f32x2 a = gelu_pk((f32x2){v0[0], v0[1]}), b = gelu_pk((f32x2){v0[2], v0[3]}), c = gelu_pk((f32x2){v1[0], v1[1]}), d = gelu_pk((f32x2){v1[2], v1[3]});
                        v0 = (f32x4){a.x, a.y, b.x, b.y}; v1 = (f32x4){c.x, c.y, d.x, d.y}; }
                    v0 = v0 * sc; v1 = v1 * sc; u32x4 w; w.x = cvt_pk_bf16(v0[0], v0[1]); w.y = cvt_pk_bf16(v0[2], v0[3]); w.z = cvt_pk_bf16(v1[0], v1[1]); w.w = cvt_pk_bf16(v1[2], v1[3]);
                    *(u32x4*)(rowp + bj * HALF) = w; } }
    }
};
struct EpiResF32 {
    static constexpr bool PERM = true, AFTER_DRAIN = false;
    const float* X; float* O; int ldc;
    __device__ __forceinline__ void operator()(const f32x4 (&acc)[2][2][4][2], const Unit& u, int wr, int wc, int fr, int fq) const {
        const int row0 = u.pm * BM + wr * 64 + fr, col0 = u.pn * BM + wc * 32 + 8 * fq;
#pragma unroll
        for (int ai = 0; ai < 2; ++ai)
#pragma unroll
            for (int m = 0; m < 4; ++m) { const size_t ro = (size_t)(row0 + ai * HALF + m * 16) * ldc + col0;
#pragma unroll
                for (int bj = 0; bj < 2; ++bj) { const size_t off = ro + bj * HALF;
                    const f32x4 x0 = *(const f32x4*)(X + off), x1 = *(const f32x4*)(X + off + 4);
                    *(f32x4*)(O + off) = x0 + acc[ai][bj][m][0]; *(f32x4*)(O + off + 4) = x1 + acc[ai][bj][m][1]; } }
    }
};
struct EpiResF32X {
    static constexpr bool PERM = true, AFTER_DRAIN = false;
    const float* X; int ldc; bf16_t* HB; unsigned char* X8; float* SSP; int tok;
    static __device__ __forceinline__ unsigned pk8(float a, float b, float c, float d) { int w = __builtin_amdgcn_cvt_pk_fp8_f32(a, b, 0, false); w = __builtin_amdgcn_cvt_pk_fp8_f32(c, d, w, true); return (unsigned)w; }
    __device__ __forceinline__ void operator()(const f32x4 (&acc)[2][2][4][2], const Unit& u, int wr, int wc, int fr, int fq) const {
        const int row0 = u.pm * BM + wr * 64 + fr, col0 = u.pn * BM + wc * 32 + 8 * fq;
#pragma unroll
        for (int ai = 0; ai < 2; ++ai) {
            f32x4 xv[4][2][2];
#pragma unroll
            for (int m = 0; m < 4; ++m)
#pragma unroll
                for (int bj = 0; bj < 2; ++bj) { const size_t off = (size_t)(row0 + ai * HALF + m * 16) * ldc + col0 + bj * HALF; xv[m][bj][0] = *(const f32x4*)(X + off); xv[m][bj][1] = *(const f32x4*)(X + off + 4); }
#pragma unroll
            for (int m = 0; m < 4; ++m) { const int row = row0 + ai * HALF + m * 16; const size_t ro = (size_t)row * ldc + col0; float ss = 0.f;
#pragma unroll
                for (int bj = 0; bj < 2; ++bj) { const size_t off = ro + bj * HALF;
                    const f32x4 h0 = xv[m][bj][0] + acc[ai][bj][m][0], h1 = xv[m][bj][1] + acc[ai][bj][m][1];
                    ss += (h0.x * h0.x + h0.y * h0.y) + (h0.z * h0.z + h0.w * h0.w) + (h1.x * h1.x + h1.y * h1.y) + (h1.z * h1.z + h1.w * h1.w);
                    u32x4 w; w.x = cvt_pk_bf16(h0.x, h0.y); w.y = cvt_pk_bf16(h0.z, h0.w); w.z = cvt_pk_bf16(h1.x, h1.y); w.w = cvt_pk_bf16(h1.z, h1.w);
                    *(u32x4*)(HB + off) = w;
                    typedef unsigned u32x2 __attribute__((ext_vector_type(2)));
                    const u32x2 q = {pk8(h0.x, h0.y, h0.z, h0.w), pk8(h1.x, h1.y, h1.z, h1.w)};
                    *(u32x2*)(X8 + ((size_t)((col0 + bj * HALF) >> 3) * tok + row) * 8) = q; }
                ss += __shfl_xor(ss, 16); ss += __shfl_xor(ss, 32);
                if (fq == 0) SSP[(size_t)row * 16 + u.pn * 4 + wc] = ss; } }
    }
};
struct EpiBf16Row {
    static constexpr bool PERM = true, AFTER_DRAIN = false;
    bf16_t* O; int ldc; const float* SSP; float* RSTD; float eps, inv_n;
    __device__ __forceinline__ void operator()(const f32x4 (&acc)[2][2][4][2], const Unit& u, int wr, int wc, int fr, int fq) const {
        const int row0 = u.pm * BM + wr * 64 + fr, col0 = u.pn * BM + wc * 32 + 8 * fq;
#pragma unroll
        for (int ai = 0; ai < 2; ++ai) {
            float rs[4];
#pragma unroll
            for (int m = 0; m < 4; ++m) { const f32x4* sp = (const f32x4*)(SSP + (size_t)(row0 + ai * HALF + m * 16) * 16);
                const f32x4 s4 = (sp[0] + sp[1]) + (sp[2] + sp[3]); rs[m] = 1.f / sqrtf(((s4.x + s4.y) + (s4.z + s4.w)) * inv_n + eps); }
#pragma unroll
            for (int m = 0; m < 4; ++m) { const int row = row0 + ai * HALF + m * 16; bf16_t* rowp = O + (size_t)row * ldc + col0;
                const float rstd = rs[m];
                if (u.pn == 0 && wc == 0 && fq == 0) RSTD[row] = rstd;
#pragma unroll
                for (int bj = 0; bj < 2; ++bj) { const f32x4 v0 = acc[ai][bj][m][0] * rstd, v1 = acc[ai][bj][m][1] * rstd;
                    u32x4 w; w.x = cvt_pk_bf16(v0[0], v0[1]); w.y = cvt_pk_bf16(v0[2], v0[3]); w.z = cvt_pk_bf16(v1[0], v1[1]); w.w = cvt_pk_bf16(v1[2], v1[3]);
                    *(u32x4*)(rowp + bj * HALF) = w; } } }
    }
};
template <class Epi, class Sched, bool ALIGN_EPI = false, bool SP2 = false>
__device__ __forceinline__ void gemm_phase(PG8_LAS unsigned char* lds, const Gemm g, const Sched& S, const Epi& E) {
    const int tid = threadIdx.x, wid = __builtin_amdgcn_readfirstlane(tid >> 6), lane = tid & 63, wr = wid >> 2, wc = wid & 3, fr = lane & 15, fq = lane >> 4;
    const int K = g.K, nt = K / BK;
    unsigned voffA[2], voffB[2];
#pragma unroll
    for (int i = 0; i < 2; ++i) { int R, C; stage_rc(tid * 16 + i * 8192, R, C); const int Rb = Epi::PERM ? ((R & ~31) + perm32(R & 31)) : R;
        voffA[i] = (unsigned)(R * K + C) * 2u; voffB[i] = (unsigned)(Rb * K + C) * 2u; }
    const size_t kstep = (size_t)(BK * 2);
    const size_t hstep = (size_t)HALF * K * 2;
    const size_t tstep = 2 * hstep;
    const unsigned ldsw = (unsigned)wid * 1024u;
    const int aoff = lds_byte(wr * 64 + fr, fq * 8), boff = lds_byte(wc * 32 + fr, fq * 8);
#define PG8_SA(b, h) (((b) * 2 + (h)) * HTB)
#define PG8_SB(b, h) ((4 + (b) * 2 + (h)) * HTB)
#define PG8_STAGE(bufoff, gbase, voff) do { _Pragma("unroll") for (int _i = 0; _i < 2; ++_i) \
        __builtin_amdgcn_global_load_lds((const unsigned*)((const char*)(gbase) + (voff)[_i]), (PG8_LAS unsigned*)(lds + (bufoff) + ldsw + _i * 8192), 16, 0, 0); } while (0)
#define PG8_LDA(dst, b, h) do { _Pragma("unroll") for (int m = 0; m < 4; ++m) _Pragma("unroll") for (int k = 0; k < 2; ++k) dst[m][k] = *(const PG8_LAS bf16x8*)(lds + PG8_SA(b, h) + aoff + m * 2048 + k * 1024); } while (0)
#define PG8_LDB(dst, b, h) do { _Pragma("unroll") for (int n = 0; n < 2; ++n) _Pragma("unroll") for (int k = 0; k < 2; ++k) dst[n][k] = *(const PG8_LAS bf16x8*)(lds + PG8_SB(b, h) + boff + n * 2048 + k * 1024); } while (0)
#define PG8_MMA(ai, bj, At, Bt) do { __builtin_amdgcn_s_setprio(1); _Pragma("unroll") for (int m = 0; m < 4; ++m) _Pragma("unroll") for (int n = 0; n < 2; ++n) _Pragma("unroll") for (int k = 0; k < 2; ++k) \
        acc[ai][bj][m][n] = __builtin_amdgcn_mfma_f32_16x16x32_bf16(Bt[n][k], At[m][k], acc[ai][bj][m][n], 0, 0, 0); __builtin_amdgcn_s_setprio(0); } while (0)
#define PG8_WAIT_V(n) asm volatile("s_waitcnt vmcnt(" #n ")" ::: "memory")
#define PG8_WAIT_L(n) asm volatile("s_waitcnt lgkmcnt(" #n ")" ::: "memory")
#define PG8_BAR __builtin_amdgcn_s_barrier()
#define PG8_SCHED __builtin_amdgcn_sched_barrier(0)
    Unit cur, nxt; int ui = 0;
    if (!S.next(0, cur)) return;
    f32x4 acc[2][2][4][2];
#pragma unroll
    for (int a = 0; a < 2; ++a)
#pragma unroll
        for (int b = 0; b < 2; ++b)
#pragma unroll
            for (int m = 0; m < 4; ++m)
#pragma unroll
                for (int n = 0; n < 2; ++n) acc[a][b][m][n] = (f32x4){0.f, 0.f, 0.f, 0.f};
    bf16x8 At[4][2], B0[2][2], B1[2][2];
    const char* cA = (const char*)g.A + (size_t)cur.pm * tstep; const char* cB = (const char*)g.Bt + (size_t)cur.pn * tstep;
    S.a_ready(cur);
    if constexpr (SP2) {
        PG8_STAGE(PG8_SB(0, 0), cB, voffB); PG8_STAGE(PG8_SB(0, 1), cB + hstep, voffB); PG8_STAGE(PG8_SA(0, 0), cA, voffA); PG8_STAGE(PG8_SA(0, 1), cA + hstep, voffA);
        if (wr == 1) PG8_BAR;
        PG8_WAIT_V(2); PG8_BAR;
        PG8_STAGE(PG8_SB(1, 0), cB + kstep, voffB); PG8_STAGE(PG8_SA(1, 0), cA + kstep, voffA); PG8_STAGE(PG8_SB(1, 1), cB + hstep + kstep, voffB);
        PG8_WAIT_V(6); PG8_BAR;
    } else {
        PG8_STAGE(PG8_SB(0, 0), cB, voffB); PG8_STAGE(PG8_SA(0, 0), cA, voffA); PG8_STAGE(PG8_SB(0, 1), cB + hstep, voffB); PG8_STAGE(PG8_SA(0, 1), cA + hstep, voffA);
        if (wr == 1) PG8_BAR;
        PG8_WAIT_V(4); PG8_BAR;
        PG8_STAGE(PG8_SB(1, 0), cB + kstep, voffB); PG8_STAGE(PG8_SA(1, 0), cA + kstep, voffA); PG8_STAGE(PG8_SB(1, 1), cB + hstep + kstep, voffB);
        PG8_WAIT_V(6); PG8_BAR;
    }
    for (;;) {
        const bool has_next = S.next(ui + 1, nxt);
        const char* nA = has_next ? (const char*)g.A + (size_t)nxt.pm * tstep : cA; const char* nB = has_next ? (const char*)g.Bt + (size_t)nxt.pn * tstep : cB;
        for (int t = 0; t < nt; t += 2) {
            const bool last = (t == nt - 2);
            const char* a1 = cA + (size_t)(t + 1) * kstep;
            const char* a2 = last ? nA : cA + (size_t)(t + 2) * kstep; const char* b2 = last ? nB : cB + (size_t)(t + 2) * kstep;
            const char* a3 = a2 + kstep; const char* b3 = b2 + kstep;
            if (last && has_next) S.a_ready(nxt);
            if constexpr (SP2) {
            PG8_LDB(B0, 0, 0); PG8_LDB(B1, 0, 1); PG8_SCHED; PG8_LDA(At, 0, 0); PG8_STAGE(PG8_SA(1, 1), a1 + hstep, voffA);
            PG8_WAIT_V(8); PG8_WAIT_L(0); PG8_BAR; PG8_MMA(0, 0, At, B0); PG8_MMA(0, 1, At, B1); PG8_BAR; PG8_SCHED;
            PG8_LDA(At, 0, 1); PG8_STAGE(PG8_SB(0, 0), b2, voffB); PG8_STAGE(PG8_SB(0, 1), b2 + hstep, voffB); PG8_STAGE(PG8_SA(0, 0), a2, voffA);
            PG8_WAIT_V(8); PG8_WAIT_L(0); PG8_BAR; PG8_MMA(1, 0, At, B0); PG8_MMA(1, 1, At, B1); PG8_BAR; PG8_SCHED;
            PG8_LDB(B0, 1, 0); PG8_LDB(B1, 1, 1); PG8_SCHED; PG8_LDA(At, 1, 0); PG8_STAGE(PG8_SA(0, 1), a2 + hstep, voffA);
            PG8_WAIT_V(8); PG8_WAIT_L(0); PG8_BAR; PG8_MMA(0, 0, At, B0); PG8_MMA(0, 1, At, B1); PG8_BAR; PG8_SCHED;
            PG8_LDA(At, 1, 1); PG8_STAGE(PG8_SB(1, 0), b3, voffB); PG8_STAGE(PG8_SB(1, 1), b3 + hstep, voffB); PG8_STAGE(PG8_SA(1, 0), a3, voffA);
            PG8_WAIT_V(8); PG8_WAIT_L(0); PG8_BAR; PG8_MMA(1, 0, At, B0); PG8_MMA(1, 1, At, B1); PG8_BAR; PG8_SCHED;
            } else {
            PG8_LDB(B0, 0, 0); PG8_SCHED; PG8_LDA(At, 0, 0); PG8_STAGE(PG8_SA(1, 1), a1 + hstep, voffA);
            PG8_WAIT_L(8); PG8_BAR; PG8_WAIT_L(0); PG8_MMA(0, 0, At, B0); PG8_BAR; PG8_SCHED;
            PG8_LDB(B1, 0, 1); PG8_STAGE(PG8_SB(0, 0), b2, voffB);
            PG8_BAR; PG8_WAIT_L(0); PG8_MMA(0, 1, At, B1); PG8_BAR;
            PG8_LDA(At, 0, 1); PG8_STAGE(PG8_SA(0, 0), a2, voffA);
            PG8_BAR; PG8_WAIT_L(0); PG8_MMA(1, 0, At, B0); PG8_BAR; PG8_SCHED;
            PG8_STAGE(PG8_SB(0, 1), b2 + hstep, voffB);
            PG8_WAIT_V(6); PG8_BAR; PG8_MMA(1, 1, At, B1); PG8_BAR;
            PG8_LDB(B0, 1, 0); PG8_SCHED; PG8_LDA(At, 1, 0); PG8_STAGE(PG8_SA(0, 1), a2 + hstep, voffA);
            PG8_WAIT_L(8); PG8_BAR; PG8_WAIT_L(0); PG8_MMA(0, 0, At, B0); PG8_BAR; PG8_SCHED;
            PG8_LDB(B1, 1, 1); PG8_STAGE(PG8_SB(1, 0), b3, voffB);
            PG8_BAR; PG8_WAIT_L(0); PG8_MMA(0, 1, At, B1); PG8_BAR;
            PG8_LDA(At, 1, 1); PG8_STAGE(PG8_SA(1, 0), a3, voffA);
            PG8_BAR; PG8_WAIT_L(0); PG8_MMA(1, 0, At, B0); PG8_BAR; PG8_SCHED;
            PG8_STAGE(PG8_SB(1, 1), b3 + hstep, voffB);
            PG8_WAIT_V(6); PG8_BAR; PG8_MMA(1, 1, At, B1); PG8_BAR;
            }
        }
        if constexpr (ALIGN_EPI) { if (wr == 0) PG8_BAR; }
        if constexpr (!Epi::AFTER_DRAIN) { E(acc, cur, wr, wc, fr, fq); S.done(cur); }
        if (!has_next) break;
#pragma unroll
        for (int a = 0; a < 2; ++a)
#pragma unroll
            for (int b = 0; b < 2; ++b)
#pragma unroll
                for (int m = 0; m < 4; ++m)
#pragma unroll
                    for (int n = 0; n < 2; ++n) acc[a][b][m][n] = (f32x4){0.f, 0.f, 0.f, 0.f};
        cur = nxt; cA = nA; cB = nB; ++ui;
        if constexpr (ALIGN_EPI) { if (wr == 1) PG8_BAR; }
    }
    PG8_WAIT_V(0);
    if constexpr (!ALIGN_EPI) { if (wr == 0) PG8_BAR; }
    PG8_BAR;
    if constexpr (Epi::AFTER_DRAIN) { E.fused(acc, cur, wr, wc, fr, fq, lds, wid, lane); S.done(cur); }
#undef PG8_SA
#undef PG8_SB
#undef PG8_STAGE
#undef PG8_LDA
#undef PG8_LDB
#undef PG8_MMA
#undef PG8_WAIT_V
#undef PG8_WAIT_L
#undef PG8_BAR
#undef PG8_SCHED
}
}

#ifndef PG8_SP2
#define PG8_SP2 true
#endif
#ifndef PG8_ALIGN
#define PG8_ALIGN true
#endif
#include <hip/hip_bf16.h>
#include <cmath>
namespace attn_body {
using bf16=__hip_bfloat16;
using bf16x8=__attribute__((ext_vector_type(8)))short;
using s16x4=__attribute__((ext_vector_type(4)))short;
using f32x16=__attribute__((ext_vector_type(16)))float;
using u32x4=__attribute__((ext_vector_type(4)))unsigned;
constexpr int SEQ=8192,D=64,PQ=3328,PK=3328,PV=3328,PO=2048;
constexpr int NW=8,QBLK=32,QB=QBLK*NW,KVBLK=64,NQB=SEQ/QB;
constexpr int ATTN_UNIT_ROWS=QB;
__device__ __forceinline__ int crow(int r,int hi){return (r&3)+8*(r>>2)+4*hi;}
#define SBAR() __builtin_amdgcn_sched_barrier(0)
__device__ __forceinline__ void cmask(f32x16&p0,f32x16&p1,int jb,int qrel,int hi){
  const float NEG=-INFINITY; int kb=64*jb+4*hi;
  #pragma unroll
  for(int r=0;r<16;++r){int kv=kb+(r&3)+8*(r>>2); if(kv>qrel)p0[r]=NEG; if(kv+32>qrel)p1[r]=NEG;}
}

constexpr int NSLOT=3, SLOTB=8192;
constexpr int LDS_K=0, LDS_V=NSLOT*SLOTB, LDS_WS=2*NSLOT*SLOTB, LDS_OST=LDS_WS+NW*64*4, LDS_BYTES=LDS_OST+NW*4096;
constexpr float C2=0.125f*1.4426950408889634f;
__device__ __forceinline__ void glds16(const void*gsrc,unsigned lds_dst){unsigned keep;
  asm volatile("s_mov_b32 %0, m0\n\ts_mov_b32 m0, %2\n\ts_nop 0\n\tglobal_load_lds_dwordx4 %1, off\n\ts_mov_b32 m0, %0":"=&s"(keep):"v"(gsrc),"s"(lds_dst):"memory");}
__device__ __forceinline__ float max3f(float a,float b,float c){float r;asm("v_max3_f32 %0, %1, %2, %3":"=v"(r):"v"(a),"v"(b),"v"(c));return r;}
__device__ __forceinline__ float max2f(float a,float b){float r;asm("v_max_f32_e32 %0, %1, %2":"=v"(r):"v"(a),"v"(b));return r;}
__device__ __forceinline__ float fadd_s(float a,float b){float r;asm("v_add_f32_e32 %0, %1, %2":"=v"(r):"v"(a),"v"(b));return r;}
__device__ __forceinline__ float fsub_s(float a,float b){float r;asm("v_sub_f32_e32 %0, %1, %2":"=v"(r):"v"(a),"v"(b));return r;}
typedef float f32x2_t __attribute__((ext_vector_type(2))); typedef __bf16 bf16x2_t __attribute__((ext_vector_type(2)));
__device__ __forceinline__ unsigned cvtpk_s(float lo,float hi){f32x2_t v={lo,hi};bf16x2_t b=__builtin_convertvector(v,bf16x2_t);return __builtin_bit_cast(unsigned,b);}
#define WAIT_BAR(N) asm volatile("s_waitcnt vmcnt(" #N ") lgkmcnt(0)\n\ts_barrier":::"memory")

__device__ __forceinline__ void qkt(f32x16&p0,f32x16&p1,const char*Kslot,const bf16x8*qr,const f32x16&negm,int r32,int hi){
  const char*kb=Kslot+hi*1024+r32*16;
  #pragma unroll
  for(int d0=0;d0<4;++d0){
    const bf16x8 b0=*reinterpret_cast<const bf16x8*>(kb+d0*2048);
    const bf16x8 b1=*reinterpret_cast<const bf16x8*>(kb+d0*2048+512);
    if(d0==0){p0=__builtin_amdgcn_mfma_f32_32x32x16_bf16(b0,qr[0],negm,0,0,0);p1=__builtin_amdgcn_mfma_f32_32x32x16_bf16(b1,qr[0],negm,0,0,0);}
    else{p0=__builtin_amdgcn_mfma_f32_32x32x16_bf16(b0,qr[d0],p0,0,0,0);p1=__builtin_amdgcn_mfma_f32_32x32x16_bf16(b1,qr[d0],p1,0,0,0);}}
}
typedef __attribute__((address_space(3))) const char* lds_cptr;
typedef short v4i16_t __attribute__((ext_vector_type(4)));
__device__ __forceinline__ void kload8(bf16x8*kf,lds_cptr kp){
  kf[0]=*(const __attribute__((address_space(3))) bf16x8*)(kp);      kf[1]=*(const __attribute__((address_space(3))) bf16x8*)(kp+512);
  kf[2]=*(const __attribute__((address_space(3))) bf16x8*)(kp+2048); kf[3]=*(const __attribute__((address_space(3))) bf16x8*)(kp+2560);
  kf[4]=*(const __attribute__((address_space(3))) bf16x8*)(kp+4096); kf[5]=*(const __attribute__((address_space(3))) bf16x8*)(kp+4608);
  kf[6]=*(const __attribute__((address_space(3))) bf16x8*)(kp+6144); kf[7]=*(const __attribute__((address_space(3))) bf16x8*)(kp+6656);
}
__device__ __forceinline__ void kload2(bf16x8*kf,lds_cptr kp,int j){ kf[2*j]=*(const __attribute__((address_space(3))) bf16x8*)(kp+j*2048); kf[2*j+1]=*(const __attribute__((address_space(3))) bf16x8*)(kp+j*2048+512); }
__device__ __forceinline__ s16x4 vtr(lds_cptr p){ return __builtin_bit_cast(s16x4,__builtin_amdgcn_ds_read_tr16_b64_v4i16((__attribute__((address_space(3))) v4i16_t*)p)); }
__device__ __forceinline__ float rowmax(const f32x16&p0,const f32x16&p1){
  float a=max3f(p0[0],p0[1],p1[0]),b=max3f(p0[2],p0[3],p1[1]);a=max3f(a,p1[2],p1[3]);
  #pragma unroll
  for(int r=4;r<16;r+=4){a=max3f(a,p0[r],p0[r+1]);b=max3f(b,p0[r+2],p0[r+3]);a=max3f(a,p1[r],p1[r+1]);b=max3f(b,p1[r+2],p1[r+3]);}
  const float m=max2f(a,b);
  auto rr=__builtin_amdgcn_permlane32_swap(__float_as_uint(m),__float_as_uint(m),false,false);
  return max2f(__uint_as_float(rr[0]),__uint_as_float(rr[1]));
}
__device__ __forceinline__ void pv(f32x16*o,int vb,bf16x8 pa0,bf16x8 pa1,bf16x8 pa2,bf16x8 pa3){
  #pragma unroll
  for(int d0=0;d0<2;++d0){s16x4 lo[4],hi[4];
    #pragma unroll
    for(int ks=0;ks<4;++ks){
      asm volatile("ds_read_b64_tr_b16 %0,%1 offset:%c2":"=&v"(lo[ks]):"v"(vb),"i"(d0*4096+ks*1024):"memory");
      asm volatile("ds_read_b64_tr_b16 %0,%1 offset:%c2":"=&v"(hi[ks]):"v"(vb),"i"(d0*4096+ks*1024+512):"memory");}
    asm volatile("s_waitcnt lgkmcnt(0)":::"memory");SBAR();
    #define PK(k) (bf16x8){lo[k][0],lo[k][1],lo[k][2],lo[k][3],hi[k][0],hi[k][1],hi[k][2],hi[k][3]}
    o[d0]=__builtin_amdgcn_mfma_f32_32x32x16_bf16(pa0,PK(0),o[d0],0,0,0);
    o[d0]=__builtin_amdgcn_mfma_f32_32x32x16_bf16(pa1,PK(1),o[d0],0,0,0);
    o[d0]=__builtin_amdgcn_mfma_f32_32x32x16_bf16(pa2,PK(2),o[d0],0,0,0);
    o[d0]=__builtin_amdgcn_mfma_f32_32x32x16_bf16(pa3,PK(3),o[d0],0,0,0);
    #undef PK
  }
}

#ifndef ATTN_STORE16
#define ATTN_STORE16(p,v) (*(u32x4*)(p)=(v))
#endif
template<int THRL> __device__ __forceinline__ void attn_unit(int b,int qcol,int kcol,int vcol,int ocol,int qb,const bf16*Q,const bf16*__restrict__ K,const bf16*__restrict__ V,bf16*O,char*shm){
  int tid=threadIdx.x; asm volatile("":"+v"(tid));
  const int lane=tid&63,r32=lane&31,hi=lane>>5; const int wid=__builtin_amdgcn_readfirstlane(tid>>6);
  const long rowbase=(long)b*SEQ; const int q0=qb*QB;
  const bf16*Qw=Q+(rowbase+q0+wid*QBLK)*PQ+qcol;
  const bf16*Kh=K+rowbase*PK+kcol,*Vh=V+rowbase*PV+vcol;
  const unsigned lds0=(unsigned)(uintptr_t)shm;
  float*wsf=(float*)(shm+LDS_WS)+wid*64;
  const bf16*ksrc=Kh+(long)lane*PK+wid*8;
  const bf16*vsrc=Vh+(long)(16*(wid&3)+(lane>>2))*PV+(wid>>2)*32+(lane&3)*8;
  const unsigned kdst=lds0+LDS_K+wid*1024, vdst=lds0+LDS_V+wid*1024;
  #define DMA_K(t,slot) glds16(ksrc+(long)(t)*KVBLK*PK,(unsigned)__builtin_amdgcn_readfirstlane(kdst+(slot)))
  #define DMA_V(t,slot) glds16(vsrc+(long)(t)*KVBLK*PV,(unsigned)__builtin_amdgcn_readfirstlane(vdst+(slot)))
  const int vb0=(int)(lds0+LDS_V)+((lane>>4)&1)*32+(lane&3)*8+(4*hi+((lane&15)>>2))*64;
  const char*Kbase=shm+LDS_K; bf16x8 kf[8];
  const lds_cptr shm3=(lds_cptr)shm; const lds_cptr kp0=shm3+LDS_K+hi*1024+r32*16; const lds_cptr vp0=shm3+LDS_V+((lane>>4)&1)*32+(lane&3)*8+(4*hi+((lane&15)>>2))*64;
  const int NT=(q0+QB)/KVBLK;
  DMA_K(0,0);DMA_V(0,0);DMA_K(1,SLOTB);
  bf16x8 qr[4];
  #pragma unroll
  for(int d0=0;d0<4;++d0)qr[d0]=*reinterpret_cast<const bf16x8*>(&Qw[(long)r32*PQ+d0*16+hi*8]);
  float mhat=0.f,l_reg=0.f;f32x16 o[2];o[0]=f32x16{};o[1]=f32x16{};f32x16 negm=f32x16{};asm volatile("":"+v"(negm));
  const int qrel=wid*QBLK+r32;
  #define CMASK(P0,P1,t) do{int jb_=(t)-(NT-4); if(jb_>=0)cmask(P0,P1,jb_,qrel,hi);}while(0)
  bool resc=false;
  #define START(P0,P1) do{ const float rm=rowmax(P0,P1); resc=false; \
    { const float dl=rm; mhat=fadd_s(mhat,dl); \
      _Pragma("unroll") for(int r=0;r<16;++r){P0[r]=fsub_s(P0[r],dl);P1[r]=fsub_s(P1[r],dl);} \
      _Pragma("unroll") for(int r=0;r<16;++r)negm[r]=-mhat; asm volatile("":"+v"(negm)); } \
    _Pragma("unroll") for(int r=0;r<16;++r)P0[r]=__builtin_amdgcn_exp2f(P0[r]); }while(0)
  #define RESC() do{ if(resc){ asm volatile("s_waitcnt lgkmcnt(0)":::"memory"); \
      _Pragma("unroll") for(int d_=0;d_<2;++d_) _Pragma("unroll") for(int r=0;r<16;++r)o[d_][r]*=wsf[crow(r,hi)]; } }while(0)
  f32x16 pA0,pA1,pB0,pB1;
  int sl_prev=0,sl_cur=0,sl_next=SLOTB;
  #define ROT() do{sl_prev=sl_cur;sl_cur=sl_next;sl_next=(sl_next==(NSLOT-1)*SLOTB)?0:sl_next+SLOTB;}while(0)
  DMA_K(2,2*SLOTB);
  WAIT_BAR(3);
  qkt(pA0,pA1,Kbase,qr,negm,r32,hi);asm volatile("s_nop 15\n\ts_nop 7":"+v"(pA0),"+v"(pA1));CMASK(pA0,pA1,0);
  START(pA0,pA1);
  _Pragma("unroll") for(int r=0;r<16;++r)pA1[r]=__builtin_amdgcn_exp2f(pA1[r]);
  WAIT_BAR(0);
  DMA_K(3,0);DMA_V(1,SLOTB);
  ROT();
  kload8(kf,kp0+sl_cur);
  WAIT_BAR(2);
  s16x4 vlo[8],vhi[8]; u32x4 pw0,pw1,pw2,pw3;
  #define PKW(P,B) cvtpk_s(P[B],P[B+1])
  #define PAF(k) __builtin_bit_cast(bf16x8,pw##k)
  #define VFR(i) (bf16x8){vlo[i][0],vlo[i][1],vlo[i][2],vlo[i][3],vhi[i][0],vhi[i][1],vhi[i][2],vhi[i][3]}
  #define PIN(x) asm volatile("":"+v"(x))
  #define MX3(a,b,c) __builtin_fmaxf(__builtin_fmaxf((a),(b)),(c))
  #define GAPA(MF,A0,A1,A2,A3,W0,W1,PW) do{ MF; sacc+=A0; sacc+=A1; sacc+=A2; sacc+=A3; PIN(sacc); W0; W1; PIN(PW); SBAR(); }while(0)
  #define EX(v) __builtin_amdgcn_exp2f(v)
  #define GAPB(MF,X,B) do{ MF; X[B]=EX(X[B]); X[B+1]=EX(X[B+1]); X[B+2]=EX(X[B+2]); X[B+3]=EX(X[B+3]); PIN(X); SBAR(); }while(0)
  #define VRD(i) do{ vlo[i]=vtr(vp_+(((i)>>2)*4096+((i)&3)*1024)); vhi[i]=vtr(vp_+(((i)>>2)*4096+((i)&3)*1024+512)); }while(0)
  #define KRD(G,j) do{ if(G){ kload2(kf,kp0+sl_next,j); SBAR(); } }while(0)
  #define STEP(C0,C1,P0,P1,t,GK,GV,GL) do{ SBAR(); \
    const lds_cptr vp_=vp0+sl_prev; \
    VRD(0); SBAR(); float sacc=(P0[0]+P0[1]); \
    GAPA(C0=__builtin_amdgcn_mfma_f32_32x32x16_bf16(kf[0],qr[0],negm,0,0,0), P0[2],P0[3],P0[4],P0[5],     pw0[0]=PKW(P0,0), pw0[1]=PKW(P0,2), pw0); \
    VRD(4); SBAR(); GAPA(C1=__builtin_amdgcn_mfma_f32_32x32x16_bf16(kf[1],qr[0],negm,0,0,0), P0[6],P0[7],P0[8],P0[9],     pw0[2]=PKW(P0,4), pw0[3]=PKW(P0,6), pw0); \
    VRD(1); SBAR(); GAPA(C0=__builtin_amdgcn_mfma_f32_32x32x16_bf16(kf[2],qr[1],C0,0,0,0),   P0[10],P0[11],P0[12],P0[13], pw1[0]=PKW(P0,8), pw1[1]=PKW(P0,10), pw1); \
    VRD(5); SBAR(); GAPA(C1=__builtin_amdgcn_mfma_f32_32x32x16_bf16(kf[3],qr[1],C1,0,0,0),   P0[14],P0[15],P1[0],P1[1],   pw1[2]=PKW(P0,12),pw1[3]=PKW(P0,14), pw1); \
    VRD(2); SBAR(); GAPA(C0=__builtin_amdgcn_mfma_f32_32x32x16_bf16(kf[4],qr[2],C0,0,0,0),   P1[2],P1[3],P1[4],P1[5],     pw2[0]=PKW(P1,0), pw2[1]=PKW(P1,2), pw2); \
    VRD(6); SBAR(); GAPA(C1=__builtin_amdgcn_mfma_f32_32x32x16_bf16(kf[5],qr[2],C1,0,0,0),   P1[6],P1[7],P1[8],P1[9],     pw2[2]=PKW(P1,4), pw2[3]=PKW(P1,6), pw2); \
    VRD(3); SBAR(); GAPA(C0=__builtin_amdgcn_mfma_f32_32x32x16_bf16(kf[6],qr[3],C0,0,0,0),   P1[10],P1[11],P1[12],P1[13], pw3[0]=PKW(P1,8), pw3[1]=PKW(P1,10), pw3); \
    VRD(7); SBAR(); GAPA(C1=__builtin_amdgcn_mfma_f32_32x32x16_bf16(kf[7],qr[3],C1,0,0,0),   P1[14],P1[15],0.f,0.f,       pw3[2]=PKW(P1,12),pw3[3]=PKW(P1,14), pw3); \
    l_reg+=sacc; \
    if(GK){DMA_K((t)+3,sl_cur);} if(GV){DMA_V((t)+1,sl_next);} \
    CMASK(C0,C1,t); \
    { float a=MX3(C0[0],C0[1],C1[0]),b=MX3(C0[2],C0[3],C1[1]); a=MX3(a,C1[2],C1[3]); \
      _Pragma("unroll") for(int r=4;r<16;r+=4){a=MX3(a,C0[r],C0[r+1]);b=MX3(b,C0[r+2],C0[r+3]);a=MX3(a,C1[r],C1[r+1]);b=MX3(b,C1[r+2],C1[r+3]);} \
      float rm=__builtin_fmaxf(a,b); { auto rr=__builtin_amdgcn_permlane32_swap(__float_as_uint(rm),__float_as_uint(rm),false,false); rm=__builtin_fmaxf(__uint_as_float(rr[0]),__uint_as_float(rr[1])); } \
      resc=false; \
      if(__builtin_expect(__any(rm>(float)THRL),0)){ const float dl=__builtin_fmaxf(rm,0.f); mhat+=dl; \
        _Pragma("unroll") for(int r=0;r<16;++r){C0[r]-=dl;C1[r]-=dl;} \
        _Pragma("unroll") for(int r=0;r<16;++r)negm[r]=-mhat; asm volatile("":"+v"(negm)); \
        const float f=__builtin_amdgcn_exp2f(-dl); l_reg*=f; if(hi==0)wsf[r32]=f; resc=true; } } \
    SBAR(); \
    GAPB(o[0]=__builtin_amdgcn_mfma_f32_32x32x16_bf16(PAF(0),VFR(0),o[0],0,0,0), C0,0); \
    GAPB(o[1]=__builtin_amdgcn_mfma_f32_32x32x16_bf16(PAF(0),VFR(4),o[1],0,0,0), C0,4); \
    KRD(GL,0); GAPB(o[0]=__builtin_amdgcn_mfma_f32_32x32x16_bf16(PAF(1),VFR(1),o[0],0,0,0), C0,8); \
    KRD(GL,1); GAPB(o[1]=__builtin_amdgcn_mfma_f32_32x32x16_bf16(PAF(1),VFR(5),o[1],0,0,0), C0,12); \
    KRD(GL,2); GAPB(o[0]=__builtin_amdgcn_mfma_f32_32x32x16_bf16(PAF(2),VFR(2),o[0],0,0,0), C1,0); \
    KRD(GL,3); GAPB(o[1]=__builtin_amdgcn_mfma_f32_32x32x16_bf16(PAF(2),VFR(6),o[1],0,0,0), C1,4); \
    GAPB(o[0]=__builtin_amdgcn_mfma_f32_32x32x16_bf16(PAF(3),VFR(3),o[0],0,0,0), C1,8); \
    GAPB(o[1]=__builtin_amdgcn_mfma_f32_32x32x16_bf16(PAF(3),VFR(7),o[1],0,0,0), C1,12); \
    }while(0)
  int t=1;
  #undef CMASK
  #define CMASK(P0,P1,t) do{}while(0)
  for(;t+5<NT;t+=2){
    STEP(pB0,pB1,pA0,pA1,t,true,true,true);     WAIT_BAR(2); RESC(); ROT();
    STEP(pA0,pA1,pB0,pB1,t+1,true,true,true);   WAIT_BAR(2); RESC(); ROT();
  }
  #undef CMASK
  #define CMASK(P0,P1,t) do{int jb_=(t)-(NT-4); if(jb_>=0)cmask(P0,P1,jb_,qrel,hi);}while(0)
  #define ENDW(tt) do{ if((tt)+3<NT){WAIT_BAR(2);} else if((tt)+2<NT){WAIT_BAR(1);} else {WAIT_BAR(0);} }while(0)
  for(;t+1<NT;t+=2){
    STEP(pB0,pB1,pA0,pA1,t,(t+3<NT),(t+1<NT),(t+1<NT));       ENDW(t);   RESC(); ROT();
    STEP(pA0,pA1,pB0,pB1,t+1,(t+4<NT),(t+2<NT),(t+2<NT));     ENDW(t+1); RESC(); ROT();
  }
  STEP(pB0,pB1,pA0,pA1,NT-1,false,false,false); RESC();
  { float sacc=pB0[0]+pB0[1]; _Pragma("unroll") for(int r=2;r<16;++r)sacc+=pB0[r]; _Pragma("unroll") for(int r=0;r<16;++r)sacc+=pB1[r]; l_reg+=sacc;
    pw0=(u32x4){PKW(pB0,0),PKW(pB0,2),PKW(pB0,4),PKW(pB0,6)};pw1=(u32x4){PKW(pB0,8),PKW(pB0,10),PKW(pB0,12),PKW(pB0,14)};pw2=(u32x4){PKW(pB1,0),PKW(pB1,2),PKW(pB1,4),PKW(pB1,6)};pw3=(u32x4){PKW(pB1,8),PKW(pB1,10),PKW(pB1,12),PKW(pB1,14)};
    SBAR(); pv(o,vb0+sl_cur,PAF(0),PAF(1),PAF(2),PAF(3)); }
  #undef PKW
  #undef PAF
  #undef VFR
  #undef PIN
  #undef MX3
  #undef GAPA
  #undef GAPB
  #undef EX
  #undef VRD
  #undef KRD
  #undef STEP
  #undef ENDW
  {auto rr=__builtin_amdgcn_permlane32_swap(__float_as_uint(l_reg),__float_as_uint(l_reg),false,false);l_reg=__uint_as_float(rr[0])+__uint_as_float(rr[1]);}
  if(hi==0)wsf[32+r32]=l_reg;asm volatile("s_waitcnt lgkmcnt(0)":::"memory");
  float rli[16];
  #pragma unroll
  for(int r=0;r<16;++r)rli[r]=__builtin_amdgcn_rcpf(wsf[32+crow(r,hi)]);
  bf16*Ow=O+(rowbase+q0+wid*QBLK)*PO+ocol;
  { bf16*stg=(bf16*)(shm+LDS_OST)+wid*2048;
    #pragma unroll
    for(int r=0;r<16;++r){const int orow=crow(r,hi);
      #pragma unroll
      for(int d0=0;d0<2;++d0)stg[orow*64+d0*32+r32]=__float2bfloat16(o[d0][r]*rli[r]);}
    asm volatile("s_waitcnt lgkmcnt(0)":::"memory");
    #pragma unroll
    for(int i=0;i<4;++i){const int row=i*8+(lane>>3),ch=lane&7; const u32x4 v=*(const u32x4*)(stg+row*64+ch*8); ATTN_STORE16(Ow+(long)row*PO+ch*8,v);} }
  asm volatile("s_waitcnt lgkmcnt(0)\n\ts_barrier":::"memory");
  #undef DMA_K
  #undef DMA_V
  #undef CMASK
  #undef START
  #undef RESC
  #undef ROT
}
constexpr int ATTN_LDS_BYTES=LDS_BYTES;
#undef SBAR
#undef WAIT_BAR
}
#include <hip/hip_bf16.h>
#include <cmath>
namespace attn_body2 {
using bf16=__hip_bfloat16;
using bf16x8=__attribute__((ext_vector_type(8)))short;
using s16x4=__attribute__((ext_vector_type(4)))short;
using f32x16=__attribute__((ext_vector_type(16)))float;
using u32x4=__attribute__((ext_vector_type(4)))unsigned;
constexpr int SEQ=8192,D=64,PQ=3328,PK=3328,PV=3328,PO=2048;
constexpr int NW=8,QBLK=32,QB=QBLK*NW,KVBLK=64,NQB=SEQ/QB;
constexpr int ATTN_UNIT_ROWS=QB;
__device__ __forceinline__ int crow(int r,int hi){return (r&3)+8*(r>>2)+4*hi;}
#define SBAR() __builtin_amdgcn_sched_barrier(0)
__device__ __forceinline__ void cmask(f32x16&p0,f32x16&p1,int jb,int qrel,int hi){
  const float NEG=-INFINITY; int kb=64*jb+4*hi;
  #pragma unroll
  for(int r=0;r<16;++r){int kv=kb+(r&3)+8*(r>>2); if(kv>qrel)p0[r]=NEG; if(kv+32>qrel)p1[r]=NEG;}
}

constexpr int NSLOT=3, SLOTB=8192, VSLOT=16384;
constexpr int LDS_K=0, LDS_V=NSLOT*SLOTB, LDS_WS=LDS_V+NSLOT*VSLOT, LDS_OST=LDS_WS+NW*64*4, LDS_BYTES=LDS_OST+NW*8192;
constexpr float C2=0.125f*1.4426950408889634f;
__device__ __forceinline__ void glds16(const void*gsrc,unsigned lds_dst){unsigned keep;
  asm volatile("s_mov_b32 %0, m0\n\ts_mov_b32 m0, %2\n\ts_nop 0\n\tglobal_load_lds_dwordx4 %1, off\n\ts_mov_b32 m0, %0":"=&s"(keep):"v"(gsrc),"s"(lds_dst):"memory");}
__device__ __forceinline__ float max3f(float a,float b,float c){float r;asm("v_max3_f32 %0, %1, %2, %3":"=v"(r):"v"(a),"v"(b),"v"(c));return r;}
__device__ __forceinline__ float max2f(float a,float b){float r;asm("v_max_f32_e32 %0, %1, %2":"=v"(r):"v"(a),"v"(b));return r;}
__device__ __forceinline__ float fadd_s(float a,float b){float r;asm("v_add_f32_e32 %0, %1, %2":"=v"(r):"v"(a),"v"(b));return r;}
__device__ __forceinline__ float fsub_s(float a,float b){float r;asm("v_sub_f32_e32 %0, %1, %2":"=v"(r):"v"(a),"v"(b));return r;}
typedef float f32x2_t __attribute__((ext_vector_type(2))); typedef __bf16 bf16x2_t __attribute__((ext_vector_type(2)));
__device__ __forceinline__ unsigned cvtpk_s(float lo,float hi){f32x2_t v={lo,hi};bf16x2_t b=__builtin_convertvector(v,bf16x2_t);return __builtin_bit_cast(unsigned,b);}
#define WAIT_BAR(N) asm volatile("s_waitcnt vmcnt(" #N ") lgkmcnt(0)\n\ts_barrier":::"memory")

__device__ __forceinline__ void qkt(f32x16&p0,f32x16&p1,const char*Kslot,const bf16x8*qr,const f32x16&negm,int r32,int hi){
  const char*kb=Kslot+hi*1024+r32*16;
  #pragma unroll
  for(int d0=0;d0<4;++d0){
    const bf16x8 b0=*reinterpret_cast<const bf16x8*>(kb+d0*2048);
    const bf16x8 b1=*reinterpret_cast<const bf16x8*>(kb+d0*2048+512);
    if(d0==0){p0=__builtin_amdgcn_mfma_f32_32x32x16_bf16(b0,qr[0],negm,0,0,0);p1=__builtin_amdgcn_mfma_f32_32x32x16_bf16(b1,qr[0],negm,0,0,0);}
    else{p0=__builtin_amdgcn_mfma_f32_32x32x16_bf16(b0,qr[d0],p0,0,0,0);p1=__builtin_amdgcn_mfma_f32_32x32x16_bf16(b1,qr[d0],p1,0,0,0);}}
}
typedef __attribute__((address_space(3))) const char* lds_cptr;
typedef short v4i16_t __attribute__((ext_vector_type(4)));
__device__ __forceinline__ void kload8(bf16x8*kf,lds_cptr kp){
  kf[0]=*(const __attribute__((address_space(3))) bf16x8*)(kp);      kf[1]=*(const __attribute__((address_space(3))) bf16x8*)(kp+512);
  kf[2]=*(const __attribute__((address_space(3))) bf16x8*)(kp+2048); kf[3]=*(const __attribute__((address_space(3))) bf16x8*)(kp+2560);
  kf[4]=*(const __attribute__((address_space(3))) bf16x8*)(kp+4096); kf[5]=*(const __attribute__((address_space(3))) bf16x8*)(kp+4608);
  kf[6]=*(const __attribute__((address_space(3))) bf16x8*)(kp+6144); kf[7]=*(const __attribute__((address_space(3))) bf16x8*)(kp+6656);
}
__device__ __forceinline__ void kload2(bf16x8*kf,lds_cptr kp,int j){ kf[2*j]=*(const __attribute__((address_space(3))) bf16x8*)(kp+j*2048); kf[2*j+1]=*(const __attribute__((address_space(3))) bf16x8*)(kp+j*2048+512); }
__device__ __forceinline__ s16x4 vtr(lds_cptr p){ return __builtin_bit_cast(s16x4,__builtin_amdgcn_ds_read_tr16_b64_v4i16((__attribute__((address_space(3))) v4i16_t*)p)); }
__device__ __forceinline__ float rowmax(const f32x16&p0,const f32x16&p1){
  float a=max3f(p0[0],p0[1],p1[0]),b=max3f(p0[2],p0[3],p1[1]);a=max3f(a,p1[2],p1[3]);
  #pragma unroll
  for(int r=4;r<16;r+=4){a=max3f(a,p0[r],p0[r+1]);b=max3f(b,p0[r+2],p0[r+3]);a=max3f(a,p1[r],p1[r+1]);b=max3f(b,p1[r+2],p1[r+3]);}
  const float m=max2f(a,b);
  auto rr=__builtin_amdgcn_permlane32_swap(__float_as_uint(m),__float_as_uint(m),false,false);
  return max2f(__uint_as_float(rr[0]),__uint_as_float(rr[1]));
}
__device__ __forceinline__ void pv(f32x16*o,int vb,bf16x8 pa0,bf16x8 pa1,bf16x8 pa2,bf16x8 pa3){
  #pragma unroll
  for(int d0=0;d0<4;++d0){s16x4 lo[4],hi[4];
    #pragma unroll
    for(int ks=0;ks<4;++ks){
      asm volatile("ds_read_b64_tr_b16 %0,%1 offset:%c2":"=&v"(lo[ks]):"v"(vb),"i"(d0*4096+ks*1024):"memory");
      asm volatile("ds_read_b64_tr_b16 %0,%1 offset:%c2":"=&v"(hi[ks]):"v"(vb),"i"(d0*4096+ks*1024+512):"memory");}
    asm volatile("s_waitcnt lgkmcnt(0)":::"memory");SBAR();
    #define PK(k) (bf16x8){lo[k][0],lo[k][1],lo[k][2],lo[k][3],hi[k][0],hi[k][1],hi[k][2],hi[k][3]}
    o[d0]=__builtin_amdgcn_mfma_f32_32x32x16_bf16(pa0,PK(0),o[d0],0,0,0);
    o[d0]=__builtin_amdgcn_mfma_f32_32x32x16_bf16(pa1,PK(1),o[d0],0,0,0);
    o[d0]=__builtin_amdgcn_mfma_f32_32x32x16_bf16(pa2,PK(2),o[d0],0,0,0);
    o[d0]=__builtin_amdgcn_mfma_f32_32x32x16_bf16(pa3,PK(3),o[d0],0,0,0);
    #undef PK
  }
}

#ifndef ATTN_STORE16
#define ATTN_STORE16(p,v) (*(u32x4*)(p)=(v))
#endif
template<int THRL> __device__ __forceinline__ void attn_unit(int b,int qcol,int kcol,int vcol,int ocol,int qb,const bf16*Q,const bf16*__restrict__ K,const bf16*__restrict__ V,bf16*O,char*shm,const int mode,const float lam,const float*gsub,bf16*MX,const float post,const float eps){
  int tid=threadIdx.x; asm volatile("":"+v"(tid));
  const int lane=tid&63,r32=lane&31,hi=lane>>5; const int wid=__builtin_amdgcn_readfirstlane(tid>>6);
  const long rowbase=(long)b*SEQ; const int q0=qb*QB;
  const bf16*Qw=Q+(rowbase+q0+wid*QBLK)*PQ+qcol;
  const bf16*Kh=K+rowbase*PK+kcol,*Vh=V+rowbase*PV+vcol;
  const unsigned lds0=(unsigned)(uintptr_t)shm;
  float*wsf=(float*)(shm+LDS_WS)+wid*64;
  const bf16*ksrc=Kh+(long)lane*PK+wid*8;
  const bf16*vsrc=Vh+(long)(16*(wid&3)+(lane>>2))*PV+(wid>>2)*32+(lane&3)*8;
  const unsigned kdst=lds0+LDS_K+wid*1024, vdst=lds0+LDS_V+wid*1024;
  #define DMA_K(t,slot) glds16(ksrc+(long)(t)*KVBLK*PK,(unsigned)__builtin_amdgcn_readfirstlane(kdst+(slot)))
  #define DMA_V(t,slot) do{ glds16(vsrc+(long)(t)*KVBLK*PV,(unsigned)__builtin_amdgcn_readfirstlane(vdst+2*(slot))); glds16(vsrc+64+(long)(t)*KVBLK*PV,(unsigned)__builtin_amdgcn_readfirstlane(vdst+2*(slot)+8192)); }while(0)
  const int vb0=(int)(lds0+LDS_V)+((lane>>4)&1)*32+(lane&3)*8+(4*hi+((lane&15)>>2))*64;
  const char*Kbase=shm+LDS_K; bf16x8 kf[8];
  const lds_cptr shm3=(lds_cptr)shm; const lds_cptr kp0=shm3+LDS_K+hi*1024+r32*16; const lds_cptr vp0=shm3+LDS_V+((lane>>4)&1)*32+(lane&3)*8+(4*hi+((lane&15)>>2))*64;
  const int NT=(q0+QB)/KVBLK;
  DMA_K(0,0);DMA_V(0,0);DMA_K(1,SLOTB);
  bf16x8 qr[4];
  #pragma unroll
  for(int d0=0;d0<4;++d0)qr[d0]=*reinterpret_cast<const bf16x8*>(&Qw[(long)r32*PQ+d0*16+hi*8]);
  { u32x4*qst_=(u32x4*)(shm+LDS_OST+wid*8192);
    _Pragma("unroll") for(int d0=0;d0<4;++d0)qst_[d0*64+lane]=__builtin_bit_cast(u32x4,qr[d0]); }
  const lds_cptr qsp=(lds_cptr)shm+LDS_OST+wid*8192+lane*16;
  float mhat=0.f,l_reg=0.f;f32x16 o[4];o[0]=f32x16{};o[1]=f32x16{};o[2]=f32x16{};o[3]=f32x16{};const f32x16 ZR=f32x16{};
  const int qrel=wid*QBLK+r32;
  #define CMASK(P0,P1,t) do{int jb_=(t)-(NT-4); if(jb_>=0)cmask(P0,P1,jb_,qrel,hi);}while(0)
  bool resc=false;
  #define START(P0,P1) do{ const float rm=rowmax(P0,P1); resc=false; \
    { const float dl=rm; mhat=fadd_s(mhat,dl); \
      _Pragma("unroll") for(int r=0;r<16;++r){P0[r]=fsub_s(P0[r],dl);P1[r]=fsub_s(P1[r],dl);} \
      } \
    _Pragma("unroll") for(int r=0;r<16;++r)P0[r]=__builtin_amdgcn_exp2f(P0[r]); }while(0)
  #define RESC() do{ if(resc){ asm volatile("s_waitcnt lgkmcnt(0)":::"memory"); \
      _Pragma("unroll") for(int d_=0;d_<4;++d_) _Pragma("unroll") for(int r=0;r<16;++r)o[d_][r]*=wsf[crow(r,hi)]; } }while(0)
  f32x16 pA0,pA1,pB0,pB1;
  int sl_prev=0,sl_cur=0,sl_next=SLOTB;
  #define ROT() do{sl_prev=sl_cur;sl_cur=sl_next;sl_next=(sl_next==(NSLOT-1)*SLOTB)?0:sl_next+SLOTB;}while(0)
  DMA_K(2,2*SLOTB);
  WAIT_BAR(4);
  qkt(pA0,pA1,Kbase,qr,ZR,r32,hi);asm volatile("s_nop 15\n\ts_nop 7":"+v"(pA0),"+v"(pA1));CMASK(pA0,pA1,0);
  START(pA0,pA1);
  _Pragma("unroll") for(int r=0;r<16;++r)pA1[r]=__builtin_amdgcn_exp2f(pA1[r]);
  WAIT_BAR(0);
  DMA_K(3,0);DMA_V(1,SLOTB);
  ROT();
  kload8(kf,kp0+sl_cur);
  WAIT_BAR(3);
  s16x4 vlo[8],vhi[8]; u32x4 pw0,pw1,pw2,pw3;
  #define PKW(P,B) cvtpk_s(P[B],P[B+1])
  #define PAF(k) __builtin_bit_cast(bf16x8,pw##k)
  #define VFR(i) (bf16x8){vlo[i][0],vlo[i][1],vlo[i][2],vlo[i][3],vhi[i][0],vhi[i][1],vhi[i][2],vhi[i][3]}
  #define PIN(x) asm volatile("":"+v"(x))
  #define MX3(a,b,c) __builtin_fmaxf(__builtin_fmaxf((a),(b)),(c))
  #define GAPA(MF,A0,A1,A2,A3,W0,W1,PW) do{ MF; sacc+=A0; sacc+=A1; sacc+=A2; sacc+=A3; PIN(sacc); W0; W1; PIN(PW); SBAR(); }while(0)
  #define EX(v) __builtin_amdgcn_exp2f(v)
  #define GAPB(MF,X,B) do{ MF; X[B]=EX(X[B]); X[B+1]=EX(X[B+1]); X[B+2]=EX(X[B+2]); X[B+3]=EX(X[B+3]); PIN(X); SBAR(); }while(0)
  #define VRD(i) do{ vlo[i]=vtr(vp_+(((i)>>2)*4096+((i)&3)*1024)); vhi[i]=vtr(vp_+(((i)>>2)*4096+((i)&3)*1024+512)); }while(0)
  #define VRD2(i) do{ vlo[i]=vtr(vp_+((((i)>>2)+2)*4096+((i)&3)*1024)); vhi[i]=vtr(vp_+((((i)>>2)+2)*4096+((i)&3)*1024+512)); }while(0)
  #define GAPB2(MF,X,B,RD) do{ MF; X[B]=__builtin_amdgcn_exp2f(X[B]); X[B+1]=__builtin_amdgcn_exp2f(X[B+1]); asm volatile("":"+v"(X)); RD; SBAR(); }while(0)
  #define KRD(G,j) do{ if(G){ kload2(kf,kp0+sl_next,j); SBAR(); } }while(0)
  #define STEP(C0,C1,P0,P1,t,GK,GV,GL) do{ SBAR(); \
    const lds_cptr vp_=vp0+2*sl_prev; \
    _Pragma("unroll") for(int d0=0;d0<4;++d0)qr[d0]=*(const __attribute__((address_space(3))) bf16x8*)(qsp+d0*1024); SBAR(); \
    float sacc=(P0[0]+P0[1]); \
    GAPA(C0=__builtin_amdgcn_mfma_f32_32x32x16_bf16(kf[0],qr[0],ZR,0,0,0), P0[2],P0[3],P0[4],P0[5],     pw0[0]=PKW(P0,0), pw0[1]=PKW(P0,2), pw0); VRD(0); SBAR(); \
    GAPA(C1=__builtin_amdgcn_mfma_f32_32x32x16_bf16(kf[1],qr[0],ZR,0,0,0), P0[6],P0[7],P0[8],P0[9],     pw0[2]=PKW(P0,4), pw0[3]=PKW(P0,6), pw0); VRD(4); SBAR(); \
    GAPA(C0=__builtin_amdgcn_mfma_f32_32x32x16_bf16(kf[2],qr[1],C0,0,0,0),   P0[10],P0[11],P0[12],P0[13], pw1[0]=PKW(P0,8), pw1[1]=PKW(P0,10), pw1); VRD(1); SBAR(); \
    GAPA(C1=__builtin_amdgcn_mfma_f32_32x32x16_bf16(kf[3],qr[1],C1,0,0,0),   P0[14],P0[15],P1[0],P1[1],   pw1[2]=PKW(P0,12),pw1[3]=PKW(P0,14), pw1); VRD(5); SBAR(); \
    GAPA(C0=__builtin_amdgcn_mfma_f32_32x32x16_bf16(kf[4],qr[2],C0,0,0,0),   P1[2],P1[3],P1[4],P1[5],     pw2[0]=PKW(P1,0), pw2[1]=PKW(P1,2), pw2); VRD(2); SBAR(); \
    GAPA(C1=__builtin_amdgcn_mfma_f32_32x32x16_bf16(kf[5],qr[2],C1,0,0,0),   P1[6],P1[7],P1[8],P1[9],     pw2[2]=PKW(P1,4), pw2[3]=PKW(P1,6), pw2); VRD(6); SBAR(); \
    GAPA(C0=__builtin_amdgcn_mfma_f32_32x32x16_bf16(kf[6],qr[3],C0,0,0,0),   P1[10],P1[11],P1[12],P1[13], pw3[0]=PKW(P1,8), pw3[1]=PKW(P1,10), pw3); VRD(3); SBAR(); \
    GAPA(C1=__builtin_amdgcn_mfma_f32_32x32x16_bf16(kf[7],qr[3],C1,0,0,0),   P1[14],P1[15],0.f,0.f,       pw3[2]=PKW(P1,12),pw3[3]=PKW(P1,14), pw3); VRD(7); SBAR(); \
    _Pragma("unroll") for(int r=0;r<16;++r){C0[r]-=mhat;C1[r]-=mhat;} \
    l_reg+=sacc; \
    if(GK){DMA_K((t)+3,sl_cur);} if(GV){DMA_V((t)+1,sl_next);} \
    CMASK(C0,C1,t); \
    { float a=MX3(C0[0],C0[1],C1[0]),b=MX3(C0[2],C0[3],C1[1]); a=MX3(a,C1[2],C1[3]); \
      _Pragma("unroll") for(int r=4;r<16;r+=4){a=MX3(a,C0[r],C0[r+1]);b=MX3(b,C0[r+2],C0[r+3]);a=MX3(a,C1[r],C1[r+1]);b=MX3(b,C1[r+2],C1[r+3]);} \
      float rm=__builtin_fmaxf(a,b); { auto rr=__builtin_amdgcn_permlane32_swap(__float_as_uint(rm),__float_as_uint(rm),false,false); rm=__builtin_fmaxf(__uint_as_float(rr[0]),__uint_as_float(rr[1])); } \
      resc=false; \
      if(__builtin_expect(__any(rm>(float)THRL),0)){ const float dl=__builtin_fmaxf(rm,0.f); mhat+=dl; \
        _Pragma("unroll") for(int r=0;r<16;++r){C0[r]-=dl;C1[r]-=dl;} \
        const float f=__builtin_amdgcn_exp2f(-dl); l_reg*=f; if(hi==0)wsf[r32]=f; resc=true; } } \
    SBAR(); \
      \
    GAPB2(o[0]=__builtin_amdgcn_mfma_f32_32x32x16_bf16(PAF(0),VFR(0),o[0],0,0,0), C0,0,  VRD2(0)); \
    GAPB2(o[1]=__builtin_amdgcn_mfma_f32_32x32x16_bf16(PAF(0),VFR(4),o[1],0,0,0), C0,2,  VRD2(4)); \
    GAPB2(o[0]=__builtin_amdgcn_mfma_f32_32x32x16_bf16(PAF(1),VFR(1),o[0],0,0,0), C0,4,  VRD2(1)); \
    GAPB2(o[1]=__builtin_amdgcn_mfma_f32_32x32x16_bf16(PAF(1),VFR(5),o[1],0,0,0), C0,6,  VRD2(5)); \
    GAPB2(o[0]=__builtin_amdgcn_mfma_f32_32x32x16_bf16(PAF(2),VFR(2),o[0],0,0,0), C0,8,  VRD2(2)); \
    GAPB2(o[1]=__builtin_amdgcn_mfma_f32_32x32x16_bf16(PAF(2),VFR(6),o[1],0,0,0), C0,10, VRD2(6)); \
    GAPB2(o[0]=__builtin_amdgcn_mfma_f32_32x32x16_bf16(PAF(3),VFR(3),o[0],0,0,0), C0,12, VRD2(3)); \
    GAPB2(o[1]=__builtin_amdgcn_mfma_f32_32x32x16_bf16(PAF(3),VFR(7),o[1],0,0,0), C0,14, VRD2(7)); \
      \
    GAPB2(o[2]=__builtin_amdgcn_mfma_f32_32x32x16_bf16(PAF(0),VFR(0),o[2],0,0,0), C1,0,  (void)0); \
    GAPB2(o[3]=__builtin_amdgcn_mfma_f32_32x32x16_bf16(PAF(0),VFR(4),o[3],0,0,0), C1,2,  (void)0); \
    KRD(GL,0); GAPB2(o[2]=__builtin_amdgcn_mfma_f32_32x32x16_bf16(PAF(1),VFR(1),o[2],0,0,0), C1,4,  (void)0); \
    KRD(GL,1); GAPB2(o[3]=__builtin_amdgcn_mfma_f32_32x32x16_bf16(PAF(1),VFR(5),o[3],0,0,0), C1,6,  (void)0); \
    KRD(GL,2); GAPB2(o[2]=__builtin_amdgcn_mfma_f32_32x32x16_bf16(PAF(2),VFR(2),o[2],0,0,0), C1,8,  (void)0); \
    KRD(GL,3); GAPB2(o[3]=__builtin_amdgcn_mfma_f32_32x32x16_bf16(PAF(2),VFR(6),o[3],0,0,0), C1,10, (void)0); \
    GAPB2(o[2]=__builtin_amdgcn_mfma_f32_32x32x16_bf16(PAF(3),VFR(3),o[2],0,0,0), C1,12, (void)0); \
    GAPB2(o[3]=__builtin_amdgcn_mfma_f32_32x32x16_bf16(PAF(3),VFR(7),o[3],0,0,0), C1,14, (void)0); \
    }while(0)
  int t=1;
  #undef CMASK
  #define CMASK(P0,P1,t) do{}while(0)
  for(;t+5<NT;t+=2){
    STEP(pB0,pB1,pA0,pA1,t,true,true,true);     WAIT_BAR(3); RESC(); ROT();
    STEP(pA0,pA1,pB0,pB1,t+1,true,true,true);   WAIT_BAR(3); RESC(); ROT();
  }
  #undef CMASK
  #define CMASK(P0,P1,t) do{int jb_=(t)-(NT-4); if(jb_>=0)cmask(P0,P1,jb_,qrel,hi);}while(0)
  #define ENDW(tt) do{ if((tt)+3<NT){WAIT_BAR(3);} else if((tt)+2<NT){WAIT_BAR(2);} else {WAIT_BAR(0);} }while(0)
  for(;t+1<NT;t+=2){
    STEP(pB0,pB1,pA0,pA1,t,(t+3<NT),(t+1<NT),(t+1<NT));       ENDW(t);   RESC(); ROT();
    STEP(pA0,pA1,pB0,pB1,t+1,(t+4<NT),(t+2<NT),(t+2<NT));     ENDW(t+1); RESC(); ROT();
  }
  STEP(pB0,pB1,pA0,pA1,NT-1,false,false,false); RESC();
  { float sacc=pB0[0]+pB0[1]; _Pragma("unroll") for(int r=2;r<16;++r)sacc+=pB0[r]; _Pragma("unroll") for(int r=0;r<16;++r)sacc+=pB1[r]; l_reg+=sacc;
    pw0=(u32x4){PKW(pB0,0),PKW(pB0,2),PKW(pB0,4),PKW(pB0,6)};pw1=(u32x4){PKW(pB0,8),PKW(pB0,10),PKW(pB0,12),PKW(pB0,14)};pw2=(u32x4){PKW(pB1,0),PKW(pB1,2),PKW(pB1,4),PKW(pB1,6)};pw3=(u32x4){PKW(pB1,8),PKW(pB1,10),PKW(pB1,12),PKW(pB1,14)};
    SBAR(); pv(o,vb0+2*sl_cur,PAF(0),PAF(1),PAF(2),PAF(3)); }
  #undef PKW
  #undef PAF
  #undef VFR
  #undef PIN
  #undef MX3
  #undef GAPA
  #undef GAPB
  #undef EX
  #undef VRD
  #undef VRD2
  #undef GAPB2
  #undef KRD
  #undef STEP
  #undef ENDW
  {auto rr=__builtin_amdgcn_permlane32_swap(__float_as_uint(l_reg),__float_as_uint(l_reg),false,false);l_reg=__uint_as_float(rr[0])+__uint_as_float(rr[1]);}
  if(hi==0)wsf[32+r32]=l_reg;asm volatile("s_waitcnt lgkmcnt(0)":::"memory");
  float rli[16];
  #pragma unroll
  for(int r=0;r<16;++r)rli[r]=__builtin_amdgcn_rcpf(wsf[32+crow(r,hi)]);
  bf16*Ow=O+(rowbase+q0+wid*QBLK)*PO+ocol;
  { bf16*stg=(bf16*)(shm+LDS_OST)+wid*4096;
    #pragma unroll
    for(int r=0;r<16;++r){const int orow=crow(r,hi);
      #pragma unroll
      for(int d0=0;d0<4;++d0)stg[orow*128+d0*32+r32]=__float2bfloat16(o[d0][r]*rli[r]);}
    asm volatile("s_waitcnt lgkmcnt(0)":::"memory");
    if(mode==0){
    #pragma unroll
    for(int i=0;i<8;++i){const int row=i*4+(lane>>4),ch=lane&15; const u32x4 v=*(const u32x4*)(stg+row*128+ch*8); ATTN_STORE16(Ow+(long)row*PO+ch*8,v);} }
    else{ const int ch=lane&15; float gs[8];
    #pragma unroll
    for(int j=0;j<8;++j)gs[j]=gsub[ch*8+j];
    bf16*Mw=MX+(rowbase+q0+wid*QBLK)*1024;
    #pragma unroll
    for(int i0=0;i0<8;i0+=4){ u32x4 o1[4];
    #pragma unroll
    for(int i=0;i<4;++i){const int row=(i0+i)*4+(lane>>4); o1[i]=*(const u32x4*)(Ow+(long)row*PO+ch*8);}
    #pragma unroll
    for(int i=0;i<4;++i){const int row=(i0+i)*4+(lane>>4); const u32x4 v=*(const u32x4*)(stg+row*128+ch*8); const u32x4 a_=o1[i]; float y[8];
      const unsigned aw[4]={a_.x,a_.y,a_.z,a_.w}, vw[4]={v.x,v.y,v.z,v.w};
      #pragma unroll
      for(int j=0;j<4;++j){ y[2*j]=__uint_as_float(aw[j]<<16)-lam*__uint_as_float(vw[j]<<16); y[2*j+1]=__uint_as_float(aw[j]&0xffff0000u)-lam*__uint_as_float(vw[j]&0xffff0000u); }
      float ss=0.f;
      #pragma unroll
      for(int j=0;j<8;++j)ss+=y[j]*y[j];
      ss+=__uint_as_float((unsigned)__builtin_amdgcn_mov_dpp((int)__float_as_uint(ss),0xB1,0xF,0xF,true)); ss+=__uint_as_float((unsigned)__builtin_amdgcn_mov_dpp((int)__float_as_uint(ss),0x4E,0xF,0xF,true));
      ss+=__uint_as_float((unsigned)__builtin_amdgcn_mov_dpp((int)__float_as_uint(ss),0x141,0xF,0xF,true)); ss+=__uint_as_float((unsigned)__builtin_amdgcn_mov_dpp((int)__float_as_uint(ss),0x140,0xF,0xF,true));
      const float rstd=post*__builtin_amdgcn_rsqf(ss*(1.f/128.f)+eps);
      u32x4 w; w.x=pg8::cvt_pk_bf16(y[0]*rstd*gs[0],y[1]*rstd*gs[1]); w.y=pg8::cvt_pk_bf16(y[2]*rstd*gs[2],y[3]*rstd*gs[3]); w.z=pg8::cvt_pk_bf16(y[4]*rstd*gs[4],y[5]*rstd*gs[5]); w.w=pg8::cvt_pk_bf16(y[6]*rstd*gs[6],y[7]*rstd*gs[7]);
      *(u32x4*)(Mw+(long)row*1024+ch*8)=w; } } } }
  asm volatile("s_waitcnt lgkmcnt(0)\n\ts_barrier":::"memory");
  #undef DMA_K
  #undef DMA_V
  #undef CMASK
  #undef START
  #undef RESC
  #undef ROT
}
constexpr int ATTN_LDS_BYTES=LDS_BYTES;
#undef SBAR
#undef WAIT_BAR
}
constexpr int NWAVES = 8;
#ifndef MK_N_LAUNCHES
#define MK_N_LAUNCHES 1
#endif
constexpr int NPHASE = 13;
constexpr int N_LAUNCHES = MK_N_LAUNCHES;

constexpr int NB = 4, SEQL = 8192, DMODEL = 1024, TOK = NB * SEQL;
constexpr int IN_W = 3088;
constexpr int NPROJ = 3328;
constexpr int C_GQ = 0, C_GK = 256, C_GV = 512, C_GZ = 1024, C_GR = 1280, C_DQ = 1792, C_DK = 2304, C_DV = 2816;
constexpr int NUNIT = 2048;
constexpr int PEER_N = 16384, NQP = 2048;
constexpr float RMS_EPS = 1e-6f;
constexpr float LAMBDA_INIT = 0.2f;

constexpr size_t MiB = 1u << 20;
constexpr size_t WS_CTL = 0, CTL_ZERO_BYTES = 65536;
constexpr size_t WS_WIN = 1 * MiB, WS_WOUT = 8 * MiB, WS_WQ = 10 * MiB, WS_KEYS = 14 * MiB;
constexpr size_t WS_KVT = 16 * MiB, WS_VT = 48 * MiB;
constexpr size_t WS_U = 16 * MiB, WS_V = 48 * MiB;
constexpr size_t WS_SGE = 80 * MiB, WS_AE = 96 * MiB, WS_OFFS = 112 * MiB;
constexpr size_t WS_XT = 384 * MiB;
constexpr size_t WS_AE2 = 208 * MiB, WS_CNT = 113 * MiB;
constexpr size_t WS_XN = 80 * MiB, WS_MIX = 80 * MiB;
constexpr size_t WS_PROJ = 144 * MiB;
constexpr size_t WS_XN2 = 144 * MiB, WS_QP = 208 * MiB;
constexpr size_t WS_O = 352 * MiB;
constexpr size_t WS_IDX = 352 * MiB;
constexpr size_t WS_KTT = 480 * MiB;
constexpr size_t WS_DEC = 496 * MiB;
constexpr size_t WS_ROPE = 497 * MiB;
constexpr int NVT = PEER_N * DMODEL / 8, NUT = PEER_N * DMODEL / 16;
constexpr size_t WS_SSP = 499 * MiB, WS_RSTD = 501 * MiB;
constexpr size_t WS_END = 502 * MiB;
constexpr int CW_BAR = 4096;

constexpr int RING_OFF = 0, RING_BYTES = 131072;
constexpr int LDSCTL_OFF = 163840 - 512, MISC_OFF = LDSCTL_OFF + 320;
constexpr int LDS_BYTES = 163840;
static_assert(MISC_OFF + 128 <= LDS_BYTES, "LDS map");

#define GAS __attribute__((address_space(1)))
#define LAS __attribute__((address_space(3)))
typedef unsigned short bf16;
typedef unsigned v4u __attribute__((ext_vector_type(4)));
typedef unsigned v2u __attribute__((ext_vector_type(2)));
typedef float f32x4 __attribute__((ext_vector_type(4)));
typedef float f32x16 __attribute__((ext_vector_type(16)));
typedef short bf16x8 __attribute__((ext_vector_type(8)));
typedef short s16x4 __attribute__((ext_vector_type(4)));
typedef GAS unsigned gu32;
typedef _Float16 h2 __attribute__((ext_vector_type(2)));
typedef _Float16 f16x8 __attribute__((ext_vector_type(8)));
#define RLX_AGENT __ATOMIC_RELAXED, __HIP_MEMORY_SCOPE_AGENT
#define LDS_WAIT() asm volatile("s_waitcnt lgkmcnt(0)" ::: "memory")
#define VM_WAIT() asm volatile("s_waitcnt vmcnt(0)" ::: "memory")
__device__ __forceinline__ unsigned f2bf(float f) { unsigned u = __builtin_bit_cast(unsigned, f); return (u + 0x7fffu + ((u >> 16) & 1u)) >> 16; }
__device__ __forceinline__ unsigned pk2(float lo, float hi) { return f2bf(lo) | (f2bf(hi) << 16); }
__device__ __forceinline__ unsigned pkh(float lo, float hi) { h2 v; v.x = (_Float16)lo; v.y = (_Float16)hi; return __builtin_bit_cast(unsigned, v); }
__device__ __forceinline__ void glds16s(const void* sbase, unsigned voff, unsigned lds_dst) { unsigned keep;
  asm volatile("s_mov_b32 %0, m0\n\ts_mov_b32 m0, %3\n\ts_nop 0\n\tglobal_load_lds_dwordx4 %1, %2\n\ts_mov_b32 m0, %0" : "=&s"(keep) : "v"(voff), "s"(sbase), "s"(lds_dst) : "memory"); }
__device__ __forceinline__ unsigned f2h16(float f) { const _Float16 h = (_Float16)f; return (unsigned)__builtin_bit_cast(unsigned short, h); }
__device__ __forceinline__ h2 u2h(unsigned u) { return __builtin_bit_cast(h2, u); }
__device__ __forceinline__ void fma_mix_lo(float& acc, unsigned hb, float a) { asm("v_fma_mix_f32 %0, %1, %2, %0 op_sel_hi:[1,0,0]" : "+v"(acc) : "v"(hb), "v"(a)); }
__device__ __forceinline__ void fma_mix_hi(float& acc, unsigned hb, float a) { asm("v_fma_mix_f32 %0, %1, %2, %0 op_sel:[1,0,0] op_sel_hi:[1,0,0]" : "+v"(acc) : "v"(hb), "v"(a)); }
__device__ __forceinline__ f16x8 v2f16x8(v4u v) { return __builtin_bit_cast(f16x8, v); }
__device__ __forceinline__ long v2l(v2u v) { return __builtin_bit_cast(long, v); }
__device__ __forceinline__ unsigned pk8(float a, float b, float c, float d) { int w = __builtin_amdgcn_cvt_pk_fp8_f32(a, b, 0, false); w = __builtin_amdgcn_cvt_pk_fp8_f32(c, d, w, true); return (unsigned)w; }
__device__ __forceinline__ float bf2f(unsigned b) { return __builtin_bit_cast(float, b << 16); }
__device__ __forceinline__ float bflo(unsigned w) { return __builtin_bit_cast(float, w << 16); }
__device__ __forceinline__ float bfhi(unsigned w) { return __builtin_bit_cast(float, w & 0xffff0000u); }
__device__ __forceinline__ int crow(int r, int hi) { return (r & 3) + 8 * (r >> 2) + 4 * hi; }
__device__ __forceinline__ float wave_sum(float v) {
#pragma unroll
    for (int o = 1; o < 64; o <<= 1) v += __shfl_xor(v, o);
    return v;
}
__device__ __forceinline__ float fmax_s(float a, float b) { float r; asm("v_max_f32_e32 %0, %1, %2" : "=v"(r) : "v"(a), "v"(b)); return r; }
__device__ __forceinline__ float fmin_s(float a, float b) { float r; asm("v_min_f32_e32 %0, %1, %2" : "=v"(r) : "v"(a), "v"(b)); return r; }

#define XB_TMO      128
#define XB_XCNT(j)  (256  + 64 * (j))
#define XB_XSUB(j)  (1280 + 64 * (j))
#define XB_XGEN(j)  (2304 + 64 * (j))
#define XB_TOP      3328
#define XB_TOPGEN   3392
#define XCD_BAR_WORDS 3456
#define XB_SPIN_CAP (1u << 18)

__device__ __forceinline__ unsigned xb_ld(unsigned* p)              { return __hip_atomic_load(p, __ATOMIC_RELAXED, __HIP_MEMORY_SCOPE_AGENT); }
__device__ __forceinline__ unsigned xb_add(unsigned* p, unsigned v) { return __hip_atomic_fetch_add(p, v, __ATOMIC_RELAXED, __HIP_MEMORY_SCOPE_AGENT); }
__device__ __forceinline__ unsigned xb_xcc_id() { return (unsigned)__builtin_amdgcn_s_getreg((3 << 11) | 20) & 0xFu; }
#define XB_SPIN(cond, bar) do { unsigned _sp = 0; while (cond) { __builtin_amdgcn_s_sleep(1); \
    if ((++_sp & 255u) == 0u) { if (xb_ld(&(bar)[XB_TMO])) break; if (_sp > XB_SPIN_CAP) { atomicAdd(&(bar)[XB_TMO], 1u); break; } } } } while (0)

struct XcdBarrier {
    unsigned* bar; unsigned x;
    volatile LAS unsigned* st;
};

__device__ __forceinline__ XcdBarrier xcd_barrier_post(unsigned* bar, volatile LAS unsigned* st) {
    XcdBarrier b; b.bar = bar; b.x = xb_xcc_id(); b.st = st;
    if (threadIdx.x == 0) (void)xb_add(&bar[XB_XCNT(b.x)], 1u);
    return b;
}
__device__ __forceinline__ void xcd_barrier_complete(unsigned* bar, unsigned x, unsigned& nloc, unsigned& nx) {
    const unsigned G = gridDim.x * gridDim.y * gridDim.z;
    unsigned sum, cnt, mine, sp = 0u;
    for (;;) {
        sum = 0u; cnt = 0u; mine = 0u;
#pragma unroll
        for (unsigned j = 0; j < 16; ++j) { const unsigned c = xb_ld(&bar[XB_XCNT(j)]); sum += c; cnt += (c > 0u) ? 1u : 0u; mine = (j == x) ? c : mine; }
        if (sum == G) break;
        __builtin_amdgcn_s_sleep(1);
        if ((++sp & 255u) == 0u) { if (xb_ld(&bar[XB_TMO])) break; if (sp > XB_SPIN_CAP) { atomicAdd(&bar[XB_TMO], 1u); break; } }
    }
    nloc = mine > 0u ? mine : 1u; nx = cnt > 0u ? cnt : 1u;
}

__device__ __forceinline__ void xcd_barrier(const XcdBarrier& b) {
    asm volatile("s_waitcnt vmcnt(0)" ::: "memory");
    __syncthreads();
    if (threadIdx.x == 0) {
        unsigned* bar = b.bar;
        __builtin_amdgcn_s_waitcnt(0);
        unsigned nloc = b.st[0], nx = b.st[1];
        if (nloc == 0u) { xcd_barrier_complete(bar, b.x, nloc, nx); b.st[0] = nloc; b.st[1] = nx; }
        const unsigned old = xb_add(&bar[XB_XSUB(b.x)], 1u);
        const unsigned gen = old / nloc;
        if (old + 1u == (gen + 1u) * nloc) {
            __builtin_amdgcn_fence(__ATOMIC_RELEASE, "agent");
            asm volatile("s_waitcnt vmcnt(0)" ::: "memory");
            const unsigned og = xb_add(&bar[XB_TOP], 1u);
            const unsigned tg = og / nx;
            if (og + 1u == (tg + 1u) * nx) xb_add(&bar[XB_TOPGEN], 1u);
            else XB_SPIN(xb_ld(&bar[XB_TOPGEN]) == tg, bar);
            __builtin_amdgcn_fence(__ATOMIC_ACQUIRE, "agent");
            xb_add(&bar[XB_XGEN(b.x)], 1u);
            asm volatile("s_waitcnt vmcnt(0)" ::: "memory");
        } else {
            XB_SPIN(xb_ld(&bar[XB_XGEN(b.x)]) == gen, bar);
            __builtin_amdgcn_fence(__ATOMIC_ACQUIRE, "agent");
            asm volatile("s_waitcnt vmcnt(0)" ::: "memory");
        }
    }
    __syncthreads();
}


__device__ __forceinline__ void transpose_item(const float* W, int pitch, int K, bf16* WT, int row_off, LAS float* scr, int kb, int nb, int lane, const float* ksc = nullptr) {
    const int k0 = 64 * kb, n0 = 32 * nb;
#pragma unroll 8
    for (int i = 0; i < 32; ++i) { const int kk = 2 * i + (lane >> 5); const float w_ = W[(size_t)(k0 + kk) * pitch + n0 + (lane & 31)]; scr[kk * 33 + (lane & 31)] = ksc ? w_ * ksc[k0 + kk] : w_; }
    LDS_WAIT(); asm volatile("" ::: "memory");
    const int c = lane & 7;
#pragma unroll
    for (int j = 0; j < 4; ++j) { const int n = (lane >> 3) + 8 * j; const LAS float* s = scr + (8 * c) * 33 + n;
        v4u o; o.x = pk2(s[0 * 33], s[1 * 33]); o.y = pk2(s[2 * 33], s[3 * 33]); o.z = pk2(s[4 * 33], s[5 * 33]); o.w = pk2(s[6 * 33], s[7 * 33]);
        *(GAS v4u*)(WT + (size_t)(row_off + n0 + n) * K + k0 + 8 * c) = o; }
    LDS_WAIT(); asm volatile("" ::: "memory");
}
template <bool HALF_COPY> __device__ __forceinline__ void rms_row_to_bf16(const float* xrow, const float* gain, bf16* orow, LAS unsigned char* hrow, int lane) {
    const GAS f32x4* xr = (const GAS f32x4*)xrow + lane; const GAS f32x4* gr = (const GAS f32x4*)gain + lane;
    f32x4 v[4]; float s = 0.f;
#pragma unroll
    for (int j = 0; j < 4; ++j) { v[j] = xr[64 * j]; s += (v[j].x * v[j].x + v[j].y * v[j].y) + (v[j].z * v[j].z + v[j].w * v[j].w); }
    const float rstd = 1.f / sqrtf(wave_sum(s) * (1.f / DMODEL) + RMS_EPS);
    GAS unsigned long long* o8 = (GAS unsigned long long*)orow + lane;
#pragma unroll
    for (int j = 0; j < 4; ++j) { const f32x4 g = gr[64 * j];
        o8[64 * j] = (unsigned long long)pk2(v[j].x * rstd * g.x, v[j].y * rstd * g.y) | ((unsigned long long)pk2(v[j].z * rstd * g.z, v[j].w * rstd * g.w) << 32);
        if (HALF_COPY) ((LAS unsigned*)hrow + lane)[64 * j] = pk8(v[j].x * rstd * g.x, v[j].y * rstd * g.y, v[j].z * rstd * g.z, v[j].w * rstd * g.w); }
}

template <int S> __device__ __forceinline__ int shfl_xor_c(int v) {
    if constexpr (S == 1) return __builtin_amdgcn_mov_dpp(v, 0xB1, 0xF, 0xF, true);
    else if constexpr (S == 2) return __builtin_amdgcn_mov_dpp(v, 0x4E, 0xF, 0xF, true);
    else if constexpr (S == 4) return __builtin_amdgcn_mov_dpp(__builtin_amdgcn_mov_dpp(v, 0x1B, 0xF, 0xF, true), 0x141, 0xF, 0xF, true);
    else if constexpr (S == 8) return __builtin_amdgcn_mov_dpp(__builtin_amdgcn_mov_dpp(v, 0x141, 0xF, 0xF, true), 0x140, 0xF, 0xF, true);
    else return __shfl_xor(v, S);
}
template <int SIZE, int STRIDE> __device__ __forceinline__ void sort128_level(int& k0, int& k1, int lane) {
    if constexpr (STRIDE == 64) { const int mn = min(k0, k1), mxv = max(k0, k1); k0 = mn; k1 = mxv; }
    else {
        const bool lower = (lane & STRIDE) == 0;
        { const int o = shfl_xor_c<STRIDE>(k0); const bool up = ((lane & SIZE) == 0); k0 = (lower == up) ? min(k0, o) : max(k0, o); }
        { const int o = shfl_xor_c<STRIDE>(k1); const bool up = (((64 + lane) & SIZE) == 0); k1 = (lower == up) ? min(k1, o) : max(k1, o); }
    }
}
template <int SIZE, int STRIDE> __device__ __forceinline__ void sort128_merge(int& k0, int& k1, int lane) {
    sort128_level<SIZE, STRIDE>(k0, k1, lane);
    if constexpr (STRIDE > 1) sort128_merge<SIZE, STRIDE / 2>(k0, k1, lane);
}
template <int SIZE> __device__ __forceinline__ void sort128_from(int& k0, int& k1, int lane) {
    sort128_merge<SIZE, SIZE / 2>(k0, k1, lane);
    if constexpr (SIZE < 128) sort128_from<SIZE * 2>(k0, k1, lane);
}

__device__ __forceinline__ void ce_desc(float& a, float& b) { const float mx = fmax_s(a, b), mn = fmin_s(a, b); a = mx; b = mn; }
__device__ __forceinline__ void sort16_desc(float (&v)[16]) {
#pragma unroll
    for (int k = 2; k <= 16; k <<= 1) {
#pragma unroll
        for (int j = k >> 1; j > 0; j >>= 1) {
#pragma unroll
            for (int i = 0; i < 16; ++i) { const int l = i ^ j; if (l > i) { if ((i & k) == 0) ce_desc(v[i], v[l]); else ce_desc(v[l], v[i]); } }
        }
    }
}
__device__ __forceinline__ void merge16_desc(float (&a)[16], const float (&b)[16]) {
#pragma unroll
    for (int i = 0; i < 16; ++i) a[i] = fmax_s(a[i], b[15 - i]);
#pragma unroll
    for (int j = 8; j > 0; j >>= 1) {
#pragma unroll
        for (int i = 0; i < 16; ++i) { const int l = i ^ j; if (l > i) ce_desc(a[i], a[l]); }
    }
}
__device__ __forceinline__ float gelu_erf(float v) {
    const float av = fabsf(v), t = __builtin_amdgcn_rcpf(av * 0.2316418882f + 1.0f);
    float q = t * 0.5307027145f + (-0.7265760135f); q = q * t + 0.7107068705f; q = q * t + (-0.142248368f); q = q * t + 0.127414796f; q = q * t;
    const float e = __builtin_amdgcn_exp2f((v * v) * (-0.72134752044f));
    const float m = v * (q * e);
    return v < 0.f ? m : v - m;
}

struct Args { const void* in[20]; float* out; unsigned char* ws; int ph_lo, ph_hi, li, pad; };
__global__ void __launch_bounds__(NWAVES * 64, 2) hymba_fwd(Args args) {
    extern __shared__ __attribute__((aligned(16))) unsigned char lds[];
    LAS unsigned char* const ldsl = (LAS unsigned char*)lds;
    volatile LAS unsigned* const MISC = (volatile LAS unsigned*)(ldsl + MISC_OFF);
    const int tid = threadIdx.x, lane = tid & 63, wave = __builtin_amdgcn_readfirstlane(tid >> 6);
    const int G = gridDim.x; const int bx = blockIdx.x; const int vcu = (G % 8 == 0) ? (bx % 8) * (G / 8) + bx / 8 : bx;
    const int gw = vcu * NWAVES + wave, NGW = G * NWAVES;
    const int gt = vcu * (NWAVES * 64) + tid, NGT = G * NWAVES * 64;
    const int r32 = lane & 31, hi = lane >> 5;
#define PHASE_LOCALS int tid_o_ = threadIdx.x; asm volatile("" : "+v"(tid_o_)); const int tid = tid_o_, lane = tid & 63, r32 = lane & 31, hi = lane >> 5; const int gt = vcu * (NWAVES * 64) + tid; (void)r32; (void)hi; (void)gt; (void)lane;
    unsigned char* const ws = args.ws;
    gu32* const ctl = (gu32*)(ws + WS_CTL);
    const float* x = (const float*)args.in[0]; const int* positions = (const int*)args.in[1]; const float* g_mix = (const float*)args.in[2]; const float* w_in = (const float*)args.in[3];
    const float* w_gate = (const float*)args.in[4]; const float* b_gate = (const float*)args.in[5]; const float* g_gla_out = (const float*)args.in[6]; const float* g_q = (const float*)args.in[7];
    const float* g_k = (const float*)args.in[8]; const float* lq1 = (const float*)args.in[9]; const float* lk1 = (const float*)args.in[10]; const float* lq2 = (const float*)args.in[11];
    const float* lk2 = (const float*)args.in[12]; const float* g_sub = (const float*)args.in[13]; const float* w_out = (const float*)args.in[14]; const float* g_ffn = (const float*)args.in[15];
    const float* w_pq = (const float*)args.in[16]; const float* sub_keys = (const float*)args.in[17]; const float* peer_u = (const float*)args.in[18]; const float* peer_v = (const float*)args.in[19];
    float* const out = args.out;
    bf16* const Win_t = (bf16*)(ws + WS_WIN); bf16* const Wout_t = (bf16*)(ws + WS_WOUT); bf16* const Wq_t = (bf16*)(ws + WS_WQ); bf16* const KEYS = (bf16*)(ws + WS_KEYS);
    bf16* const KVT = (bf16*)(ws + WS_KVT); bf16* const VT = (bf16*)(ws + WS_VT); bf16* const UB = (bf16*)(ws + WS_U); bf16* const VB = (bf16*)(ws + WS_V);
    bf16* const XN = (bf16*)(ws + WS_XN); bf16* const MIX = (bf16*)(ws + WS_MIX); bf16* const PROJ = (bf16*)(ws + WS_PROJ); bf16* const XN2 = (bf16*)(ws + WS_XN2);
    bf16* const QP = (bf16*)(ws + WS_QP); bf16* const OAT = (bf16*)(ws + WS_O); int* const IDX = (int*)(ws + WS_IDX);
    unsigned* const SGE = (unsigned*)(ws + WS_SGE); unsigned* const AE = (unsigned*)(ws + WS_AE); unsigned char* const OFFS = ws + WS_OFFS; bf16* const XT = (bf16*)(ws + WS_XT); unsigned* const AE2 = (unsigned*)(ws + WS_AE2); unsigned char* const CNT = ws + WS_CNT;
    bf16* const UH = UB; bf16* const VH = VB;
    float* const SSP = (float*)(ws + WS_SSP); float* const RSTD = (float*)(ws + WS_RSTD);
    bf16* const KTT = (bf16*)(ws + WS_KTT); float* const DEC = (float*)(ws + WS_DEC); float* const ROPE_C = (float*)(ws + WS_ROPE); float* const ROPE_S = ROPE_C + TOK * 8;

    for (int u = tid; u < (LDS_BYTES - LDSCTL_OFF) / 4; u += NWAVES * 64) ((LAS unsigned*)(ldsl + LDSCTL_OFF))[u] = 0u;
    __syncthreads();
    XcdBarrier bar; bar.bar = (unsigned*)(ctl + CW_BAR); bar.x = 0; bar.st = nullptr;
    if (N_LAUNCHES == 1) bar = xcd_barrier_post((unsigned*)(ctl + CW_BAR), MISC + 8);
#define GRID_BAR() do { if (N_LAUNCHES == 1) { xcd_barrier(bar); } } while (0)
    const int lo = args.ph_lo, hi_ph = args.ph_hi;
#ifndef PHASE_MASK
#define PHASE_MASK 0x1fff
#endif
#define IN(k) (((PHASE_MASK >> (k)) & 1) && lo <= (k) && (k) < hi_ph)
#define BOTH(k) (IN(k) && IN((k) + 1))

    if (IN(0)) {
        PHASE_LOCALS
        LAS float* scr = (LAS float*)(ldsl + RING_OFF + wave * 16384);
        for (int it = gw; it < 3072; it += NGW) {
            int r = it;
            if (r < 512) { transpose_item(w_in, IN_W, DMODEL, Win_t, 0, scr, r >> 5, r & 31, lane); continue; } r -= 512;
            if (r < 1024) { transpose_item(w_in + 1040, IN_W, DMODEL, Win_t, 1280, scr, r >> 6, r & 63, lane); continue; } r -= 1024;
            if (r < 512) { transpose_item(w_out, DMODEL, DMODEL, Wout_t, 0, scr, r >> 5, r & 31, lane); continue; } r -= 512;
            transpose_item(w_pq, NQP, DMODEL, Wq_t, 0, scr, r >> 6, r & 63, lane, g_ffn);
        }
        for (int task = gt; task < 32768; task += NGT) {
            const int n = task >> 7, k0 = (task & 127) * 8;
            float wg[16];
#pragma unroll
            for (int r = 0; r < 16; ++r) wg[r] = w_gate[r * 256 + n];
            float acc[8];
#pragma unroll
            for (int j = 0; j < 8; ++j) { const f32x4* wr = (const f32x4*)(w_in + (size_t)(k0 + j) * IN_W + 1024); float a = 0.f;
#pragma unroll
                for (int q = 0; q < 4; ++q) { const f32x4 w4 = wr[q]; a += w4.x * wg[4 * q] + w4.y * wg[4 * q + 1] + w4.z * wg[4 * q + 2] + w4.w * wg[4 * q + 3]; }
                acc[j] = a; }
            v4u o; o.x = pk2(acc[0], acc[1]); o.y = pk2(acc[2], acc[3]); o.z = pk2(acc[4], acc[5]); o.w = pk2(acc[6], acc[7]);
            *(v4u*)(Win_t + (size_t)(1024 + n) * DMODEL + k0) = o;
        }
        for (int task = gt; task < 32768; task += NGT) {
            const f32x4 a = ((const f32x4*)sub_keys)[2 * task], b = ((const f32x4*)sub_keys)[2 * task + 1];
            v4u o; o.x = pk2(a.x, a.y); o.y = pk2(a.z, a.w); o.z = pk2(b.x, b.y); o.w = pk2(b.z, b.w); ((v4u*)KEYS)[task] = o;
        }
        for (int task = gt; task < TOK * 8; task += NGT) {
            const int t = task >> 3, i = task & 7;
            const double invf[8] = {1.0, 0.19392274474868576, 0.03760603093086393, 0.007292664737217109, 0.001414213562373095, 0.0002742481756762073, 5.318295896944988e-05, 1.031338537721246e-05};
            double inv = invf[0];
#pragma unroll
            for (int q = 1; q < 8; ++q) inv = (i == q) ? invf[q] : inv;
            const double ang = (double)positions[t] * inv;
            const double rr = ang - 6.283185307179586 * rint(ang * 0.15915494309189535);
            const float rf = (float)rr;
            ROPE_C[task] = cosf(rf); ROPE_S[task] = sinf(rf);
        }
        {
            f32x4 gg[4], vn[4];
#pragma unroll
            for (int j = 0; j < 4; ++j) { gg[j] = ((const f32x4*)g_mix)[lane + 64 * j]; vn[j] = ((const f32x4*)(x + (size_t)gw * DMODEL))[lane + 64 * j]; }
            for (int m = gw; m < TOK; m += NGW) {
                f32x4 v[4]; float sq = 0.f;
#pragma unroll
                for (int j = 0; j < 4; ++j) { v[j] = vn[j]; sq += (v[j].x * v[j].x + v[j].y * v[j].y) + (v[j].z * v[j].z + v[j].w * v[j].w); }
                const int mn = (m + NGW < TOK) ? m + NGW : m;
#pragma unroll
                for (int j = 0; j < 4; ++j) vn[j] = ((const f32x4*)(x + (size_t)mn * DMODEL))[lane + 64 * j];
                const float rstd = 1.f / sqrtf(wave_sum(sq) * (1.f / DMODEL) + RMS_EPS);
                unsigned long long* o8 = (unsigned long long*)(XN + (size_t)m * DMODEL) + lane;
#pragma unroll
                for (int j = 0; j < 4; ++j) o8[64 * j] = (unsigned long long)pk2(v[j].x * rstd * gg[j].x, v[j].y * rstd * gg[j].y) | ((unsigned long long)pk2(v[j].z * rstd * gg[j].z, v[j].w * rstd * gg[j].w) << 32);
            }
        }
        if (BOTH(0)) GRID_BAR();
    }

    if (IN(1)) {
        PHASE_LOCALS
        pg8::Gemm g{XN, Win_t, TOK, NPROJ, DMODEL}; pg8::StaticOrder S; S.init(TOK, NPROJ, G, (int)blockIdx.x);
        pg8::EpiBf16<0> E{PROJ, NPROJ, nullptr, 0, 0, 1.f};
        pg8::gemm_phase<pg8::EpiBf16<0>, pg8::StaticOrder, PG8_ALIGN, PG8_SP2>(ldsl + RING_OFF, g, S, E);
        if (BOTH(1)) GRID_BAR();
    }

    if (IN(2)) {
        PHASE_LOCALS
        for (int u = gw; u < NUNIT; u += NGW) {
            const int g = u >> 2, h = u & 3; const int su = ((g >> 7) * 4 + h) * 128 + (g & 127);
            bf16* const rowp = PROJ + (size_t)(g * 64) * NPROJ;
            const float bg = b_gate[h * 64 + lane];
            float bsum = 0.f;
            unsigned ktt[32], vt0[32], vt1[32];
#pragma unroll
            for (int c0 = 0; c0 < 64; c0 += 16) {
                unsigned zz[16], qq[16], kk[16], va[16], vb[16];
#pragma unroll
                for (int j = 0; j < 16; ++j) { const bf16* const r = rowp + (size_t)(c0 + j) * NPROJ;
                    zz[j] = r[C_GZ + h * 64 + lane]; qq[j] = r[C_GQ + h * 64 + lane]; kk[j] = r[C_GK + h * 64 + lane]; va[j] = r[C_GV + h * 128 + lane]; vb[j] = r[C_GV + h * 128 + 64 + lane]; }
#pragma unroll
                for (int j = 0; j < 16; ++j) { const int c = c0 + j;
                    bf16* const r = rowp + (size_t)c * NPROJ;
                    const float z = bf2f(zz[j]) + bg;
                    const float ls = fminf(z, 0.f) - __logf(1.f + __expf(-fabsf(z)));
                    bsum += ls * (1.f / 16.f);
                    const float eb = __expf(bsum), ebi = __expf(-bsum);
                    const float q = bf2f(qq[j]) * 0.125f * eb;
                    const float kt = bf2f(kk[j]) * ebi;
                    const unsigned ktb = f2bf(kt);
                    r[C_GQ + h * 64 + lane] = (bf16)f2bf(q); r[C_GK + h * 64 + lane] = (bf16)ktb;
                    const unsigned v0 = va[j], v1 = vb[j];
                    if (c & 1) { ktt[c >> 1] |= ktb << 16; vt0[c >> 1] |= v0 << 16; vt1[c >> 1] |= v1 << 16; }
                    else { ktt[c >> 1] = ktb; vt0[c >> 1] = v0; vt1[c >> 1] = v1; }
                }
            }
            DEC[su * 64 + lane] = __expf(bsum);
            v4u* kp = (v4u*)(KTT + ((size_t)u * 64 + lane) * 64); v4u* vp0 = (v4u*)(VT + ((size_t)u * 128 + lane) * 64); v4u* vp1 = (v4u*)(VT + ((size_t)u * 128 + 64 + lane) * 64);
#pragma unroll
            for (int q = 0; q < 8; ++q) { kp[q] = (v4u){ktt[4 * q], ktt[4 * q + 1], ktt[4 * q + 2], ktt[4 * q + 3]};
                vp0[q] = (v4u){vt0[4 * q], vt0[4 * q + 1], vt0[4 * q + 2], vt0[4 * q + 3]}; vp1[q] = (v4u){vt1[4 * q], vt1[4 * q + 1], vt1[4 * q + 2], vt1[4 * q + 3]}; }
        }
        {
            const int v = lane >> 2, qd = lane & 3;
            const int col = (v < 8 ? C_DQ + v * 64 : C_DK + (v - 8) * 64) + qd * 16;
            const float* gp = (v < 8 ? g_q : g_k) + qd * 16;
            float gn[16];
#pragma unroll
            for (int i = 0; i < 16; ++i) gn[i] = gp[i];
            const float osc = (v < 8) ? attn_body::C2 : 1.f;
            v4u w0 = ((const v4u*)(PROJ + (size_t)gw * NPROJ + col))[0], w1 = ((const v4u*)(PROJ + (size_t)gw * NPROJ + col))[1];
            f32x4 rc0 = *(const f32x4*)(ROPE_C + gw * 8), rc1 = *(const f32x4*)(ROPE_C + gw * 8 + 4), rs0 = *(const f32x4*)(ROPE_S + gw * 8), rs1 = *(const f32x4*)(ROPE_S + gw * 8 + 4);
            for (int t = gw; t < TOK; t += NGW) {
                v4u* p = (v4u*)(PROJ + (size_t)t * NPROJ + col);
                const int tn = (t + NGW < TOK) ? t + NGW : t;
                const v4u* pn = (const v4u*)(PROJ + (size_t)tn * NPROJ + col);
                const v4u n0 = pn[0], n1 = pn[1];
                const f32x4 c0 = rc0, c1 = rc1, s0 = rs0, s1 = rs1;
                rc0 = *(const f32x4*)(ROPE_C + tn * 8); rc1 = *(const f32x4*)(ROPE_C + tn * 8 + 4); rs0 = *(const f32x4*)(ROPE_S + tn * 8); rs1 = *(const f32x4*)(ROPE_S + tn * 8 + 4);
                float y[16];
                y[0] = bflo(w0.x); y[1] = bfhi(w0.x); y[2] = bflo(w0.y); y[3] = bfhi(w0.y); y[4] = bflo(w0.z); y[5] = bfhi(w0.z); y[6] = bflo(w0.w); y[7] = bfhi(w0.w);
                y[8] = bflo(w1.x); y[9] = bfhi(w1.x); y[10] = bflo(w1.y); y[11] = bfhi(w1.y); y[12] = bflo(w1.z); y[13] = bfhi(w1.z); y[14] = bflo(w1.w); y[15] = bfhi(w1.w);
                float ss = 0.f;
#pragma unroll
                for (int i = 0; i < 16; ++i) ss += y[i] * y[i];
                ss += __shfl_xor(ss, 1); ss += __shfl_xor(ss, 2);
                const float rstd = 1.f / sqrtf(ss * (1.f / 64.f) + RMS_EPS);
#pragma unroll
                for (int i = 0; i < 16; ++i) y[i] = y[i] * rstd * gn[i];
                if (qd == 0) {
                    const float cs[8] = {c0.x, c0.y, c0.z, c0.w, c1.x, c1.y, c1.z, c1.w}, sn[8] = {s0.x, s0.y, s0.z, s0.w, s1.x, s1.y, s1.z, s1.w};
#pragma unroll
                    for (int i = 0; i < 8; ++i) { const float a = y[i], b = y[i + 8]; y[i] = a * cs[i] - b * sn[i]; y[i + 8] = b * cs[i] + a * sn[i]; }
                }
#pragma unroll
                for (int i = 0; i < 16; ++i) y[i] *= osc;
                p[0] = (v4u){pk2(y[0], y[1]), pk2(y[2], y[3]), pk2(y[4], y[5]), pk2(y[6], y[7])};
                p[1] = (v4u){pk2(y[8], y[9]), pk2(y[10], y[11]), pk2(y[12], y[13]), pk2(y[14], y[15])};
                w0 = n0; w1 = n1;
            }
        }
        if (BOTH(2)) GRID_BAR();
    }

    if (IN(3)) {
        PHASE_LOCALS
        float lam;
        { int l_ = threadIdx.x; asm volatile("" : "+v"(l_)); l_ &= 63;
          lam = __uint_as_float(__builtin_amdgcn_readfirstlane(__float_as_uint(expf(wave_sum(lq1[l_] * lk1[l_])) - expf(wave_sum(lq2[l_] * lk2[l_])) + LAMBDA_INIT))); }
        for (int L = vcu; L < 256; L += G) {
            const int bhh = L >> 4, xq = L & 15, b = bhh >> 2, hh = bhh & 3;
#pragma unroll 1
            for (int k = 0; k < 4; ++k) { const int qb = (k & 1) ? xq : 31 - xq, mp = k >> 1;
                attn_body2::attn_unit<8>(b, C_DQ + (hh * 2 + mp) * 64, C_DK + (hh * 2 + mp) * 64, C_DV + hh * 128, (hh * 2) * 128, qb,
                                         (const attn_body2::bf16*)PROJ, (const attn_body2::bf16*)PROJ, (const attn_body2::bf16*)PROJ, (attn_body2::bf16*)OAT, (char*)lds + RING_OFF,
                                         mp, lam, g_sub, (attn_body2::bf16*)(MIX + 512 + hh * 128), 1.f - LAMBDA_INIT, RMS_EPS); }
        }
        { int t2_ = threadIdx.x; asm volatile("" : "+v"(t2_)); const int lane = t2_ & 63, r32 = lane & 31, hi = lane >> 5; (void)lane;
        for (int u = gw; u < NUNIT; u += NGW) {
            const int g = u >> 2, h = u & 3; const int su = ((g >> 7) * 4 + h) * 128 + (g & 127);
            const bf16* vt = VT + (size_t)u * 8192; const bf16* kt = KTT + (size_t)u * 4096;
            f32x16 acc[4][2];
#pragma unroll
            for (int a = 0; a < 4; ++a) { acc[a][0] = f32x16{}; acc[a][1] = f32x16{}; }
#pragma unroll
            for (int k2 = 0; k2 < 4; k2 += 2) {
                bf16x8 af[2][4], bfr[2][2];
#pragma unroll
                for (int kq = 0; kq < 2; ++kq) { const int ks = k2 + kq;
#pragma unroll
                    for (int et = 0; et < 4; ++et) af[kq][et] = *(const bf16x8*)(vt + (et * 32 + r32) * 64 + ks * 16 + hi * 8);
#pragma unroll
                    for (int dt = 0; dt < 2; ++dt) bfr[kq][dt] = *(const bf16x8*)(kt + (dt * 32 + r32) * 64 + ks * 16 + hi * 8); }
                __builtin_amdgcn_sched_barrier(0);
#pragma unroll
                for (int kq = 0; kq < 2; ++kq)
#pragma unroll
                    for (int et = 0; et < 4; ++et)
#pragma unroll
                        for (int dt = 0; dt < 2; ++dt) acc[et][dt] = __builtin_amdgcn_mfma_f32_32x32x16_bf16(af[kq][et], bfr[kq][dt], acc[et][dt], 0, 0, 0);
            }
            bf16* const kv = KVT + (size_t)su * 8192;
            const float dcv[2] = {DEC[su * 64 + r32], DEC[su * 64 + 32 + r32]};
#pragma unroll
            for (int dt = 0; dt < 2; ++dt) { const float dc = dcv[dt];
#pragma unroll
                for (int et = 0; et < 4; ++et)
#pragma unroll
                    for (int r = 0; r < 16; ++r) kv[(et * 32 + crow(r, hi)) * 64 + dt * 32 + r32] = (bf16)f2bf(acc[et][dt][r] * dc); }
        }
        }
        if (BOTH(3)) GRID_BAR();
    }

    if (IN(4)) {
        PHASE_LOCALS
        for (int el = gt; el < 16 * 8192; el += NGT) {
            const int bh = el >> 13, ed = el & 8191, d = ed & 63;
            bf16* p = KVT + (size_t)bh * 128 * 8192 + ed; const float* dp = DEC + bh * 128 * 64 + d;
            float s = 0.f;
            unsigned kva[16], kvb[16]; float dca[16], dcb[16];
#define SCAN_LOAD(KV_, DC_, n0_) do { _Pragma("unroll") for (int j = 0; j < 16; ++j) { KV_[j] = p[(size_t)((n0_) + j) * 8192]; DC_[j] = dp[((n0_) + j) * 64]; } } while (0)
#define SCAN_RUN(KV_, DC_, n0_) do { _Pragma("unroll") for (int j = 0; j < 16; ++j) { const float o = s; s = DC_[j] * s + bf2f(KV_[j]); p[(size_t)((n0_) + j) * 8192] = (bf16)f2bf(o); } } while (0)
            SCAN_LOAD(kva, dca, 0);
#pragma unroll 1
            for (int n0 = 0; n0 < 128; n0 += 32) {
                SCAN_LOAD(kvb, dcb, n0 + 16);
                SCAN_RUN(kva, dca, n0);
                if (n0 + 32 < 128) SCAN_LOAD(kva, dca, n0 + 32);
                SCAN_RUN(kvb, dcb, n0 + 16);
            }
#undef SCAN_LOAD
#undef SCAN_RUN
        }
        if (BOTH(4)) GRID_BAR();
    }

    if (IN(5)) {
        PHASE_LOCALS
        for (int u = gw; u < NUNIT; u += NGW) {
            const int g = u >> 2, h = u & 3; const int su = ((g >> 7) * 4 + h) * 128 + (g & 127);
            const bf16* vt = VT + (size_t)u * 8192; const bf16* st = KVT + (size_t)su * 8192;
            const bf16* qtp = PROJ + (size_t)(g * 64) * NPROJ + C_GQ + h * 64; const bf16* ktp = PROJ + (size_t)(g * 64) * NPROJ + C_GK + h * 64;
#pragma unroll
            for (int ct = 0; ct < 2; ++ct) {
                bf16x8 qf[4];
#pragma unroll
                for (int ks = 0; ks < 4; ++ks) qf[ks] = *(const bf16x8*)(qtp + (size_t)(ct * 32 + r32) * NPROJ + ks * 16 + hi * 8);
                f32x16 o[4];
#pragma unroll
                for (int et = 0; et < 4; ++et) o[et] = f32x16{};
                bf16x8 sf[4][4], kfa[2][4];
#pragma unroll
                for (int ks = 0; ks < 4; ++ks)
#pragma unroll
                    for (int et = 0; et < 4; ++et) sf[ks][et] = *(const bf16x8*)(st + (et * 32 + r32) * 64 + ks * 16 + hi * 8);
#pragma unroll
                for (int stl = 0; stl <= ct; ++stl)
#pragma unroll
                    for (int ks = 0; ks < 4; ++ks) kfa[stl][ks] = *(const bf16x8*)(ktp + (size_t)(stl * 32 + r32) * NPROJ + ks * 16 + hi * 8);
                __builtin_amdgcn_sched_barrier(0);
#pragma unroll
                for (int ks = 0; ks < 4; ++ks)
#pragma unroll
                    for (int et = 0; et < 4; ++et) o[et] = __builtin_amdgcn_mfma_f32_32x32x16_bf16(sf[ks][et], qf[ks], o[et], 0, 0, 0);
#pragma unroll
                for (int stl = 0; stl <= ct; ++stl) {
                    v4u vfa[2][4];
#pragma unroll
                    for (int kk = 0; kk < 2; ++kk)
#pragma unroll
                        for (int et = 0; et < 4; ++et) { const bf16* ap = vt + (et * 32 + r32) * 64 + stl * 32 + 16 * kk + 4 * hi;
                            const v2u a0 = *(const v2u*)ap, a1 = *(const v2u*)(ap + 8); vfa[kk][et] = (v4u){a0.x, a0.y, a1.x, a1.y}; }
                    __builtin_amdgcn_sched_barrier(0);
                    f32x16 xx = f32x16{};
#pragma unroll
                    for (int ks = 0; ks < 4; ++ks) xx = __builtin_amdgcn_mfma_f32_32x32x16_bf16(kfa[stl][ks], qf[ks], xx, 0, 0, 0);
                    if (stl == ct) {
#pragma unroll
                        for (int r = 0; r < 16; ++r) if (crow(r, hi) > r32) xx[r] = 0.f;
                    }
#pragma unroll
                    for (int kk = 0; kk < 2; ++kk) {
                        v4u w; w.x = pk2(xx[8 * kk], xx[8 * kk + 1]); w.y = pk2(xx[8 * kk + 2], xx[8 * kk + 3]); w.z = pk2(xx[8 * kk + 4], xx[8 * kk + 5]); w.w = pk2(xx[8 * kk + 6], xx[8 * kk + 7]);
                        const bf16x8 pb = __builtin_bit_cast(bf16x8, w);
#pragma unroll
                        for (int et = 0; et < 4; ++et) o[et] = __builtin_amdgcn_mfma_f32_32x32x16_bf16(__builtin_bit_cast(bf16x8, vfa[kk][et]), pb, o[et], 0, 0, 0);
                    }
                }
                float ss = 0.f;
#pragma unroll
                for (int et = 0; et < 4; ++et)
#pragma unroll
                    for (int r = 0; r < 16; ++r) ss += o[et][r] * o[et][r];
                ss += __shfl_xor(ss, 32);
                const float rstd = 1.f / sqrtf(ss * (1.f / 128.f) + RMS_EPS);
                const int t = g * 64 + ct * 32 + r32;
                LAS unsigned char* const stg = ldsl + wave * 8448;
                { v4u gt[8];
#pragma unroll
                  for (int i = 0; i < 8; ++i) { const int row = i * 4 + (lane >> 4), ch = lane & 15; gt[i] = *(const v4u*)(PROJ + (size_t)(g * 64 + ct * 32 + row) * NPROJ + C_GR + h * 128 + ch * 8); }
#pragma unroll
                  for (int i = 0; i < 8; ++i) { const int row = i * 4 + (lane >> 4), ch = lane & 15; LAS v2u* p = (LAS v2u*)(stg + row * 264 + ch * 16); p[0] = (v2u){gt[i].x, gt[i].y}; p[1] = (v2u){gt[i].z, gt[i].w}; } }
                f32x4 goa[16];
#pragma unroll
                for (int i = 0; i < 16; ++i) { const int e0 = (i >> 2) * 32 + 8 * (i & 3) + 4 * hi; goa[i] = *(const f32x4*)(g_gla_out + e0); }
#pragma unroll
                for (int et = 0; et < 4; ++et)
#pragma unroll
                    for (int q4 = 0; q4 < 4; ++q4) {
                        const int e0 = et * 32 + 8 * q4 + 4 * hi;
                        LAS v2u* const gp = (LAS v2u*)(stg + r32 * 264 + e0 * 2);
                        const v2u gw2 = *gp;
                        const f32x4 go = goa[et * 4 + q4];
                        const float gr0 = bflo(gw2.x), gr1 = bfhi(gw2.x), gr2 = bflo(gw2.y), gr3 = bfhi(gw2.y);
                        const float y0 = o[et][4 * q4] * rstd * go.x * (gr0 / (1.f + __expf(-gr0)));
                        const float y1 = o[et][4 * q4 + 1] * rstd * go.y * (gr1 / (1.f + __expf(-gr1)));
                        const float y2 = o[et][4 * q4 + 2] * rstd * go.z * (gr2 / (1.f + __expf(-gr2)));
                        const float y3 = o[et][4 * q4 + 3] * rstd * go.w * (gr3 / (1.f + __expf(-gr3)));
                        *gp = (v2u){pk2(y0, y1), pk2(y2, y3)};
                    }
#pragma unroll
                for (int i = 0; i < 8; ++i) { const int row = i * 4 + (lane >> 4), ch = lane & 15; const LAS v2u* p = (const LAS v2u*)(stg + row * 264 + ch * 16); const v2u a0 = p[0], a1 = p[1];
                    *(v4u*)(MIX + (size_t)(g * 64 + ct * 32 + row) * DMODEL + h * 128 + ch * 8) = (v4u){a0.x, a0.y, a1.x, a1.y}; }
            }
        }
        if (BOTH(5)) GRID_BAR();
    }

    if (IN(6)) {
        PHASE_LOCALS
        pg8::Gemm g{MIX, Wout_t, TOK, DMODEL, DMODEL}; pg8::StaticOrder S; S.init(TOK, DMODEL, G, (int)blockIdx.x);
        pg8::EpiResF32X E{x, DMODEL, XN2, (unsigned char*)XT, SSP, TOK};
        pg8::gemm_phase<pg8::EpiResF32X, pg8::StaticOrder, PG8_ALIGN, PG8_SP2>(ldsl + RING_OFF, g, S, E);
        if (BOTH(6)) GRID_BAR();
    }


    if (IN(8)) {
        PHASE_LOCALS
        pg8::Gemm g{XN2, Wq_t, TOK, NQP, DMODEL}; pg8::StaticOrder S; S.init(TOK, NQP, G, (int)blockIdx.x);
        pg8::EpiBf16Row E{QP, NQP, SSP, RSTD, RMS_EPS, 1.f / DMODEL};
        pg8::gemm_phase<pg8::EpiBf16Row, pg8::StaticOrder, PG8_ALIGN, PG8_SP2>(ldsl + RING_OFF, g, S, E);
        if (BOTH(8)) GRID_BAR();
    }

    if (IN(9)) {
        PHASE_LOCALS
        const int nper = G / 8;
        const int head = vcu % 8, part = vcu / 8;
        for (int c = tid; c < 4096; c += NWAVES * 64) {
            const int p = c >> 11, row = (c >> 4) & 127, ch = c & 15;
            const v4u v = *(const v4u*)(KEYS + ((size_t)(head * 2 + p) * 128 + row) * 128 + ch * 8);
            *(LAS v4u*)(ldsl + p * 32768 + row * 256 + ((ch ^ (row & 15)) * 16)) = v;
        }
        __syncthreads();
        LAS unsigned* const lscr = (LAS unsigned*)(ldsl + 65536 + wave * 8192);
        int cvit = 0;
        for (int tg = part * NWAVES + wave; tg < TOK / 32; tg += nper * NWAVES, cvit += 4) {
            const int t0 = tg * 32;
            float top[2][16];
#pragma unroll
            for (int p = 0; p < 2; ++p) {
                bf16x8 qf[8];
#pragma unroll
                for (int ks = 0; ks < 8; ++ks) qf[ks] = *(const bf16x8*)(QP + (size_t)(t0 + r32) * NQP + head * 256 + p * 128 + ks * 16 + hi * 8);
                f32x4 cva[2], cvb[2]; int cvo[2];
#pragma unroll
                for (int j = 0; j < 2; ++j) { const int o = gt + (cvit + 2 * p + j) * NGT; cvo[j] = o; if (o < NVT) { const int sl_ = o >> 17, r_ = (o >> 3) & (PEER_N - 1), c_ = o & 7;
                    const int e_ = ((((r_ >> 7) - (r_ & 127)) & 127) << 7) | (r_ & 127);
                    const f32x4* src = (const f32x4*)peer_v + (size_t)e_ * 256 + (sl_ * 8 + c_) * 2; cva[j] = src[0]; cvb[j] = src[1]; } }
                float sc[4][16];
#pragma unroll
                for (int tile = 0; tile < 4; ++tile) {
                    f32x16 acc = f32x16{};
#pragma unroll
                    for (int ks = 0; ks < 8; ++ks) {
                        const bf16x8 kf = *(const LAS bf16x8*)(ldsl + p * 32768 + (tile * 32 + r32) * 256 + (((2 * ks + hi) ^ (r32 & 15)) * 16));
                        acc = __builtin_amdgcn_mfma_f32_32x32x16_bf16(kf, qf[ks], acc, 0, 0, 0);
                    }
#pragma unroll
                    for (int r = 0; r < 16; ++r) { const unsigned kid = (unsigned)(tile * 32 + crow(r, hi));
                        const float av = acc[r];
                        sc[tile][r] = __uint_as_float((__float_as_uint(av) & 0xffffff80u) | (127u - kid)); }
                    sort16_desc(sc[tile]);
                }
                merge16_desc(sc[0], sc[1]); merge16_desc(sc[2], sc[3]); merge16_desc(sc[0], sc[2]);
                float ot[16];
#pragma unroll
                for (int i = 0; i < 16; ++i) ot[i] = __shfl_xor(sc[0][i], 32);
                merge16_desc(sc[0], ot);
#pragma unroll
                for (int i = 0; i < 16; ++i) top[p][i] = sc[0][i];
#pragma unroll
                for (int j = 0; j < 2; ++j) if (cvo[j] < NVT) ((v4u*)VB)[cvo[j]] = (v4u){pkh(cva[j].x, cva[j].y), pkh(cva[j].z, cva[j].w), pkh(cvb[j].x, cvb[j].y), pkh(cvb[j].z, cvb[j].w)};
            }
#pragma unroll
            for (int i = 0; i < 16; ++i) { lscr[i * 64 + lane] = 127u - (__float_as_uint(top[0][i]) & 127u); lscr[(16 + i) * 64 + lane] = 127u - (__float_as_uint(top[1][i]) & 127u); }
            float v0[16], v1[16];
#pragma unroll
            for (int i = 0; i < 16; ++i) { v0[i] = __uint_as_float(__float_as_uint(top[0][i]) & 0xffffff80u); v1[i] = __uint_as_float(__float_as_uint(top[1][i]) & 0xffffff80u); }
#define CAND(i, j) __uint_as_float((__float_as_uint(v0[i] + v1[j]) & 0xffffff00u) | (255u - (unsigned)((i) * 16 + (j))))
            const float NEGB = -3.0e38f;
            float cA[16], cB[16], cC[16], cD[16];
#pragma unroll
            for (int j = 0; j < 16; ++j) cA[j] = CAND(0, j);
#pragma unroll
            for (int j = 0; j < 8; ++j) cB[j] = CAND(1, j);
#pragma unroll
            for (int j = 0; j < 5; ++j) cB[8 + j] = CAND(2, j);
            cB[13] = NEGB; cB[14] = NEGB; cB[15] = NEGB;
#pragma unroll
            for (int j = 0; j < 4; ++j) cC[j] = CAND(3, j);
#pragma unroll
            for (int j = 0; j < 3; ++j) cC[4 + j] = CAND(4, j);
            cC[7] = CAND(5, 0); cC[8] = CAND(5, 1); cC[9] = CAND(6, 0); cC[10] = CAND(6, 1); cC[11] = CAND(7, 0); cC[12] = CAND(7, 1);
            cC[13] = NEGB; cC[14] = NEGB; cC[15] = NEGB;
            cD[0] = CAND(8, 0); cD[1] = CAND(9, 0); cD[2] = CAND(10, 0); cD[3] = CAND(11, 0); cD[4] = CAND(12, 0); cD[5] = CAND(13, 0); cD[6] = CAND(14, 0); cD[7] = CAND(15, 0);
#pragma unroll
            for (int j = 8; j < 16; ++j) cD[j] = NEGB;
#undef CAND
            sort16_desc(cB); sort16_desc(cC); sort16_desc(cD);
            merge16_desc(cA, cB); merge16_desc(cC, cD); merge16_desc(cA, cC);
            LDS_WAIT();
            float gv[16]; int ex[16]; float gsum = 0.f;
            const float mx = __uint_as_float(__float_as_uint(cA[0]) & 0xffffff00u);
#pragma unroll
            for (int w = 0; w < 16; ++w) {
                const unsigned bits = __float_as_uint(cA[w]); const unsigned code = 255u - (bits & 255u);
                const float val = __uint_as_float(bits & 0xffffff00u);
                gv[w] = __expf(val - mx); gsum += gv[w];
                const unsigned e0 = lscr[(code >> 4) * 64 + lane], e1 = lscr[(16 + (code & 15)) * 64 + lane];
                ex[w] = (int)(e0 * 128u + e1);
            }
            const float ginv = 1.f / gsum;
            const size_t ob = (size_t)(t0 + r32) * 128 + head * 16;
#pragma unroll
            for (int q = 0; q < 4; ++q) if ((q >> 1) == hi)
                *(v4u*)(IDX + ob + 4 * q) = (v4u){(f2bf(gv[4 * q] * ginv) << 16) | (unsigned)ex[4 * q], (f2bf(gv[4 * q + 1] * ginv) << 16) | (unsigned)ex[4 * q + 1],
                                                  (f2bf(gv[4 * q + 2] * ginv) << 16) | (unsigned)ex[4 * q + 2], (f2bf(gv[4 * q + 3] * ginv) << 16) | (unsigned)ex[4 * q + 3]};
            LDS_WAIT();
        }
        for (int o = gt + cvit * NGT; o < NVT; o += NGT) {
            const int sl_ = o >> 17, r_ = (o >> 3) & (PEER_N - 1), c_ = o & 7; const int e_ = ((((r_ >> 7) - (r_ & 127)) & 127) << 7) | (r_ & 127);
            const f32x4* src = (const f32x4*)peer_v + (size_t)e_ * 256 + (sl_ * 8 + c_) * 2; const f32x4 a = src[0], b = src[1];
            ((v4u*)VB)[o] = (v4u){pkh(a.x, a.y), pkh(a.z, a.w), pkh(b.x, b.y), pkh(b.z, b.w)}; }
        if (BOTH(9)) GRID_BAR();
    }

    if (IN(10)) {
        PHASE_LOCALS
        LAS int* const hst = (LAS int*)(ldsl + wave * 256);
        int w0n = IDX[(size_t)gw * 128 + lane], w1n = IDX[(size_t)gw * 128 + 64 + lane];
        f32x4 ua, ub, uc, ud, uga, ugb, ugc, ugd; int uo = NUT, ujt = 0;
#define UCV_LOAD(o_) do { const int sl_ = (o_) >> 16, r_ = ((o_) >> 2) & (PEER_N - 1), c_ = (o_) & 3; const int e_ = ((((r_ >> 7) - (r_ & 127)) & 127) << 7) | (r_ & 127); \
            const f32x4* src = (const f32x4*)peer_u + (size_t)e_ * 256 + (sl_ * 4 + c_) * 4; const f32x4* gs_ = (const f32x4*)g_ffn + (sl_ * 4 + c_) * 4; \
            ua = src[0]; ub = src[1]; uc = src[2]; ud = src[3]; uga = gs_[0]; ugb = gs_[1]; ugc = gs_[2]; ugd = gs_[3]; } while (0)
#define UCV_STORE(o_) do { const f32x4 a_ = ua * 32.f * uga, b_ = ub * 32.f * ugb, c_ = uc * 32.f * ugc, d_ = ud * 32.f * ugd; \
            ((v4u*)UB)[o_] = (v4u){pk8(a_.x, a_.y, a_.z, a_.w), pk8(b_.x, b_.y, b_.z, b_.w), pk8(c_.x, c_.y, c_.z, c_.w), pk8(d_.x, d_.y, d_.z, d_.w)}; } while (0)
        for (int t = gw; t < TOK; t += NGW, ++ujt) {
            if ((ujt & 1) == 0) { uo = gt + (ujt >> 1) * NGT; if (uo < NUT) UCV_LOAD(uo); }
            const int w0 = w0n, w1 = w1n;
            { const int tn = (t + NGW < TOK) ? t + NGW : t; w0n = IDX[(size_t)tn * 128 + lane]; w1n = IDX[(size_t)tn * 128 + 64 + lane]; }
            const int x0 = w0 & 0xffff, x1 = w1 & 0xffff;
            const int r0 = ((((x0 >> 7) + (x0 & 127)) & 127) << 7) | (x0 & 127), r1 = ((((x1 >> 7) + (x1 & 127)) & 127) << 7) | (x1 & 127);
            const int b0 = r0 >> 9, b1 = r1 >> 9;
            if (lane < 32) hst[lane] = 0;
            const int rk0 = __hip_atomic_fetch_add(hst + b0, 1, __ATOMIC_RELAXED, __HIP_MEMORY_SCOPE_WORKGROUP);
            const int rk1 = __hip_atomic_fetch_add(hst + b1, 1, __ATOMIC_RELAXED, __HIP_MEMORY_SCOPE_WORKGROUP);
            const int myc = __hip_atomic_load(hst + (lane & 31), __ATOMIC_RELAXED, __HIP_MEMORY_SCOPE_WORKGROUP);
            int incl = myc;
#pragma unroll
            for (int o = 1; o < 32; o <<= 1) { const int v = __shfl_up(incl, o); if ((lane & 31) >= o) incl += v; }
            if (lane < 32) { OFFS[(size_t)t * 32 + lane] = (unsigned char)(incl - myc); __hip_atomic_store(hst + 32 + lane, incl - myc, __ATOMIC_RELAXED, __HIP_MEMORY_SCOPE_WORKGROUP); }
            const int o0 = __hip_atomic_load(hst + 32 + b0, __ATOMIC_RELAXED, __HIP_MEMORY_SCOPE_WORKGROUP), o1 = __hip_atomic_load(hst + 32 + b1, __ATOMIC_RELAXED, __HIP_MEMORY_SCOPE_WORKGROUP);
            SGE[(size_t)t * 128 + o0 + rk0] = ((unsigned)w0 & 0xffff0000u) | (unsigned)r0; SGE[(size_t)t * 128 + o1 + rk1] = ((unsigned)w1 & 0xffff0000u) | (unsigned)r1;
            if ((ujt & 1) == 1 && uo < NUT) { UCV_STORE(uo); uo = NUT; }
        }
        if (uo < NUT) { UCV_STORE(uo); }
        for (int o = gt + ((ujt + 1) >> 1) * NGT; o < NUT; o += NGT) { UCV_LOAD(o); UCV_STORE(o); }
#undef UCV_LOAD
#undef UCV_STORE
        if (BOTH(10)) GRID_BAR();
    }

    if (IN(11)) {
        PHASE_LOCALS
        constexpr int NC = 112, NTL = 7;
        LAS unsigned* const GCOL = (LAS unsigned*)(ldsl + 132096);
        LAS unsigned* const GW = (LAS unsigned*)(ldsl + 132096 + 32 * NC * 4);
        LAS int* const gcnt = (LAS int*)(ldsl + 132096 + 2 * 32 * NC * 4);
        LAS float* const RSL = (LAS float*)(ldsl + 132096 + 2 * 32 * NC * 4 + 128);
        const unsigned lds0 = (unsigned)(uintptr_t)lds;
        const unsigned u_lane_off = (unsigned)(lane >> 2) * 64u + (unsigned)(((lane & 3) ^ ((lane >> 4) & 3)) * 16);
        for (int k = 0; k < 2048; k += 1) {
            int tb, eb;
            if (G == 256) { if (k >= 8) break; eb = vcu & 31; tb = 8 * (vcu >> 5) + (((vcu & 31) + k) & 7); }
            else { const int task = vcu + k * G; if (task >= 2048) break; tb = task >> 5; eb = task & 31; }
            const int t = tb * 512 + tid;
            const unsigned char* usrc = (const unsigned char*)UH + (size_t)eb * 512 * 64;
            const unsigned char* xsrc = (const unsigned char*)XT + ((size_t)tb * 512) * 8;
#define DMA_UX(hs_, buf_) do { unsigned ulo_ = u_lane_off, xlo_ = (unsigned)lane * 16u; asm volatile("" : "+v"(ulo_), "+v"(xlo_)); _Pragma("unroll") for (int q_ = 0; q_ < 4; ++q_) { const int j_ = wave + 8 * q_; \
                attn_body::glds16(usrc + ulo_ + (size_t)(hs_) * (PEER_N * 64) + (size_t)j_ * 1024, (unsigned)__builtin_amdgcn_readfirstlane(lds0 + (buf_) * 32768 + j_ * 1024)); \
                attn_body::glds16(xsrc + xlo_ + (size_t)((hs_) * 8 + (j_ >> 2)) * ((size_t)TOK * 8) + (size_t)(j_ & 3) * 1024, (unsigned)__builtin_amdgcn_readfirstlane(lds0 + 65536 + (buf_) * 32896 + (j_ >> 2) * 4112 + (j_ & 3) * 1024)); } } while (0)
            DMA_UX(0, 0);
            for (int c = tid; c < 32 * NC; c += NWAVES * 64) GCOL[c] = 0u;
            if (tid < 32) gcnt[tid] = 0;
            RSL[tid] = RSTD[t];
            const int p0 = OFFS[(size_t)t * 32 + eb]; const int p1 = (eb < 31) ? (int)OFFS[(size_t)t * 32 + eb + 1] : 128; const int n = p1 - p0;
            unsigned ent[16];
#pragma unroll
            for (int i = 0; i < 16; ++i) ent[i] = (i < n) ? SGE[(size_t)t * 128 + p0 + i] : 0u;
            unsigned tid_o = (unsigned)tid; asm volatile("" : "+v"(tid_o));
            unsigned char* const a2u = (unsigned char*)AE2 + ((size_t)(tb * 32 + eb) * 12) * 2048; const unsigned toff4 = tid_o * 4u;
            CNT[(size_t)(tb * 32 + eb) * 512 + tid] = (unsigned char)n;
            __syncthreads();
            unsigned ovmask = 0u;
            int cs_[16];
#pragma unroll
            for (int i = 0; i < 16; ++i) { cs_[i] = 0; if (i < n) cs_[i] = __hip_atomic_fetch_add(gcnt + (int)((ent[i] >> 4) & 31u), 1, __ATOMIC_RELAXED, __HIP_MEMORY_SCOPE_WORKGROUP); }
#pragma unroll
            for (int i = 0; i < 16; ++i) if (i < n) { const unsigned r = ent[i] & 0xffffu; const int g = (int)((r >> 4) & 31u); const int c = cs_[i];
                if (c < NC) { GCOL[g * NC + c] = ((unsigned)tid << 15) | ((unsigned)(p0 + i) << 8) | ((unsigned)i << 4) | (r & 15u); GW[g * NC + c] = ent[i]; } else ovmask |= 1u << i; }
            __syncthreads();
            int cg[4]; unsigned tko[4][NTL]; f32x4 acc[4][NTL];
            const unsigned aoff = (unsigned)((4 * wave) * 16 + (lane & 15)) * 64u + (unsigned)((((lane >> 5) & 1) ^ ((lane >> 2) & 3)) * 16) + (unsigned)((lane >> 4) & 1) * 8u;
#pragma unroll
            for (int gi = 0; gi < 4; ++gi) { const int cc = gcnt[4 * wave + gi]; cg[gi] = __builtin_amdgcn_readfirstlane(cc < NC ? cc : NC);
#pragma unroll
                for (int ct = 0; ct < NTL; ++ct) { tko[gi][ct] = 65536u + (unsigned)(lane >> 4) * 4112u + (GCOL[(4 * wave + gi) * NC + ct * 16 + (lane & 15)] >> 15) * 8u;     acc[gi][ct] = (f32x4){0.f, 0.f, 0.f, 0.f}; } }
#define UPM_BRD(ct_, d0_, d1_, buf_) do { d0_ = v2l(*(const LAS v2u*)(ldsl + tko[gi][ct_] + (buf_) * 32896)); d1_ = v2l(*(const LAS v2u*)(ldsl + tko[gi][ct_] + 16448 + (buf_) * 32896)); } while (0)
#define UPM_TILES(NT_, buf_) do { long p0_[2], p1_[2]; UPM_BRD(0, p0_[0], p1_[0], buf_); \
                _Pragma("unroll") for (int ct = 0; ct < (NT_); ++ct) { if (ct + 1 < (NT_)) UPM_BRD(ct + 1, p0_[(ct + 1) & 1], p1_[(ct + 1) & 1], buf_); \
                    acc[gi][ct] = __builtin_amdgcn_mfma_f32_16x16x32_fp8_fp8(af0_, p0_[ct & 1], acc[gi][ct], 0, 0, 0); \
                    acc[gi][ct] = __builtin_amdgcn_mfma_f32_16x16x32_fp8_fp8(af1_, p1_[ct & 1], acc[gi][ct], 0, 0, 0); if ((ct & 1) == 1) __builtin_amdgcn_sched_barrier(0); } } while (0)
#define UPM_ARD(g_, buf_) do { afa_[(g_) & 1] = v2l(*(const LAS v2u*)(ldsl + aoff + (g_) * 1024 + (buf_) * 32768)); afb_[(g_) & 1] = v2l(*(const LAS v2u*)(ldsl + (aoff ^ 32u) + (g_) * 1024 + (buf_) * 32768)); } while (0)
#define UPM_COMPUTE(buf_) do { long afa_[2], afb_[2]; UPM_ARD(0, buf_); _Pragma("unroll") for (int gi = 0; gi < 4; ++gi) { if (gi + 1 < 4) UPM_ARD(gi + 1, buf_); __builtin_amdgcn_sched_barrier(0); if (cg[gi] > 0) { \
                const long af0_ = afa_[gi & 1], af1_ = afb_[gi & 1]; \
                const int nt_ = (cg[gi] + 15) >> 4; \
                if (nt_ <= 4) { if (nt_ <= 2) { if (nt_ == 1) UPM_TILES(1, buf_); else UPM_TILES(2, buf_); } else { if (nt_ == 3) UPM_TILES(3, buf_); else UPM_TILES(4, buf_); } } \
                else { if (nt_ == 5) UPM_TILES(5, buf_); else if (nt_ == 6) UPM_TILES(6, buf_); else UPM_TILES(7, buf_); } } } } while (0)
#pragma unroll 1
            for (int hs = 0; hs < 16; hs += 2) {
                __builtin_amdgcn_s_waitcnt(0x0F70); __syncthreads();
                DMA_UX(hs + 1, 1);
                UPM_COMPUTE(0);
                __builtin_amdgcn_s_waitcnt(0x0F70); __syncthreads();
                if (hs + 2 < 16) DMA_UX(hs + 2, 0);
                UPM_COMPUTE(1);
            }
#undef UPM_COMPUTE
#undef UPM_ARD
#undef UPM_TILES
#undef UPM_BRD
#undef DMA_UX
            int lq_ = lane; asm volatile("" : "+v"(lq_));
#pragma unroll
            for (int gi = 0; gi < 4; ++gi) {
                unsigned en_[NTL], gw_[NTL];
#pragma unroll
                for (int ct = 0; ct < NTL; ++ct) { const int c = ct * 16 + (lq_ & 15); en_[ct] = GCOL[(4 * wave + gi) * NC + c]; gw_[ct] = GW[(4 * wave + gi) * NC + c]; }
#pragma unroll
                for (int ct = 0; ct < NTL; ++ct) if (ct * 16 < cg[gi]) {
                    const int c = ct * 16 + (lq_ & 15); const unsigned en = en_[ct], gw = gw_[ct];
                    const unsigned row = en & 15u; const f32x4 av = acc[gi][ct];
                    const float hsel = (row & 2u) ? ((row & 1u) ? av.w : av.z) : ((row & 1u) ? av.y : av.x);
                    if (c < cg[gi] && (int)(row >> 2) == (lq_ >> 4)) {
                        const unsigned tk = en >> 15, pp = (en >> 8) & 127u, ii = (en >> 4) & 15u;
                        const unsigned w = (f2h16(gelu_erf(hsel * (1.f / 32.f) * RSL[tk]) * __uint_as_float(gw & 0xffff0000u)) << 16) | ((gw & 511u) << 7);
                        if (ii < 12u) *(unsigned*)(a2u + tk * 48u + ii * 4u) = w; else AE[((size_t)tb * 512 + tk) * 128 + pp] = w;
                    }
                }
                __builtin_amdgcn_sched_barrier(0);
            }
            if (__any(n > 16 || ovmask != 0u)) {
                for (int i = 0; i < n; ++i) if (i >= 16 || ((ovmask >> i) & 1u)) { const unsigned en = SGE[(size_t)t * 128 + p0 + i]; const unsigned rr_ = en & 0xffffu; float a_ = 0.f;
                    for (int c = 0; c < 128; ++c) {
                        const v2u r_ = *(const v2u*)((const unsigned char*)UH + ((size_t)(c >> 3) * PEER_N + rr_) * 64 + (c & 7) * 8), x_ = *(const v2u*)((const unsigned char*)XT + ((size_t)c * TOK + t) * 8);
                        const int r0 = (int)r_.x, r1 = (int)r_.y, x0 = (int)x_.x, x1 = (int)x_.y;
                        a_ += __builtin_amdgcn_cvt_f32_fp8(r0, 0) * __builtin_amdgcn_cvt_f32_fp8(x0, 0) + __builtin_amdgcn_cvt_f32_fp8(r0, 1) * __builtin_amdgcn_cvt_f32_fp8(x0, 1)
                            + __builtin_amdgcn_cvt_f32_fp8(r0, 2) * __builtin_amdgcn_cvt_f32_fp8(x0, 2) + __builtin_amdgcn_cvt_f32_fp8(r0, 3) * __builtin_amdgcn_cvt_f32_fp8(x0, 3)
                            + __builtin_amdgcn_cvt_f32_fp8(r1, 0) * __builtin_amdgcn_cvt_f32_fp8(x1, 0) + __builtin_amdgcn_cvt_f32_fp8(r1, 1) * __builtin_amdgcn_cvt_f32_fp8(x1, 1)
                            + __builtin_amdgcn_cvt_f32_fp8(r1, 2) * __builtin_amdgcn_cvt_f32_fp8(x1, 2) + __builtin_amdgcn_cvt_f32_fp8(r1, 3) * __builtin_amdgcn_cvt_f32_fp8(x1, 3); }
                    const unsigned w_ = (f2h16(gelu_erf(a_ * (1.f / 32.f) * RSTD[t]) * __uint_as_float(en & 0xffff0000u)) << 16) | ((en & 511u) << 7); if (i < 12) *(unsigned*)(a2u + toff4 * 12u + (unsigned)i * 4u) = w_; else AE[(size_t)t * 128 + p0 + i] = w_; }
            }
            __syncthreads();
        }
        if (BOTH(11)) GRID_BAR();
    }

#define DMA_T(src, ds_, buf_) do { unsigned dlo_ = (unsigned)lane * 16u; asm volatile("" : "+v"(dlo_)); _Pragma("unroll") for (int q_ = 0; q_ < 8; ++q_) { const int j_ = wave + 8 * q_; \
                const uintptr_t sp_ = (uintptr_t)((src) + (size_t)j_ * 1024 + (size_t)(ds_) * (PEER_N * 128));     \
                const unsigned slo_ = (unsigned)__builtin_amdgcn_readfirstlane((unsigned)sp_), shi_ = (unsigned)__builtin_amdgcn_readfirstlane((unsigned)(sp_ >> 32)); \
                glds16s((const void*)(((uintptr_t)shi_ << 32) | (uintptr_t)slo_), dlo_, (unsigned)__builtin_amdgcn_readfirstlane(lds0 + (buf_) * 65536 + j_ * 1024)); } } while (0)
#define ROW_READ(R_, ew_, buf_) do { unsigned ra_ = ((ew_) & 0xff80u) | (l7s + lds0 + (unsigned)((buf_) * 65536)); asm volatile("" : "+v"(ra_));     \
                _Pragma("unroll") for (int c = 0; c < 8; ++c) R_[c] = *(const LAS v4u*)(uintptr_t)(ra_ ^ (unsigned)(c * 16)); } while (0)
    if (IN(12)) {
        PHASE_LOCALS
        const unsigned lds0 = (unsigned)(uintptr_t)lds;
        const unsigned dma_lane_off = (unsigned)lane * 16u;
        unsigned l7s = ((unsigned)lane & 7u) << 4; asm volatile("" : "+v"(l7s));
        for (int k = 0; k < 512; ++k) {
            int tb2, ds;
            if (G == 256) { if (k >= 2) break; const int c_ = vcu & 31; ds = c_ & 15; tb2 = 4 * (vcu >> 5) + (((c_ >> 4) + 2 * k) & 3); }
            else { const int task = vcu + k * G; if (task >= 512) break; tb2 = task >> 4; ds = task & 15; }
            const int tA = tb2 * 1024 + tid, tB = tA + 512;
            h2 accA[32], accB[32];
#pragma unroll
            for (int d = 0; d < 32; ++d) { accA[d] = (h2){(_Float16)0.f, (_Float16)0.f}; accB[d] = (h2){(_Float16)0.f, (_Float16)0.f}; }
            const unsigned char* vsrc = (const unsigned char*)VH + (size_t)ds * (PEER_N * 128);
            const unsigned char* const a2uA = (const unsigned char*)AE2 + ((size_t)(tb2 * 2 * 32) * 12) * 2048;
            const unsigned char* const a2uB = a2uA + (size_t)(32 * 12) * 2048;
            const unsigned char* const cnuA = CNT + (size_t)(tb2 * 2 * 32) * 512; const unsigned char* const cnuB = cnuA + 32 * 512;
            unsigned tid_o = (unsigned)tid; asm volatile("" : "+v"(tid_o));
            const unsigned toff48 = tid_o * 48u, toff1 = tid_o;
#define DN_FMA(ACC_, R_, ew_) do { const h2 ev_ = u2h(ew_); const h2 a2_ = (h2){ev_.y, ev_.y}; _Pragma("unroll") for (int c = 0; c < 8; ++c) { \
                ACC_[4 * c + 0] = u2h(R_[c].x) * a2_ + ACC_[4 * c + 0]; ACC_[4 * c + 1] = u2h(R_[c].y) * a2_ + ACC_[4 * c + 1]; \
                ACC_[4 * c + 2] = u2h(R_[c].z) * a2_ + ACC_[4 * c + 2]; ACC_[4 * c + 3] = u2h(R_[c].w) * a2_ + ACC_[4 * c + 3]; } } while (0)
#define LOAD_ENT(a2u_, cnu_, E_, n_, sb_) do { n_ = *((cnu_) + (size_t)(sb_) * 512 + toff1);     \
                const unsigned char* eb_ = (a2u_) + (size_t)(sb_) * 24576; const v4u x0_ = *(const v4u*)(eb_ + toff48), x1_ = *(const v4u*)(eb_ + toff48 + 16), x2_ = *(const v4u*)(eb_ + toff48 + 32); \
                E_[0] = x0_.x; E_[1] = x0_.y; E_[2] = x0_.z; E_[3] = x0_.w; E_[4] = x1_.x; E_[5] = x1_.y; E_[6] = x1_.z; E_[7] = x1_.w; E_[8] = x2_.x; E_[9] = x2_.y; E_[10] = x2_.z; E_[11] = x2_.w; } while (0)
#define DN_BODY(ACC_, tt_, E_, n_, sb_, buf_) do { \
                  _Pragma("unroll") for (int i = 0; i < 12; ++i) { if (!__any(i < n_)) break; {     \
                    if (i + 1 < 12) { ee_[(i + 1) & 1] = (i + 1 < n_) ? E_[i + 1] : 0u; ROW_READ(RR[(i + 1) & 1], ee_[(i + 1) & 1], buf_); }     __builtin_amdgcn_sched_barrier(0);     \
                    DN_FMA(ACC_, RR[i & 1], ee_[i & 1]); __builtin_amdgcn_sched_barrier(0); } } \
                  if (__any(n_ > 12)) { if (n_ > 12) { int tv_ = (tt_); asm volatile("" : "+v"(tv_));     \
                      const unsigned* ao_ = AE + (size_t)tv_ * 128 + OFFS[(size_t)tv_ * 32 + (sb_)]; \
                      for (int i = 12; i < n_; ++i) { const unsigned en_ = ao_[i]; ROW_READ(RR[0], en_, buf_); DN_FMA(ACC_, RR[0], en_); } } } } while (0)
#define DN_STEP2(EA_, nA_, EB_, nB_, sb_, buf_, EAn_, nAn_, EBn_, nBn_, has_next_) do { \
                  unsigned ee_[2]; ee_[0] = (0 < nA_) ? EA_[0] : 0u; ee_[1] = 0u; ROW_READ(RR[0], ee_[0], buf_);     \
                  if (has_next_) { DMA_T(vsrc + (size_t)((sb_) + 1) * (512 * 128), 0, 1 - (buf_)); LOAD_ENT(a2uA, cnuA, EAn_, nAn_, (sb_) + 1); LOAD_ENT(a2uB, cnuB, EBn_, nBn_, (sb_) + 1); } \
                  DN_BODY(accA, tA, EA_, nA_, sb_, buf_); \
                  ee_[0] = (0 < nB_) ? EB_[0] : 0u; ROW_READ(RR[0], ee_[0], buf_); \
                  DN_BODY(accB, tB, EB_, nB_, sb_, buf_); } while (0)
            unsigned eA0[12], eB0[12], eA1[12], eB1[12]; int nA0, nB0, nA1, nB1; v4u RR[2][8];
#pragma unroll
            for (int c = 0; c < 8; ++c) { RR[0][c] = (v4u){0u, 0u, 0u, 0u}; RR[1][c] = (v4u){0u, 0u, 0u, 0u}; }
            DMA_T(vsrc, 0, 0); LOAD_ENT(a2uA, cnuA, eA0, nA0, 0); LOAD_ENT(a2uB, cnuB, eB0, nB0, 0);
#pragma unroll 1
            for (int sb = 0; sb < 32; sb += 2) {
                __builtin_amdgcn_s_waitcnt(0x0F70); __syncthreads();
                DN_STEP2(eA0, nA0, eB0, nB0, sb, 0, eA1, nA1, eB1, nB1, true);
                __builtin_amdgcn_s_waitcnt(0x0F70); __syncthreads();
                DN_STEP2(eA1, nA1, eB1, nB1, sb + 1, 1, eA0, nA0, eB0, nB0, (sb + 2 < 32));
            }
#undef DN_STEP2
#undef DN_BODY
#undef LOAD_ENT
#undef DN_FMA
#define DN_FINAL(ACC_, tt_) do { int tq_ = (tt_); unsigned l7 = (unsigned)lane; asm volatile("" : "+v"(tq_), "+v"(l7)); l7 &= 7u;     \
            f32x4* op = (f32x4*)(out + (size_t)tq_ * DMODEL + ds * 64); const v4u* hp = (const v4u*)(XN2 + (size_t)tq_ * DMODEL + ds * 64);     \
            v4u hba[8];                                               \
            _Pragma("unroll") for (int c = 0; c < 8; ++c) hba[c] = hp[(unsigned)c ^ l7]; \
            _Pragma("unroll") for (int c = 0; c < 8; ++c) { const unsigned cc = (unsigned)c ^ l7; const v4u hb = hba[c]; \
                f32x4 o0, o1; o0.x = bflo(hb.x) + (float)ACC_[4 * c].x; o0.y = bfhi(hb.x) + (float)ACC_[4 * c].y; o0.z = bflo(hb.y) + (float)ACC_[4 * c + 1].x; o0.w = bfhi(hb.y) + (float)ACC_[4 * c + 1].y; \
                o1.x = bflo(hb.z) + (float)ACC_[4 * c + 2].x; o1.y = bfhi(hb.z) + (float)ACC_[4 * c + 2].y; o1.z = bflo(hb.w) + (float)ACC_[4 * c + 3].x; o1.w = bfhi(hb.w) + (float)ACC_[4 * c + 3].y; \
                op[2 * cc] = o0; op[2 * cc + 1] = o1; } } while (0)
            { DN_FINAL(accA, tA); DN_FINAL(accB, tB); }
#undef DN_FINAL
        }
#undef ROW_READ
#undef DMA_T
    }
#undef IN
#undef BOTH
#undef GRID_BAR
}

extern "C" void kernel_launch(void* const* d_in, const int* in_sizes, int n_in, void* d_out, int out_size, void* d_ws, size_t ws_size, hipStream_t stream) {
    static int grid = 0;
    if (grid == 0) {
        if (n_in != 20 || in_sizes[0] != TOK * DMODEL || out_size != TOK * DMODEL || ws_size < WS_END) {
            fprintf(stderr, "kernel_launch: unexpected shapes: n_in %d in0 %d out %d ws %zu (need %zu); nothing launched\n", n_in, n_in > 0 ? in_sizes[0] : -1, out_size, ws_size, (size_t)WS_END); grid = -1; return; }
        int dev = 0, cus = 0, per_cu = 0;
        if (hipGetDevice(&dev) != hipSuccess || hipDeviceGetAttribute(&cus, hipDeviceAttributeMultiprocessorCount, dev) != hipSuccess) { grid = -1; return; }
        if (hipFuncSetAttribute((const void*)hymba_fwd, hipFuncAttributeMaxDynamicSharedMemorySize, LDS_BYTES) != hipSuccess) { fprintf(stderr, "kernel_launch: hipFuncSetAttribute failed\n"); grid = -1; return; }
        if (hipOccupancyMaxActiveBlocksPerMultiprocessor(&per_cu, (const void*)hymba_fwd, NWAVES * 64, LDS_BYTES) != hipSuccess || per_cu < 1)
            fprintf(stderr, "kernel_launch: note: occupancy query reports %d workgroups per CU\n", per_cu);
        (void)hipGetLastError();
        grid = cus;
        grid -= grid % 8;
        if (grid < 8) { grid = -1; return; }
    }
    if (grid < 0) return;
    if (hipMemsetAsync((char*)d_ws + WS_CTL, 0, CTL_ZERO_BYTES, stream) != hipSuccess) return;
    Args a{};
    for (int i = 0; i < 20; ++i) a.in[i] = d_in[i];
    a.out = (float*)d_out; a.ws = (unsigned char*)d_ws;
    for (int li = 0; li < N_LAUNCHES; ++li) {
        a.ph_lo = (N_LAUNCHES == 1) ? 0 : li; a.ph_hi = (N_LAUNCHES == 1) ? NPHASE : li + 1; a.li = li; a.pad = 0;
        hipLaunchKernelGGL(hymba_fwd, dim3(grid), dim3(NWAVES * 64), LDS_BYTES, stream, a);
        const hipError_t le = hipPeekAtLastError();
        if (le != hipSuccess) { fprintf(stderr, "kernel_launch: launch %d failed: %s\n", li, hipGetErrorName(le)); break; }
    }
}
```
